# Optimizing an MI355X kernel written in HIP

```python
import math
import jax, jax.numpy as jnp
from jax import lax
import numpy as np

D_MODEL = 1024
BATCH = 8
SEQ = 2048
DEPTH = 2
DEC_BATCH = 128
DEC_SEQ = 1
PAST_LEN = 16384
PAGE_SIZE = 128

H_RET = 4
DK_RET = 128
DV_RET = 256
H_GDN = 4
DK_GDN = 128
DV_GDN = 256
CONV_W = 4
H_X = 4
HD_X = 256
N_MEM = 256
D_FF = 2816
CHUNK = 64
ROPE_BASE = 10000.0
EPS = 1e-6

RET_QK = H_RET * DK_RET
RET_V = H_RET * DV_RET
GDN_QK = H_GDN * DK_GDN
GDN_V = H_GDN * DV_GDN
CONV_DIM = 2 * GDN_QK + GDN_V
X_W = H_X * HD_X
_W_IN_SIZES = (RET_QK, RET_QK, RET_V, RET_V, CONV_DIM, GDN_V, H_GDN, H_GDN, X_W, 3 * D_MODEL)
W_IN_DIM = sum(_W_IN_SIZES)
W_IN_SPLITS = tuple(sum(_W_IN_SIZES[:i]) for i in range(1, len(_W_IN_SIZES)))

kernel_name = 'hybrid_retention_gdn_memory_decoder_step'


def rms_norm(x, gain=None):
    xf = x.astype(jnp.float32)
    y = xf * lax.rsqrt(jnp.mean(xf * xf, axis=-1, keepdims=True) + EPS)
    if gain is not None:
        y = y * gain.astype(jnp.float32)
    return y.astype(x.dtype)


def l2_normalize(x):
    return x * lax.rsqrt(jnp.sum(x * x, axis=-1, keepdims=True) + EPS)


def swiglu(x, w_in, w_out):
    gate, up = jnp.split(x @ w_in, 2, axis=-1)
    return (jax.nn.silu(gate) * up) @ w_out


def rotary(x, pos):
    half = x.shape[-1] // 2
    inv_freq = ROPE_BASE ** (-jnp.arange(half, dtype=jnp.float32) / half)
    ang = pos.astype(jnp.float32)[:, None] * inv_freq[None, :]
    cos = jnp.cos(ang)[:, None, :]
    sin = jnp.sin(ang)[:, None, :]
    x1, x2 = x[..., :half], x[..., half:]
    return jnp.concatenate([x1 * cos - x2 * sin, x1 * sin + x2 * cos], axis=-1)


def heads_first(t):
    return jnp.swapaxes(t, 1, 2)


def chunk_decay_scan(q, k, v, g, beta, s0):
    b_, h_, L, dk = q.shape
    dv = v.shape[-1]
    c = min(CHUNK, L)
    n = -(-L // c)
    pad = n * c - L
    if pad:
        q, k, v = (jnp.pad(t, ((0, 0), (0, 0), (0, pad), (0, 0))) for t in (q, k, v))
        g = jnp.pad(g, ((0, 0), (0, 0), (0, pad)))
        if beta is not None:
            beta = jnp.pad(beta, ((0, 0), (0, 0), (0, pad)))
    q, k, v = (t.reshape(b_, h_, n, c, t.shape[-1]) for t in (q, k, v))
    b = jnp.cumsum(g.reshape(b_, h_, n, c), axis=-1)
    causal = jnp.tril(jnp.ones((c, c), dtype=bool))
    decay = jnp.exp(jnp.where(causal, b[..., :, None] - b[..., None, :], -jnp.inf))
    attn = jnp.einsum('bhncd,bhnmd->bhncm', q, k) * decay
    q_dec = q * jnp.exp(b)[..., None]
    k_dec = k * jnp.exp(b[..., -1:] - b)[..., None]
    chunk_decay = jnp.exp(b[..., -1])
    if beta is None:
        xs = (q_dec, k_dec, v, attn, chunk_decay)
    else:
        beta = beta.reshape(b_, h_, n, c)[..., None]
        k_beta = k * beta
        strict = jnp.tril(jnp.ones((c, c), dtype=bool), -1)
        a = jnp.where(strict, jnp.einsum('bhncd,bhnmd->bhncm', k_beta, k) * decay, 0.0)
        rhs = jnp.concatenate([v * beta, k_beta * jnp.exp(b)[..., None]], axis=-1)
        sol = lax.linalg.triangular_solve(a, rhs, left_side=True, lower=True, unit_diagonal=True)
        xs = (q_dec, k_dec, sol[..., :dv], attn, chunk_decay, sol[..., dv:])
    xs = tuple(jnp.moveaxis(t, 2, 0) for t in xs)

    def step(s, inp):
        q_c, k_c, u_c, a_c, d_c = inp[:5]
        v_new = u_c if beta is None else u_c - jnp.einsum('bhcd,bhde->bhce', inp[5], s)
        o_c = jnp.einsum('bhcd,bhde->bhce', q_c, s) + jnp.einsum('bhcm,bhme->bhce', a_c, v_new)
        s = s * d_c[..., None, None] + jnp.einsum('bhcd,bhce->bhde', k_c, v_new)
        return s, o_c

    s_fin, o = lax.scan(step, s0.astype(jnp.float32), xs)
    o = jnp.moveaxis(o, 0, 2).reshape(b_, h_, n * c, dv)[:, :, :L]
    return o, s_fin


def retention_branch(q_raw, k_raw, v_raw, g_raw, pos, s0):
    bsz, L, _ = q_raw.shape
    f32 = jnp.float32
    q = rotary(q_raw.astype(f32).reshape(bsz, L, H_RET, DK_RET), pos)
    k = rotary(k_raw.astype(f32).reshape(bsz, L, H_RET, DK_RET), pos) * DK_RET ** -0.5
    v = v_raw.astype(f32).reshape(bsz, L, H_RET, DV_RET)
    log_gamma = jnp.log1p(-jnp.exp2(-5.0 - jnp.arange(H_RET, dtype=f32)))
    g = jnp.broadcast_to(log_gamma[None, :, None], (bsz, H_RET, L))
    o, s = chunk_decay_scan(heads_first(q), heads_first(k), heads_first(v), g, None, s0)
    o = heads_first(rms_norm(o)).reshape(bsz, L, RET_V)
    return (jax.nn.silu(g_raw.astype(f32)) * o).astype(q_raw.dtype), s


def gated_delta_branch(qkv_raw, z_raw, a_raw, b_raw, conv_buf, conv_w, a_log, dt_bias, norm_w, s0):
    bsz, L, _ = qkv_raw.shape
    f32 = jnp.float32
    full = jnp.concatenate([conv_buf.astype(qkv_raw.dtype), qkv_raw], axis=1)
    conv = sum(full[:, j:j + L] * conv_w[j] for j in range(CONV_W))
    new_buf = full[:, L:]
    qkv = jax.nn.silu(conv.astype(f32))
    q, k, v = jnp.split(qkv, [GDN_QK, 2 * GDN_QK], axis=-1)
    q = l2_normalize(q.reshape(bsz, L, H_GDN, DK_GDN)) * DK_GDN ** -0.5
    k = l2_normalize(k.reshape(bsz, L, H_GDN, DK_GDN))
    v = v.reshape(bsz, L, H_GDN, DV_GDN)
    beta = jax.nn.sigmoid(b_raw.astype(f32))
    g = -jnp.exp(a_log.astype(f32)) * jax.nn.softplus(a_raw.astype(f32) + dt_bias.astype(f32))
    o, s = chunk_decay_scan(heads_first(q), heads_first(k), heads_first(v),
                            jnp.swapaxes(g, 1, 2), jnp.swapaxes(beta, 1, 2), s0)
    o = rms_norm(heads_first(o), norm_w)
    z = z_raw.astype(f32).reshape(bsz, L, H_GDN, DV_GDN)
    o = (o * jax.nn.silu(z)).reshape(bsz, L, GDN_V)
    return o.astype(qkv_raw.dtype), s, new_buf


def memory_attention(q_raw, mem_k, mem_v):
    bsz, L, _ = q_raw.shape
    q = q_raw.reshape(bsz, L, H_X, HD_X)
    s = jnp.einsum('blhd,bmhd->bhlm', q, mem_k.astype(q.dtype)).astype(jnp.float32) * HD_X ** -0.5
    prob = jax.nn.softmax(s, axis=-1).astype(q.dtype)
    o = jnp.einsum('bhlm,bmhd->blhd', prob, mem_v.astype(q.dtype))
    return o.reshape(bsz, L, X_W)


def token_mixing(xn, pos, mem_k, mem_v, s_ret, s_gdn, conv_buf, p):
    bsz, L, _ = xn.shape
    r_q, r_k, r_v, r_g, g_qkv, g_z, g_a, g_b, m_q, gates = jnp.split(xn @ p['w_in'], W_IN_SPLITS, axis=-1)
    o_ret, s_ret = retention_branch(r_q, r_k, r_v, r_g, pos, s_ret)
    o_gdn, s_gdn, conv_buf = gated_delta_branch(g_qkv, g_z, g_a, g_b, conv_buf, p['gdn_conv_w'],
                                                p['gdn_a_log'], p['gdn_dt_bias'], p['gdn_norm'], s_gdn)
    o_mem = memory_attention(m_q, mem_k, mem_v)
    gate = jax.nn.sigmoid(gates.astype(jnp.float32)).astype(xn.dtype).reshape(bsz, L, 3, D_MODEL)
    merged = (gate[:, :, 0] * (o_ret @ p['w_branch_ret'])
              + gate[:, :, 1] * (o_gdn @ p['w_branch_gdn'])
              + gate[:, :, 2] * (o_mem @ p['w_branch_mem']))
    return merged @ p['w_out'], s_ret, s_gdn, conv_buf


def decoder_layer(x, pos, mem_k, mem_v, s_ret, s_gdn, conv_buf, p):
    h = x + 0.5 * rms_norm(swiglu(rms_norm(x, p['n_ffn1_pre']), p['ffn1_w_in'], p['ffn1_w_out']), p['n_ffn1_post'])
    m, s_ret, s_gdn, conv_buf = token_mixing(rms_norm(h, p['n_mix_pre']), pos, mem_k, mem_v,
                                             s_ret, s_gdn, conv_buf, p)
    h = h + rms_norm(m, p['n_mix_post'])
    h = h + 0.5 * rms_norm(swiglu(rms_norm(h, p['n_ffn2_pre']), p['ffn2_w_in'], p['ffn2_w_out']), p['n_ffn2_post'])
    return h, s_ret, s_gdn, conv_buf


def setup_inputs(seed: int = 0) -> dict:
    key = jax.random.key(seed)
    keys = iter(jax.random.split(key, 40))

    def nrm(shape, scale):
        return scale * jax.random.normal(next(keys), shape, jnp.float32)

    def gain(width=D_MODEL):
        return 1.0 + nrm((DEPTH, width), 0.02)

    a_log = jnp.log(jax.random.uniform(next(keys), (DEPTH, H_GDN), jnp.float32, 1.0, 16.0))
    dt = jnp.exp(jax.random.uniform(next(keys), (DEPTH, H_GDN), jnp.float32, math.log(1e-3), math.log(1e-1)))
    dt_bias = dt + jnp.log(-jnp.expm1(-dt))
    return {
        'x_prompt': nrm((BATCH, SEQ, D_MODEL), 1.0),
        'x_sample': nrm((DEC_BATCH, DEC_SEQ, D_MODEL), 1.0),
        'mem_prompt': nrm((BATCH, N_MEM, D_MODEL), 1.0),
        'state_ret': nrm((DEPTH, DEC_BATCH, H_RET, DK_RET, DV_RET), 0.5),
        'state_gdn': nrm((DEPTH, DEC_BATCH, H_GDN, DK_GDN, DV_GDN), 0.5),
        'state_conv': nrm((DEPTH, DEC_BATCH, CONV_W - 1, CONV_DIM), 1.0),
        'cache_mem_k': nrm((DEPTH, DEC_BATCH, N_MEM, H_X, HD_X), 1.0),
        'cache_mem_v': nrm((DEPTH, DEC_BATCH, N_MEM, H_X, HD_X), 1.0),
        'norm_ffn1_pre': gain(),
        'norm_ffn1_post': gain(),
        'ffn1_w_in': nrm((DEPTH, D_MODEL, 2 * D_FF), D_MODEL ** -0.5),
        'ffn1_w_out': nrm((DEPTH, D_FF, D_MODEL), D_FF ** -0.5),
        'norm_mix_pre': gain(),
        'norm_mix_post': gain(),
        'w_in': nrm((DEPTH, D_MODEL, W_IN_DIM), D_MODEL ** -0.5),
        'gdn_conv_w': nrm((DEPTH, CONV_W, CONV_DIM), 0.5),
        'gdn_a_log': a_log,
        'gdn_dt_bias': dt_bias,
        'gdn_norm': gain(DV_GDN),
        'norm_mem': gain(),
        'w_mem_k': nrm((DEPTH, D_MODEL, X_W), D_MODEL ** -0.5),
        'w_mem_v': nrm((DEPTH, D_MODEL, X_W), D_MODEL ** -0.5),
        'w_branch_ret': nrm((DEPTH, RET_V, D_MODEL), RET_V ** -0.5),
        'w_branch_gdn': nrm((DEPTH, GDN_V, D_MODEL), GDN_V ** -0.5),
        'w_branch_mem': nrm((DEPTH, X_W, D_MODEL), X_W ** -0.5),
        'w_out': nrm((DEPTH, D_MODEL, D_MODEL), D_MODEL ** -0.5),
        'norm_ffn2_pre': gain(),
        'norm_ffn2_post': gain(),
        'ffn2_w_in': nrm((DEPTH, D_MODEL, 2 * D_FF), D_MODEL ** -0.5),
        'ffn2_w_out': nrm((DEPTH, D_FF, D_MODEL), D_FF ** -0.5),
    }


def reference(x_prompt, x_sample, mem_prompt, state_ret, state_gdn, state_conv, cache_mem_k, cache_mem_v,
              norm_ffn1_pre, norm_ffn1_post, ffn1_w_in, ffn1_w_out, norm_mix_pre, norm_mix_post, w_in,
              gdn_conv_w, gdn_a_log, gdn_dt_bias, gdn_norm, norm_mem, w_mem_k, w_mem_v,
              w_branch_ret, w_branch_gdn, w_branch_mem, w_out, norm_ffn2_pre, norm_ffn2_post,
              ffn2_w_in, ffn2_w_out):
    f32 = jnp.float32
    dt = x_prompt.dtype
    bp, sp = x_prompt.shape[0], x_prompt.shape[1]
    ss = x_sample.shape[1]
    pos_prompt = jnp.arange(sp)
    pos_sample = PAST_LEN + jnp.arange(ss)
    hp, hs = x_prompt, x_sample
    ret_p, gdn_p, conv_p, mk_p, mv_p, ret_s, gdn_s, conv_s = ([] for _ in range(8))
    for l in range(DEPTH):
        p = dict(n_ffn1_pre=norm_ffn1_pre[l], n_ffn1_post=norm_ffn1_post[l],
                 ffn1_w_in=ffn1_w_in[l], ffn1_w_out=ffn1_w_out[l],
                 n_mix_pre=norm_mix_pre[l], n_mix_post=norm_mix_post[l], w_in=w_in[l],
                 gdn_conv_w=gdn_conv_w[l], gdn_a_log=gdn_a_log[l], gdn_dt_bias=gdn_dt_bias[l],
                 gdn_norm=gdn_norm[l], w_branch_ret=w_branch_ret[l], w_branch_gdn=w_branch_gdn[l],
                 w_branch_mem=w_branch_mem[l], w_out=w_out[l],
                 n_ffn2_pre=norm_ffn2_pre[l], n_ffn2_post=norm_ffn2_post[l],
                 ffn2_w_in=ffn2_w_in[l], ffn2_w_out=ffn2_w_out[l])
        mem_n = rms_norm(mem_prompt, norm_mem[l])
        mk = (mem_n @ w_mem_k[l]).reshape(bp, N_MEM, H_X, HD_X)
        mv = (mem_n @ w_mem_v[l]).reshape(bp, N_MEM, H_X, HD_X)
        hp, sr, sg, cb = decoder_layer(hp, pos_prompt, mk, mv,
                                       jnp.zeros((bp, H_RET, DK_RET, DV_RET), f32),
                                       jnp.zeros((bp, H_GDN, DK_GDN, DV_GDN), f32),
                                       jnp.zeros((bp, CONV_W - 1, CONV_DIM), dt), p)
        ret_p.append(sr)
        gdn_p.append(sg)
        conv_p.append(cb)
        mk_p.append(mk)
        mv_p.append(mv)
        hs, sr, sg, cb = decoder_layer(hs, pos_sample, cache_mem_k[l], cache_mem_v[l],
                                       state_ret[l], state_gdn[l], state_conv[l], p)
        ret_s.append(sr)
        gdn_s.append(sg)
        conv_s.append(cb)
    return (hp, hs,
            jnp.stack(ret_p).astype(dt), jnp.stack(gdn_p).astype(dt), jnp.stack(conv_p).astype(dt),
            jnp.stack(mk_p).astype(dt), jnp.stack(mv_p).astype(dt),
            jnp.stack(ret_s).astype(dt), jnp.stack(gdn_s).astype(dt), jnp.stack(conv_s).astype(dt))
```

```cpp
#include <hip/hip_runtime.h>
#include <cstdio>
#include <cstdint>

#define LAS __attribute__((address_space(3)))
#define GAS __attribute__((address_space(1)))
typedef unsigned short bf16_t;
typedef short bf16x8 __attribute__((ext_vector_type(8)));
typedef short bf16x4 __attribute__((ext_vector_type(4)));
typedef float f32x4 __attribute__((ext_vector_type(4)));
typedef float f32x2 __attribute__((ext_vector_type(2)));
typedef unsigned u32x4 __attribute__((ext_vector_type(4)));
typedef unsigned u32x2 __attribute__((ext_vector_type(2)));
typedef __bf16 bf16x2_t __attribute__((ext_vector_type(2)));
typedef GAS unsigned gu32;

constexpr int D = 1024, SEQ = 2048, NB = 8, MP = NB * SEQ, MS = 128, MREAL = MP + MS, MPAD = 16640;
constexpr int DFF = 2816, NFFI = 2 * DFF, NWIN = 10240, WIN_RAW = 10248;
constexpr int NH = 4, DK = 128, DV = 256, CH = 64, NCH = SEQ / CH, NMEM = 256, CONVD = 2048;
constexpr int PC_RQ = 0, PC_RK = 512, PC_RV = 1024, PC_RG = 2048, PC_GQKV = 3072, PC_GZ = 5120, PC_MQ = 6144, PC_GATE = 7168;
constexpr float EPS = 1e-6f;
constexpr int PAST_LEN = 16384;

__device__ __forceinline__ unsigned f2bf(float f) { unsigned u = __builtin_bit_cast(unsigned, f); return (u + 0x7fffu + ((u >> 16) & 1u)) >> 16; }
__device__ __forceinline__ float bf2f(unsigned b) { return __builtin_bit_cast(float, b << 16); }
__device__ __forceinline__ unsigned pk2(float lo, float hi) { f32x2 v = {lo, hi}; bf16x2_t b = __builtin_convertvector(v, bf16x2_t); return __builtin_bit_cast(unsigned, b); }
__device__ __forceinline__ bf16x8 pack8(f32x4 a, f32x4 b) { u32x4 p; p.x = pk2(a.x, a.y); p.y = pk2(a.z, a.w); p.z = pk2(b.x, b.y); p.w = pk2(b.z, b.w); return __builtin_bit_cast(bf16x8, p); }
__device__ __forceinline__ float fexp(float x) { return __builtin_amdgcn_exp2f(x * 1.4426950408889634f); }
__device__ __forceinline__ float sigmoidf_(float x) { return __builtin_amdgcn_rcpf(1.0f + fexp(-x)); }
__device__ __forceinline__ float siluf_(float x) { return x * sigmoidf_(x); }
__device__ __forceinline__ float wave_sum(float v) {
#pragma unroll
    for (int o = 1; o < 64; o <<= 1) v += __shfl_xor(v, o);
    return v;
}
#define MFMA16(a, b, c) __builtin_amdgcn_mfma_f32_16x16x32_bf16((a), (b), (c), 0, 0, 0)

namespace pg8 {
#define PG8_LAS __attribute__((address_space(3)))
constexpr int BM = 256, BK = 64, HALF = 128, HTB = HALF * BK * 2  , STAGE_BYTES = 8 * HTB, NXCD = 8, WGM = 8;
__host__ __device__ __forceinline__ int lds_byte(int r, int c) { const int st = (r >> 4) * 2 + (c >> 5), rr = r & 15, cc = c & 31, ob = rr * 64 + cc * 2; return st * 1024 + (ob ^ (((ob >> 9) & 1) << 5)); }
__host__ __device__ __forceinline__ void stage_rc(int b, int& R, int& C) { const int st = b / 1024, sb = b % 1024, swz = sb ^ (((sb >> 9) & 1) << 5); R = (st >> 1) * 16 + swz / 64; C = (st & 1) * 32 + (swz % 64) / 2; }
__host__ __device__ __forceinline__ int perm32(int rho) { const int n = rho >> 4, i = rho & 15; return 8 * (i >> 2) + 4 * n + (i & 3); }

struct Unit { int pm, pn, seg; size_t aofs, bofs; };
struct Gemm { const bf16_t* A; const bf16_t* Bt; int K; };

struct StaticOrder {
    int nM, nN, nwg, G, c; size_t tstep;
    __device__ void init(int M, int N, int K, int G_, int c_) { nM = M / BM; nN = N / BM; nwg = nM * nN; G = G_; c = c_; tstep = (size_t)BM * K * 2; }
    __device__ bool tile(long L, int& pm, int& pn) const {
        if (L >= nwg) return false;
        int wgid = (int)L; { const int q = nwg / NXCD, r = nwg % NXCD, xcd = wgid % NXCD, off = wgid / NXCD; wgid = (xcd < r ? xcd * (q + 1) : r * (q + 1) + (xcd - r) * q) + off; }
        const int nig = WGM * nN, gid = wgid / nig, fm = gid * WGM, gsz = (nM - fm) < WGM ? (nM - fm) : WGM;
        pm = fm + ((wgid % nig) % gsz); pn = (wgid % nig) / gsz; return true;
    }
    __device__ bool next(int i, Unit& u) const {
        if (!tile((long)i * G + c, u.pm, u.pn)) return false;
        u.seg = 0; u.aofs = (size_t)u.pm * tstep; u.bofs = (size_t)u.pn * tstep; return true;
    }
    __device__ __forceinline__ void a_ready(const Unit&) const {}
    __device__ __forceinline__ void done(const Unit&) const {}
};
struct GroupAOrder : StaticOrder {
    int grp; size_t astride;
    __device__ bool next(int i, Unit& u) const {
        if (!tile((long)i * G + c, u.pm, u.pn)) return false;
        u.seg = 0; u.aofs = (size_t)(u.pn / grp) * astride + (size_t)u.pm * tstep; u.bofs = (size_t)u.pn * tstep; return true;
    }
};
struct SegOrder : StaticOrder {
    int nseg; size_t aseg, bseg;
    __device__ bool next(int i, Unit& u) const {
        const int round = i / nseg, seg = i - round * nseg;
        if (!tile((long)round * G + c, u.pm, u.pn)) return false;
        u.seg = seg; u.aofs = (size_t)seg * aseg + (size_t)u.pm * tstep; u.bofs = (size_t)seg * bseg + (size_t)u.pn * tstep; return true;
    }
};

struct EpiF32 {
    static constexpr bool PERM = false, AFTER_DRAIN = false;
    float* C; int ldc;
    __device__ __forceinline__ void operator()(const f32x4 (&acc)[2][2][4][2], const Unit& u, int wr, int wc, int fr, int fq) const {
        const int row0 = u.pm * BM + wr * 64 + fr, col0 = u.pn * BM + wc * 32 + 4 * fq;
#pragma unroll
        for (int ai = 0; ai < 2; ++ai)
#pragma unroll
            for (int m = 0; m < 4; ++m) { float* rowp = C + (size_t)(row0 + ai * HALF + m * 16) * ldc + col0;
#pragma unroll
                for (int bj = 0; bj < 2; ++bj)
#pragma unroll
                    for (int n = 0; n < 2; ++n) *(f32x4*)(rowp + bj * HALF + n * 16) = acc[ai][bj][m][n]; }
    }
};
struct EpiBf16 {
    static constexpr bool PERM = true, AFTER_DRAIN = false;
    bf16_t* O; int ldc;
    __device__ __forceinline__ void operator()(const f32x4 (&acc)[2][2][4][2], const Unit& u, int wr, int wc, int fr, int fq) const {
        const int row0 = u.pm * BM + wr * 64 + fr, col0 = u.pn * BM + wc * 32 + 8 * fq;
        unsigned bo = ((unsigned)row0 * (unsigned)ldc + (unsigned)col0) * 2u; asm volatile("" : "+v"(bo));
        const unsigned rs = (unsigned)ldc * 2u;
#pragma unroll
        for (int ai = 0; ai < 2; ++ai)
#pragma unroll
            for (int m = 0; m < 4; ++m) {
#pragma unroll
                for (int bj = 0; bj < 2; ++bj) { const f32x4 v0 = acc[ai][bj][m][0], v1 = acc[ai][bj][m][1];
                    u32x4 w; w.x = pk2(v0[0], v0[1]); w.y = pk2(v0[2], v0[3]); w.z = pk2(v1[0], v1[1]); w.w = pk2(v1[2], v1[3]);
                    *(u32x4*)((char*)O + (bo + (unsigned)(ai * HALF + m * 16) * rs + (unsigned)(bj * HALF * 2))) = w; } }
    }
};
struct EpiSwiGLU {
    static constexpr bool PERM = true, AFTER_DRAIN = false;
    bf16_t* O;
    __device__ __forceinline__ void operator()(const f32x4 (&acc)[2][2][4][2], const Unit& u, int wr, int wc, int fr, int fq) const {
        const int row0 = u.pm * BM + wr * 64 + fr, col0 = u.pn * HALF + wc * 32 + 8 * fq;
#pragma unroll
        for (int ai = 0; ai < 2; ++ai)
#pragma unroll
            for (int m = 0; m < 4; ++m) { bf16_t* rowp = O + (size_t)(row0 + ai * HALF + m * 16) * DFF + col0;
                float r[8];
#pragma unroll
                for (int n = 0; n < 2; ++n)
#pragma unroll
                    for (int j = 0; j < 4; ++j) { const float g = acc[ai][0][m][n][j], up = acc[ai][1][m][n][j]; r[4 * n + j] = siluf_(g) * up; }
                u32x4 w; w.x = pk2(r[0], r[1]); w.y = pk2(r[2], r[3]); w.z = pk2(r[4], r[5]); w.w = pk2(r[6], r[7]);
                *(u32x4*)rowp = w; }
    }
};
struct EpiMemKV {
    static constexpr bool PERM = false, AFTER_DRAIN = false;
    float* outK; float* outV; bf16_t* MK; bf16_t* MVT;
    __device__ __forceinline__ void operator()(const f32x4 (&acc)[2][2][4][2], const Unit& u, int wr, int wc, int fr, int fq) const {
        const int layer = u.pn >> 3, isv = (u.pn >> 2) & 1, cb = (u.pn & 3) * BM;
        const int row0 = u.pm * BM + wr * 64 + fr, col0 = cb + wc * 32 + 4 * fq;
        float* of = (isv ? outV : outK) + (size_t)layer * (NB * NMEM * D);
#pragma unroll
        for (int ai = 0; ai < 2; ++ai)
#pragma unroll
            for (int m = 0; m < 4; ++m) { const int row = row0 + ai * HALF + m * 16;
#pragma unroll
                for (int bj = 0; bj < 2; ++bj)
#pragma unroll
                    for (int n = 0; n < 2; ++n) { const int col = col0 + bj * HALF + n * 16; const f32x4 v = acc[ai][bj][m][n];
                        *(f32x4*)(of + (size_t)row * D + col) = v;
                        const int b = row >> 8, key = row & 255, h = col >> 8, dd = col & 255;
                        unsigned char* fb = (unsigned char*)(isv ? MVT : MK) + ((((size_t)layer * NB + b) * NH + h) << 17);
                        if (!isv) { u32x2 w; w.x = pk2(v[0], v[1]); w.y = pk2(v[2], v[3]);
                            *(u32x2*)(fb + ((((key >> 4) * 8 + (dd >> 5)) * 64 + (key & 15) + 16 * ((dd & 31) >> 3)) << 4) + ((dd & 4) << 1)) = w; }
                        else {
                            const int ks = key >> 5, w5 = key & 31, gg = (w5 & 15) >> 2, jj = (w5 & 3) + 4 * (w5 >> 4);
#pragma unroll
                            for (int j = 0; j < 4; ++j) { const int e = dd + j; *(bf16_t*)(fb + (((((e >> 4) * 8 + ks) * 64 + (e & 15) + 16 * gg) << 4) + jj * 2)) = (bf16_t)f2bf(v[j]); } } } }
    }
};
struct EpiBranch {
    static constexpr bool PERM = true, AFTER_DRAIN = false;
    bf16_t* O; const bf16_t* proj;
    __device__ __forceinline__ void operator()(const f32x4 (&acc)[2][2][4][2], const Unit& u, int wr, int wc, int fr, int fq) const {
        const int row0 = u.pm * BM + wr * 64 + fr, col0 = u.pn * BM + wc * 32 + 8 * fq;
#pragma unroll
        for (int ai = 0; ai < 2; ++ai)
#pragma unroll
            for (int m = 0; m < 4; ++m) { const int row = row0 + ai * HALF + m * 16; bf16_t* rowp = O + (size_t)row * D + col0; const bf16_t* gp = proj + (size_t)row * NWIN + PC_GATE + u.seg * D + col0;
#pragma unroll
                for (int bj = 0; bj < 2; ++bj) { const u32x4 gw = *(const u32x4*)(gp + bj * HALF); float r[8];
                    u32x4 old = (u32x4){0u, 0u, 0u, 0u}; if (u.seg != 0) old = *(const u32x4*)(rowp + bj * HALF);
#pragma unroll
                    for (int q = 0; q < 4; ++q) { const unsigned g2 = gw[q], o2 = old[q];
                        const float a0 = acc[ai][bj][m][q >> 1][(q & 1) * 2], a1 = acc[ai][bj][m][q >> 1][(q & 1) * 2 + 1];
                        r[2 * q] = bf2f(o2 & 0xffffu) + sigmoidf_(bf2f(g2 & 0xffffu)) * a0; r[2 * q + 1] = bf2f(o2 >> 16) + sigmoidf_(bf2f(g2 >> 16)) * a1; }
                    u32x4 w; w.x = pk2(r[0], r[1]); w.y = pk2(r[2], r[3]); w.z = pk2(r[4], r[5]); w.w = pk2(r[6], r[7]);
                    *(u32x4*)(rowp + bj * HALF) = w; } }
    }
};

template <class Epi, class Sched, bool ALIGN_EPI = false, bool SP2 = false>
__device__ __forceinline__ void gemm_phase(PG8_LAS unsigned char* lds, const Gemm g, const Sched& S, const Epi& E, const int tid) {
    const int wid = __builtin_amdgcn_readfirstlane(tid >> 6), lane = tid & 63, wr = wid >> 2, wc = wid & 3, fr = lane & 15, fq = lane >> 4;
    const int K = g.K, nt = K / BK;
    unsigned voffA[2], voffB[2];
#pragma unroll
    for (int i = 0; i < 2; ++i) { int R, C; stage_rc(tid * 16 + i * 8192, R, C); const int Rb = Epi::PERM ? ((R & ~31) + perm32(R & 31)) : R;
        voffA[i] = (unsigned)(R * K + C) * 2u; voffB[i] = (unsigned)(Rb * K + C) * 2u; }
    const size_t kstep = (size_t)(BK * 2);
    const size_t hstep = (size_t)HALF * K * 2;
    const unsigned ldsw = (unsigned)wid * 1024u;
    const int aoff = lds_byte(wr * 64 + fr, fq * 8), boff = lds_byte(wc * 32 + fr, fq * 8);
#define PG8_SA(b, h) (((b) * 2 + (h)) * HTB)
#define PG8_SB(b, h) ((4 + (b) * 2 + (h)) * HTB)
#define PG8_STAGE(bufoff, gbase, voff) do { _Pragma("unroll") for (int _i = 0; _i < 2; ++_i) \
        __builtin_amdgcn_global_load_lds((const unsigned*)((const char*)(gbase) + (voff)[_i]), (PG8_LAS unsigned*)(lds + (bufoff) + ldsw + _i * 8192), 16, 0, 0); } while (0)
#define PG8_LDA(dst, b, h) do { _Pragma("unroll") for (int m = 0; m < 4; ++m) _Pragma("unroll") for (int k = 0; k < 2; ++k) dst[m][k] = *(const PG8_LAS bf16x8*)(lds + PG8_SA(b, h) + aoff + m * 2048 + k * 1024); } while (0)
#define PG8_LDB(dst, b, h) do { _Pragma("unroll") for (int n = 0; n < 2; ++n) _Pragma("unroll") for (int k = 0; k < 2; ++k) dst[n][k] = *(const PG8_LAS bf16x8*)(lds + PG8_SB(b, h) + boff + n * 2048 + k * 1024); } while (0)
#define PG8_MMA(ai, bj, At, Bt) do { __builtin_amdgcn_s_setprio(1); _Pragma("unroll") for (int m = 0; m < 4; ++m) _Pragma("unroll") for (int n = 0; n < 2; ++n) _Pragma("unroll") for (int k = 0; k < 2; ++k) \
        acc[ai][bj][m][n] = __builtin_amdgcn_mfma_f32_16x16x32_bf16(Bt[n][k], At[m][k], acc[ai][bj][m][n], 0, 0, 0); __builtin_amdgcn_s_setprio(0); } while (0)
#define PG8_WAIT_V(n) asm volatile("s_waitcnt vmcnt(" #n ")" ::: "memory")
#define PG8_WAIT_L(n) asm volatile("s_waitcnt lgkmcnt(" #n ")" ::: "memory")
#define PG8_BAR __builtin_amdgcn_s_barrier()
#define PG8_SCHED __builtin_amdgcn_sched_barrier(0)
    Unit cur, nxt; int ui = 0;
    if (!S.next(0, cur)) return;
    f32x4 acc[2][2][4][2];
#pragma unroll
    for (int a = 0; a < 2; ++a)
#pragma unroll
        for (int b = 0; b < 2; ++b)
#pragma unroll
            for (int m = 0; m < 4; ++m)
#pragma unroll
                for (int n = 0; n < 2; ++n) acc[a][b][m][n] = (f32x4){0.f, 0.f, 0.f, 0.f};
    bf16x8 At[4][2], B0[2][2], B1[2][2];
    const char* cA = (const char*)g.A + cur.aofs; const char* cB = (const char*)g.Bt + cur.bofs;
    S.a_ready(cur);
    if constexpr (SP2) {
        PG8_STAGE(PG8_SB(0, 0), cB, voffB); PG8_STAGE(PG8_SB(0, 1), cB + hstep, voffB); PG8_STAGE(PG8_SA(0, 0), cA, voffA); PG8_STAGE(PG8_SA(0, 1), cA + hstep, voffA);
        if (wr == 1) PG8_BAR;
        PG8_WAIT_V(2); PG8_BAR;
        PG8_STAGE(PG8_SB(1, 0), cB + kstep, voffB); PG8_STAGE(PG8_SA(1, 0), cA + kstep, voffA); PG8_STAGE(PG8_SB(1, 1), cB + hstep + kstep, voffB);
        PG8_WAIT_V(6); PG8_BAR;
    } else {
        PG8_STAGE(PG8_SB(0, 0), cB, voffB); PG8_STAGE(PG8_SA(0, 0), cA, voffA); PG8_STAGE(PG8_SB(0, 1), cB + hstep, voffB); PG8_STAGE(PG8_SA(0, 1), cA + hstep, voffA);
        if (wr == 1) PG8_BAR;
        PG8_WAIT_V(4); PG8_BAR;
        PG8_STAGE(PG8_SB(1, 0), cB + kstep, voffB); PG8_STAGE(PG8_SA(1, 0), cA + kstep, voffA); PG8_STAGE(PG8_SB(1, 1), cB + hstep + kstep, voffB);
        PG8_WAIT_V(6); PG8_BAR;
    }
    for (;;) {
        const bool has_next = S.next(ui + 1, nxt);
        const char* nA = has_next ? (const char*)g.A + nxt.aofs : cA; const char* nB = has_next ? (const char*)g.Bt + nxt.bofs : cB;
        for (int t = 0; t < nt; t += 2) {
            const bool last = (t == nt - 2);
            const char* a1 = cA + (size_t)(t + 1) * kstep;
            const char* a2 = last ? nA : cA + (size_t)(t + 2) * kstep; const char* b2 = last ? nB : cB + (size_t)(t + 2) * kstep;
            const char* a3 = a2 + kstep; const char* b3 = b2 + kstep;
            if (last && has_next) S.a_ready(nxt);
            if constexpr (SP2) {
            PG8_LDB(B0, 0, 0); PG8_LDB(B1, 0, 1); PG8_SCHED; PG8_LDA(At, 0, 0); PG8_STAGE(PG8_SA(1, 1), a1 + hstep, voffA);
            PG8_WAIT_V(8); PG8_WAIT_L(0); PG8_BAR; PG8_MMA(0, 0, At, B0); PG8_MMA(0, 1, At, B1); PG8_BAR; PG8_SCHED;
            PG8_LDA(At, 0, 1); PG8_STAGE(PG8_SB(0, 0), b2, voffB); PG8_STAGE(PG8_SB(0, 1), b2 + hstep, voffB); PG8_STAGE(PG8_SA(0, 0), a2, voffA);
            PG8_WAIT_V(8); PG8_WAIT_L(0); PG8_BAR; PG8_MMA(1, 0, At, B0); PG8_MMA(1, 1, At, B1); PG8_BAR; PG8_SCHED;
            PG8_LDB(B0, 1, 0); PG8_LDB(B1, 1, 1); PG8_SCHED; PG8_LDA(At, 1, 0); PG8_STAGE(PG8_SA(0, 1), a2 + hstep, voffA);
            PG8_WAIT_V(8); PG8_WAIT_L(0); PG8_BAR; PG8_MMA(0, 0, At, B0); PG8_MMA(0, 1, At, B1); PG8_BAR; PG8_SCHED;
            PG8_LDA(At, 1, 1); PG8_STAGE(PG8_SB(1, 0), b3, voffB); PG8_STAGE(PG8_SB(1, 1), b3 + hstep, voffB); PG8_STAGE(PG8_SA(1, 0), a3, voffA);
            PG8_WAIT_V(8); PG8_WAIT_L(0); PG8_BAR; PG8_MMA(1, 0, At, B0); PG8_MMA(1, 1, At, B1); PG8_BAR; PG8_SCHED;
            } else {
            PG8_LDB(B0, 0, 0); PG8_SCHED; PG8_LDA(At, 0, 0); PG8_STAGE(PG8_SA(1, 1), a1 + hstep, voffA);
            PG8_WAIT_L(8); PG8_BAR; PG8_WAIT_L(0); PG8_MMA(0, 0, At, B0); PG8_BAR; PG8_SCHED;
            PG8_LDB(B1, 0, 1); PG8_STAGE(PG8_SB(0, 0), b2, voffB);
            PG8_BAR; PG8_WAIT_L(0); PG8_MMA(0, 1, At, B1); PG8_BAR;
            PG8_LDA(At, 0, 1); PG8_STAGE(PG8_SA(0, 0), a2, voffA);
            PG8_BAR; PG8_WAIT_L(0); PG8_MMA(1, 0, At, B0); PG8_BAR; PG8_SCHED;
            PG8_STAGE(PG8_SB(0, 1), b2 + hstep, voffB);
            PG8_WAIT_V(6); PG8_BAR; PG8_MMA(1, 1, At, B1); PG8_BAR;
            PG8_LDB(B0, 1, 0); PG8_SCHED; PG8_LDA(At, 1, 0); PG8_STAGE(PG8_SA(0, 1), a2 + hstep, voffA);
            PG8_WAIT_L(8); PG8_BAR; PG8_WAIT_L(0); PG8_MMA(0, 0, At, B0); PG8_BAR; PG8_SCHED;
            PG8_LDB(B1, 1, 1); PG8_STAGE(PG8_SB(1, 0), b3, voffB);
            PG8_BAR; PG8_WAIT_L(0); PG8_MMA(0, 1, At, B1); PG8_BAR;
            PG8_LDA(At, 1, 1); PG8_STAGE(PG8_SA(1, 0), a3, voffA);
            PG8_BAR; PG8_WAIT_L(0); PG8_MMA(1, 0, At, B0); PG8_BAR; PG8_SCHED;
            PG8_STAGE(PG8_SB(1, 1), b3 + hstep, voffB);
            PG8_WAIT_V(6); PG8_BAR; PG8_MMA(1, 1, At, B1); PG8_BAR;
            }
        }
        if constexpr (ALIGN_EPI) { if (wr == 0) PG8_BAR; }
        if constexpr (!Epi::AFTER_DRAIN) { E(acc, cur, wr, wc, fr, fq); S.done(cur); }
        if (!has_next) break;
#pragma unroll
        for (int a = 0; a < 2; ++a)
#pragma unroll
            for (int b = 0; b < 2; ++b)
#pragma unroll
                for (int m = 0; m < 4; ++m)
#pragma unroll
                    for (int n = 0; n < 2; ++n) acc[a][b][m][n] = (f32x4){0.f, 0.f, 0.f, 0.f};
        cur = nxt; cA = nA; cB = nB; ++ui;
        if constexpr (ALIGN_EPI) { if (wr == 1) PG8_BAR; }
    }
    PG8_WAIT_V(0);
    if constexpr (!ALIGN_EPI) { if (wr == 0) PG8_BAR; }
    PG8_BAR;
    if constexpr (Epi::AFTER_DRAIN) { E.fused(acc, cur, wr, wc, fr, fq, lds, wid, lane); S.done(cur); }
#undef PG8_SA
#undef PG8_SB
#undef PG8_STAGE
#undef PG8_LDA
#undef PG8_LDB
#undef PG8_MMA
#undef PG8_WAIT_V
#undef PG8_WAIT_L
#undef PG8_BAR
#undef PG8_SCHED
}
}

constexpr size_t MiB = 1u << 20;
constexpr size_t WS_CTL = 0, CTL_ZERO_BYTES = 1 * MiB;
constexpr size_t WS_W0 = 1 * MiB, WS_WL = 61 * MiB;
constexpr size_t OFF_W1I = 0, OFF_W1O = 11 * MiB, OFF_WIN = 16 * MiB + MiB / 2, OFF_WBR = 36 * MiB + MiB / 2, OFF_WO = 42 * MiB + MiB / 2, OFF_W2I = 44 * MiB + MiB / 2, OFF_W2O = 55 * MiB + MiB / 2;
static_assert(OFF_W2O + (size_t)D * DFF * 2 == WS_WL, "layer weight map");
constexpr size_t WS_WMKV = 123 * MiB;
constexpr size_t WS_MISC = 131 * MiB;
constexpr size_t MISC_WAB = 0, MISC_COS = 65536, MISC_SIN = 65536 + 2049 * 64 * 4;
constexpr size_t WS_MEMN = 133 * MiB, WS_MK = 141 * MiB, WS_MVT = 149 * MiB, WS_AB = 157 * MiB;
constexpr size_t WS_H = 158 * MiB, WS_TMP = 223 * MiB, WS_XN = 288 * MiB, WS_MERGED = 320 * MiB + MiB / 2, WS_OBR = 353 * MiB;
constexpr size_t OBR_STRIDE = (size_t)MPAD * D;
constexpr size_t WS_BIG = 451 * MiB;
constexpr int GCH_W = 0, GCH_QD = 16384, GCH_ATT = 32768, GCH_KDT = 40960, GCH_BYTES = 57344;
constexpr int RCH_QD = 0, RCH_ATT = 16384, RCH_KDT = 24576, RCH_BYTES = 40960;
constexpr size_t WS_RCH = 776 * MiB, WS_RVT = 816 * MiB;
constexpr size_t WS_GCH = 848 * MiB, WS_GUT = 904 * MiB, WS_GDCH = 968 * MiB;
constexpr size_t WS_END = 969 * MiB;
static_assert(WS_H + (size_t)MPAD * D * 4 == WS_TMP && WS_TMP + (size_t)MPAD * D * 4 == WS_XN && WS_XN + (size_t)MPAD * D * 2 == WS_MERGED && WS_MERGED + (size_t)MPAD * D * 2 == WS_OBR, "activation map");
static_assert(WS_OBR + 3 * OBR_STRIDE * 2 <= WS_BIG && WS_BIG + (size_t)MPAD * NWIN * 2 <= WS_RCH && WS_RCH + (size_t)1024 * RCH_BYTES <= WS_RVT && WS_GCH + (size_t)1024 * GCH_BYTES <= WS_GUT, "activation map 2");
constexpr int CW_BAR = 4096;

constexpr size_t O_YP = 0, O_YS = O_YP + (size_t)MP * D, O_SRP = O_YS + (size_t)MS * D, O_SGP = O_SRP + (size_t)2 * NB * NH * DK * DV, O_CVP = O_SGP + (size_t)2 * NB * NH * DK * DV,
                 O_MKP = O_CVP + (size_t)2 * NB * 3 * CONVD, O_MVP = O_MKP + (size_t)2 * NB * NMEM * D, O_SRS = O_MVP + (size_t)2 * NB * NMEM * D, O_SGS = O_SRS + (size_t)2 * MS * NH * DK * DV,
                 O_CVS = O_SGS + (size_t)2 * MS * NH * DK * DV, O_END = O_CVS + (size_t)2 * MS * 3 * CONVD;
static_assert(O_END == 98271232, "output size");

constexpr int RING_BYTES = 131072, MISC_OFF = RING_BYTES + 320, LDS_BYTES = 147456;

#define XB_TMO      128
#define XB_XCNT(j)  (256  + 64 * (j))
#define XB_XSUB(j)  (1280 + 64 * (j))
#define XB_XGEN(j)  (2304 + 64 * (j))
#define XB_TOP      3328
#define XB_TOPGEN   3392
#define XCD_BAR_WORDS 3456
#define XB_SPIN_CAP (1u << 18)

__device__ __forceinline__ unsigned xb_ld(unsigned* p)              { return __hip_atomic_load(p, __ATOMIC_RELAXED, __HIP_MEMORY_SCOPE_AGENT); }
__device__ __forceinline__ unsigned xb_add(unsigned* p, unsigned v) { return __hip_atomic_fetch_add(p, v, __ATOMIC_RELAXED, __HIP_MEMORY_SCOPE_AGENT); }
__device__ __forceinline__ unsigned xb_xcc_id() { return (unsigned)__builtin_amdgcn_s_getreg((3 << 11) | 20) & 0xFu; }
#define XB_SPIN(cond, bar) do { unsigned _sp = 0; while (cond) { __builtin_amdgcn_s_sleep(1); \
    if ((++_sp & 255u) == 0u) { if (xb_ld(&(bar)[XB_TMO])) break; if (_sp > XB_SPIN_CAP) { atomicAdd(&(bar)[XB_TMO], 1u); break; } } } } while (0)

struct XcdBarrier {
    unsigned* bar; unsigned x;
    volatile LAS unsigned* st;
};

__device__ __forceinline__ XcdBarrier xcd_barrier_post(unsigned* bar, volatile LAS unsigned* st) {
    XcdBarrier b; b.bar = bar; b.x = xb_xcc_id(); b.st = st;
    if (threadIdx.x == 0) (void)xb_add(&bar[XB_XCNT(b.x)], 1u);
    return b;
}
__device__ __forceinline__ void xcd_barrier_complete(unsigned* bar, unsigned x, unsigned& nloc, unsigned& nx) {
    const unsigned G = gridDim.x * gridDim.y * gridDim.z;
    unsigned sum, cnt, mine, sp = 0u;
    for (;;) {
        sum = 0u; cnt = 0u; mine = 0u;
#pragma unroll
        for (unsigned j = 0; j < 16; ++j) { const unsigned c = xb_ld(&bar[XB_XCNT(j)]); sum += c; cnt += (c > 0u) ? 1u : 0u; mine = (j == x) ? c : mine; }
        if (sum == G) break;
        __builtin_amdgcn_s_sleep(1);
        if ((++sp & 255u) == 0u) { if (xb_ld(&bar[XB_TMO])) break; if (sp > XB_SPIN_CAP) { atomicAdd(&bar[XB_TMO], 1u); break; } }
    }
    nloc = mine > 0u ? mine : 1u; nx = cnt > 0u ? cnt : 1u;
}

__device__ __forceinline__ void xcd_barrier(const XcdBarrier& b, const bool is_thread0) {
    asm volatile("s_waitcnt vmcnt(0)" ::: "memory");
    __syncthreads();
    if (is_thread0) {
        unsigned* bar = b.bar;
        __builtin_amdgcn_s_waitcnt(0);
        unsigned nloc = b.st[0], nx = b.st[1];
        if (nloc == 0u) { xcd_barrier_complete(bar, b.x, nloc, nx); b.st[0] = nloc; b.st[1] = nx; }
        const unsigned old = xb_add(&bar[XB_XSUB(b.x)], 1u);
        const unsigned gen = old / nloc;
        if (old + 1u == (gen + 1u) * nloc) {
            __builtin_amdgcn_fence(__ATOMIC_RELEASE, "agent");
            asm volatile("s_waitcnt vmcnt(0)" ::: "memory");
            const unsigned og = xb_add(&bar[XB_TOP], 1u);
            const unsigned tg = og / nx;
            if (og + 1u == (tg + 1u) * nx) xb_add(&bar[XB_TOPGEN], 1u);
            else XB_SPIN(xb_ld(&bar[XB_TOPGEN]) == tg, bar);
            __builtin_amdgcn_fence(__ATOMIC_ACQUIRE, "agent");
            xb_add(&bar[XB_XGEN(b.x)], 1u);
            asm volatile("s_waitcnt vmcnt(0)" ::: "memory");
        } else {
            XB_SPIN(xb_ld(&bar[XB_XGEN(b.x)]) == gen, bar);
            __builtin_amdgcn_fence(__ATOMIC_ACQUIRE, "agent");
            asm volatile("s_waitcnt vmcnt(0)" ::: "memory");
        }
    }
    __syncthreads();
}

constexpr int NWAVES = 8;
struct Args { const float* in[30]; float* out; unsigned char* ws; int ph_lo, ph_hi, sel, pad; };
struct Frame {
    LAS unsigned char* lds; int tid, lane, wave, G, bid;
    const Args* A; float* out; unsigned char* ws; int zo;
    __device__ __forceinline__ const float* inp(int k) const { return *(const float* const*)((const char*)A + zo + 8 * k); }
    __device__ __forceinline__ bf16_t* XN() const { return (bf16_t*)(ws + WS_XN); }
    __device__ __forceinline__ bf16_t* MERGED() const { return (bf16_t*)(ws + WS_MERGED); }
    __device__ __forceinline__ bf16_t* OBR() const { return (bf16_t*)(ws + WS_OBR); }
    __device__ __forceinline__ bf16_t* PROJ() const { return (bf16_t*)(ws + WS_BIG); }
    __device__ __forceinline__ bf16_t* ACT() const { return (bf16_t*)(ws + WS_BIG); }
    __device__ __forceinline__ bf16_t* MEMN() const { return (bf16_t*)(ws + WS_MEMN); }
    __device__ __forceinline__ bf16_t* MK() const { return (bf16_t*)(ws + WS_MK); }
    __device__ __forceinline__ bf16_t* MVT() const { return (bf16_t*)(ws + WS_MVT); }
    __device__ __forceinline__ float* H() const { return (float*)(ws + WS_H); }
    __device__ __forceinline__ float* TMP() const { return (float*)(ws + WS_TMP); }
    __device__ __forceinline__ float* AB() const { return (float*)(ws + WS_AB); }
    __device__ __forceinline__ float* WAB() const { return (float*)(ws + WS_MISC + MISC_WAB); }
    __device__ __forceinline__ float* COS() const { return (float*)(ws + WS_MISC + MISC_COS); }
    __device__ __forceinline__ float* SIN() const { return (float*)(ws + WS_MISC + MISC_SIN); }
    __device__ __forceinline__ unsigned char* RCH() const { return ws + WS_RCH; }
    __device__ __forceinline__ unsigned char* RVT() const { return ws + WS_RVT; }
    __device__ __forceinline__ unsigned char* GCH() const { return ws + WS_GCH; }
    __device__ __forceinline__ float* GUT() const { return (float*)(ws + WS_GUT); }
    __device__ __forceinline__ float* GDCH() const { return (float*)(ws + WS_GDCH); }
};
#define LDS_WAIT() asm volatile("s_waitcnt lgkmcnt(0)" ::: "memory")

enum { WM_PLAIN = 0, WM_FFNIN = 1, WM_WIN = 2 };
__device__ __forceinline__ int map_col(int mode, int n0) {
    if (mode == WM_FFNIN) { const int tile = n0 >> 8, w = n0 & 255; return (w < 128) ? tile * 128 + w : DFF + tile * 128 + (w - 128); }
    if (mode == WM_WIN) return n0 < PC_MQ ? n0 : n0 + 8;
    return n0;
}
__device__ __forceinline__ void transpose_item(const float* W, int K, int Nraw, int N, int mode, bf16_t* WT, LAS float* scr, int item, int lane) {
    const int nblk = N / 32, kb = item / nblk, nb = item % nblk, k0 = 64 * kb, n0 = 32 * nb, nr0 = map_col(mode, n0);
#pragma unroll 8
    for (int i = 0; i < 32; ++i) { const int kk = 2 * i + (lane >> 5); scr[kk * 33 + (lane & 31)] = W[(size_t)(k0 + kk) * Nraw + nr0 + (lane & 31)]; }
    LDS_WAIT(); asm volatile("" ::: "memory");
    const int c = lane & 7;
#pragma unroll
    for (int j = 0; j < 4; ++j) { const int n = (lane >> 3) + 8 * j; const LAS float* s = scr + (8 * c) * 33 + n;
        u32x4 o; o.x = pk2(s[0 * 33], s[1 * 33]); o.y = pk2(s[2 * 33], s[3 * 33]); o.z = pk2(s[4 * 33], s[5 * 33]); o.w = pk2(s[6 * 33], s[7 * 33]);
        *(u32x4*)(WT + (size_t)(n0 + n) * K + k0 + 8 * c) = o; }
    LDS_WAIT(); asm volatile("" ::: "memory");
}
struct TJob { const float* W; int K, Nraw, N, mode; bf16_t* WT; };
__device__ __forceinline__ TJob get_job(int j, const Frame& F) {
    const int l = j / 11, t = j % 11; unsigned char* wl = F.ws + WS_W0 + (size_t)l * WS_WL; TJob r;
    switch (t) {
    case 0:  r = TJob{F.inp(10) + (size_t)l * D * NFFI, D, NFFI, NFFI, WM_FFNIN, (bf16_t*)(wl + OFF_W1I)}; break;
    case 1:  r = TJob{F.inp(11) + (size_t)l * DFF * D, DFF, D, D, WM_PLAIN, (bf16_t*)(wl + OFF_W1O)}; break;
    case 2:  r = TJob{F.inp(14) + (size_t)l * D * WIN_RAW, D, WIN_RAW, NWIN, WM_WIN, (bf16_t*)(wl + OFF_WIN)}; break;
    case 3:  r = TJob{F.inp(20) + (size_t)l * D * D, D, D, D, WM_PLAIN, (bf16_t*)(F.ws + WS_WMKV) + (size_t)(l * 2048) * D}; break;
    case 4:  r = TJob{F.inp(21) + (size_t)l * D * D, D, D, D, WM_PLAIN, (bf16_t*)(F.ws + WS_WMKV) + (size_t)(l * 2048 + 1024) * D}; break;
    case 5:  r = TJob{F.inp(22) + (size_t)l * D * D, D, D, D, WM_PLAIN, (bf16_t*)(wl + OFF_WBR)}; break;
    case 6:  r = TJob{F.inp(23) + (size_t)l * D * D, D, D, D, WM_PLAIN, (bf16_t*)(wl + OFF_WBR) + (size_t)D * D}; break;
    case 7:  r = TJob{F.inp(24) + (size_t)l * D * D, D, D, D, WM_PLAIN, (bf16_t*)(wl + OFF_WBR) + (size_t)2 * D * D}; break;
    case 8:  r = TJob{F.inp(25) + (size_t)l * D * D, D, D, D, WM_PLAIN, (bf16_t*)(wl + OFF_WO)}; break;
    case 9:  r = TJob{F.inp(28) + (size_t)l * D * NFFI, D, NFFI, NFFI, WM_FFNIN, (bf16_t*)(wl + OFF_W2I)}; break;
    default: r = TJob{F.inp(29) + (size_t)l * DFF * D, DFF, D, D, WM_PLAIN, (bf16_t*)(wl + OFF_W2O)}; break;
    }
    return r;
}

struct NormArgs { const float* tmp; const float* gpost; float scale; const float* gpre; const float* wab; int first, fin; };
__device__ __forceinline__ void norm_phase(const Frame& F, const NormArgs na) {
    const int gw = F.bid * NWAVES + F.wave, NGW = F.G * NWAVES, lane = F.lane;
    for (int m = gw; m < MREAL; m += NGW) {
        f32x4 h[4];
        if (na.first) {
            const float* src = (m < MP) ? F.inp(0) + (size_t)m * D : F.inp(1) + (size_t)(m - MP) * D;
#pragma unroll
            for (int j = 0; j < 4; ++j) h[j] = (m < MREAL) ? *((const f32x4*)src + lane + 64 * j) : (f32x4){0.f, 0.f, 0.f, 0.f};
        } else {
#pragma unroll
            for (int j = 0; j < 4; ++j) h[j] = *((const f32x4*)(F.H() + (size_t)m * D) + lane + 64 * j);
        }
        if (na.tmp) {
            f32x4 t[4]; float ss = 0.f;
#pragma unroll
            for (int j = 0; j < 4; ++j) { t[j] = *((const f32x4*)(na.tmp + (size_t)m * D) + lane + 64 * j); ss += (t[j].x * t[j].x + t[j].y * t[j].y) + (t[j].z * t[j].z + t[j].w * t[j].w); }
            const float r = na.scale / sqrtf(wave_sum(ss) * (1.f / D) + EPS);
#pragma unroll
            for (int j = 0; j < 4; ++j) { const f32x4 gp = *((const f32x4*)na.gpost + lane + 64 * j); h[j] = h[j] + t[j] * gp * r; }
        }
#pragma unroll
        for (int j = 0; j < 4; ++j) *((f32x4*)(F.H() + (size_t)m * D) + lane + 64 * j) = h[j];
        if (na.fin && m < MREAL) {
            float* dst = (m < MP) ? F.out + O_YP + (size_t)m * D : F.out + O_YS + (size_t)(m - MP) * D;
#pragma unroll
            for (int j = 0; j < 4; ++j) *((f32x4*)dst + lane + 64 * j) = h[j];
        }
        float s2 = 0.f;
#pragma unroll
        for (int j = 0; j < 4; ++j) s2 += (h[j].x * h[j].x + h[j].y * h[j].y) + (h[j].z * h[j].z + h[j].w * h[j].w);
        const float r2 = 1.f / sqrtf(wave_sum(s2) * (1.f / D) + EPS);
        u32x2* o8 = (u32x2*)(F.XN() + (size_t)m * D) + lane;
#pragma unroll
        for (int j = 0; j < 4; ++j) { const f32x4 gp = *((const f32x4*)na.gpre + lane + 64 * j); h[j] = h[j] * gp * r2; u32x2 w; w.x = pk2(h[j].x, h[j].y); w.y = pk2(h[j].z, h[j].w); o8[64 * j] = w; }
        if (na.wab) {
            float d8 = 0.f;
#pragma unroll
            for (int q = 0; q < 8; ++q) { float s = 0.f;
#pragma unroll
                for (int j = 0; j < 4; ++j) { const f32x4 w = *((const f32x4*)(na.wab + q * D) + lane + 64 * j); s += (h[j].x * w.x + h[j].y * w.y) + (h[j].z * w.z + h[j].w * w.w); }
                s = wave_sum(s); d8 = (lane == q) ? s : d8; }
            if (lane < 8) F.AB()[(size_t)m * 8 + lane] = d8;
        }
    }
}

__device__ __forceinline__ void p0_prologue(const Frame& F) {
    LAS float* scr = (LAS float*)(F.lds + F.wave * 16384);
    const int gw = F.bid * NWAVES + F.wave, NGW = F.G * NWAVES;
    for (int j = 0; j < 16; ++j) { if (j >= 11 && j != 14 && j != 15) continue;
        const TJob tj = get_job(j, F); const int nitems = (tj.K / 64) * (tj.N / 32);
        for (int it = gw; it < nitems; it += NGW) transpose_item(tj.W, tj.K, tj.Nraw, tj.N, tj.mode, tj.WT, scr, it, F.lane); }
    const int gt = F.bid * (NWAVES * 64) + F.tid, NGT = F.G * NWAVES * 64;
    for (int i = gt; i < 2 * 8 * D; i += NGT) { const int l = i / (8 * D), q = (i / D) % 8, k = i % D; F.WAB()[i] = F.inp(14)[(size_t)l * D * WIN_RAW + (size_t)k * WIN_RAW + PC_MQ + q]; }
    for (int i = gt; i < 2049 * 64; i += NGT) { const int p = i >> 6, d = i & 63; const double pos = (p == 2048) ? (double)PAST_LEN : (double)p;
        const double ang = pos * pow(10000.0, -(double)d / 64.0); F.COS()[i] = (float)cos(ang); F.SIN()[i] = (float)sin(ang); }
    for (int r = gw; r < 2 * NB * NMEM; r += NGW) { const int l = r / (NB * NMEM), row = r % (NB * NMEM);
        f32x4 v[4]; float ss = 0.f;
#pragma unroll
        for (int j = 0; j < 4; ++j) { v[j] = *((const f32x4*)(F.inp(2) + (size_t)row * D) + F.lane + 64 * j); ss += (v[j].x * v[j].x + v[j].y * v[j].y) + (v[j].z * v[j].z + v[j].w * v[j].w); }
        const float rr = 1.f / sqrtf(wave_sum(ss) * (1.f / D) + EPS);
        u32x2* o8 = (u32x2*)(F.MEMN() + (size_t)r * D) + F.lane;
#pragma unroll
        for (int j = 0; j < 4; ++j) { const f32x4 gp = *((const f32x4*)(F.inp(19) + (size_t)l * D) + F.lane + 64 * j); const f32x4 y = v[j] * gp * rr; u32x2 w; w.x = pk2(y.x, y.y); w.y = pk2(y.z, y.w); o8[64 * j] = w; }
    }
    NormArgs na{nullptr, nullptr, 0.f, F.inp(8), nullptr, 1, 0};
    norm_phase(F, na);
}

__device__ __forceinline__ void convert_layer1(const Frame& F, int idx, int nw) {
    LAS float* scr = (LAS float*)(F.lds + F.wave * 16384);
    const int gw = idx * NWAVES + F.wave, NGW = nw * NWAVES;
    for (int j = 11; j < 22; ++j) { if (j == 14 || j == 15) continue;
        const TJob tj = get_job(j, F); const int nitems = (tj.K / 64) * (tj.N / 32);
        for (int it = gw; it < nitems; it += NGW) transpose_item(tj.W, tj.K, tj.Nraw, tj.N, tj.mode, tj.WT, scr, it, F.lane); }
}

__device__ __forceinline__ bf16x8 ldnat(const void* base, unsigned row_boff, int s, int g) { return *(const bf16x8*)((const char*)base + (row_boff + 64u * s + 16u * g)); }
__device__ __forceinline__ bf16x8 ldperm(const void* base, unsigned row_boff, int s, int g) {
    const unsigned o = row_boff + 64u * s + 8u * g; const bf16x4 lo = *(const bf16x4*)((const char*)base + o), hi = *(const bf16x4*)((const char*)base + (o + 32u));
    return __builtin_shufflevector(lo, hi, 0, 1, 2, 3, 4, 5, 6, 7);
}
#define CBAR() asm volatile("" ::: "memory")
__device__ __forceinline__ bf16x8 lds_frag(const LAS float* rowp, int s, int g, float scale) {
    const f32x4 a = *(const LAS f32x4*)(rowp + 32 * s + 8 * g), b = *(const LAS f32x4*)(rowp + 32 * s + 8 * g + 4);
    return pack8(a * scale, b * scale);
}

__device__ __forceinline__ void ret_prep(const Frame& F, int ci) {
    const int tid = F.tid, lane = F.lane, wv = F.wave;
    const int bh = ci >> 5, n = ci & 31, b = bh >> 2, h = bh & 3, m0 = b * SEQ + n * CH;
    const float lg = log1pf(-exp2f(-5.0f - (float)h));
    LAS float* qf = (LAS float*)F.lds;
    LAS float* kf = qf + 64 * 132;
    LAS bf16_t* vs = (LAS bf16_t*)(kf + 64 * 132);
    {   const int i = tid >> 3, d0 = (tid & 7) * 8, t = n * CH + i;
        const bf16_t* qrow = F.PROJ() + (size_t)(m0 + i) * NWIN + PC_RQ + h * DK; const bf16_t* krow = F.PROJ() + (size_t)(m0 + i) * NWIN + PC_RK + h * DK;
        const u32x4 q1 = *(const u32x4*)(qrow + d0), q2 = *(const u32x4*)(qrow + 64 + d0), k1 = *(const u32x4*)(krow + d0), k2 = *(const u32x4*)(krow + 64 + d0);
        const float* cp = F.COS() + t * 64 + d0; const float* sp = F.SIN() + t * 64 + d0;
        float cs[8], sn[8];
#pragma unroll
        for (int e = 0; e < 8; ++e) { cs[e] = cp[e]; sn[e] = sp[e]; }
        const float qd = fexp(lg * (float)(i + 1));
        float o1[8], o2[8];
#pragma unroll
        for (int e = 0; e < 8; ++e) { const unsigned w1 = q1[e >> 1], w2 = q2[e >> 1]; const float x1 = (e & 1) ? bf2f(w1 >> 16) : bf2f(w1 & 0xffffu), x2 = (e & 1) ? bf2f(w2 >> 16) : bf2f(w2 & 0xffffu);
            o1[e] = x1 * cs[e] - x2 * sn[e]; o2[e] = x1 * sn[e] + x2 * cs[e]; qf[i * 132 + d0 + e] = o1[e]; qf[i * 132 + 64 + d0 + e] = o2[e]; }
        {
            unsigned char* qb = F.RCH() + (size_t)ci * RCH_BYTES + RCH_QD + (i >> 4) * 4096 + (i & 15) * 16;
#pragma unroll
            for (int hh = 0; hh < 2; ++hh) { const int D0 = d0 + 64 * hh, s = D0 >> 5, half = (D0 >> 4) & 1, g0 = (D0 & 15) >> 2; const float* o = hh ? o2 : o1;
                u32x2 w; w.x = pk2(o[0] * qd, o[1] * qd); w.y = pk2(o[2] * qd, o[3] * qd); *(u32x2*)(qb + s * 1024 + g0 * 256 + half * 8) = w;
                w.x = pk2(o[4] * qd, o[5] * qd); w.y = pk2(o[6] * qd, o[7] * qd); *(u32x2*)(qb + s * 1024 + (g0 + 1) * 256 + half * 8) = w; }
        }
        const float ksc = 0.08838834764831845f;
#pragma unroll
        for (int e = 0; e < 8; ++e) { const unsigned w1 = k1[e >> 1], w2 = k2[e >> 1]; const float x1 = (e & 1) ? bf2f(w1 >> 16) : bf2f(w1 & 0xffffu), x2 = (e & 1) ? bf2f(w2 >> 16) : bf2f(w2 & 0xffffu);
            kf[i * 132 + d0 + e] = (x1 * cs[e] - x2 * sn[e]) * ksc; kf[i * 132 + 64 + d0 + e] = (x1 * sn[e] + x2 * cs[e]) * ksc; }
    }
#pragma unroll
    for (int r = 0; r < 4; ++r) { const int p = tid + 512 * r, row = p >> 5, c8 = (p & 31) * 8;
        *(LAS u32x4*)(vs + row * 264 + c8) = *(const u32x4*)(F.PROJ() + (size_t)(m0 + row) * NWIN + PC_RV + h * DV + c8); }
    __syncthreads();
    {
        const int d = tid >> 2, i0 = (tid & 3) * 16; unsigned w[8];
#pragma unroll
        for (int r = 0; r < 16; r += 2) { const float v0 = kf[(i0 + r) * 132 + d] * fexp(lg * (float)(63 - (i0 + r))), v1 = kf[(i0 + r + 1) * 132 + d] * fexp(lg * (float)(62 - (i0 + r))); w[r >> 1] = pk2(v0, v1); }
        unsigned char* kb = F.RCH() + (size_t)ci * RCH_BYTES + RCH_KDT + (d >> 4) * 2048 + (d & 15) * 16 + (i0 >> 5) * 1024 + ((i0 & 31) >> 3) * 256;
        *(u32x4*)kb = (u32x4){w[0], w[1], w[2], w[3]}; *(u32x4*)(kb + 256) = (u32x4){w[4], w[5], w[6], w[7]};
    }
    {
        const int e = tid >> 1, i0 = (tid & 1) * 32; unsigned w[16];
#pragma unroll
        for (int r = 0; r < 32; r += 2) w[r >> 1] = (unsigned)vs[(i0 + r) * 264 + e] | ((unsigned)vs[(i0 + r + 1) * 264 + e] << 16);
        unsigned char* vb = F.RVT() + (size_t)ci * 32768 + ((e >> 4) * 2 + (i0 >> 5)) * 1024 + (e & 15) * 16;
#pragma unroll
        for (int q = 0; q < 4; ++q) *(u32x4*)(vb + q * 256) = (u32x4){w[4 * q], w[4 * q + 1], w[4 * q + 2], w[4 * q + 3]};
    }
    {
        const int c = lane & 15, g = lane >> 4;
#pragma unroll
        for (int x = 0; x < 2; ++x) { const int tt = 2 * wv + x, jt = tt >> 2, it = tt & 3;
            f32x4 acc = (f32x4){0.f, 0.f, 0.f, 0.f};
            if (it >= jt) {
#pragma unroll
                for (int s = 0; s < 4; ++s) { const bf16x8 A = lds_frag(kf + (16 * jt + c) * 132, s, g, 1.0f), B = lds_frag(qf + (16 * it + c) * 132, s, g, 1.0f); acc = MFMA16(A, B, acc); }
            }
            const int i = 16 * it + c; float r4[4];
#pragma unroll
            for (int r = 0; r < 4; ++r) { const int j = 16 * jt + 4 * g + r; r4[r] = (i >= j) ? acc[r] * fexp(lg * (float)(i - j)) : 0.f; }
            u32x2 w; w.x = pk2(r4[0], r4[1]); w.y = pk2(r4[2], r4[3]);
            *(u32x2*)(F.RCH() + (size_t)ci * RCH_BYTES + RCH_ATT + (it * 2 + (jt >> 1)) * 1024 + (c + 16 * (2 * (jt & 1) + (g >> 1))) * 16 + (g & 1) * 8) = w; }
    }
    __syncthreads();
}

__device__ __forceinline__ void gdn_prep(const Frame& F, int l, int ci) {
    const int tid = F.tid, lane = F.lane, wv = F.wave;
    const int bh = ci >> 5, n = ci & 31, b = bh >> 2, h = bh & 3, m0 = b * SEQ + n * CH;
    LAS bf16_t* raw = (LAS bf16_t*)F.lds;
    LAS float* qf = (LAS float*)F.lds;
    LAS float* kf = qf + 64 * 132;
    LAS bf16_t* wst = (LAS bf16_t*)F.lds;
    LAS float* Am = (LAS float*)(F.lds + 69888);
    LAS float* sm = (LAS float*)(F.lds + 86272);
    LAS float* bcum = sm; LAS float* beta = sm + 64; LAS float* rq = sm + 128; LAS float* rk = sm + 192; LAS float* eb = sm + 256;
    for (int p = tid; p < 67 * 64; p += 512) { const int row = p >> 6, pc = p & 63, col8 = pc * 8;
        const int sc = (pc < 16) ? PC_GQKV + h * DK + col8 : (pc < 32) ? PC_GQKV + 512 + h * DK + (col8 - 128) : PC_GQKV + 1024 + h * DV + (col8 - 256);
        const int t = n * CH + row - 3; u32x4 v = (u32x4){0u, 0u, 0u, 0u};
        if (t >= 0) v = *(const u32x4*)(F.PROJ() + (size_t)(b * SEQ + t) * NWIN + sc);
        *(LAS u32x4*)(raw + row * 520 + col8) = v; }
    if (wv == 0) { const int m = m0 + lane; const float a = F.AB()[(size_t)m * 8 + h], bb = F.AB()[(size_t)m * 8 + 4 + h];
        const float x = a + F.inp(17)[l * 4 + h]; const float sp = fmaxf(x, 0.f) + log1pf(expf(-fabsf(x)));
        float gg = -expf(F.inp(16)[l * 4 + h]) * sp;
#pragma unroll
        for (int o = 1; o < 64; o <<= 1) { const float t = __shfl_up(gg, o); if (lane >= o) gg += t; }
        bcum[lane] = gg; beta[lane] = 1.f / (1.f + expf(-bb)); eb[lane] = expf(gg); }
    __syncthreads();
    float x[64];
    {   const int col = (tid < 256) ? 256 + tid : (tid < 384) ? 128 + (tid - 256) : tid - 384;
        const int C = (tid < 256) ? 1024 + h * DV + tid : (tid < 384) ? 512 + h * DK + (tid - 256) : h * DK + (tid - 384);
        const float* cw = F.inp(15) + (size_t)l * 4 * CONVD + C; const float w0 = cw[0], w1 = cw[CONVD], w2 = cw[2 * CONVD], w3 = cw[3 * CONVD];
        float r0 = bf2f(raw[0 * 520 + col]), r1 = bf2f(raw[1 * 520 + col]), r2 = bf2f(raw[2 * 520 + col]);
#pragma unroll
        for (int i0 = 0; i0 < 64; i0 += 16) { unsigned rr[16];
#pragma unroll
            for (int i = 0; i < 16; ++i) rr[i] = raw[(i0 + i + 3) * 520 + col];
            asm volatile("" ::: "memory");
#pragma unroll
            for (int i = 0; i < 16; ++i) { const float r3 = bf2f(rr[i]); x[i0 + i] = siluf_(r0 * w0 + r1 * w1 + r2 * w2 + r3 * w3); r0 = r1; r1 = r2; r2 = r3; } }
    }
    __syncthreads();
    if (tid >= 256) { LAS float* dst = (tid < 384) ? kf + (tid - 256) : qf + (tid - 384);
#pragma unroll
        for (int i = 0; i < 64; ++i) dst[i * 132] = x[i]; }
    __syncthreads();
    {   const int i = tid >> 3, p = tid & 7; float sq = 0.f, sk = 0.f;
#pragma unroll
        for (int d = 0; d < 16; ++d) { const float a = qf[i * 132 + 16 * p + d], bq = kf[i * 132 + 16 * p + d]; sq += a * a; sk += bq * bq; }
        sq += __shfl_xor(sq, 1); sq += __shfl_xor(sq, 2); sq += __shfl_xor(sq, 4); sk += __shfl_xor(sk, 1); sk += __shfl_xor(sk, 2); sk += __shfl_xor(sk, 4);
        if (p == 0) { rq[i] = 0.08838834764831845f / sqrtf(sq + EPS); rk[i] = 1.f / sqrtf(sk + EPS); } }
    __syncthreads();
    unsigned char* gch = F.GCH() + (size_t)ci * GCH_BYTES; asm volatile("" : "+s"(gch));
#pragma unroll
    for (int rep = 0; rep < 2; ++rep) { const int idx = tid + 512 * rep;
        {   const int i = idx >> 4, s = (idx >> 2) & 3, g = idx & 3; const float sc = rq[i] * eb[i];
            const f32x4 lo = *(const LAS f32x4*)(qf + i * 132 + 32 * s + 4 * g), hi = *(const LAS f32x4*)(qf + i * 132 + 32 * s + 16 + 4 * g);
            *(bf16x8*)(gch + GCH_QD + ((i >> 4) * 4 + s) * 1024 + ((i & 15) + 16 * g) * 16) = pack8(lo * sc, hi * sc); }
        {   const int d = idx >> 3, s = (idx >> 2) & 1, g = idx & 3; const float bl = bcum[63]; float v[8];
#pragma unroll
            for (int j = 0; j < 8; ++j) { const int p = 32 * s + 16 * (j >> 2) + 4 * g + (j & 3); v[j] = kf[p * 132 + d] * rk[p] * fexp(bl - bcum[p]); }
            u32x4 w; w.x = pk2(v[0], v[1]); w.y = pk2(v[2], v[3]); w.z = pk2(v[4], v[5]); w.w = pk2(v[6], v[7]);
            *(u32x4*)(gch + GCH_KDT + ((d >> 4) * 2 + s) * 1024 + ((d & 15) + 16 * g) * 16) = w; }
    }
    if (tid == 0) F.GDCH()[ci] = fexp(bcum[63]);
    {
        const int c = lane & 15, g = lane >> 4, jt = wv >> 1;
        bf16x8 A[4];
#pragma unroll
        for (int s = 0; s < 4; ++s) A[s] = lds_frag(kf + (16 * jt + c) * 132, s, g, rk[16 * jt + c]);
#pragma unroll
        for (int xx = 0; xx < 2; ++xx) { const int it = 2 * (wv & 1) + xx, i = 16 * it + c;
            f32x4 aq = (f32x4){0.f, 0.f, 0.f, 0.f}, ak = (f32x4){0.f, 0.f, 0.f, 0.f};
            if (it >= jt) {
#pragma unroll
                for (int s = 0; s < 4; ++s) { const bf16x8 Bq = lds_frag(qf + i * 132, s, g, rq[i]), Bk = lds_frag(kf + i * 132, s, g, rk[i]); aq = MFMA16(A[s], Bq, aq); ak = MFMA16(Bk, A[s], ak); }
            }
            const float bi = bcum[i]; float ra[4]; f32x4 rm;
#pragma unroll
            for (int r = 0; r < 4; ++r) { const int j = 16 * jt + 4 * g + r; const float dec = fexp(fminf(bi - bcum[j], 0.f)); ra[r] = (i >= j) ? aq[r] * dec : 0.f; }
            const int j2 = 16 * jt + c; const float bj2 = bcum[j2];
#pragma unroll
            for (int r = 0; r < 4; ++r) { const int i2 = 16 * it + 4 * g + r; rm[r] = (i2 > j2) ? beta[i2] * ak[r] * fexp(fminf(bcum[i2] - bj2, 0.f)) : 0.f; }
            u32x2 w; w.x = pk2(ra[0], ra[1]); w.y = pk2(ra[2], ra[3]);
            *(u32x2*)(gch + GCH_ATT + (it * 2 + (jt >> 1)) * 1024 + (c + 16 * g) * 16 + (jt & 1) * 8) = w;
            *(LAS f32x4*)(Am + j2 * 64 + 16 * it + 4 * g) = rm; }
    }
    __syncthreads();
    if (tid < 384) {
        int z0; asm volatile("v_mov_b32 %0, 0" : "=v"(z0)); const LAS float* Amz = Am + z0; const LAS float* smz = sm + z0;
        if (tid < 256) {
#pragma unroll
            for (int i = 0; i < 64; ++i) x[i] *= smz[64 + i];
        } else {
#pragma unroll
            for (int i = 0; i < 64; ++i) x[i] *= smz[64 + i] * smz[192 + i] * smz[256 + i];
        }
#pragma unroll
        for (int j = 0; j < 63; ++j) { const float xj = x[j];
#pragma unroll
            for (int i4 = (j + 1) / 4; i4 < 16; ++i4) { const f32x4 a = *(const LAS f32x4*)(Amz + j * 64 + 4 * i4);
                if (4 * i4 > j) x[4 * i4] -= a.x * xj; if (4 * i4 + 1 > j) x[4 * i4 + 1] -= a.y * xj; if (4 * i4 + 2 > j) x[4 * i4 + 2] -= a.z * xj; x[4 * i4 + 3] -= a.w * xj; } CBAR(); }
        if (tid < 256) { float* dstb = F.GUT() + (size_t)ci * 16384; asm volatile("" : "+s"(dstb)); float* dst = dstb + (tid >> 4) * 1024 + (tid & 15) * 4;
#pragma unroll
            for (int q = 0; q < 16; ++q) *(f32x4*)(dst + (q >> 2) * 256 + (q & 3) * 64) = (f32x4){x[4 * q], x[4 * q + 1], x[4 * q + 2], x[4 * q + 3]}; }
        else { const int d = tid - 256;
#pragma unroll
            for (int i = 0; i < 64; ++i) wst[i * 136 + d] = (bf16_t)f2bf(x[i]); }
    }
    __syncthreads();
#pragma unroll
    for (int rep = 0; rep < 2; ++rep) { const int idx = tid + 512 * rep, i = idx >> 4, s = (idx >> 2) & 3, g = idx & 3;
        const u32x2 lo = *(const LAS u32x2*)(wst + i * 136 + 32 * s + 4 * g), hi = *(const LAS u32x2*)(wst + i * 136 + 32 * s + 16 + 4 * g);
        *(u32x4*)(gch + GCH_W + ((i >> 4) * 4 + s) * 1024 + ((i & 15) + 16 * g) * 16) = (u32x4){lo.x, lo.y, hi.x, hi.y}; }
    __syncthreads();
}

__device__ __forceinline__ void mem_attn_unit(const Frame& F, int l, int u) {
    const int lane = F.lane, wv = F.wave, c = lane & 15, g = lane >> 4;
    const int bh = u >> 4, qb = u & 15, b = bh >> 2, h = bh & 3, mq = b * SEQ + qb * 128 + wv * 16;
    bf16x8 Qf[8]; { const unsigned qo = ((unsigned)(mq + c) * NWIN + PC_MQ + h * 256) * 2u;
#pragma unroll
        for (int s = 0; s < 8; ++s) Qf[s] = ldnat(F.PROJ(), qo, s, g); }
    asm volatile("s_waitcnt vmcnt(0)" ::: "memory");
    const unsigned char* kf = (const unsigned char*)F.MK() + ((((size_t)l * NB + b) * NH + h) << 17) + lane * 16;
    const unsigned char* vf = (const unsigned char*)F.MVT() + ((((size_t)l * NB + b) * NH + h) << 17) + lane * 16;
    LAS unsigned char* ring = F.lds;
#define ATT_DMA(ch_) do { const unsigned char* src_ = ((ch_) < 4 ? kf + (ch_) * 32768 : vf + ((ch_) - 4) * 32768); LAS unsigned char* dst_ = ring + ((ch_) % 3) * 32768; \
        _Pragma("unroll") for (int k_ = 0; k_ < 4; ++k_) __builtin_amdgcn_global_load_lds((const unsigned*)(src_ + (wv + 8 * k_) * 1024), (LAS unsigned*)(dst_ + (wv + 8 * k_) * 1024), 16, 0, 0); } while (0)
#define ATT_WAIT(n_) do { if ((n_) == 4) asm volatile("s_waitcnt vmcnt(4)" ::: "memory"); else if ((n_) == 8) asm volatile("s_waitcnt vmcnt(8)" ::: "memory"); else asm volatile("s_waitcnt vmcnt(12)" ::: "memory"); \
        __builtin_amdgcn_s_barrier(); asm volatile("" ::: "memory"); } while (0)
    ATT_DMA(0); ATT_DMA(1);
    f32x4 sacc[16]; bf16x8 Pf[8]; float inv = 1.f;
    bf16_t* obase = F.OBR() + 2 * OBR_STRIDE; const unsigned oo = ((unsigned)(mq + c) * D + h * 256 + 4 * g) * 2u;
#pragma unroll
    for (int ch = 0; ch < 8; ++ch) {
        ATT_WAIT((ch + 1 < 8 ? 4 : 0) + (ch - 1 >= 4 ? 4 : 0) + (ch - 2 >= 4 ? 4 : 0));
        if (ch + 2 < 8) ATT_DMA(ch + 2);
        const LAS unsigned char* Bq = ring + (ch % 3) * 32768 + lane * 16;
        if (ch < 4) {
#pragma unroll
            for (int k4 = 0; k4 < 4; ++k4) { f32x4 a0 = (f32x4){0.f, 0.f, 0.f, 0.f};
#pragma unroll
                for (int s = 0; s < 8; ++s) a0 = MFMA16(*(const LAS bf16x8*)(Bq + (k4 * 8 + s) * 1024), Qf[s], a0);
                sacc[4 * ch + k4] = a0; }
            if (ch == 3) {
                float mx = -3.0e38f;
#pragma unroll
                for (int kt = 0; kt < 16; ++kt)
#pragma unroll
                    for (int r = 0; r < 4; ++r) mx = fmaxf(mx, sacc[kt][r]);
                mx = fmaxf(mx, __shfl_xor(mx, 16)); mx = fmaxf(mx, __shfl_xor(mx, 32));
                float sum = 0.f; const float sc = 0.0625f * 1.4426950408889634f;
#pragma unroll
                for (int kt = 0; kt < 16; ++kt)
#pragma unroll
                    for (int r = 0; r < 4; ++r) { const float p = __builtin_amdgcn_exp2f((sacc[kt][r] - mx) * sc); sacc[kt][r] = p; sum += p; }
                sum += __shfl_xor(sum, 16); sum += __shfl_xor(sum, 32);
                inv = 1.f / sum;
#pragma unroll
                for (int ks = 0; ks < 8; ++ks) Pf[ks] = pack8(sacc[2 * ks], sacc[2 * ks + 1]);
            }
        } else {
#pragma unroll
            for (int e4 = 0; e4 < 4; ++e4) { f32x4 a0 = (f32x4){0.f, 0.f, 0.f, 0.f}; const int et = 4 * (ch - 4) + e4;
#pragma unroll
                for (int ks = 0; ks < 8; ++ks) a0 = MFMA16(*(const LAS bf16x8*)(Bq + (e4 * 8 + ks) * 1024), Pf[ks], a0);
                u32x2 w; w.x = pk2(a0[0] * inv, a0[1] * inv); w.y = pk2(a0[2] * inv, a0[3] * inv);
                *(u32x2*)((char*)obase + (oo + 32u * et)) = w; }
        }
        asm volatile("" ::: "memory");
    }
    asm volatile("s_waitcnt lgkmcnt(0)" ::: "memory"); __builtin_amdgcn_s_barrier(); asm volatile("" ::: "memory");
#undef ATT_DMA
#undef ATT_WAIT
}

template <bool GDN> __device__ __forceinline__ void scan_bh(const Frame& F, int l, int bh) {
    const int lane = F.lane, wv = F.wave, c = lane & 15, g = lane >> 4, b = bh >> 2, h = bh & 3, e0 = 32 * wv;
    constexpr int CHB = GDN ? GCH_BYTES : RCH_BYTES, NBLK = CHB / 1024, OQD = GDN ? GCH_QD : RCH_QD, OATT = GDN ? GCH_ATT : RCH_ATT, OKDT = GDN ? GCH_KDT : RCH_KDT, LBUF = 57344;
    const unsigned char* chb = (GDN ? F.GCH() : F.RCH()) + (size_t)(bh * 32) * CHB + lane * 16;
    LAS unsigned char* lbuf = F.lds;
    LAS float* ssq = (LAS float*)(F.lds + 2 * LBUF);
    const float lg = log1pf(-exp2f(-5.0f - (float)h)); const float dch_ret = fexp(lg * 64.f);
    f32x4 S[8][2];
#pragma unroll
    for (int t = 0; t < 8; ++t) { S[t][0] = (f32x4){0.f, 0.f, 0.f, 0.f}; S[t][1] = (f32x4){0.f, 0.f, 0.f, 0.f}; }
    const int colg = (GDN ? PC_GZ : PC_RG) + h * DV;
    bf16_t* obr = F.OBR() + (GDN ? OBR_STRIDE : 0); const bf16_t* PROJp = F.PROJ();
    f32x4 gn[2]; gn[0] = (f32x4){1.f, 1.f, 1.f, 1.f}; gn[1] = gn[0];
    if (GDN) { gn[0] = *(const f32x4*)(F.inp(18) + l * DV + e0 + 4 * g); gn[1] = *(const f32x4*)(F.inp(18) + l * DV + e0 + 16 + 4 * g); }
#define SCAN_STAGE(n_, bi_) do { _Pragma("unroll") for (int k_ = 0; k_ < (NBLK + 7) / 8; ++k_) { const int kb_ = wv + 8 * k_; if (kb_ < NBLK) \
        __builtin_amdgcn_global_load_lds((const unsigned*)(chb + (size_t)(n_) * CHB + kb_ * 1024), (LAS unsigned*)(lbuf + (bi_) * LBUF + kb_ * 1024), 16, 0, 0); } } while (0)
#define LFRAG(off_) (*(const LAS bf16x8*)(Bq + (off_)))
#define RAW_BAR() do { asm volatile("s_waitcnt lgkmcnt(0)" ::: "memory"); __builtin_amdgcn_s_barrier(); asm volatile("" ::: "memory"); } while (0)
#define LOAD_GATES(dst_, n_) do { unsigned m0o_ = (unsigned)(b * SEQ + (n_) * CH + c); asm volatile("" : "+v"(m0o_)); const unsigned pb_ = (m0o_ * NWIN + colg + e0 + 4 * g) * 2u; \
        _Pragma("unroll") for (int rt_ = 0; rt_ < 4; ++rt_) { dst_[rt_][0] = *(const u32x2*)((const char*)PROJp + (pb_ + (unsigned)(16 * rt_) * NWIN * 2u)); dst_[rt_][1] = *(const u32x2*)((const char*)PROJp + (pb_ + (unsigned)(16 * rt_) * NWIN * 2u + 32u)); } } while (0)
    u32x2 gw[4][2];
    SCAN_STAGE(0, 0);
    LOAD_GATES(gw, 0);
    asm volatile("s_waitcnt vmcnt(0)" ::: "memory"); RAW_BAR();
    for (int n = 0; n < NCH; ++n) {
        unsigned ci = (unsigned)(bh * 32 + n); asm volatile("" : "+v"(ci) :: "memory");
        const int m0 = b * SEQ + n * CH, buf = n & 1;
        const LAS unsigned char* Bq = lbuf + buf * LBUF + lane * 16;
        f32x4 vn[4][2]; bf16x8 Vb[2][2];
        if (GDN) {
            const float* up = F.GUT() + (size_t)(bh * 32 + n) * 16384 + (2 * wv) * 1024 + lane * 4;
#pragma unroll
            for (int rt = 0; rt < 4; ++rt) { vn[rt][0] = *(const f32x4*)(up + rt * 256); vn[rt][1] = *(const f32x4*)(up + 1024 + rt * 256); }
        } else {
            const unsigned char* vp = F.RVT() + (size_t)(bh * 32 + n) * 32768 + (2 * wv) * 2048 + lane * 16;
#pragma unroll
            for (int s = 0; s < 2; ++s) { Vb[s][0] = *(const bf16x8*)(vp + s * 1024); Vb[s][1] = *(const bf16x8*)(vp + 2048 + s * 1024); }
        }
        float dch = dch_ret;
        if (GDN) { unsigned dci = (unsigned)(bh * 32 + n) * 4u + (unsigned)(lane & 0) ; asm volatile("" : "+v"(dci)); dch = *(const float*)((const char*)F.GDCH() + dci); }
        CBAR();
        u32x2 gwn[4][2];
#define ISSUE_NEXT() do { if (n + 1 < NCH) { SCAN_STAGE(n + 1, buf ^ 1); CBAR(); LOAD_GATES(gwn, n + 1); } else { _Pragma("unroll") for (int rt_ = 0; rt_ < 4; ++rt_) { gwn[rt_][0] = gw[rt_][0]; gwn[rt_][1] = gw[rt_][1]; } } CBAR(); } while (0)
        bf16x8 Sb[4][2];
#pragma unroll
        for (int s = 0; s < 4; ++s) { Sb[s][0] = pack8(S[2 * s][0], S[2 * s + 1][0]); Sb[s][1] = pack8(S[2 * s][1], S[2 * s + 1][1]); }
        if (GDN) {
#pragma unroll
            for (int rt = 0; rt < 4; ++rt) { f32x4 p0 = (f32x4){0.f, 0.f, 0.f, 0.f}, p1 = p0;
#pragma unroll
                for (int s = 0; s < 4; ++s) { const bf16x8 A = LFRAG(GCH_W + (rt * 4 + s) * 1024); p0 = MFMA16(A, Sb[s][0], p0); p1 = MFMA16(A, Sb[s][1], p1); }
                vn[rt][0] -= p0; vn[rt][1] -= p1; if (rt & 1) CBAR(); }
#pragma unroll
            for (int s = 0; s < 2; ++s) { Vb[s][0] = pack8(vn[2 * s][0], vn[2 * s + 1][0]); Vb[s][1] = pack8(vn[2 * s][1], vn[2 * s + 1][1]); }
            CBAR();
            ISSUE_NEXT();
        }
        f32x4 OT[4][2];
#pragma unroll
        for (int rt = 0; rt < 4; ++rt) { f32x4 o0 = (f32x4){0.f, 0.f, 0.f, 0.f}, o1 = o0;
#pragma unroll
            for (int s = 0; s < 4; ++s) { const bf16x8 Bf = LFRAG(OQD + (rt * 4 + s) * 1024); o0 = MFMA16(Sb[s][0], Bf, o0); o1 = MFMA16(Sb[s][1], Bf, o1); }
            OT[rt][0] = o0; OT[rt][1] = o1; if (rt & 1) CBAR(); }
#pragma unroll
        for (int rt = 0; rt < 4; ++rt) { f32x4 o0 = OT[rt][0], o1 = OT[rt][1];
#pragma unroll
            for (int s = 0; s < 2; ++s) { const bf16x8 Bf = LFRAG(OATT + (rt * 2 + s) * 1024); o0 = MFMA16(Vb[s][0], Bf, o0); o1 = MFMA16(Vb[s][1], Bf, o1); }
            OT[rt][0] = o0; OT[rt][1] = o1; }
        CBAR();
        if (!GDN) ISSUE_NEXT();
#undef ISSUE_NEXT
#pragma unroll
        for (int t = 0; t < 8; ++t) { f32x4 s0 = S[t][0] * dch, s1 = S[t][1] * dch;
#pragma unroll
            for (int s = 0; s < 2; ++s) { const bf16x8 A = LFRAG(OKDT + (t * 2 + s) * 1024); s0 = MFMA16(A, Vb[s][0], s0); s1 = MFMA16(A, Vb[s][1], s1); }
            S[t][0] = s0; S[t][1] = s1; if ((t & 3) == 3) CBAR(); }
#pragma unroll
        for (int rt = 0; rt < 4; ++rt) { float q = 0.f;
#pragma unroll
            for (int r = 0; r < 4; ++r) q += OT[rt][0][r] * OT[rt][0][r] + OT[rt][1][r] * OT[rt][1][r];
            q += __shfl_xor(q, 16); q += __shfl_xor(q, 32);
            if (g == 0) ssq[(buf * 8 + wv) * 64 + 16 * rt + c] = q; }
        RAW_BAR();
        {   unsigned m0o = (unsigned)(m0 + c); asm volatile("" : "+v"(m0o));
            const unsigned ob = (m0o * D + h * DV + e0 + 4 * g) * 2u;
#pragma unroll
            for (int rt = 0; rt < 4; ++rt) { float tot = 0.f;
#pragma unroll
                for (int w = 0; w < 8; ++w) tot += ssq[(buf * 8 + w) * 64 + 16 * rt + c];
                const float rstd = 1.f / sqrtf(tot * (1.f / DV) + EPS);
#pragma unroll
                for (int cb = 0; cb < 2; ++cb) { const u32x2 gq = gw[rt][cb]; const f32x4 o = OT[rt][cb] * rstd;
                    const float r0 = o[0] * siluf_(bf2f(gq.x & 0xffffu)) * gn[cb][0], r1 = o[1] * siluf_(bf2f(gq.x >> 16)) * gn[cb][1], r2 = o[2] * siluf_(bf2f(gq.y & 0xffffu)) * gn[cb][2], r3 = o[3] * siluf_(bf2f(gq.y >> 16)) * gn[cb][3];
                    u32x2 w2; w2.x = pk2(r0, r1); w2.y = pk2(r2, r3);
                    *(u32x2*)((char*)obr + (ob + (unsigned)(16 * rt) * D * 2u + 32u * cb)) = w2; } } }
#pragma unroll
        for (int rt = 0; rt < 4; ++rt) { gw[rt][0] = gwn[rt][0]; gw[rt][1] = gwn[rt][1]; }
        asm volatile("s_waitcnt vmcnt(8)" ::: "memory"); RAW_BAR();
    }
#undef RAW_BAR
#undef LOAD_GATES
#undef SCAN_STAGE
#undef LFRAG
    float* so = F.out + (GDN ? O_SGP : O_SRP) + ((size_t)(l * NB + b) * NH + h) * (size_t)(DK * DV);
    unsigned sbo = (unsigned)((4 * g) * DV + e0 + c) * 4u; asm volatile("" : "+v"(sbo));
#pragma unroll
    for (int t = 0; t < 8; ++t)
#pragma unroll
        for (int cb = 0; cb < 2; ++cb)
#pragma unroll
            for (int r = 0; r < 4; ++r) *(float*)((char*)so + (sbo + (unsigned)((16 * t + r) * DV + 16 * cb) * 4u)) = S[t][cb][r];
}

template <bool GDN> __device__ __forceinline__ void sample_step(const Frame& F, int l, int item) {
    const int tid = F.tid, lane = F.lane, wv = F.wave, s = item >> 2, h = item & 3; const size_t m = (size_t)(MP + s);
    LAS float* qv = (LAS float*)F.lds;
    LAS float* kv = qv + 128;
    LAS float* vv = qv + 256;
    LAS float* sc = qv + 512;
    LAS float* partq = qv + 1024;
    LAS float* partk = partq + 2048;
    float dec, beta_ = 1.f;
    if (GDN) {
        const int C = (tid < 256) ? 1024 + h * DV + tid : (tid < 384) ? 512 + h * DK + (tid - 256) : h * DK + (tid - 384);
        const float* cbp = F.inp(5) + ((size_t)(l * MS + s) * 3) * CONVD + C; const float* cw = F.inp(15) + (size_t)l * 4 * CONVD + C;
        const float c0 = cbp[0], c1 = cbp[CONVD], c2 = cbp[2 * CONVD], rw = bf2f(F.PROJ()[m * NWIN + PC_GQKV + C]);
        const float val = siluf_(c0 * cw[0] + c1 * cw[CONVD] + c2 * cw[2 * CONVD] + rw * cw[3 * CONVD]);
        float* cvo = F.out + O_CVS + ((size_t)(l * MS + s) * 3) * CONVD + C; cvo[0] = c1; cvo[CONVD] = c2; cvo[2 * CONVD] = rw;
        if (tid < 256) vv[tid] = val; else if (tid < 384) kv[tid - 256] = val; else qv[tid - 384] = val;
        __syncthreads();
        if (wv < 2) { LAS float* p = (wv == 0) ? qv : kv; const float a = p[lane], bq = p[lane + 64]; const float ss = wave_sum(a * a + bq * bq);
            if (lane == 0) sc[wv] = (wv == 0) ? 0.08838834764831845f / sqrtf(ss + EPS) : 1.f / sqrtf(ss + EPS); }
        __syncthreads();
        const float rq = sc[0], rk = sc[1];
        __syncthreads();
        if (tid < 128) { qv[tid] *= rq; kv[tid] *= rk; }
        const float a = F.AB()[m * 8 + h], bb = F.AB()[m * 8 + 4 + h]; const float x = a + F.inp(17)[l * 4 + h]; const float sp = fmaxf(x, 0.f) + log1pf(expf(-fabsf(x)));
        dec = expf(-expf(F.inp(16)[l * 4 + h]) * sp); beta_ = 1.f / (1.f + expf(-bb));
    } else {
        if (tid < 64) { const int d = tid; const bf16_t* qrow = F.PROJ() + m * NWIN + PC_RQ + h * DK; const bf16_t* krow = F.PROJ() + m * NWIN + PC_RK + h * DK;
            const float cs = F.COS()[2048 * 64 + d], sn = F.SIN()[2048 * 64 + d]; const float q1 = bf2f(qrow[d]), q2 = bf2f(qrow[d + 64]), k1 = bf2f(krow[d]), k2 = bf2f(krow[d + 64]);
            qv[d] = q1 * cs - q2 * sn; qv[d + 64] = q1 * sn + q2 * cs; kv[d] = (k1 * cs - k2 * sn) * 0.08838834764831845f; kv[d + 64] = (k1 * sn + k2 * cs) * 0.08838834764831845f; }
        else if (tid < 320) vv[tid - 64] = bf2f(F.PROJ()[m * NWIN + PC_RV + h * DV + (tid - 64)]);
        dec = 1.f - exp2f(-5.0f - (float)h);
    }
    __syncthreads();
    float qk = 0.f;
#pragma unroll 8
    for (int d = 0; d < 128; ++d) qk += qv[d] * kv[d];
    const int e4 = lane * 4, dq = wv;
    const size_t sofs = ((size_t)(l * MS + s) * NH + h) * (size_t)(DK * DV);
    const float* S0 = F.inp(GDN ? 4 : 3) + sofs + (size_t)(16 * dq) * DV + e4;
    f32x4 st[16]; f32x4 aq = (f32x4){0.f, 0.f, 0.f, 0.f}, ak = aq;
#pragma unroll
    for (int i = 0; i < 16; ++i) st[i] = *(const f32x4*)(S0 + (size_t)i * DV);
#pragma unroll
    for (int i = 0; i < 16; ++i) { aq += st[i] * qv[16 * dq + i]; if (GDN) ak += st[i] * kv[16 * dq + i]; }
    *(LAS f32x4*)(partq + dq * 256 + e4) = aq; if (GDN) *(LAS f32x4*)(partk + dq * 256 + e4) = ak;
    __syncthreads();
    f32x4 qS = (f32x4){0.f, 0.f, 0.f, 0.f}, kS = qS;
#pragma unroll
    for (int w = 0; w < 8; ++w) { qS += *(const LAS f32x4*)(partq + w * 256 + e4); if (GDN) kS += *(const LAS f32x4*)(partk + w * 256 + e4); }
    const f32x4 v4 = *(const LAS f32x4*)(vv + e4);
    const f32x4 vnew = GDN ? (v4 - kS * dec) * beta_ : v4;
    const f32x4 o = qS * dec + vnew * qk;
    float* S1 = F.out + (GDN ? O_SGS : O_SRS) + sofs + (size_t)(16 * dq) * DV + e4;
#pragma unroll
    for (int i = 0; i < 16; ++i) *(f32x4*)(S1 + (size_t)i * DV) = st[i] * dec + vnew * kv[16 * dq + i];
    const float ssq = wave_sum((o.x * o.x + o.y * o.y) + (o.z * o.z + o.w * o.w));
    if (dq == 0) { const float rstd = 1.f / sqrtf(ssq * (1.f / DV) + EPS); const bf16_t* gp = F.PROJ() + m * NWIN + (GDN ? PC_GZ : PC_RG) + h * DV + e4; float r4[4];
#pragma unroll
        for (int j = 0; j < 4; ++j) { float gate = siluf_(bf2f(gp[j])); if (GDN) gate *= F.inp(18)[l * DV + e4 + j]; r4[j] = o[j] * rstd * gate; }
        u32x2 w; w.x = pk2(r4[0], r4[1]); w.y = pk2(r4[2], r4[3]);
        *(u32x2*)(F.OBR() + (GDN ? OBR_STRIDE : 0) + m * D + h * DV + e4) = w; }
    __syncthreads();
}
__device__ __forceinline__ void sample_attn(const Frame& F, int l, int item) {
    const int tid = F.tid, lane = F.lane, wv = F.wave, s = item >> 2, h = item & 3; const size_t m = (size_t)(MP + s);
    LAS float* scs = (LAS float*)F.lds;
    LAS float* part = scs + 512;
    LAS float* sinv = scs + 256;
    f32x4 q4; { const u32x2 qw = *(const u32x2*)(F.PROJ() + m * NWIN + PC_MQ + h * 256 + lane * 4); q4 = (f32x4){bf2f(qw.x & 0xffffu), bf2f(qw.x >> 16), bf2f(qw.y & 0xffffu), bf2f(qw.y >> 16)}; }
    const float* Kb = F.inp(6) + (((size_t)(l * MS + s) * NMEM) * NH + h) * 256 + lane * 4;
    const float* Vb = F.inp(7) + (((size_t)(l * MS + s) * NMEM) * NH + h) * 256 + lane * 4;
    float myscore = 0.f;
#pragma unroll
    for (int k8 = 0; k8 < 4; ++k8) { f32x4 kk[8];
#pragma unroll
        for (int j = 0; j < 8; ++j) kk[j] = *(const f32x4*)(Kb + (size_t)(32 * wv + 8 * k8 + j) * (NH * 256));
#pragma unroll
        for (int j = 0; j < 8; ++j) { const float d = wave_sum((kk[j].x * q4.x + kk[j].y * q4.y) + (kk[j].z * q4.z + kk[j].w * q4.w)); if (lane == 8 * k8 + j) myscore = d; } }
    if (lane < 32) scs[32 * wv + lane] = myscore * 0.0625f;
    __syncthreads();
    if (wv == 0) { const f32x4 s4 = *(const LAS f32x4*)(scs + 4 * lane); float mx = fmaxf(fmaxf(s4.x, s4.y), fmaxf(s4.z, s4.w));
#pragma unroll
        for (int o = 1; o < 64; o <<= 1) mx = fmaxf(mx, __shfl_xor(mx, o));
        const f32x4 p = (f32x4){fexp(s4.x - mx), fexp(s4.y - mx), fexp(s4.z - mx), fexp(s4.w - mx)}; const float sum = wave_sum((p.x + p.y) + (p.z + p.w));
        *(LAS f32x4*)(scs + 4 * lane) = p; if (lane == 0) sinv[0] = 1.f / sum; }
    __syncthreads();
    f32x4 acc = (f32x4){0.f, 0.f, 0.f, 0.f};
#pragma unroll
    for (int k8 = 0; k8 < 4; ++k8) { f32x4 vv[8];
#pragma unroll
        for (int j = 0; j < 8; ++j) vv[j] = *(const f32x4*)(Vb + (size_t)(32 * wv + 8 * k8 + j) * (NH * 256));
#pragma unroll
        for (int j = 0; j < 8; ++j) acc += vv[j] * scs[32 * wv + 8 * k8 + j]; }
    *(LAS f32x4*)(part + wv * 256 + lane * 4) = acc;
    __syncthreads();
    if (wv == 0) { f32x4 o = (f32x4){0.f, 0.f, 0.f, 0.f};
#pragma unroll
        for (int w = 0; w < 8; ++w) o += *(const LAS f32x4*)(part + w * 256 + lane * 4);
        o = o * sinv[0]; u32x2 w2; w2.x = pk2(o.x, o.y); w2.y = pk2(o.z, o.w);
        *(u32x2*)(F.OBR() + 2 * OBR_STRIDE + m * D + h * 256 + lane * 4) = w2; }
    __syncthreads();
}

struct SEpiF32 { static constexpr int NBF = 1, NSEG = 1; float* C;
    __device__ __forceinline__ int brow(int st, int) const { return 16 * st; }
    __device__ __forceinline__ void fold(f32x4 (&tot)[1], const f32x4 (&acc)[1], int, int, int, int) const { tot[0] = acc[0]; }
    __device__ __forceinline__ void store(const f32x4 (&tot)[1], int row, int st, int g) const { *(f32x4*)(C + (size_t)row * D + 16 * st + 4 * g) = tot[0]; } };
struct SEpiBf16 { static constexpr int NBF = 1, NSEG = 1; bf16_t* O; int ldc;
    __device__ __forceinline__ int brow(int st, int) const { return 16 * st; }
    __device__ __forceinline__ void fold(f32x4 (&tot)[1], const f32x4 (&acc)[1], int, int, int, int) const { tot[0] = acc[0]; }
    __device__ __forceinline__ void store(const f32x4 (&tot)[1], int row, int st, int g) const { u32x2 w; w.x = pk2(tot[0][0], tot[0][1]); w.y = pk2(tot[0][2], tot[0][3]); *(u32x2*)(O + (size_t)row * ldc + 16 * st + 4 * g) = w; } };
struct SEpiSwiGLU { static constexpr int NBF = 2, NSEG = 1; bf16_t* O;
    __device__ __forceinline__ int brow(int st, int bfi) const { return (st >> 3) * 256 + (st & 7) * 16 + 128 * bfi; }
    __device__ __forceinline__ void fold(f32x4 (&tot)[2], const f32x4 (&acc)[2], int, int, int, int) const { tot[0] = acc[0]; tot[1] = acc[1]; }
    __device__ __forceinline__ void store(const f32x4 (&tot)[2], int row, int st, int g) const { float r[4];
#pragma unroll
        for (int j = 0; j < 4; ++j) r[j] = siluf_(tot[0][j]) * tot[1][j];
        u32x2 w; w.x = pk2(r[0], r[1]); w.y = pk2(r[2], r[3]); *(u32x2*)(O + (size_t)row * DFF + 16 * st + 4 * g) = w; } };
struct SEpiBranch { static constexpr int NBF = 1, NSEG = 3; bf16_t* O; const bf16_t* proj;
    __device__ __forceinline__ int brow(int st, int) const { return 16 * st; }
    __device__ __forceinline__ void fold(f32x4 (&tot)[1], const f32x4 (&acc)[1], int seg, int row, int st, int g) const {
        const u32x2 gw = *(const u32x2*)(proj + (size_t)row * NWIN + PC_GATE + seg * D + 16 * st + 4 * g);
        const f32x4 gt = (f32x4){sigmoidf_(bf2f(gw.x & 0xffffu)), sigmoidf_(bf2f(gw.x >> 16)), sigmoidf_(bf2f(gw.y & 0xffffu)), sigmoidf_(bf2f(gw.y >> 16))};
        tot[0] = (seg == 0) ? gt * acc[0] : tot[0] + gt * acc[0]; }
    __device__ __forceinline__ void store(const f32x4 (&tot)[1], int row, int st, int g) const { u32x2 w; w.x = pk2(tot[0][0], tot[0][1]); w.y = pk2(tot[0][2], tot[0][3]); *(u32x2*)(O + (size_t)row * D + 16 * st + 4 * g) = w; } };
template <int K, class EpiS> __device__ __forceinline__ void small_gemm(const Frame& F, const bf16_t* A, size_t aseg, const bf16_t* Bt, size_t bseg, int nstrips, int first, int count, const EpiS& E) {
    const int j = (F.bid - first + F.G) % F.G; if (j >= count) return;
    constexpr int NBF = EpiS::NBF, KQ = K / 4, NKS = KQ / 32, BATCH = (NBF == 2) ? 4 : 8;
    const int lane = F.lane, wv = F.wave, c = lane & 15, g = lane >> 4, rh = wv & 1, kq = wv >> 1;
    LAS f32x4* red = (LAS f32x4*)F.lds;
    for (int st = j; st < nstrips; st += count) {
        f32x4 tot[NBF][4];
#pragma unroll
        for (int seg = 0; seg < EpiS::NSEG; ++seg) {
            f32x4 acc[NBF][4];
#pragma unroll
            for (int q = 0; q < NBF; ++q)
#pragma unroll
                for (int t = 0; t < 4; ++t) acc[q][t] = (f32x4){0.f, 0.f, 0.f, 0.f};
            const char* ap = (const char*)(A + seg * aseg); unsigned ao = ((unsigned)(MP + rh * 64 + c) * K + kq * KQ + 8 * g) * 2u; asm volatile("" : "+v"(ao));
            const char* bp = (const char*)(Bt + seg * bseg); unsigned bo[NBF];
#pragma unroll
            for (int q = 0; q < NBF; ++q) { bo[q] = ((unsigned)(E.brow(st, q) + c) * K + kq * KQ + 8 * g) * 2u; asm volatile("" : "+v"(bo[q])); }
#pragma unroll
            for (int ks0 = 0; ks0 < NKS; ks0 += BATCH) {
                bf16x8 af[4][BATCH], bfr[NBF][BATCH];
#pragma unroll
                for (int s = 0; s < BATCH; ++s) if (ks0 + s < NKS) {
#pragma unroll
                    for (int q = 0; q < NBF; ++q) bfr[q][s] = *(const bf16x8*)(bp + (bo[q] + (unsigned)(ks0 + s) * 64u));
#pragma unroll
                    for (int t = 0; t < 4; ++t) af[t][s] = *(const bf16x8*)(ap + (ao + (unsigned)(t * 16 * K * 2) + (unsigned)(ks0 + s) * 64u)); }
#pragma unroll
                for (int s = 0; s < BATCH; ++s) if (ks0 + s < NKS) {
#pragma unroll
                    for (int q = 0; q < NBF; ++q)
#pragma unroll
                        for (int t = 0; t < 4; ++t) acc[q][t] = MFMA16(bfr[q][s], af[t][s], acc[q][t]); }
                CBAR();
            }
#pragma unroll
            for (int t = 0; t < 4; ++t) { f32x4 a1[NBF], t1[NBF];
#pragma unroll
                for (int q = 0; q < NBF; ++q) { a1[q] = acc[q][t]; t1[q] = tot[q][t]; }
                E.fold(t1, a1, seg, MP + (rh * 4 + t) * 16 + c, st, g);
#pragma unroll
                for (int q = 0; q < NBF; ++q) tot[q][t] = t1[q]; }
        }
#pragma unroll
        for (int q = 0; q < NBF; ++q)
#pragma unroll
            for (int t = 0; t < 4; ++t) red[((q * 8 + wv) * 4 + t) * 64 + lane] = tot[q][t];
        __syncthreads();
        {   f32x4 fin[NBF];
#pragma unroll
            for (int q = 0; q < NBF; ++q) { f32x4 s4 = (f32x4){0.f, 0.f, 0.f, 0.f};
#pragma unroll
                for (int k2 = 0; k2 < 4; ++k2) s4 += red[((q * 8 + rh + 2 * k2) * 4 + kq) * 64 + lane];
                fin[q] = s4; }
            E.store(fin, MP + (rh * 4 + kq) * 16 + c, st, g); }
        __syncthreads();
    }
}

__device__ __forceinline__ const void* opaque_ptr(const void* p) { unsigned lo = __builtin_amdgcn_readfirstlane((unsigned)(size_t)p), hi = __builtin_amdgcn_readfirstlane((unsigned)((size_t)p >> 32));
    asm volatile("" : "+s"(lo), "+s"(hi)); return (const void*)(((size_t)hi << 32) | lo); }
#ifndef EN_SITES
#define EN_SITES 0x7ff
#endif
#define SITE(k) ((EN_SITES >> (k)) & 1)
#ifndef EN_PP
#define EN_PP 0xf
#endif
#ifndef EN_SP
#define EN_SP 0x1f
#endif
#define PP(k) ((EN_PP >> (k)) & 1)
#define SP(k) ((EN_SP >> (k)) & 1)
constexpr int NPHASE = 25;
__global__ void __launch_bounds__(NWAVES * 64, 2) fwd(Args args) {
    extern __shared__ __attribute__((aligned(16))) unsigned char lds_raw[];
    Frame F;
    F.lds = (LAS unsigned char*)lds_raw; F.tid = threadIdx.x; F.lane = F.tid & 63; F.wave = __builtin_amdgcn_readfirstlane(F.tid >> 6); F.G = gridDim.x; F.bid = blockIdx.x;
    F.A = &args; F.zo = 0; F.out = args.out; F.ws = args.ws; unsigned char* ws = args.ws;
    volatile LAS unsigned* MISC = (volatile LAS unsigned*)(F.lds + MISC_OFF);
    for (int u = F.tid; u < (LDS_BYTES - RING_BYTES) / 4; u += NWAVES * 64) ((LAS unsigned*)(F.lds + RING_BYTES))[u] = 0u;
    __syncthreads();
    const int lo = args.ph_lo, hi = args.ph_hi, sel = args.sel;
    XcdBarrier bar; bar.bar = (unsigned*)(ws + WS_CTL) + CW_BAR; bar.x = 0; bar.st = nullptr;
    if (hi - lo > 1) bar = xcd_barrier_post((unsigned*)(ws + WS_CTL) + CW_BAR, MISC + 8);
#define IN(k) (lo <= (k) && (k) < hi)
#define SITE_FRAME() Frame Fp = F; { Fp.ws = (unsigned char*)opaque_ptr(F.ws); Fp.out = (float*)opaque_ptr(F.out); } { int t_ = (int)threadIdx.x, b_ = (int)blockIdx.x, z_; asm volatile("s_mov_b32 %0, 0" : "=s"(z_)); Fp.zo = z_; asm volatile("" : "+v"(t_), "+s"(b_)); Fp.tid = t_; Fp.lane = t_ & 63; Fp.wave = __builtin_amdgcn_readfirstlane(t_ >> 6); Fp.bid = b_; } const int bid = Fp.bid
#define SEAM(k) do { if (IN(k) && IN((k) + 1)) { XcdBarrier b2_ = bar; b2_.bar = (unsigned*)opaque_ptr(bar.bar); xcd_barrier(b2_, Fp.tid == 0); } } while (0)
    const int G = F.G;

    if (SITE(0) && IN(0)) { SITE_FRAME(); p0_prologue(Fp); SEAM(0); }
    for (int l = 0; l < 2; ++l) {
        const int base = 1 + 12 * l;
        for (int half = 0; half < 2; ++half) {
            const int pb = base + 9 * half;
            if (SITE(2) && IN(pb)) { SITE_FRAME();
                pg8::Gemm g{Fp.XN(), (const bf16_t*)(Fp.ws + WS_W0 + (size_t)l * WS_WL + (half ? OFF_W2I : OFF_W1I)), D}; pg8::StaticOrder S; S.init(MP, NFFI, D, G, bid);
                pg8::EpiSwiGLU E{Fp.ACT()};
                pg8::gemm_phase<pg8::EpiSwiGLU, pg8::StaticOrder, true, true>(Fp.lds, g, S, E, Fp.tid);
                if (l == 0 && half == 0 && bid >= G / 2) {
                    pg8::Gemm g2{Fp.MEMN(), (const bf16_t*)(Fp.ws + WS_WMKV), D}; pg8::GroupAOrder S2; S2.init(NB * NMEM, 4096, D, G / 2, bid - G / 2); S2.grp = 8; S2.astride = (size_t)NB * NMEM * D * 2;
                    pg8::EpiMemKV E2{Fp.out + O_MKP, Fp.out + O_MVP, Fp.MK(), Fp.MVT()};
                    pg8::gemm_phase<pg8::EpiMemKV, pg8::GroupAOrder, false, true>(Fp.lds, g2, S2, E2, Fp.tid);
                }
                { SEpiSwiGLU SE{Fp.ACT()}; small_gemm<D>(Fp, g.A, 0, g.Bt, 0, DFF / 16, G / 2, G / 2, SE); }
                SEAM(pb);
            }
            if (SITE(3) && IN(pb + 1)) { SITE_FRAME();
                pg8::Gemm g{Fp.ACT(), (const bf16_t*)(Fp.ws + WS_W0 + (size_t)l * WS_WL + (half ? OFF_W2O : OFF_W1O)), DFF}; pg8::StaticOrder S; S.init(MP, D, DFF, G, bid);
                pg8::EpiF32 E{Fp.TMP(), D};
                pg8::gemm_phase<pg8::EpiF32, pg8::StaticOrder, true, true>(Fp.lds, g, S, E, Fp.tid);
                { SEpiF32 SE{Fp.TMP()}; small_gemm<DFF>(Fp, g.A, 0, g.Bt, 0, D / 16, 0, D / 16, SE); }
                SEAM(pb + 1);
            }
            if (SITE(4) && IN(pb + 2)) { SITE_FRAME();
                NormArgs na; na.tmp = Fp.TMP(); na.scale = 0.5f; na.first = 0;
                if (half == 0) { na.gpost = Fp.inp(9) + l * D; na.gpre = Fp.inp(12) + l * D; na.wab = Fp.WAB() + (size_t)l * 8 * D; na.fin = 0; }
                else { na.gpost = Fp.inp(27) + l * D; na.gpre = Fp.inp(8) + (l == 0 ? D : 0); na.wab = nullptr; na.fin = (l == 1); }
                norm_phase(Fp, na);
                SEAM(pb + 2);
            }
            if (half == 0) {
                if (SITE(5) && IN(base + 3)) { SITE_FRAME();
                    pg8::Gemm g{Fp.XN(), (const bf16_t*)(Fp.ws + WS_W0 + (size_t)l * WS_WL + OFF_WIN), D}; pg8::StaticOrder S; S.init(MP, NWIN, D, G, bid);
                    pg8::EpiBf16 E{Fp.PROJ(), NWIN};
                    pg8::gemm_phase<pg8::EpiBf16, pg8::StaticOrder, true, true>(Fp.lds, g, S, E, Fp.tid);
                    { SEpiBf16 SE{Fp.PROJ(), NWIN}; small_gemm<D>(Fp, g.A, 0, g.Bt, 0, NWIN / 16, 0, G, SE); }
                    SEAM(base + 3);
                }
                if (SITE(6) && IN(base + 4)) { SITE_FRAME();
                    if (PP(0) && (sel & 1)) for (int ci = bid; ci < NB * NH * NCH; ci += G) gdn_prep(Fp, l, ci);
                    if (PP(1) && (sel & 2)) for (int ci = bid; ci < NB * NH * NCH; ci += G) ret_prep(Fp, ci);
                    if (PP(2) && (sel & 4)) { const int xcd = bid & 7, slot = bid >> 3, per = G >> 3;
                        if ((G & 7) == 0) { for (int ux = slot; ux < 64; ux += per) mem_attn_unit(Fp, l, (xcd * 4 + (ux >> 4)) * 16 + (ux & 15)); }
                        else for (int u = bid; u < NB * NH * 16; u += G) mem_attn_unit(Fp, l, u); }
                    if (PP(3) && bid < NB) { for (int i = Fp.tid; i < 3 * CONVD; i += NWAVES * 64) { const int j = i / CONVD, C = i % CONVD;
                        Fp.out[O_CVP + ((size_t)(l * NB + bid) * 3 + j) * CONVD + C] = bf2f(Fp.PROJ()[(size_t)(bid * SEQ + SEQ - 3 + j) * NWIN + PC_GQKV + C]); } }
                    SEAM(base + 4);
                }
                if (SITE(7) && IN(base + 5)) { SITE_FRAME();
                    if (bid < 32) { if (SP(0) && (sel & 8)) scan_bh<false>(Fp, l, bid); }
                    else if (bid < 64) { if (SP(1) && (sel & 8)) scan_bh<true>(Fp, l, bid - 32); }
                    else { const int nw = G - 64;
                        if (SP(2) && (sel & 16)) for (int it = bid - 64; it < MS * NH; it += nw) sample_step<true>(Fp, l, it);
                        if (SP(3) && (sel & 16)) for (int it = bid - 64; it < MS * NH; it += nw) sample_step<false>(Fp, l, it);
                        if (SP(4) && (sel & 32)) for (int it = bid - 64; it < MS * NH; it += nw) sample_attn(Fp, l, it);
                        if (l == 0 && (sel & 64)) convert_layer1(Fp, bid - 64, nw); }
                    SEAM(base + 5);
                }
                if (SITE(8) && IN(base + 6)) { SITE_FRAME();
                    pg8::Gemm g{Fp.OBR(), (const bf16_t*)(Fp.ws + WS_W0 + (size_t)l * WS_WL + OFF_WBR), D}; pg8::SegOrder S; S.init(MP, D, D, G, bid); S.nseg = 3; S.aseg = OBR_STRIDE * 2; S.bseg = (size_t)D * D * 2;
                    pg8::EpiBranch E{Fp.MERGED(), Fp.PROJ()};
                    pg8::gemm_phase<pg8::EpiBranch, pg8::SegOrder, true, true>(Fp.lds, g, S, E, Fp.tid);
                    { SEpiBranch SE{Fp.MERGED(), Fp.PROJ()}; small_gemm<D>(Fp, g.A, OBR_STRIDE, g.Bt, (size_t)D * D, D / 16, 0, D / 16, SE); }
                    SEAM(base + 6);
                }
                if (SITE(9) && IN(base + 7)) { SITE_FRAME();
                    pg8::Gemm g{Fp.MERGED(), (const bf16_t*)(Fp.ws + WS_W0 + (size_t)l * WS_WL + OFF_WO), D}; pg8::StaticOrder S; S.init(MP, D, D, G, bid);
                    pg8::EpiF32 E{Fp.TMP(), D};
                    pg8::gemm_phase<pg8::EpiF32, pg8::StaticOrder, true, true>(Fp.lds, g, S, E, Fp.tid);
                    { SEpiF32 SE{Fp.TMP()}; small_gemm<D>(Fp, g.A, 0, g.Bt, 0, D / 16, 0, D / 16, SE); }
                    SEAM(base + 7);
                }
                if (SITE(10) && IN(base + 8)) { SITE_FRAME();
                    NormArgs na; na.tmp = Fp.TMP(); na.scale = 1.0f; na.first = 0; na.gpost = Fp.inp(13) + l * D; na.gpre = Fp.inp(26) + l * D; na.wab = nullptr; na.fin = 0;
                    norm_phase(Fp, na);
                    SEAM(base + 8);
                }
            }
        }
    }
#undef IN
#undef SEAM
}

extern "C" void kernel_launch(void* const* d_in, const int* in_sizes, int n_in, void* d_out, int out_size, void* d_ws, size_t ws_size, hipStream_t stream) {
    static int grid = 0;
    if (grid == 0) {
        if (n_in != 30 || (size_t)out_size != O_END || ws_size < WS_END) { fprintf(stderr, "kernel_launch: unexpected shapes: n_in %d out %d ws %zu (need %zu)\n", n_in, out_size, ws_size, (size_t)WS_END); grid = -1; return; }
        int dev = 0, cus = 0, per_cu = 0;
        if (hipGetDevice(&dev) != hipSuccess || hipDeviceGetAttribute(&cus, hipDeviceAttributeMultiprocessorCount, dev) != hipSuccess) { grid = -1; return; }
        if (hipFuncSetAttribute((const void*)fwd, hipFuncAttributeMaxDynamicSharedMemorySize, LDS_BYTES) != hipSuccess) { fprintf(stderr, "kernel_launch: hipFuncSetAttribute failed\n"); grid = -1; return; }
        if (hipOccupancyMaxActiveBlocksPerMultiprocessor(&per_cu, (const void*)fwd, NWAVES * 64, LDS_BYTES) != hipSuccess || per_cu < 1) { fprintf(stderr, "kernel_launch: occupancy query reports %d\n", per_cu); }
        (void)hipGetLastError();
        grid = cus;
        if (grid < 64) { fprintf(stderr, "kernel_launch: needs >= 64 CUs\n"); grid = -1; return; }
    }
    if (grid < 0) return;
    if (hipMemsetAsync((char*)d_ws + WS_CTL, 0, CTL_ZERO_BYTES, stream) != hipSuccess) return;
    Args a{};
    for (int i = 0; i < 30; ++i) a.in[i] = (const float*)d_in[i];
    a.out = (float*)d_out; a.ws = (unsigned char*)d_ws;
#ifndef MK_ONE_LAUNCH
#define MK_ONE_LAUNCH 1
#endif
    a.sel = 0xff; a.pad = 0;
#ifndef PROBE_PH
#define PROBE_PH -1
#endif
#ifndef PROBE_SEL
#define PROBE_SEL 0xff
#endif
    if (MK_ONE_LAUNCH) { a.ph_lo = 0; a.ph_hi = NPHASE; hipLaunchKernelGGL(fwd, dim3(grid), dim3(NWAVES * 64), LDS_BYTES, stream, a); }
    else for (int p = 0; p < NPHASE; ++p) { a.ph_lo = p; a.ph_hi = p + 1; a.sel = 0xff; hipLaunchKernelGGL(fwd, dim3(grid), dim3(NWAVES * 64), LDS_BYTES, stream, a);
        if (PROBE_PH >= 0 && (p == PROBE_PH || (PROBE_PH >= 1 && p == PROBE_PH + 12))) { a.sel = PROBE_SEL; hipLaunchKernelGGL(fwd, dim3(grid), dim3(NWAVES * 64), LDS_BYTES, stream, a); } }
}
```

```cpp
#include <hip/hip_runtime.h>
#include <cstdio>
#include <cstdint>

#define LAS __attribute__((address_space(3)))
#define GAS __attribute__((address_space(1)))
typedef unsigned short bf16_t;
typedef short bf16x8 __attribute__((ext_vector_type(8)));
typedef short bf16x4 __attribute__((ext_vector_type(4)));
typedef float f32x4 __attribute__((ext_vector_type(4)));
typedef float f32x2 __attribute__((ext_vector_type(2)));
typedef unsigned u32x4 __attribute__((ext_vector_type(4)));
typedef unsigned u32x2 __attribute__((ext_vector_type(2)));
typedef __bf16 bf16x2_t __attribute__((ext_vector_type(2)));
typedef GAS unsigned gu32;

constexpr int D = 1024, SEQ = 2048, NB = 8, MP = NB * SEQ, MS = 128, MREAL = MP + MS, MPAD = 16640;
constexpr int DFF = 2816, NFFI = 2 * DFF, NWIN = 10240, WIN_RAW = 10248;
constexpr int NH = 4, DK = 128, DV = 256, CH = 64, NCH = SEQ / CH, NMEM = 256, CONVD = 2048;
constexpr int PC_RQ = 0, PC_RK = 512, PC_RV = 1024, PC_RG = 2048, PC_GQKV = 3072, PC_GZ = 5120, PC_MQ = 6144, PC_GATE = 7168;
constexpr float EPS = 1e-6f;
constexpr int PAST_LEN = 16384;

__device__ __forceinline__ unsigned f2bf(float f) { unsigned u = __builtin_bit_cast(unsigned, f); return (u + 0x7fffu + ((u >> 16) & 1u)) >> 16; }
__device__ __forceinline__ float bf2f(unsigned b) { return __builtin_bit_cast(float, b << 16); }
__device__ __forceinline__ unsigned pk2(float lo, float hi) { f32x2 v = {lo, hi}; bf16x2_t b = __builtin_convertvector(v, bf16x2_t); return __builtin_bit_cast(unsigned, b); }
__device__ __forceinline__ bf16x8 pack8(f32x4 a, f32x4 b) { u32x4 p; p.x = pk2(a.x, a.y); p.y = pk2(a.z, a.w); p.z = pk2(b.x, b.y); p.w = pk2(b.z, b.w); return __builtin_bit_cast(bf16x8, p); }
__device__ __forceinline__ float fexp(float x) { return __builtin_amdgcn_exp2f(x * 1.4426950408889634f); }
__device__ __forceinline__ float sigmoidf_(float x) { return __builtin_amdgcn_rcpf(1.0f + fexp(-x)); }
__device__ __forceinline__ float siluf_(float x) { return x * sigmoidf_(x); }
__device__ __forceinline__ float wave_sum(float v) {
#pragma unroll
    for (int o = 1; o < 64; o <<= 1) v += __shfl_xor(v, o);
    return v;
}
#define MFMA16(a, b, c) __builtin_amdgcn_mfma_f32_16x16x32_bf16((a), (b), (c), 0, 0, 0)

namespace pg8 {
#define PG8_LAS __attribute__((address_space(3)))
constexpr int BM = 256, BK = 64, HALF = 128, HTB = HALF * BK * 2  , STAGE_BYTES = 8 * HTB, NXCD = 8;
__host__ __device__ __forceinline__ int lds_byte(int r, int c) { const int st = (r >> 4) * 2 + (c >> 5), rr = r & 15, cc = c & 31, ob = rr * 64 + cc * 2; return st * 1024 + (ob ^ (((ob >> 9) & 1) << 5)); }
__host__ __device__ __forceinline__ void stage_rc(int b, int& R, int& C) { const int st = b / 1024, sb = b % 1024, swz = sb ^ (((sb >> 9) & 1) << 5); R = (st >> 1) * 16 + swz / 64; C = (st & 1) * 32 + (swz % 64) / 2; }
__host__ __device__ __forceinline__ int perm32(int rho) { const int n = rho >> 4, i = rho & 15; return 8 * (i >> 2) + 4 * n + (i & 3); }

#ifndef WGM_DEFAULT
#define WGM_DEFAULT 2
#endif
#ifndef WGM_N1024
#define WGM_N1024 8
#endif
struct Unit { int pm, pn, seg, hm; size_t aofs, bofs; };
struct Gemm { const bf16_t* A; const bf16_t* Bt; int K; };

struct StaticOrder {
    int nM, nN, nwg, G, c, WGM; size_t tstep;
    __device__ void init(int M, int N, int K, int G_, int c_, int wgm = WGM_DEFAULT) { nM = M / BM; nN = N / BM; nwg = nM * nN; G = G_; c = c_; WGM = wgm; tstep = (size_t)BM * K * 2; }
    __device__ bool tile(long L, int& pm, int& pn) const {
        if (L >= nwg) return false;
        int wgid = (int)L; { const int q = nwg / NXCD, r = nwg % NXCD, xcd = wgid % NXCD, off = wgid / NXCD; wgid = (xcd < r ? xcd * (q + 1) : r * (q + 1) + (xcd - r) * q) + off; }
        const int nig = WGM * nN, gid = wgid / nig, fm = gid * WGM, gsz = (nM - fm) < WGM ? (nM - fm) : WGM;
        pm = fm + ((wgid % nig) % gsz); pn = (wgid % nig) / gsz; return true;
    }
    __device__ bool next(int i, Unit& u) const {
        if (!tile((long)i * G + c, u.pm, u.pn)) return false;
        u.seg = 0; u.hm = 0; u.aofs = (size_t)u.pm * tstep; u.bofs = (size_t)u.pn * tstep; return true;
    }
    __device__ __forceinline__ void a_ready(const Unit&) const {}
    __device__ __forceinline__ void done(const Unit&) const {}
};
struct GroupAOrder : StaticOrder {
    int grp; size_t astride;
    __device__ bool next(int i, Unit& u) const {
        if (!tile((long)i * G + c, u.pm, u.pn)) return false;
        u.seg = 0; u.hm = 0; u.aofs = (size_t)(u.pn / grp) * astride + (size_t)u.pm * tstep; u.bofs = (size_t)u.pn * tstep; return true;
    }
};
struct HalfTailOrder : StaticOrder {
    __device__ bool next(int i, Unit& u) const {
        const int nfull = nwg / G;
        if (i < nfull) { if (!tile((long)i * G + c, u.pm, u.pn)) return false; u.hm = 0; }
        else { if (i > nfull || !tile((long)nfull * G + (c >> 1), u.pm, u.pn)) return false; u.hm = 1 + (c & 1); }
        u.seg = 0; u.aofs = (size_t)u.pm * tstep + (u.hm == 2 ? tstep / 2 : 0); u.bofs = (size_t)u.pn * tstep; return true;
    }
};
struct SegOrder : StaticOrder {
    int nseg; size_t aseg, bseg;
    __device__ bool next(int i, Unit& u) const {
        const int round = i / nseg, seg = i - round * nseg;
        if (!tile((long)round * G + c, u.pm, u.pn)) return false;
        u.seg = seg; u.hm = 0; u.aofs = (size_t)seg * aseg + (size_t)u.pm * tstep; u.bofs = (size_t)seg * bseg + (size_t)u.pn * tstep; return true;
    }
};

struct EpiF32 {
    static constexpr int NST = 32; static constexpr bool RSLDS = false; static constexpr bool PERM = false, AFTER_DRAIN = false;
    float* C; int ldc;
    __device__ __forceinline__ void operator()(const f32x4 (&acc)[2][2][4][2], const Unit& u, int wr, int wc, int fr, int fq) const {
        const int row0 = u.pm * BM + wr * 64 + fr, col0 = u.pn * BM + wc * 32 + 4 * fq;
#pragma unroll
        for (int ai = 0; ai < 2; ++ai)
#pragma unroll
            for (int m = 0; m < 4; ++m) { float* rowp = C + (size_t)(row0 + ai * HALF + m * 16) * ldc + col0;
#pragma unroll
                for (int bj = 0; bj < 2; ++bj)
#pragma unroll
                    for (int n = 0; n < 2; ++n) *(f32x4*)(rowp + bj * HALF + n * 16) = acc[ai][bj][m][n]; }
    }
};
struct EpiBf16 {
    static constexpr int NST = 16; static constexpr bool RSLDS = false; static constexpr bool PERM = true, AFTER_DRAIN = false;
    bf16_t* O; int ldc;
    __device__ __forceinline__ void operator()(const f32x4 (&acc)[2][2][4][2], const Unit& u, int wr, int wc, int fr, int fq) const {
        const int row0 = u.pm * BM + wr * 64 + fr, col0 = u.pn * BM + wc * 32 + 8 * fq;
        unsigned bo = ((unsigned)row0 * (unsigned)ldc + (unsigned)col0) * 2u; asm volatile("" : "+v"(bo));
        const unsigned rs = (unsigned)ldc * 2u;
#pragma unroll
        for (int ai = 0; ai < 2; ++ai)
#pragma unroll
            for (int m = 0; m < 4; ++m) {
#pragma unroll
                for (int bj = 0; bj < 2; ++bj) { const f32x4 v0 = acc[ai][bj][m][0], v1 = acc[ai][bj][m][1];
                    u32x4 w; w.x = pk2(v0[0], v0[1]); w.y = pk2(v0[2], v0[3]); w.z = pk2(v1[0], v1[1]); w.w = pk2(v1[2], v1[3]);
                    *(u32x4*)((char*)O + (bo + (unsigned)(ai * HALF + m * 16) * rs + (unsigned)(bj * HALF * 2))) = w; } }
    }
};
struct EpiProj {
    static constexpr int NST = 16; static constexpr bool RSLDS = true; static constexpr bool PERM = true, AFTER_DRAIN = false; __device__ static __forceinline__ bool keep_acc(const Unit&) { return false; }
    bf16_t* O; const float* gn; const float* rs;
    __device__ __forceinline__ void operator()(const f32x4 (&acc)[2][2][4][2], const Unit& u, int wr, int wc, int fr, int fq, const LAS float* rsl) const {
        const int row0 = u.pm * BM + wr * 64 + fr, col0 = u.pn * BM + wc * 32 + 8 * fq;
        unsigned bo = ((unsigned)row0 * (unsigned)NWIN + (unsigned)col0) * 2u; asm volatile("" : "+v"(bo));
        const unsigned rstride = (unsigned)NWIN * 2u;
        const int mode = (u.pn >= 8 && u.pn < 12) ? 1 : (u.pn >= 20 && u.pn < 24) ? 2 : 0;
        float gs[2][8];
#pragma unroll
        for (int bj = 0; bj < 2; ++bj)
#pragma unroll
            for (int j = 0; j < 8; ++j) gs[bj][j] = (mode == 2) ? gn[(col0 + bj * HALF + j) & 255] : 1.f;
#pragma unroll
        for (int ai = 0; ai < 2; ++ai)
#pragma unroll
            for (int m = 0; m < 4; ++m) {
#pragma unroll
                for (int bj = 0; bj < 2; ++bj) { const float rv = rsl[wr * 64 + fr + ai * HALF + m * 16]; f32x4 v0 = acc[ai][bj][m][0] * rv, v1 = acc[ai][bj][m][1] * rv;
                    if (mode != 0) {
#pragma unroll
                        for (int j = 0; j < 4; ++j) { v0[j] = siluf_(v0[j]) * gs[bj][j]; v1[j] = siluf_(v1[j]) * gs[bj][4 + j]; } }
                    u32x4 w; w.x = pk2(v0[0], v0[1]); w.y = pk2(v0[2], v0[3]); w.z = pk2(v1[0], v1[1]); w.w = pk2(v1[2], v1[3]);
                    *(u32x4*)((char*)O + (bo + (unsigned)(ai * HALF + m * 16) * rstride + (unsigned)(bj * HALF * 2))) = w; } }
    }
};
struct EpiSwiGLU {
    static constexpr int NST = 8; static constexpr bool RSLDS = true; static constexpr bool PERM = true, AFTER_DRAIN = false;
    bf16_t* O; const float* rs;
    __device__ __forceinline__ void operator()(const f32x4 (&acc)[2][2][4][2], const Unit& u, int wr, int wc, int fr, int fq, const LAS float* rsl) const {
        const int row0 = u.pm * BM + (u.hm == 2 ? HALF : 0) + wr * 64 + fr, col0 = u.pn * HALF + wc * 32 + 8 * fq;
#pragma unroll
        for (int ai = 0; ai < 2; ++ai) { if (ai == 1 && u.hm != 0) break;
#pragma unroll
            for (int m = 0; m < 4; ++m) { bf16_t* rowp = O + (size_t)(row0 + ai * HALF + m * 16) * DFF + col0;
                float r[8]; const float rv = rsl[wr * 64 + fr + ai * HALF + m * 16];
#pragma unroll
                for (int n = 0; n < 2; ++n)
#pragma unroll
                    for (int j = 0; j < 4; ++j) { const float g = acc[ai][0][m][n][j] * rv, up = acc[ai][1][m][n][j] * rv; r[4 * n + j] = siluf_(g) * up; }
                u32x4 w; w.x = pk2(r[0], r[1]); w.y = pk2(r[2], r[3]); w.z = pk2(r[4], r[5]); w.w = pk2(r[6], r[7]);
                *(u32x4*)rowp = w; } }
    }
};
struct EpiMemKV {
    static constexpr int NST = 0; static constexpr bool RSLDS = false; static constexpr bool PERM = false, AFTER_DRAIN = false;
    float* outK; float* outV; bf16_t* MK; bf16_t* MVT;
    __device__ __forceinline__ void operator()(const f32x4 (&acc)[2][2][4][2], const Unit& u, int wr, int wc, int fr, int fq) const {
        const int layer = u.pn >> 3, isv = (u.pn >> 2) & 1, cb = (u.pn & 3) * BM;
        const int row0 = u.pm * BM + wr * 64 + fr, col0 = cb + wc * 32 + 4 * fq;
        float* of = (isv ? outV : outK) + (size_t)layer * (NB * NMEM * D);
#pragma unroll
        for (int ai = 0; ai < 2; ++ai)
#pragma unroll
            for (int m = 0; m < 4; ++m) { const int row = row0 + ai * HALF + m * 16;
#pragma unroll
                for (int bj = 0; bj < 2; ++bj)
#pragma unroll
                    for (int n = 0; n < 2; ++n) { const int col = col0 + bj * HALF + n * 16; const f32x4 v = acc[ai][bj][m][n];
                        *(f32x4*)(of + (size_t)row * D + col) = v;
                        const int b = row >> 8, key = row & 255, h = col >> 8, dd = col & 255;
                        unsigned char* fb = (unsigned char*)(isv ? MVT : MK) + ((((size_t)layer * NB + b) * NH + h) << 17);
                        if (!isv) { u32x2 w; w.x = pk2(v[0], v[1]); w.y = pk2(v[2], v[3]);
                            *(u32x2*)(fb + ((((key >> 4) * 8 + (dd >> 5)) * 64 + (key & 15) + 16 * ((dd & 31) >> 3)) << 4) + ((dd & 4) << 1)) = w; }
                        else {
                            const int ks = key >> 5, w5 = key & 31, gg = (w5 & 15) >> 2, jj = (w5 & 3) + 4 * (w5 >> 4);
#pragma unroll
                            for (int j = 0; j < 4; ++j) { const int e = dd + j; *(bf16_t*)(fb + (((((e >> 4) * 8 + ks) * 64 + (e & 15) + 16 * gg) << 4) + jj * 2)) = (bf16_t)f2bf(v[j]); } } } }
    }
};
struct EpiBranch {
    static constexpr int NST = 16; static constexpr bool RSLDS = false; static constexpr bool PERM = true, AFTER_DRAIN = false;
    bf16_t* O; const bf16_t* proj;
    __device__ __forceinline__ void operator()(const f32x4 (&acc)[2][2][4][2], const Unit& u, int wr, int wc, int fr, int fq) const {
        const int row0 = u.pm * BM + wr * 64 + fr, col0 = u.pn * BM + wc * 32 + 8 * fq;
        unsigned go = ((unsigned)row0 * (unsigned)NWIN + (unsigned)(PC_GATE + u.seg * D + col0)) * 2u, oo = ((unsigned)row0 * (unsigned)D + (unsigned)col0) * 2u; asm volatile("" : "+v"(go), "+v"(oo));
        const char* gb = (const char*)proj; char* ob = (char*)O;
#pragma unroll
        for (int ai = 0; ai < 2; ++ai) {
            u32x4 gwv[4][2], oldv[4][2];
#pragma unroll
            for (int m = 0; m < 4; ++m)
#pragma unroll
                for (int bj = 0; bj < 2; ++bj) { gwv[m][bj] = *(const u32x4*)(gb + (go + (unsigned)((ai * HALF + m * 16) * NWIN + bj * HALF) * 2u));
                    oldv[m][bj] = (u32x4){0u, 0u, 0u, 0u}; if (u.seg != 0) oldv[m][bj] = *(const u32x4*)(ob + (oo + (unsigned)((ai * HALF + m * 16) * D + bj * HALF) * 2u)); }
            asm volatile("" ::: "memory");
#pragma unroll
            for (int m = 0; m < 4; ++m)
#pragma unroll
                for (int bj = 0; bj < 2; ++bj) { const u32x4 gw = gwv[m][bj], old = oldv[m][bj]; float r[8];
#pragma unroll
                    for (int q = 0; q < 4; ++q) { const unsigned g2 = gw[q], o2 = old[q];
                        const float a0 = acc[ai][bj][m][q >> 1][(q & 1) * 2], a1 = acc[ai][bj][m][q >> 1][(q & 1) * 2 + 1];
                        r[2 * q] = bf2f(o2 & 0xffffu) + sigmoidf_(bf2f(g2 & 0xffffu)) * a0; r[2 * q + 1] = bf2f(o2 >> 16) + sigmoidf_(bf2f(g2 >> 16)) * a1; }
                    u32x4 w; w.x = pk2(r[0], r[1]); w.y = pk2(r[2], r[3]); w.z = pk2(r[4], r[5]); w.w = pk2(r[6], r[7]);
                    *(u32x4*)(ob + (oo + (unsigned)((ai * HALF + m * 16) * D + bj * HALF) * 2u)) = w; }
            asm volatile("" ::: "memory");
        }
    }
};

template <class Epi, class Sched, bool ALIGN_EPI = false, bool SP2 = false, bool HM = false>
__device__ __forceinline__ void gemm_phase(PG8_LAS unsigned char* lds, const Gemm g, const Sched& S, const Epi& E, const int tid) {
    const int wid = __builtin_amdgcn_readfirstlane(tid >> 6), lane = tid & 63, wr = wid >> 2, wc = wid & 3, fr = lane & 15, fq = lane >> 4;
    const int K = g.K, nt = K / BK;
    unsigned voffA[2], voffB[2];
#pragma unroll
    for (int i = 0; i < 2; ++i) { int R, C; stage_rc(tid * 16 + i * 8192, R, C); const int Rb = Epi::PERM ? ((R & ~31) + perm32(R & 31)) : R;
        voffA[i] = (unsigned)(R * K + C) * 2u; voffB[i] = (unsigned)(Rb * K + C) * 2u; }
    const size_t kstep = (size_t)(BK * 2);
    const size_t hstep = (size_t)HALF * K * 2;
    const unsigned ldsw = (unsigned)wid * 1024u;
    const int aoff = lds_byte(wr * 64 + fr, fq * 8), boff = lds_byte(wc * 32 + fr, fq * 8);
#define PG8_SA(b, h) (((b) * 2 + (h)) * HTB)
#define PG8_SB(b, h) ((4 + (b) * 2 + (h)) * HTB)
#define PG8_STAGE(bufoff, gbase, voff) do { _Pragma("unroll") for (int _i = 0; _i < 2; ++_i) \
        __builtin_amdgcn_global_load_lds((const unsigned*)((const char*)(gbase) + (voff)[_i]), (PG8_LAS unsigned*)(lds + (bufoff) + ldsw + _i * 8192), 16, 0, 0); } while (0)
#define PG8_LDA(dst, b, h) do { _Pragma("unroll") for (int m = 0; m < 4; ++m) _Pragma("unroll") for (int k = 0; k < 2; ++k) dst[m][k] = *(const PG8_LAS bf16x8*)(lds + PG8_SA(b, h) + aoff + m * 2048 + k * 1024); } while (0)
#define PG8_LDB(dst, b, h) do { _Pragma("unroll") for (int n = 0; n < 2; ++n) _Pragma("unroll") for (int k = 0; k < 2; ++k) dst[n][k] = *(const PG8_LAS bf16x8*)(lds + PG8_SB(b, h) + boff + n * 2048 + k * 1024); } while (0)
#define PG8_MMA(ai, bj, At, Bt) do { __builtin_amdgcn_s_setprio(1); _Pragma("unroll") for (int m = 0; m < 4; ++m) _Pragma("unroll") for (int n = 0; n < 2; ++n) _Pragma("unroll") for (int k = 0; k < 2; ++k) \
        acc[ai][bj][m][n] = __builtin_amdgcn_mfma_f32_16x16x32_bf16(Bt[n][k], At[m][k], acc[ai][bj][m][n], 0, 0, 0); __builtin_amdgcn_s_setprio(0); } while (0)
#define PG8_WAIT_V(n) asm volatile("s_waitcnt vmcnt(" #n ")" ::: "memory")
#define PG8_WAIT_L(n) asm volatile("s_waitcnt lgkmcnt(" #n ")" ::: "memory")
#define PG8_BAR __builtin_amdgcn_s_barrier()
#define PG8_SCHED __builtin_amdgcn_sched_barrier(0)
    Unit cur, nxt; int ui = 0;
    if (!S.next(0, cur)) return;
    f32x4 acc[2][2][4][2];
#pragma unroll
    for (int a = 0; a < 2; ++a)
#pragma unroll
        for (int b = 0; b < 2; ++b)
#pragma unroll
            for (int m = 0; m < 4; ++m)
#pragma unroll
                for (int n = 0; n < 2; ++n) acc[a][b][m][n] = (f32x4){0.f, 0.f, 0.f, 0.f};
    bf16x8 At[4][2], B0[2][2], B1[2][2];
    const char* cA = (const char*)g.A + cur.aofs; const char* cB = (const char*)g.Bt + cur.bofs;
    S.a_ready(cur);
    if constexpr (SP2) {
        PG8_STAGE(PG8_SB(0, 0), cB, voffB); PG8_STAGE(PG8_SB(0, 1), cB + hstep, voffB); PG8_STAGE(PG8_SA(0, 0), cA, voffA); PG8_STAGE(PG8_SA(0, 1), cA + hstep, voffA);
        if (wr == 1) PG8_BAR;
        PG8_WAIT_V(2); PG8_BAR;
        PG8_STAGE(PG8_SB(1, 0), cB + kstep, voffB); PG8_STAGE(PG8_SA(1, 0), cA + kstep, voffA); PG8_STAGE(PG8_SB(1, 1), cB + hstep + kstep, voffB);
        PG8_WAIT_V(6); PG8_BAR;
    } else {
        PG8_STAGE(PG8_SB(0, 0), cB, voffB); PG8_STAGE(PG8_SA(0, 0), cA, voffA); PG8_STAGE(PG8_SB(0, 1), cB + hstep, voffB); PG8_STAGE(PG8_SA(0, 1), cA + hstep, voffA);
        if (wr == 1) PG8_BAR;
        PG8_WAIT_V(4); PG8_BAR;
        PG8_STAGE(PG8_SB(1, 0), cB + kstep, voffB); PG8_STAGE(PG8_SA(1, 0), cA + kstep, voffA); PG8_STAGE(PG8_SB(1, 1), cB + hstep + kstep, voffB);
        PG8_WAIT_V(6); PG8_BAR;
    }
    for (;;) {
        const bool has_next = S.next(ui + 1, nxt);
        if constexpr (Epi::RSLDS) {
            if (wid == 0) __builtin_amdgcn_global_load_lds((const unsigned*)(E.rs + (size_t)cur.pm * BM + (cur.hm == 2 ? HALF : 0) + lane * 4), (PG8_LAS unsigned*)(lds + STAGE_BYTES + (ui & 1) * 1024), 16, 0, 0); }
        const char* nA = has_next ? (const char*)g.A + nxt.aofs : cA; const char* nB = has_next ? (const char*)g.Bt + nxt.bofs : cB;
        for (int t = 0; t < nt; t += 2) {
            const bool last = (t == nt - 2);
            const char* a1 = cA + (size_t)(t + 1) * kstep;
            const char* a2 = last ? nA : cA + (size_t)(t + 2) * kstep; const char* b2 = last ? nB : cB + (size_t)(t + 2) * kstep;
            const char* a3 = a2 + kstep; const char* b3 = b2 + kstep;
            if (last && has_next) S.a_ready(nxt);
            if constexpr (SP2) {
            int hmu = 0; if constexpr (HM) { hmu = __builtin_amdgcn_readfirstlane(cur.hm); asm volatile("" : "+s"(hmu)); }
            PG8_LDB(B0, 0, 0); PG8_LDB(B1, 0, 1); PG8_SCHED; PG8_LDA(At, 0, 0); PG8_STAGE(PG8_SA(1, 1), a1 + hstep, voffA);
            PG8_WAIT_V(8); PG8_WAIT_L(0); PG8_BAR; PG8_MMA(0, 0, At, B0); PG8_MMA(0, 1, At, B1); PG8_BAR; PG8_SCHED;
            if (!hmu) PG8_LDA(At, 0, 1); PG8_STAGE(PG8_SB(0, 0), b2, voffB); PG8_STAGE(PG8_SB(0, 1), b2 + hstep, voffB); PG8_STAGE(PG8_SA(0, 0), a2, voffA);
            PG8_WAIT_V(8); PG8_WAIT_L(0); PG8_BAR; if (!hmu) { PG8_MMA(1, 0, At, B0); PG8_MMA(1, 1, At, B1); } PG8_BAR; PG8_SCHED;
            PG8_LDB(B0, 1, 0); PG8_LDB(B1, 1, 1); PG8_SCHED; PG8_LDA(At, 1, 0); PG8_STAGE(PG8_SA(0, 1), a2 + hstep, voffA);
            PG8_WAIT_V(8); PG8_WAIT_L(0); PG8_BAR; PG8_MMA(0, 0, At, B0); PG8_MMA(0, 1, At, B1); PG8_BAR; PG8_SCHED;
            if (!hmu) PG8_LDA(At, 1, 1); PG8_STAGE(PG8_SB(1, 0), b3, voffB); PG8_STAGE(PG8_SB(1, 1), b3 + hstep, voffB); PG8_STAGE(PG8_SA(1, 0), a3, voffA);
            PG8_WAIT_V(8); PG8_WAIT_L(0); PG8_BAR; if (!hmu) { PG8_MMA(1, 0, At, B0); PG8_MMA(1, 1, At, B1); } PG8_BAR; PG8_SCHED;
            } else {
            PG8_LDB(B0, 0, 0); PG8_SCHED; PG8_LDA(At, 0, 0); PG8_STAGE(PG8_SA(1, 1), a1 + hstep, voffA);
            PG8_WAIT_L(8); PG8_BAR; PG8_WAIT_L(0); PG8_MMA(0, 0, At, B0); PG8_BAR; PG8_SCHED;
            PG8_LDB(B1, 0, 1); PG8_STAGE(PG8_SB(0, 0), b2, voffB);
            PG8_BAR; PG8_WAIT_L(0); PG8_MMA(0, 1, At, B1); PG8_BAR;
            PG8_LDA(At, 0, 1); PG8_STAGE(PG8_SA(0, 0), a2, voffA);
            PG8_BAR; PG8_WAIT_L(0); PG8_MMA(1, 0, At, B0); PG8_BAR; PG8_SCHED;
            PG8_STAGE(PG8_SB(0, 1), b2 + hstep, voffB);
            PG8_WAIT_V(6); PG8_BAR; PG8_MMA(1, 1, At, B1); PG8_BAR;
            PG8_LDB(B0, 1, 0); PG8_SCHED; PG8_LDA(At, 1, 0); PG8_STAGE(PG8_SA(0, 1), a2 + hstep, voffA);
            PG8_WAIT_L(8); PG8_BAR; PG8_WAIT_L(0); PG8_MMA(0, 0, At, B0); PG8_BAR; PG8_SCHED;
            PG8_LDB(B1, 1, 1); PG8_STAGE(PG8_SB(1, 0), b3, voffB);
            PG8_BAR; PG8_WAIT_L(0); PG8_MMA(0, 1, At, B1); PG8_BAR;
            PG8_LDA(At, 1, 1); PG8_STAGE(PG8_SA(1, 0), a3, voffA);
            PG8_BAR; PG8_WAIT_L(0); PG8_MMA(1, 0, At, B0); PG8_BAR; PG8_SCHED;
            PG8_STAGE(PG8_SB(1, 1), b3 + hstep, voffB);
            PG8_WAIT_V(6); PG8_BAR; PG8_MMA(1, 1, At, B1); PG8_BAR;
            }
        }
        if constexpr (ALIGN_EPI) { if (wr == 0) PG8_BAR; }
        if constexpr (Epi::RSLDS) { E(acc, cur, wr, wc, fr, fq, (const PG8_LAS float*)(lds + STAGE_BYTES + (ui & 1) * 1024)); S.done(cur); } else
        if constexpr (!Epi::AFTER_DRAIN) { E(acc, cur, wr, wc, fr, fq); S.done(cur); }
        if (!has_next) break;
#pragma unroll
        for (int a = 0; a < 2; ++a)
#pragma unroll
            for (int b = 0; b < 2; ++b)
#pragma unroll
                for (int m = 0; m < 4; ++m)
#pragma unroll
                    for (int n = 0; n < 2; ++n) acc[a][b][m][n] = (f32x4){0.f, 0.f, 0.f, 0.f};
        cur = nxt; cA = nA; cB = nB; ++ui;
        if constexpr (ALIGN_EPI) { if (wr == 1) PG8_BAR; }
    }
    PG8_WAIT_V(0);
    if constexpr (!ALIGN_EPI) { if (wr == 0) PG8_BAR; }
    PG8_BAR;
    if constexpr (Epi::AFTER_DRAIN) { E.fused(acc, cur, wr, wc, fr, fq, lds, wid, lane); S.done(cur); }
#undef PG8_SA
#undef PG8_SB
#undef PG8_STAGE
#undef PG8_LDA
#undef PG8_LDB
#undef PG8_MMA
#undef PG8_WAIT_V
#undef PG8_WAIT_L
#undef PG8_BAR
#undef PG8_SCHED
}
}

constexpr size_t MiB = 1u << 20;
constexpr size_t WS_CTL = 0, CTL_ZERO_BYTES = 32768;
constexpr size_t WS_W0 = 1 * MiB, WS_WL = 61 * MiB;
constexpr size_t OFF_W1I = 0, OFF_W1O = 11 * MiB, OFF_WIN = 16 * MiB + MiB / 2, OFF_WBR = 36 * MiB + MiB / 2, OFF_WO = 42 * MiB + MiB / 2, OFF_W2I = 44 * MiB + MiB / 2, OFF_W2O = 55 * MiB + MiB / 2;
static_assert(OFF_W2O + (size_t)D * DFF * 2 == WS_WL, "layer weight map");
constexpr size_t WS_WMKV = 123 * MiB;
constexpr size_t WS_MISC = 131 * MiB;
constexpr size_t MISC_WAB = 0, MISC_COS = 65536, MISC_SIN = 65536 + 2049 * 64 * 4;
constexpr size_t WS_MEMN = 133 * MiB, WS_MK = 141 * MiB, WS_MVT = 149 * MiB, WS_AB = 157 * MiB;
constexpr size_t WS_H = 158 * MiB, WS_TMP = 223 * MiB, WS_XN = 288 * MiB, WS_MERGED = 320 * MiB + MiB / 2, WS_OBR = 353 * MiB;
constexpr size_t OBR_STRIDE = (size_t)MPAD * D;
constexpr size_t WS_BIG = 451 * MiB;
constexpr int GCH_W = 0, GCH_QD = 16384, GCH_ATT = 32768, GCH_KDT = 40960, GCH_BYTES = 57344;
constexpr int RCH_QD = 0, RCH_ATT = 16384, RCH_KDT = 24576, RCH_BYTES = 40960;
constexpr size_t WS_RCH = 776 * MiB, WS_RVT = 816 * MiB;
constexpr size_t WS_GCH = 848 * MiB, WS_GUT = 904 * MiB, WS_GDCH = 968 * MiB;
constexpr size_t WS_END = 969 * MiB;
static_assert(WS_H + (size_t)MPAD * D * 4 == WS_TMP && WS_TMP + (size_t)MPAD * D * 4 == WS_XN && WS_XN + (size_t)MPAD * D * 2 == WS_MERGED && WS_MERGED + (size_t)MPAD * D * 2 == WS_OBR, "activation map");
static_assert(WS_OBR + 3 * OBR_STRIDE * 2 <= WS_BIG && WS_BIG + (size_t)MPAD * NWIN * 2 <= WS_RCH && WS_RCH + (size_t)1024 * RCH_BYTES <= WS_RVT && WS_GCH + (size_t)1024 * GCH_BYTES <= WS_GUT, "activation map 2");
constexpr int CW_BAR = 4096;

constexpr size_t O_YP = 0, O_YS = O_YP + (size_t)MP * D, O_SRP = O_YS + (size_t)MS * D, O_SGP = O_SRP + (size_t)2 * NB * NH * DK * DV, O_CVP = O_SGP + (size_t)2 * NB * NH * DK * DV,
                 O_MKP = O_CVP + (size_t)2 * NB * 3 * CONVD, O_MVP = O_MKP + (size_t)2 * NB * NMEM * D, O_SRS = O_MVP + (size_t)2 * NB * NMEM * D, O_SGS = O_SRS + (size_t)2 * MS * NH * DK * DV,
                 O_CVS = O_SGS + (size_t)2 * MS * NH * DK * DV, O_END = O_CVS + (size_t)2 * MS * 3 * CONVD;
static_assert(O_END == 98271232, "output size");

constexpr int LDS_BYTES = 163840, MISC_OFF = LDS_BYTES - 256;

#define XB_TMO      128
#define XB_XCNT(j)  (256  + 64 * (j))
#define XB_XSUB(j)  (1280 + 64 * (j))
#define XB_XGEN(j)  (2304 + 64 * (j))
#define XB_TOP      3328
#define XB_TOPGEN   3392
#define XCD_BAR_WORDS 3456
#define XB_SPIN_CAP (1u << 18)

__device__ __forceinline__ unsigned xb_ld(unsigned* p)              { return __hip_atomic_load(p, __ATOMIC_RELAXED, __HIP_MEMORY_SCOPE_AGENT); }
__device__ __forceinline__ unsigned xb_add(unsigned* p, unsigned v) { return __hip_atomic_fetch_add(p, v, __ATOMIC_RELAXED, __HIP_MEMORY_SCOPE_AGENT); }
__device__ __forceinline__ unsigned xb_xcc_id() { return (unsigned)__builtin_amdgcn_s_getreg((3 << 11) | 20) & 0xFu; }
#define XB_SPIN(cond, bar) do { unsigned _sp = 0; while (cond) { __builtin_amdgcn_s_sleep(1); \
    if ((++_sp & 255u) == 0u) { if (xb_ld(&(bar)[XB_TMO])) break; if (_sp > XB_SPIN_CAP) { atomicAdd(&(bar)[XB_TMO], 1u); break; } } } } while (0)

struct XcdBarrier {
    unsigned* bar; unsigned x;
    volatile LAS unsigned* st;
};

__device__ __forceinline__ XcdBarrier xcd_barrier_post(unsigned* bar, volatile LAS unsigned* st) {
    XcdBarrier b; b.bar = bar; b.x = xb_xcc_id(); b.st = st;
    if (threadIdx.x == 0) (void)xb_add(&bar[XB_XCNT(b.x)], 1u);
    return b;
}
__device__ __forceinline__ void xcd_barrier_complete(unsigned* bar, unsigned x, unsigned& nloc, unsigned& nx) {
    const unsigned G = gridDim.x * gridDim.y * gridDim.z;
    unsigned sum, cnt, mine, sp = 0u;
    for (;;) {
        sum = 0u; cnt = 0u; mine = 0u;
#pragma unroll
        for (unsigned j = 0; j < 16; ++j) { const unsigned c = xb_ld(&bar[XB_XCNT(j)]); sum += c; cnt += (c > 0u) ? 1u : 0u; mine = (j == x) ? c : mine; }
        if (sum == G) break;
        __builtin_amdgcn_s_sleep(1);
        if ((++sp & 255u) == 0u) { if (xb_ld(&bar[XB_TMO])) break; if (sp > XB_SPIN_CAP) { atomicAdd(&bar[XB_TMO], 1u); break; } }
    }
    nloc = mine > 0u ? mine : 1u; nx = cnt > 0u ? cnt : 1u;
}

__device__ __forceinline__ void xcd_barrier(const XcdBarrier& b, const bool is_thread0) {
    asm volatile("s_waitcnt vmcnt(0)" ::: "memory");
    __syncthreads();
    if (is_thread0) {
        unsigned* bar = b.bar;
        __builtin_amdgcn_s_waitcnt(0);
        unsigned nloc = b.st[0], nx = b.st[1];
        if (nloc == 0u) { xcd_barrier_complete(bar, b.x, nloc, nx); b.st[0] = nloc; b.st[1] = nx; }
        const unsigned old = xb_add(&bar[XB_XSUB(b.x)], 1u);
        const unsigned gen = old / nloc;
        if (old + 1u == (gen + 1u) * nloc) {
            __builtin_amdgcn_fence(__ATOMIC_RELEASE, "agent");
            asm volatile("s_waitcnt vmcnt(0)" ::: "memory");
            const unsigned og = xb_add(&bar[XB_TOP], 1u);
            const unsigned tg = og / nx;
            if (og + 1u == (tg + 1u) * nx) xb_add(&bar[XB_TOPGEN], 1u);
            else XB_SPIN(xb_ld(&bar[XB_TOPGEN]) == tg, bar);
            __builtin_amdgcn_fence(__ATOMIC_ACQUIRE, "agent");
            xb_add(&bar[XB_XGEN(b.x)], 1u);
            asm volatile("s_waitcnt vmcnt(0)" ::: "memory");
        } else {
            XB_SPIN(xb_ld(&bar[XB_XGEN(b.x)]) == gen, bar);
            __builtin_amdgcn_fence(__ATOMIC_ACQUIRE, "agent");
            asm volatile("s_waitcnt vmcnt(0)" ::: "memory");
        }
    }
    __syncthreads();
}

constexpr int NWAVES = 8;
struct Args { const float* in[30]; float* out; unsigned char* ws; int ph_lo, ph_hi, sel, pad; };
struct Frame {
    LAS unsigned char* lds; int tid, lane, wave, G, bid;
    const Args* A; float* out; unsigned char* ws; int zo;
    __device__ __forceinline__ const float* inp(int k) const { return *(const float* const*)((const char*)A + zo + 8 * k); }
    __device__ __forceinline__ float* RS() const { return (float*)(ws + WS_XN); }
    __device__ __forceinline__ bf16_t* MERGED() const { return (bf16_t*)(ws + WS_MERGED); }
    __device__ __forceinline__ bf16_t* OBR() const { return (bf16_t*)(ws + WS_OBR); }
    __device__ __forceinline__ bf16_t* PROJ() const { return (bf16_t*)(ws + WS_BIG); }
    __device__ __forceinline__ bf16_t* ACT() const { return (bf16_t*)(ws + WS_BIG); }
    __device__ __forceinline__ bf16_t* MEMN() const { return (bf16_t*)(ws + WS_MEMN); }
    __device__ __forceinline__ bf16_t* MK() const { return (bf16_t*)(ws + WS_MK); }
    __device__ __forceinline__ bf16_t* MVT() const { return (bf16_t*)(ws + WS_MVT); }
    __device__ __forceinline__ bf16_t* H() const { return (bf16_t*)(ws + WS_H); }
    __device__ __forceinline__ bf16_t* TMP() const { return (bf16_t*)(ws + WS_TMP); }
    __device__ __forceinline__ float* AB() const { return (float*)(ws + WS_AB); }
    __device__ __forceinline__ float* WAB() const { return (float*)(ws + WS_MISC + MISC_WAB); }
    __device__ __forceinline__ float* COS() const { return (float*)(ws + WS_MISC + MISC_COS); }
    __device__ __forceinline__ float* SIN() const { return (float*)(ws + WS_MISC + MISC_SIN); }
    __device__ __forceinline__ unsigned char* RCH() const { return ws + WS_RCH; }
    __device__ __forceinline__ unsigned char* RVT() const { return ws + WS_RVT; }
    __device__ __forceinline__ unsigned char* GCH() const { return ws + WS_GCH; }
    __device__ __forceinline__ float* GUT() const { return (float*)(ws + WS_GUT); }
    __device__ __forceinline__ float* GDCH() const { return (float*)(ws + WS_GDCH); }
};
#define LDS_WAIT() asm volatile("s_waitcnt lgkmcnt(0)" ::: "memory")

enum { WM_PLAIN = 0, WM_FFNIN = 1, WM_WIN = 2 };
__device__ __forceinline__ int map_col(int mode, int n0) {
    if (mode == WM_FFNIN) { const int tile = n0 >> 8, w = n0 & 255; return (w < 128) ? tile * 128 + w : DFF + tile * 128 + (w - 128); }
    if (mode == WM_WIN) return n0 < PC_MQ ? n0 : n0 + 8;
    return n0;
}
__device__ __forceinline__ void transpose_item(const float* W, int K, int Nraw, int N, int mode, bf16_t* WT, const float* gk, LAS float* scr, int item, int lane) {
    const int nblk = N / 32, kb = item / nblk, nb = item % nblk, k0 = 64 * kb, n0 = 32 * nb, nr0 = map_col(mode, n0);
    f32x4 wv[8];
#pragma unroll
    for (int i = 0; i < 8; ++i) wv[i] = *(const f32x4*)(W + (size_t)(k0 + 8 * i + (lane >> 3)) * Nraw + nr0 + 4 * (lane & 7));
    if (gk) {
#pragma unroll
        for (int i = 0; i < 8; ++i) wv[i] = wv[i] * gk[k0 + 8 * i + (lane >> 3)]; }
#pragma unroll
    for (int i = 0; i < 8; ++i) { LAS float* d = scr + (8 * i + (lane >> 3)) * 33 + 4 * (lane & 7); d[0] = wv[i].x; d[1] = wv[i].y; d[2] = wv[i].z; d[3] = wv[i].w; }
    LDS_WAIT(); asm volatile("" ::: "memory");
    const int c = lane & 7;
#pragma unroll
    for (int j = 0; j < 4; ++j) { const int n = (lane >> 3) + 8 * j; const LAS float* s = scr + (8 * c) * 33 + n;
        u32x4 o; o.x = pk2(s[0 * 33], s[1 * 33]); o.y = pk2(s[2 * 33], s[3 * 33]); o.z = pk2(s[4 * 33], s[5 * 33]); o.w = pk2(s[6 * 33], s[7 * 33]);
        *(u32x4*)(WT + (size_t)(n0 + n) * K + k0 + 8 * c) = o; }
    LDS_WAIT(); asm volatile("" ::: "memory");
}
struct TJob { const float* W; int K, Nraw, N, mode; bf16_t* WT; const float* gk; };
__device__ __forceinline__ TJob get_job(int j, const Frame& F) {
    const int l = j / 11, t = j % 11; unsigned char* wl = F.ws + WS_W0 + (size_t)l * WS_WL; TJob r;
    switch (t) {
    case 0:  r = TJob{F.inp(10) + (size_t)l * D * NFFI, D, NFFI, NFFI, WM_FFNIN, (bf16_t*)(wl + OFF_W1I), F.inp(8) + (size_t)l * D}; break;
    case 1:  r = TJob{F.inp(11) + (size_t)l * DFF * D, DFF, D, D, WM_PLAIN, (bf16_t*)(wl + OFF_W1O), nullptr}; break;
    case 2:  r = TJob{F.inp(14) + (size_t)l * D * WIN_RAW, D, WIN_RAW, NWIN, WM_WIN, (bf16_t*)(wl + OFF_WIN), F.inp(12) + (size_t)l * D}; break;
    case 3:  r = TJob{F.inp(20) + (size_t)l * D * D, D, D, D, WM_PLAIN, (bf16_t*)(F.ws + WS_WMKV) + (size_t)(l * 2048) * D, nullptr}; break;
    case 4:  r = TJob{F.inp(21) + (size_t)l * D * D, D, D, D, WM_PLAIN, (bf16_t*)(F.ws + WS_WMKV) + (size_t)(l * 2048 + 1024) * D, nullptr}; break;
    case 5:  r = TJob{F.inp(22) + (size_t)l * D * D, D, D, D, WM_PLAIN, (bf16_t*)(wl + OFF_WBR), nullptr}; break;
    case 6:  r = TJob{F.inp(23) + (size_t)l * D * D, D, D, D, WM_PLAIN, (bf16_t*)(wl + OFF_WBR) + (size_t)D * D, nullptr}; break;
    case 7:  r = TJob{F.inp(24) + (size_t)l * D * D, D, D, D, WM_PLAIN, (bf16_t*)(wl + OFF_WBR) + (size_t)2 * D * D, nullptr}; break;
    case 8:  r = TJob{F.inp(25) + (size_t)l * D * D, D, D, D, WM_PLAIN, (bf16_t*)(wl + OFF_WO), nullptr}; break;
    case 9:  r = TJob{F.inp(28) + (size_t)l * D * NFFI, D, NFFI, NFFI, WM_FFNIN, (bf16_t*)(wl + OFF_W2I), F.inp(26) + (size_t)l * D}; break;
    default: r = TJob{F.inp(29) + (size_t)l * DFF * D, DFF, D, D, WM_PLAIN, (bf16_t*)(wl + OFF_W2O), nullptr}; break;
    }
    return r;
}

struct NormArgs { const bf16_t* tmp; const float* gpost; float scale; const float* gpre; const float* wab; int first, fin; };
__device__ __forceinline__ void norm_phase(const Frame& F, const NormArgs na) {
    const int gw = F.bid * NWAVES + F.wave, NGW = F.G * NWAVES, lane = F.lane;
#define FI(j) (2 * lane + 128 * ((j) >> 1) + ((j) & 1))
#define NP_LD(mm, hh, tt) do { if ((mm) < MREAL) { _Pragma("unroll") for (int jj = 0; jj < 2; ++jj) { hh[jj] = *((const u32x4*)(F.H() + (size_t)(mm) * D) + lane + 64 * jj); tt[jj] = *((const u32x4*)(na.tmp + (size_t)(mm) * D) + lane + 64 * jj); } } } while (0)
#define NP_LDX(mm, xx) do { if ((mm) < MREAL) { const float* src_ = ((mm) < MP) ? F.inp(0) + (size_t)(mm) * D : F.inp(1) + (size_t)((mm) - MP) * D; _Pragma("unroll") for (int j = 0; j < 4; ++j) xx[j] = *((const f32x4*)src_ + FI(j)); } } while (0)
    const u32x4 z4 = (u32x4){0u, 0u, 0u, 0u};
    f32x4 gpq[4];
#pragma unroll
    for (int j = 0; j < 4; ++j) gpq[j] = na.tmp ? *((const f32x4*)na.gpost + FI(j)) : (f32x4){0.f, 0.f, 0.f, 0.f};
    f32x4 wq[8][4];
#pragma unroll
    for (int q = 0; q < 8; ++q)
#pragma unroll
        for (int j = 0; j < 4; ++j) wq[q][j] = na.wab ? *((const f32x4*)(na.wab + q * D) + FI(j)) : (f32x4){0.f, 0.f, 0.f, 0.f};
    u32x4 h0[2] = {z4, z4}, t0[2] = {z4, z4}, h1[2] = {z4, z4}, t1[2] = {z4, z4};
    f32x4 x0[4];
#pragma unroll
    for (int j = 0; j < 4; ++j) x0[j] = (f32x4){0.f, 0.f, 0.f, 0.f};
    if (na.first) NP_LDX(gw, x0); else { NP_LD(gw, h0, t0); NP_LD(gw + NGW, h1, t1); }
    for (int m = gw; m < MREAL; m += NGW) {
        f32x4 h[4]; const u32x4 tc[2] = {t0[0], t0[1]};
        if (na.first) {
#pragma unroll
            for (int j = 0; j < 4; ++j) h[j] = x0[j];
            NP_LDX(m + NGW, x0);
        } else {
            const u32x4 hc[2] = {h0[0], h0[1]};
            h0[0] = h1[0]; h0[1] = h1[1]; t0[0] = t1[0]; t0[1] = t1[1];
            NP_LD(m + 2 * NGW, h1, t1);
#pragma unroll
            for (int jj = 0; jj < 2; ++jj) { const u32x4 w = hc[jj]; h[2 * jj] = (f32x4){bf2f(w.x & 0xffffu), bf2f(w.x >> 16), bf2f(w.y & 0xffffu), bf2f(w.y >> 16)}; h[2 * jj + 1] = (f32x4){bf2f(w.z & 0xffffu), bf2f(w.z >> 16), bf2f(w.w & 0xffffu), bf2f(w.w >> 16)}; }
        }
        if (na.tmp) {
            f32x4 t[4]; float ss = 0.f;
#pragma unroll
            for (int jj = 0; jj < 2; ++jj) { const u32x4 w = tc[jj]; t[2 * jj] = (f32x4){bf2f(w.x & 0xffffu), bf2f(w.x >> 16), bf2f(w.y & 0xffffu), bf2f(w.y >> 16)}; t[2 * jj + 1] = (f32x4){bf2f(w.z & 0xffffu), bf2f(w.z >> 16), bf2f(w.w & 0xffffu), bf2f(w.w >> 16)}; }
#pragma unroll
            for (int j = 0; j < 4; ++j) ss += (t[j].x * t[j].x + t[j].y * t[j].y) + (t[j].z * t[j].z + t[j].w * t[j].w);
            const float r = na.scale / sqrtf(wave_sum(ss) * (1.f / D) + EPS);
#pragma unroll
            for (int j = 0; j < 4; ++j) h[j] = h[j] + t[j] * gpq[j] * r;
        }
        if (!na.fin) {
#pragma unroll
            for (int jj = 0; jj < 2; ++jj) { u32x4 w; w.x = pk2(h[2 * jj].x, h[2 * jj].y); w.y = pk2(h[2 * jj].z, h[2 * jj].w); w.z = pk2(h[2 * jj + 1].x, h[2 * jj + 1].y); w.w = pk2(h[2 * jj + 1].z, h[2 * jj + 1].w); *((u32x4*)(F.H() + (size_t)m * D) + lane + 64 * jj) = w; } }
        if (na.fin && m < MREAL) {
            float* dst = (m < MP) ? F.out + O_YP + (size_t)m * D : F.out + O_YS + (size_t)(m - MP) * D;
#pragma unroll
            for (int j = 0; j < 4; ++j) *((f32x4*)dst + FI(j)) = h[j];
        }
        float s2 = 0.f;
#pragma unroll
        for (int j = 0; j < 4; ++j) s2 += (h[j].x * h[j].x + h[j].y * h[j].y) + (h[j].z * h[j].z + h[j].w * h[j].w);
        const float r2 = 1.f / sqrtf(wave_sum(s2) * (1.f / D) + EPS);
        if (lane == 0) F.RS()[m] = r2;
        if (na.wab) {
            float d8 = 0.f;
#pragma unroll
            for (int q = 0; q < 8; ++q) { float s = 0.f;
#pragma unroll
                for (int j = 0; j < 4; ++j) { const f32x4 w = wq[q][j]; s += (h[j].x * w.x + h[j].y * w.y) + (h[j].z * w.z + h[j].w * w.w); }
                s = wave_sum(s) * r2; d8 = (lane == q) ? s : d8; }
            if (lane < 8) F.AB()[(size_t)m * 8 + lane] = d8;
        }
    }
}
#undef FI
#undef NP_LD
#undef NP_LDX

__device__ __forceinline__ void p0_prologue(const Frame& F) {
    LAS float* scr = (LAS float*)(F.lds + F.wave * 16384);
    const int gw = F.bid * NWAVES + F.wave, NGW = F.G * NWAVES;
    int dealt = 0;
    for (int j = 0; j < 16; ++j) { if (j >= 5 && j != 14 && j != 15) continue;
        const TJob tj = get_job(j, F); const int nitems = (tj.K / 64) * (tj.N / 32);
        int first = (gw - dealt) % NGW; if (first < 0) first += NGW;
        for (int it = first; it < nitems; it += NGW) transpose_item(tj.W, tj.K, tj.Nraw, tj.N, tj.mode, tj.WT, tj.gk, scr, it, F.lane);
        dealt = (dealt + nitems) % NGW; }
    const int gt = F.bid * (NWAVES * 64) + F.tid, NGT = F.G * NWAVES * 64;
    for (int i = gt; i < 2 * 8 * D; i += NGT) { const int l = i / (8 * D), q = (i / D) % 8, k = i % D; F.WAB()[i] = F.inp(14)[(size_t)l * D * WIN_RAW + (size_t)k * WIN_RAW + PC_MQ + q] * F.inp(12)[(size_t)l * D + k]; }
    for (int i = gt; i < 2049 * 64; i += NGT) { const int p = i >> 6, d = i & 63; const double pos = (p == 2048) ? (double)PAST_LEN : (double)p;
        const double ang = pos * pow(10000.0, -(double)d / 64.0); F.COS()[i] = (float)cos(ang); F.SIN()[i] = (float)sin(ang); }
    for (int r = gw; r < 2 * NB * NMEM; r += NGW) { const int l = r / (NB * NMEM), row = r % (NB * NMEM);
        f32x4 v[4], gq[4]; float ss = 0.f;
#pragma unroll
        for (int j = 0; j < 4; ++j) { v[j] = *((const f32x4*)(F.inp(2) + (size_t)row * D) + F.lane + 64 * j); ss += (v[j].x * v[j].x + v[j].y * v[j].y) + (v[j].z * v[j].z + v[j].w * v[j].w); }
        const float rr = 1.f / sqrtf(wave_sum(ss) * (1.f / D) + EPS);
        u32x2* o8 = (u32x2*)(F.MEMN() + (size_t)r * D) + F.lane;
#pragma unroll
        for (int j = 0; j < 4; ++j) gq[j] = *((const f32x4*)(F.inp(19) + (size_t)l * D) + F.lane + 64 * j);
        asm volatile("" ::: "memory");
#pragma unroll
        for (int j = 0; j < 4; ++j) { const f32x4 y = v[j] * gq[j] * rr; u32x2 w; w.x = pk2(y.x, y.y); w.y = pk2(y.z, y.w); o8[64 * j] = w; }
    }
    NormArgs na{nullptr, nullptr, 0.f, F.inp(8), nullptr, 1, 0};
    norm_phase(F, na);
}

__device__ __forceinline__ void convert_layer1(const Frame& F, int idx, int nw) {
    LAS float* scr = (LAS float*)(F.lds + F.wave * 16384);
    const int gw = idx * NWAVES + F.wave, NGW = nw * NWAVES;
    int dealt = 0;
    for (int j = 5; j < 22; ++j) { if (j == 14 || j == 15) continue;
        const TJob tj = get_job(j, F); const int nitems = (tj.K / 64) * (tj.N / 32);
        int first = (gw - dealt) % NGW; if (first < 0) first += NGW;
        for (int it = first; it < nitems; it += NGW) transpose_item(tj.W, tj.K, tj.Nraw, tj.N, tj.mode, tj.WT, tj.gk, scr, it, F.lane);
        dealt = (dealt + nitems) % NGW; }
}

__device__ __forceinline__ bf16x8 ldnat(const void* base, unsigned row_boff, int s, int g) { return *(const bf16x8*)((const char*)base + (row_boff + 64u * s + 16u * g)); }
__device__ __forceinline__ bf16x8 ldperm(const void* base, unsigned row_boff, int s, int g) {
    const unsigned o = row_boff + 64u * s + 8u * g; const bf16x4 lo = *(const bf16x4*)((const char*)base + o), hi = *(const bf16x4*)((const char*)base + (o + 32u));
    return __builtin_shufflevector(lo, hi, 0, 1, 2, 3, 4, 5, 6, 7);
}
#define CBAR() asm volatile("" ::: "memory")
__device__ __forceinline__ bf16x8 lds_frag(const LAS float* rowp, int s, int g, float scale) {
    const f32x4 a = *(const LAS f32x4*)(rowp + 32 * s + 8 * g), b = *(const LAS f32x4*)(rowp + 32 * s + 8 * g + 4);
    return pack8(a * scale, b * scale);
}

__device__ __forceinline__ void ret_prep(const Frame& F, int ci) {
    const int tid = F.tid, lane = F.lane, wv = F.wave;
    const int bh = ci >> 5, n = ci & 31, b = bh >> 2, h = bh & 3, m0 = b * SEQ + n * CH;
    const float lg = log1pf(-exp2f(-5.0f - (float)h));
    LAS float* qf = (LAS float*)F.lds;
    LAS float* kf = qf + 64 * 132;
    LAS bf16_t* vs = (LAS bf16_t*)(kf + 64 * 132);
    u32x4 vr[4];
#pragma unroll
    for (int r = 0; r < 4; ++r) { const int p = tid + 512 * r, row = p >> 5, c8 = (p & 31) * 8; vr[r] = *(const u32x4*)(F.PROJ() + (size_t)(m0 + row) * NWIN + PC_RV + h * DV + c8); }
    {   const int i = tid >> 3, d0 = (tid & 7) * 8, t = n * CH + i;
        const bf16_t* qrow = F.PROJ() + (size_t)(m0 + i) * NWIN + PC_RQ + h * DK; const bf16_t* krow = F.PROJ() + (size_t)(m0 + i) * NWIN + PC_RK + h * DK;
        const u32x4 q1 = *(const u32x4*)(qrow + d0), q2 = *(const u32x4*)(qrow + 64 + d0), k1 = *(const u32x4*)(krow + d0), k2 = *(const u32x4*)(krow + 64 + d0);
        const float* cp = F.COS() + t * 64 + d0; const float* sp = F.SIN() + t * 64 + d0;
        float cs[8], sn[8];
#pragma unroll
        for (int e = 0; e < 8; ++e) { cs[e] = cp[e]; sn[e] = sp[e]; }
        const float qd = fexp(lg * (float)(i + 1));
        float o1[8], o2[8];
#pragma unroll
        for (int e = 0; e < 8; ++e) { const unsigned w1 = q1[e >> 1], w2 = q2[e >> 1]; const float x1 = (e & 1) ? bf2f(w1 >> 16) : bf2f(w1 & 0xffffu), x2 = (e & 1) ? bf2f(w2 >> 16) : bf2f(w2 & 0xffffu);
            o1[e] = x1 * cs[e] - x2 * sn[e]; o2[e] = x1 * sn[e] + x2 * cs[e]; qf[i * 132 + d0 + e] = o1[e]; qf[i * 132 + 64 + d0 + e] = o2[e]; }
        {
            unsigned char* qb = F.RCH() + (size_t)ci * RCH_BYTES + RCH_QD + (i >> 4) * 4096 + (i & 15) * 16;
#pragma unroll
            for (int hh = 0; hh < 2; ++hh) { const int D0 = d0 + 64 * hh, s = D0 >> 5, half = (D0 >> 4) & 1, g0 = (D0 & 15) >> 2; const float* o = hh ? o2 : o1;
                u32x2 w; w.x = pk2(o[0] * qd, o[1] * qd); w.y = pk2(o[2] * qd, o[3] * qd); *(u32x2*)(qb + s * 1024 + g0 * 256 + half * 8) = w;
                w.x = pk2(o[4] * qd, o[5] * qd); w.y = pk2(o[6] * qd, o[7] * qd); *(u32x2*)(qb + s * 1024 + (g0 + 1) * 256 + half * 8) = w; }
        }
        const float ksc = 0.08838834764831845f;
#pragma unroll
        for (int e = 0; e < 8; ++e) { const unsigned w1 = k1[e >> 1], w2 = k2[e >> 1]; const float x1 = (e & 1) ? bf2f(w1 >> 16) : bf2f(w1 & 0xffffu), x2 = (e & 1) ? bf2f(w2 >> 16) : bf2f(w2 & 0xffffu);
            kf[i * 132 + d0 + e] = (x1 * cs[e] - x2 * sn[e]) * ksc; kf[i * 132 + 64 + d0 + e] = (x1 * sn[e] + x2 * cs[e]) * ksc; }
    }
#pragma unroll
    for (int r = 0; r < 4; ++r) { const int p = tid + 512 * r, row = p >> 5, c8 = (p & 31) * 8; *(LAS u32x4*)(vs + row * 264 + c8) = vr[r]; }
    __syncthreads();
    {
        const int d = tid >> 2, i0 = (tid & 3) * 16; unsigned w[8];
#pragma unroll
        for (int r = 0; r < 16; r += 2) { const float v0 = kf[(i0 + r) * 132 + d] * fexp(lg * (float)(63 - (i0 + r))), v1 = kf[(i0 + r + 1) * 132 + d] * fexp(lg * (float)(62 - (i0 + r))); w[r >> 1] = pk2(v0, v1); }
        unsigned char* kb = F.RCH() + (size_t)ci * RCH_BYTES + RCH_KDT + (d >> 4) * 2048 + (d & 15) * 16 + (i0 >> 5) * 1024 + ((i0 & 31) >> 3) * 256;
        *(u32x4*)kb = (u32x4){w[0], w[1], w[2], w[3]}; *(u32x4*)(kb + 256) = (u32x4){w[4], w[5], w[6], w[7]};
    }
    {
        const int e = tid >> 1, i0 = (tid & 1) * 32; unsigned w[16];
#pragma unroll
        for (int r = 0; r < 32; r += 2) w[r >> 1] = (unsigned)vs[(i0 + r) * 264 + e] | ((unsigned)vs[(i0 + r + 1) * 264 + e] << 16);
        unsigned char* vb = F.RVT() + (size_t)ci * 32768 + ((e >> 4) * 2 + (i0 >> 5)) * 1024 + (e & 15) * 16;
#pragma unroll
        for (int q = 0; q < 4; ++q) *(u32x4*)(vb + q * 256) = (u32x4){w[4 * q], w[4 * q + 1], w[4 * q + 2], w[4 * q + 3]};
    }
    {
        const int c = lane & 15, g = lane >> 4;
#pragma unroll
        for (int x = 0; x < 2; ++x) { const int tt = 2 * wv + x, jt = tt >> 2, it = tt & 3;
            f32x4 acc = (f32x4){0.f, 0.f, 0.f, 0.f};
            if (it >= jt) {
#pragma unroll
                for (int s = 0; s < 4; ++s) { const bf16x8 A = lds_frag(kf + (16 * jt + c) * 132, s, g, 1.0f), B = lds_frag(qf + (16 * it + c) * 132, s, g, 1.0f); acc = MFMA16(A, B, acc); }
            }
            const int i = 16 * it + c; float r4[4];
#pragma unroll
            for (int r = 0; r < 4; ++r) { const int j = 16 * jt + 4 * g + r; r4[r] = (i >= j) ? acc[r] * fexp(lg * (float)(i - j)) : 0.f; }
            u32x2 w; w.x = pk2(r4[0], r4[1]); w.y = pk2(r4[2], r4[3]);
            *(u32x2*)(F.RCH() + (size_t)ci * RCH_BYTES + RCH_ATT + (it * 2 + (jt >> 1)) * 1024 + (c + 16 * (2 * (jt & 1) + (g >> 1))) * 16 + (g & 1) * 8) = w; }
    }
    __syncthreads();
}

__device__ __forceinline__ void gdn_prep(const Frame& F, int l, int ci) {
    const int tid = F.tid, lane = F.lane, wv = F.wave;
    const int bh = ci >> 5, n = ci & 31, b = bh >> 2, h = bh & 3, m0 = b * SEQ + n * CH;
    LAS bf16_t* raw = (LAS bf16_t*)F.lds;
    LAS float* qf = (LAS float*)F.lds;
    LAS float* kf = qf + 64 * 132;
    LAS bf16_t* wst = (LAS bf16_t*)F.lds;
    LAS float* Am = (LAS float*)(F.lds + 69888);
    LAS float* sm = (LAS float*)(F.lds + 86272);
    LAS float* bcum = sm; LAS float* beta = sm + 64; LAS float* rq = sm + 128; LAS float* rk = sm + 192; LAS float* eb = sm + 256;
    float ab_a = 0.f, ab_b = 0.f;
    if (wv == 0) { const int m = m0 + lane; ab_a = F.AB()[(size_t)m * 8 + h]; ab_b = F.AB()[(size_t)m * 8 + 4 + h]; }
    {
        u32x4 rv[9]; const int pc = tid & 63, col8 = pc * 8;
        const int sc = (pc < 16) ? PC_GQKV + h * DK + col8 : (pc < 32) ? PC_GQKV + 512 + h * DK + (col8 - 128) : PC_GQKV + 1024 + h * DV + (col8 - 256);
#pragma unroll
        for (int it = 0; it < 9; ++it) { const int row = (tid >> 6) + 8 * it, t = n * CH + row - 3; rv[it] = (u32x4){0u, 0u, 0u, 0u};
            if (row < 67 && t >= 0) rv[it] = *(const u32x4*)(F.PROJ() + (size_t)(b * SEQ + t) * NWIN + sc); }
        asm volatile("" ::: "memory");
#pragma unroll
        for (int it = 0; it < 9; ++it) { const int row = (tid >> 6) + 8 * it; if (row < 67) *(LAS u32x4*)(raw + row * 520 + col8) = rv[it]; }
    }
    if (wv == 0) { const float a = ab_a, bb = ab_b;
        const float x = a + F.inp(17)[l * 4 + h]; const float sp = fmaxf(x, 0.f) + log1pf(expf(-fabsf(x)));
        float gg = -expf(F.inp(16)[l * 4 + h]) * sp;
#pragma unroll
        for (int o = 1; o < 64; o <<= 1) { const float t = __shfl_up(gg, o); if (lane >= o) gg += t; }
        bcum[lane] = gg; beta[lane] = 1.f / (1.f + expf(-bb)); eb[lane] = expf(gg); }
    __syncthreads();
    LAS float* vpark = (LAS float*)(F.lds + 88832);
    {   float x[64];
        const int col = (tid < 256) ? 256 + tid : (tid < 384) ? 128 + (tid - 256) : tid - 384;
        const int C = (tid < 256) ? 1024 + h * DV + tid : (tid < 384) ? 512 + h * DK + (tid - 256) : h * DK + (tid - 384);
        const float* cw = F.inp(15) + (size_t)l * 4 * CONVD + C; const float w0 = cw[0], w1 = cw[CONVD], w2 = cw[2 * CONVD], w3 = cw[3 * CONVD];
        float r0 = bf2f(raw[0 * 520 + col]), r1 = bf2f(raw[1 * 520 + col]), r2 = bf2f(raw[2 * 520 + col]);
#pragma unroll
        for (int i0 = 0; i0 < 64; i0 += 16) { unsigned rr[16];
#pragma unroll
            for (int i = 0; i < 16; ++i) rr[i] = raw[(i0 + i + 3) * 520 + col];
            asm volatile("" ::: "memory");
#pragma unroll
            for (int i = 0; i < 16; ++i) { const float r3 = bf2f(rr[i]); x[i0 + i] = siluf_(r0 * w0 + r1 * w1 + r2 * w2 + r3 * w3); r0 = r1; r1 = r2; r2 = r3; } }
    __syncthreads();
    {
        LAS float* dst = (tid < 256) ? vpark + tid : (tid < 384) ? kf + (tid - 256) : qf + (tid - 384); const int pitch = (tid < 256) ? 260 : 132;
#pragma unroll
        for (int i = 0; i < 64; ++i) dst[i * pitch] = x[i]; }
    }
    __syncthreads();
    {   const int i = tid >> 3, p = tid & 7; float sq = 0.f, sk = 0.f;
#pragma unroll
        for (int d = 0; d < 16; ++d) { const float a = qf[i * 132 + 16 * p + d], bq = kf[i * 132 + 16 * p + d]; sq += a * a; sk += bq * bq; }
        sq += __shfl_xor(sq, 1); sq += __shfl_xor(sq, 2); sq += __shfl_xor(sq, 4); sk += __shfl_xor(sk, 1); sk += __shfl_xor(sk, 2); sk += __shfl_xor(sk, 4);
        if (p == 0) { rq[i] = 0.08838834764831845f / sqrtf(sq + EPS); rk[i] = 1.f / sqrtf(sk + EPS); } }
    __syncthreads();
    unsigned char* gch = F.GCH() + (size_t)ci * GCH_BYTES; asm volatile("" : "+s"(gch)); gch = (unsigned char*)(GAS unsigned char*)gch;
#pragma unroll
    for (int rep = 0; rep < 2; ++rep) { const int idx = tid + 512 * rep;
        {   const int i = idx >> 4, s = (idx >> 2) & 3, g = idx & 3; const float sc = rq[i] * eb[i];
            const f32x4 lo = *(const LAS f32x4*)(qf + i * 132 + 32 * s + 4 * g), hi = *(const LAS f32x4*)(qf + i * 132 + 32 * s + 16 + 4 * g);
            *(bf16x8*)(gch + GCH_QD + ((i >> 4) * 4 + s) * 1024 + ((i & 15) + 16 * g) * 16) = pack8(lo * sc, hi * sc); }
        {   const int d = idx >> 3, s = (idx >> 2) & 1, g = idx & 3; const float bl = bcum[63]; float v[8];
#pragma unroll
            for (int j = 0; j < 8; ++j) { const int p = 32 * s + 16 * (j >> 2) + 4 * g + (j & 3); v[j] = kf[p * 132 + d] * rk[p] * fexp(bl - bcum[p]); }
            u32x4 w; w.x = pk2(v[0], v[1]); w.y = pk2(v[2], v[3]); w.z = pk2(v[4], v[5]); w.w = pk2(v[6], v[7]);
            *(u32x4*)(gch + GCH_KDT + ((d >> 4) * 2 + s) * 1024 + ((d & 15) + 16 * g) * 16) = w; }
    }
    if (tid == 0) F.GDCH()[ci] = fexp(bcum[63]);
    CBAR();
    {
        const int c = lane & 15, g = lane >> 4, jt = wv >> 1;
        bf16x8 A[4];
#pragma unroll
        for (int s = 0; s < 4; ++s) A[s] = lds_frag(kf + (16 * jt + c) * 132, s, g, rk[16 * jt + c]);
#pragma unroll
        for (int xx = 0; xx < 2; ++xx) { const int it = 2 * (wv & 1) + xx, i = 16 * it + c;
            f32x4 aq = (f32x4){0.f, 0.f, 0.f, 0.f}, ak = (f32x4){0.f, 0.f, 0.f, 0.f};
            if (it >= jt) {
#pragma unroll
                for (int s = 0; s < 4; ++s) { const bf16x8 Bq = lds_frag(qf + i * 132, s, g, rq[i]), Bk = lds_frag(kf + i * 132, s, g, rk[i]); aq = MFMA16(A[s], Bq, aq); ak = MFMA16(Bk, A[s], ak); CBAR(); }
            }
            const float bi = bcum[i]; float ra[4]; f32x4 rm;
#pragma unroll
            for (int r = 0; r < 4; ++r) { const int j = 16 * jt + 4 * g + r; const float dec = fexp(fminf(bi - bcum[j], 0.f)); ra[r] = (i >= j) ? aq[r] * dec : 0.f; }
            const int j2 = 16 * jt + c; const float bj2 = bcum[j2];
#pragma unroll
            for (int r = 0; r < 4; ++r) { const int i2 = 16 * it + 4 * g + r; rm[r] = (i2 > j2) ? beta[i2] * ak[r] * fexp(fminf(bcum[i2] - bj2, 0.f)) : 0.f; }
            u32x2 w; w.x = pk2(ra[0], ra[1]); w.y = pk2(ra[2], ra[3]);
            *(u32x2*)(gch + GCH_ATT + (it * 2 + (jt >> 1)) * 1024 + (c + 16 * g) * 16 + (jt & 1) * 8) = w;
            *(LAS f32x4*)(Am + j2 * 64 + 16 * it + 4 * g) = rm; }
    }
    __syncthreads();
    if (tid < 384) {
        int z0; asm volatile("v_mov_b32 %0, 0" : "=v"(z0)); const LAS float* Amz = Am + z0; const LAS float* smz = sm + z0;
        f32x2 xv[32];
        if (tid < 256) {
#pragma unroll
            for (int i = 0; i < 64; ++i) xv[i >> 1][i & 1] = vpark[i * 260 + tid] * smz[64 + i];
        } else {
#pragma unroll
            for (int i = 0; i < 64; ++i) xv[i >> 1][i & 1] = kf[i * 132 + (tid - 256)] * (smz[64 + i] * smz[192 + i] * smz[256 + i]);
        }
#pragma unroll
        for (int j = 0; j < 63; ++j) { const float xj = xv[j >> 1][j & 1]; const f32x2 xj2 = (f32x2){xj, xj};
#pragma unroll
            for (int i4 = (j + 1) / 4; i4 < 16; ++i4) { const f32x4 a = *(const LAS f32x4*)(Amz + j * 64 + 4 * i4);
                xv[2 * i4] -= (f32x2){a.x, a.y} * xj2; xv[2 * i4 + 1] -= (f32x2){a.z, a.w} * xj2; if ((i4 & 3) == 3) CBAR(); } CBAR(); }
        float x[64];
#pragma unroll
        for (int i = 0; i < 64; ++i) x[i] = xv[i >> 1][i & 1];
        if (tid < 256) { unsigned char* dstb = (unsigned char*)F.GUT() + (size_t)ci * 32768; asm volatile("" : "+s"(dstb)); dstb = (unsigned char*)(GAS unsigned char*)dstb; unsigned char* dst = dstb + (tid >> 4) * 2048 + (tid & 15) * 16;
#pragma unroll
            for (int q = 0; q < 16; ++q) { u32x2 w; w.x = pk2(x[4 * q], x[4 * q + 1]); w.y = pk2(x[4 * q + 2], x[4 * q + 3]); *(u32x2*)(dst + (q >> 3) * 1024 + (q & 3) * 256 + ((q >> 2) & 1) * 8) = w; } }
        else { const int d = tid - 256;
#pragma unroll
            for (int i = 0; i < 64; ++i) wst[i * 136 + d] = (bf16_t)f2bf(x[i]); }
    }
    __syncthreads();
#pragma unroll
    for (int rep = 0; rep < 2; ++rep) { const int idx = tid + 512 * rep, i = idx >> 4, s = (idx >> 2) & 3, g = idx & 3;
        const u32x2 lo = *(const LAS u32x2*)(wst + i * 136 + 32 * s + 4 * g), hi = *(const LAS u32x2*)(wst + i * 136 + 32 * s + 16 + 4 * g);
        *(u32x4*)(gch + GCH_W + ((i >> 4) * 4 + s) * 1024 + ((i & 15) + 16 * g) * 16) = (u32x4){lo.x, lo.y, hi.x, hi.y}; }
    __syncthreads();
}

__device__ __forceinline__ void mem_attn_unit(const Frame& F, int l, int u) {
    const int lane = F.lane, wv = F.wave, c = lane & 15, g = lane >> 4;
    const int bh = u >> 4, qb = u & 15, b = bh >> 2, h = bh & 3, mq = b * SEQ + qb * 128 + wv * 16;
    bf16x8 Qf[8]; { const unsigned qo = ((unsigned)(mq + c) * NWIN + PC_MQ + h * 256) * 2u;
#pragma unroll
        for (int s = 0; s < 8; ++s) Qf[s] = ldnat(F.PROJ(), qo, s, g); }
    asm volatile("s_waitcnt vmcnt(0)" ::: "memory");
    const unsigned char* kf = (const unsigned char*)F.MK() + ((((size_t)l * NB + b) * NH + h) << 17) + lane * 16;
    const unsigned char* vf = (const unsigned char*)F.MVT() + ((((size_t)l * NB + b) * NH + h) << 17) + lane * 16;
    LAS unsigned char* ring = F.lds;
#define ATT_DMA(ch_) do { const unsigned char* src_ = ((ch_) < 4 ? kf + (ch_) * 32768 : vf + ((ch_) - 4) * 32768); LAS unsigned char* dst_ = ring + ((ch_) % 3) * 32768; \
        _Pragma("unroll") for (int k_ = 0; k_ < 4; ++k_) __builtin_amdgcn_global_load_lds((const unsigned*)(src_ + (wv + 8 * k_) * 1024), (LAS unsigned*)(dst_ + (wv + 8 * k_) * 1024), 16, 0, 0); } while (0)
#define ATT_WAIT(n_) do { if ((n_) == 4) asm volatile("s_waitcnt vmcnt(4)" ::: "memory"); else if ((n_) == 8) asm volatile("s_waitcnt vmcnt(8)" ::: "memory"); else asm volatile("s_waitcnt vmcnt(12)" ::: "memory"); \
        __builtin_amdgcn_s_barrier(); asm volatile("" ::: "memory"); } while (0)
    ATT_DMA(0); ATT_DMA(1);
    f32x4 sacc[16]; bf16x8 Pf[8]; float inv = 1.f;
    bf16_t* obase = F.OBR() + 2 * OBR_STRIDE; const unsigned oo = ((unsigned)(mq + c) * D + h * 256 + 4 * g) * 2u;
#pragma unroll
    for (int ch = 0; ch < 8; ++ch) {
        ATT_WAIT((ch + 1 < 8 ? 4 : 0) + (ch - 1 >= 4 ? 4 : 0) + (ch - 2 >= 4 ? 4 : 0));
        if (ch + 2 < 8) ATT_DMA(ch + 2);
        const LAS unsigned char* Bq = ring + (ch % 3) * 32768 + lane * 16;
        if (ch < 4) {
#pragma unroll
            for (int k4 = 0; k4 < 4; ++k4) { f32x4 a0 = (f32x4){0.f, 0.f, 0.f, 0.f};
#pragma unroll
                for (int s = 0; s < 8; ++s) a0 = MFMA16(*(const LAS bf16x8*)(Bq + (k4 * 8 + s) * 1024), Qf[s], a0);
                sacc[4 * ch + k4] = a0; }
            if (ch == 3) {
                float mx = -3.0e38f;
#pragma unroll
                for (int kt = 0; kt < 16; ++kt)
#pragma unroll
                    for (int r = 0; r < 4; ++r) mx = fmaxf(mx, sacc[kt][r]);
                mx = fmaxf(mx, __shfl_xor(mx, 16)); mx = fmaxf(mx, __shfl_xor(mx, 32));
                float sum = 0.f; const float sc = 0.0625f * 1.4426950408889634f;
#pragma unroll
                for (int kt = 0; kt < 16; ++kt)
#pragma unroll
                    for (int r = 0; r < 4; ++r) { const float p = __builtin_amdgcn_exp2f((sacc[kt][r] - mx) * sc); sacc[kt][r] = p; sum += p; }
                sum += __shfl_xor(sum, 16); sum += __shfl_xor(sum, 32);
                inv = 1.f / sum;
#pragma unroll
                for (int ks = 0; ks < 8; ++ks) Pf[ks] = pack8(sacc[2 * ks], sacc[2 * ks + 1]);
            }
        } else {
#pragma unroll
            for (int e4 = 0; e4 < 4; ++e4) { f32x4 a0 = (f32x4){0.f, 0.f, 0.f, 0.f}; const int et = 4 * (ch - 4) + e4;
#pragma unroll
                for (int ks = 0; ks < 8; ++ks) a0 = MFMA16(*(const LAS bf16x8*)(Bq + (e4 * 8 + ks) * 1024), Pf[ks], a0);
                u32x2 w; w.x = pk2(a0[0] * inv, a0[1] * inv); w.y = pk2(a0[2] * inv, a0[3] * inv);
                *(u32x2*)((char*)obase + (oo + 32u * et)) = w; }
        }
        asm volatile("" ::: "memory");
    }
    asm volatile("s_waitcnt lgkmcnt(0)" ::: "memory"); __builtin_amdgcn_s_barrier(); asm volatile("" ::: "memory");
#undef ATT_DMA
#undef ATT_WAIT
}

struct ScanPF { bf16x8 vb[2][2]; float dch; };
#define RAW_BAR() do { asm volatile("s_waitcnt lgkmcnt(0)" ::: "memory"); __builtin_amdgcn_s_barrier(); asm volatile("" ::: "memory"); } while (0)
template <bool GDN> __device__ __forceinline__ void scan_prefetch(const Frame& F, ScanPF& P, int bh, int n, int lane, int wv, int c, int g, int colg, float dch_ret) {
    const int b = bh >> 2, e0 = 32 * wv;
    if (GDN) { const unsigned char* up = (const unsigned char*)F.GUT() + (size_t)(bh * 32 + n) * 32768 + (2 * wv) * 2048 + lane * 16;
#pragma unroll
        for (int k = 0; k < 4; ++k) __builtin_amdgcn_global_load_lds((const unsigned*)(up + k * 1024), (LAS unsigned*)(F.lds + 2 * 57344 + 4096 + wv * 4096 + k * 1024), 16, 0, 0);
        unsigned dci = (unsigned)(bh * 32 + n) * 4u; asm volatile("" : "+v"(dci)); P.dch = *(const float*)((const char*)F.GDCH() + dci);
    } else { const unsigned char* vp = F.RVT() + (size_t)(bh * 32 + n) * 32768 + (2 * wv) * 2048 + lane * 16;
#pragma unroll
        for (int s = 0; s < 2; ++s) { P.vb[s][0] = *(const bf16x8*)(vp + s * 1024); P.vb[s][1] = *(const bf16x8*)(vp + 2048 + s * 1024); }
        P.dch = dch_ret; }
}
template <bool GDN> __device__ __forceinline__ void scan_touch(ScanPF& P) {
    asm volatile("" : "+v"(P.dch));
    if (GDN) {}
    else asm volatile("" : "+v"(P.vb[0][0]), "+v"(P.vb[0][1]), "+v"(P.vb[1][0]), "+v"(P.vb[1][1]));
}
template <bool GDN, int BUF> __device__ __forceinline__ void scan_chunk(const Frame& F, f32x4 (&S)[8][2], ScanPF& cur, ScanPF& nxt, int bh, int n, int h, int colg, float dch_ret, const float* gnp, bf16_t* obr) {
    const int lane = F.lane, wv = F.wave, c = lane & 15, g = lane >> 4, b = bh >> 2, e0 = 32 * wv;
    constexpr int CHB = GDN ? GCH_BYTES : RCH_BYTES, NBLK = CHB / 1024, OQD = GDN ? GCH_QD : RCH_QD, OATT = GDN ? GCH_ATT : RCH_ATT, OKDT = GDN ? GCH_KDT : RCH_KDT, LBUF = 57344;
    LAS unsigned char* lbuf = F.lds; LAS float* ssq = (LAS float*)(F.lds + 2 * LBUF);
    const LAS unsigned char* Bq = lbuf + BUF * LBUF + lane * 16;
#define LFRAG(off_) (*(const LAS bf16x8*)(Bq + (off_)))
    scan_touch<GDN>(cur);
    f32x4 vn[4][2];
    if (GDN) {
        const LAS unsigned char* ul = F.lds + 2 * LBUF + 4096 + wv * 4096 + lane * 16;
#pragma unroll
        for (int cb = 0; cb < 2; ++cb)
#pragma unroll
            for (int rp = 0; rp < 2; ++rp) { const u32x4 uu = *(const LAS u32x4*)(ul + (cb * 2 + rp) * 1024);
                vn[2 * rp][cb] = (f32x4){bf2f(uu.x & 0xffffu), bf2f(uu.x >> 16), bf2f(uu.y & 0xffffu), bf2f(uu.y >> 16)};
                vn[2 * rp + 1][cb] = (f32x4){bf2f(uu.z & 0xffffu), bf2f(uu.z >> 16), bf2f(uu.w & 0xffffu), bf2f(uu.w >> 16)}; }
        asm volatile("s_waitcnt lgkmcnt(0)" ::: "memory");
    }
    if (n + 1 < NCH) {
        const unsigned char* chb = (GDN ? F.GCH() : F.RCH()) + (size_t)(bh * 32 + n + 1) * CHB + lane * 16;
#pragma unroll
        for (int k = 0; k < (NBLK + 7) / 8; ++k) { const int kb = wv + 8 * k; if (kb < NBLK) __builtin_amdgcn_global_load_lds((const unsigned*)(chb + kb * 1024), (LAS unsigned*)(lbuf + (BUF ^ 1) * LBUF + kb * 1024), 16, 0, 0); }
        CBAR();
        scan_prefetch<GDN>(F, nxt, bh, n + 1, lane, wv, c, g, colg, dch_ret);
    }
    CBAR();
    bf16x8 Sb[4][2];
#pragma unroll
    for (int s = 0; s < 4; ++s) { Sb[s][0] = pack8(S[2 * s][0], S[2 * s + 1][0]); Sb[s][1] = pack8(S[2 * s][1], S[2 * s + 1][1]); }
    bf16x8 Vb[2][2];
    if (GDN) {
#pragma unroll
        for (int rt = 0; rt < 4; ++rt) { f32x4 p0 = (f32x4){0.f, 0.f, 0.f, 0.f}, p1 = p0;
#pragma unroll
            for (int s = 0; s < 4; ++s) { const bf16x8 A = LFRAG(GCH_W + (rt * 4 + s) * 1024); p0 = MFMA16(A, Sb[s][0], p0); p1 = MFMA16(A, Sb[s][1], p1); }
            vn[rt][0] -= p0; vn[rt][1] -= p1; if (rt & 1) CBAR(); }
#pragma unroll
        for (int s = 0; s < 2; ++s) { Vb[s][0] = pack8(vn[2 * s][0], vn[2 * s + 1][0]); Vb[s][1] = pack8(vn[2 * s][1], vn[2 * s + 1][1]); }
    } else {
#pragma unroll
        for (int s = 0; s < 2; ++s) { Vb[s][0] = cur.vb[s][0]; Vb[s][1] = cur.vb[s][1]; }
    }
    CBAR();
    u32x2 gw[4][2];
    {   unsigned m0g = (unsigned)(b * SEQ + n * CH + c); asm volatile("" : "+v"(m0g)); const unsigned pb = (m0g * NWIN + colg + e0 + 4 * g) * 2u; const char* PROJp = (const char*)F.PROJ();
#pragma unroll
        for (int rt = 0; rt < 4; ++rt) { gw[rt][0] = *(const u32x2*)(PROJp + (pb + (unsigned)(16 * rt) * NWIN * 2u)); gw[rt][1] = *(const u32x2*)(PROJp + (pb + (unsigned)(16 * rt) * NWIN * 2u + 32u)); } }
    CBAR();
    f32x4 OT[4][2];
#pragma unroll
    for (int rt = 0; rt < 4; ++rt) { f32x4 o0 = (f32x4){0.f, 0.f, 0.f, 0.f}, o1 = o0;
#pragma unroll
        for (int s = 0; s < 4; ++s) { const bf16x8 Bf = LFRAG(OQD + (rt * 4 + s) * 1024); o0 = MFMA16(Sb[s][0], Bf, o0); o1 = MFMA16(Sb[s][1], Bf, o1); }
#pragma unroll
        for (int s = 0; s < 2; ++s) { const bf16x8 Bf = LFRAG(OATT + (rt * 2 + s) * 1024); o0 = MFMA16(Vb[s][0], Bf, o0); o1 = MFMA16(Vb[s][1], Bf, o1); }
        OT[rt][0] = o0; OT[rt][1] = o1; if (rt & 1) CBAR(); }
    const float dch = cur.dch;
#pragma unroll
    for (int t = 0; t < 8; ++t) { f32x4 s0 = S[t][0] * dch, s1 = S[t][1] * dch;
#pragma unroll
        for (int s = 0; s < 2; ++s) { const bf16x8 A = LFRAG(OKDT + (t * 2 + s) * 1024); s0 = MFMA16(A, Vb[s][0], s0); s1 = MFMA16(A, Vb[s][1], s1); }
        S[t][0] = s0; S[t][1] = s1; if ((t & 3) == 3) CBAR(); }
#pragma unroll
    for (int rt = 0; rt < 4; ++rt) { float q = 0.f;
#pragma unroll
        for (int r = 0; r < 4; ++r) q += OT[rt][0][r] * OT[rt][0][r] + OT[rt][1][r] * OT[rt][1][r];
        q += __shfl_xor(q, 16); q += __shfl_xor(q, 32);
        if (g == 0) ssq[(BUF * 8 + wv) * 64 + 16 * rt + c] = q; }
    RAW_BAR();
    {   unsigned m0o = (unsigned)(b * SEQ + n * CH + c); asm volatile("" : "+v"(m0o));
        const unsigned ob = (m0o * D + h * DV + e0 + 4 * g) * 2u;
#pragma unroll
        for (int rt = 0; rt < 4; ++rt) { float tot = 0.f;
#pragma unroll
            for (int w = 0; w < 8; ++w) tot += ssq[(BUF * 8 + w) * 64 + 16 * rt + c];
            const float rstd = 1.f / sqrtf(tot * (1.f / DV) + EPS);
#pragma unroll
            for (int cb = 0; cb < 2; ++cb) { const u32x2 gq = gw[rt][cb]; const f32x4 o = OT[rt][cb] * rstd;
                const float r0 = o[0] * bf2f(gq.x & 0xffffu), r1 = o[1] * bf2f(gq.x >> 16), r2 = o[2] * bf2f(gq.y & 0xffffu), r3 = o[3] * bf2f(gq.y >> 16);
                u32x2 w2; w2.x = pk2(r0, r1); w2.y = pk2(r2, r3);
                *(u32x2*)((char*)obr + (ob + (unsigned)(16 * rt) * D * 2u + 32u * cb)) = w2; } } }
    asm volatile("s_waitcnt vmcnt(8)" ::: "memory"); RAW_BAR();
#undef LFRAG
}
template <bool GDN> __device__ __forceinline__ void scan_bh(const Frame& F, int l, int bh) {
    const int lane = F.lane, wv = F.wave, c = lane & 15, g = lane >> 4, b = bh >> 2, h = bh & 3, e0 = 32 * wv;
    constexpr int CHB = GDN ? GCH_BYTES : RCH_BYTES, NBLK = CHB / 1024;
    const float lg = log1pf(-exp2f(-5.0f - (float)h)); const float dch_ret = fexp(lg * 64.f);
    f32x4 S[8][2];
#pragma unroll
    for (int t = 0; t < 8; ++t) { S[t][0] = (f32x4){0.f, 0.f, 0.f, 0.f}; S[t][1] = (f32x4){0.f, 0.f, 0.f, 0.f}; }
    const int colg = (GDN ? PC_GZ : PC_RG) + h * DV;
    bf16_t* obr = F.OBR() + (GDN ? OBR_STRIDE : 0);
    const float* gnp = F.inp(18) + l * DV;
    ScanPF PA, PB;
    {   const unsigned char* chb = (GDN ? F.GCH() : F.RCH()) + (size_t)(bh * 32) * CHB + lane * 16;
#pragma unroll
        for (int k = 0; k < (NBLK + 7) / 8; ++k) { const int kb = wv + 8 * k; if (kb < NBLK) __builtin_amdgcn_global_load_lds((const unsigned*)(chb + kb * 1024), (LAS unsigned*)(F.lds + kb * 1024), 16, 0, 0); } }
    scan_prefetch<GDN>(F, PA, bh, 0, lane, wv, c, g, colg, dch_ret);
    asm volatile("s_waitcnt vmcnt(0)" ::: "memory"); RAW_BAR();
    for (int n = 0; n < NCH; n += 2) {
        asm volatile("" ::: "memory");
        scan_chunk<GDN, 0>(F, S, PA, PB, bh, n, h, colg, dch_ret, gnp, obr);
        scan_chunk<GDN, 1>(F, S, PB, PA, bh, n + 1, h, colg, dch_ret, gnp, obr);
    }
    float* so = F.out + (GDN ? O_SGP : O_SRP) + ((size_t)(l * NB + b) * NH + h) * (size_t)(DK * DV);
    unsigned sbo = (unsigned)((4 * g) * DV + e0 + c) * 4u; asm volatile("" : "+v"(sbo));
#pragma unroll
    for (int t = 0; t < 8; ++t)
#pragma unroll
        for (int cb = 0; cb < 2; ++cb)
#pragma unroll
            for (int r = 0; r < 4; ++r) *(float*)((char*)so + (sbo + (unsigned)((16 * t + r) * DV + 16 * cb) * 4u)) = S[t][cb][r];
}
#undef RAW_BAR

template <bool GDN> __device__ __forceinline__ void sample_step(const Frame& F, int l, int item) {
    const int tid = F.tid, lane = F.lane, wv = F.wave, s = item >> 2, h = item & 3; const size_t m = (size_t)(MP + s);
    LAS float* qv = (LAS float*)F.lds;
    LAS float* kv = qv + 128;
    LAS float* vv = qv + 256;
    LAS float* sc = qv + 512;
    LAS float* partq = qv + 1024;
    LAS float* partk = partq + 2048;
    float dec, beta_ = 1.f;
    if (GDN) {
        const int C = (tid < 256) ? 1024 + h * DV + tid : (tid < 384) ? 512 + h * DK + (tid - 256) : h * DK + (tid - 384);
        const float* cbp = F.inp(5) + ((size_t)(l * MS + s) * 3) * CONVD + C; const float* cw = F.inp(15) + (size_t)l * 4 * CONVD + C;
        const float c0 = cbp[0], c1 = cbp[CONVD], c2 = cbp[2 * CONVD], rw = bf2f(F.PROJ()[m * NWIN + PC_GQKV + C]);
        const float val = siluf_(c0 * cw[0] + c1 * cw[CONVD] + c2 * cw[2 * CONVD] + rw * cw[3 * CONVD]);
        float* cvo = F.out + O_CVS + ((size_t)(l * MS + s) * 3) * CONVD + C; cvo[0] = c1; cvo[CONVD] = c2; cvo[2 * CONVD] = rw;
        if (tid < 256) vv[tid] = val; else if (tid < 384) kv[tid - 256] = val; else qv[tid - 384] = val;
        __syncthreads();
        if (wv < 2) { LAS float* p = (wv == 0) ? qv : kv; const float a = p[lane], bq = p[lane + 64]; const float ss = wave_sum(a * a + bq * bq);
            if (lane == 0) sc[wv] = (wv == 0) ? 0.08838834764831845f / sqrtf(ss + EPS) : 1.f / sqrtf(ss + EPS); }
        __syncthreads();
        const float rq = sc[0], rk = sc[1];
        __syncthreads();
        if (tid < 128) { qv[tid] *= rq; kv[tid] *= rk; }
        const float a = F.AB()[m * 8 + h], bb = F.AB()[m * 8 + 4 + h]; const float x = a + F.inp(17)[l * 4 + h]; const float sp = fmaxf(x, 0.f) + log1pf(expf(-fabsf(x)));
        dec = expf(-expf(F.inp(16)[l * 4 + h]) * sp); beta_ = 1.f / (1.f + expf(-bb));
    } else {
        if (tid < 64) { const int d = tid; const bf16_t* qrow = F.PROJ() + m * NWIN + PC_RQ + h * DK; const bf16_t* krow = F.PROJ() + m * NWIN + PC_RK + h * DK;
            const float cs = F.COS()[2048 * 64 + d], sn = F.SIN()[2048 * 64 + d]; const float q1 = bf2f(qrow[d]), q2 = bf2f(qrow[d + 64]), k1 = bf2f(krow[d]), k2 = bf2f(krow[d + 64]);
            qv[d] = q1 * cs - q2 * sn; qv[d + 64] = q1 * sn + q2 * cs; kv[d] = (k1 * cs - k2 * sn) * 0.08838834764831845f; kv[d + 64] = (k1 * sn + k2 * cs) * 0.08838834764831845f; }
        else if (tid < 320) vv[tid - 64] = bf2f(F.PROJ()[m * NWIN + PC_RV + h * DV + (tid - 64)]);
        dec = 1.f - exp2f(-5.0f - (float)h);
    }
    __syncthreads();
    float qk = 0.f;
#pragma unroll 8
    for (int d = 0; d < 128; ++d) qk += qv[d] * kv[d];
    const int e4 = lane * 4, dq = wv;
    const size_t sofs = ((size_t)(l * MS + s) * NH + h) * (size_t)(DK * DV);
    const float* S0 = F.inp(GDN ? 4 : 3) + sofs + (size_t)(16 * dq) * DV + e4;
    f32x4 st[16]; f32x4 aq = (f32x4){0.f, 0.f, 0.f, 0.f}, ak = aq;
#pragma unroll
    for (int i = 0; i < 16; ++i) st[i] = *(const f32x4*)(S0 + (size_t)i * DV);
#pragma unroll
    for (int i = 0; i < 16; ++i) { aq += st[i] * qv[16 * dq + i]; if (GDN) ak += st[i] * kv[16 * dq + i]; }
    *(LAS f32x4*)(partq + dq * 256 + e4) = aq; if (GDN) *(LAS f32x4*)(partk + dq * 256 + e4) = ak;
    __syncthreads();
    f32x4 qS = (f32x4){0.f, 0.f, 0.f, 0.f}, kS = qS;
#pragma unroll
    for (int w = 0; w < 8; ++w) { qS += *(const LAS f32x4*)(partq + w * 256 + e4); if (GDN) kS += *(const LAS f32x4*)(partk + w * 256 + e4); }
    const f32x4 v4 = *(const LAS f32x4*)(vv + e4);
    const f32x4 vnew = GDN ? (v4 - kS * dec) * beta_ : v4;
    const f32x4 o = qS * dec + vnew * qk;
    float* S1 = F.out + (GDN ? O_SGS : O_SRS) + sofs + (size_t)(16 * dq) * DV + e4;
#pragma unroll
    for (int i = 0; i < 16; ++i) *(f32x4*)(S1 + (size_t)i * DV) = st[i] * dec + vnew * kv[16 * dq + i];
    const float ssq = wave_sum((o.x * o.x + o.y * o.y) + (o.z * o.z + o.w * o.w));
    if (dq == 0) { const float rstd = 1.f / sqrtf(ssq * (1.f / DV) + EPS); const bf16_t* gp = F.PROJ() + m * NWIN + (GDN ? PC_GZ : PC_RG) + h * DV + e4; float r4[4];
#pragma unroll
        for (int j = 0; j < 4; ++j) r4[j] = o[j] * rstd * bf2f(gp[j]);
        u32x2 w; w.x = pk2(r4[0], r4[1]); w.y = pk2(r4[2], r4[3]);
        *(u32x2*)(F.OBR() + (GDN ? OBR_STRIDE : 0) + m * D + h * DV + e4) = w; }
    __syncthreads();
}
__device__ __forceinline__ void sample_attn(const Frame& F, int l, int item) {
    const int tid = F.tid, lane = F.lane, wv = F.wave, s = item >> 2, h = item & 3; const size_t m = (size_t)(MP + s);
    LAS float* scs = (LAS float*)F.lds;
    LAS float* part = scs + 512;
    LAS float* sinv = scs + 256;
    f32x4 q4; { const u32x2 qw = *(const u32x2*)(F.PROJ() + m * NWIN + PC_MQ + h * 256 + lane * 4); q4 = (f32x4){bf2f(qw.x & 0xffffu), bf2f(qw.x >> 16), bf2f(qw.y & 0xffffu), bf2f(qw.y >> 16)}; }
    const float* Kb = F.inp(6) + (((size_t)(l * MS + s) * NMEM) * NH + h) * 256 + lane * 4;
    const float* Vb = F.inp(7) + (((size_t)(l * MS + s) * NMEM) * NH + h) * 256 + lane * 4;
    float myscore = 0.f;
#pragma unroll
    for (int k8 = 0; k8 < 4; ++k8) { f32x4 kk[8];
#pragma unroll
        for (int j = 0; j < 8; ++j) kk[j] = *(const f32x4*)(Kb + (size_t)(32 * wv + 8 * k8 + j) * (NH * 256));
#pragma unroll
        for (int j = 0; j < 8; ++j) { const float d = wave_sum((kk[j].x * q4.x + kk[j].y * q4.y) + (kk[j].z * q4.z + kk[j].w * q4.w)); if (lane == 8 * k8 + j) myscore = d; } }
    if (lane < 32) scs[32 * wv + lane] = myscore * 0.0625f;
    __syncthreads();
    if (wv == 0) { const f32x4 s4 = *(const LAS f32x4*)(scs + 4 * lane); float mx = fmaxf(fmaxf(s4.x, s4.y), fmaxf(s4.z, s4.w));
#pragma unroll
        for (int o = 1; o < 64; o <<= 1) mx = fmaxf(mx, __shfl_xor(mx, o));
        const f32x4 p = (f32x4){fexp(s4.x - mx), fexp(s4.y - mx), fexp(s4.z - mx), fexp(s4.w - mx)}; const float sum = wave_sum((p.x + p.y) + (p.z + p.w));
        *(LAS f32x4*)(scs + 4 * lane) = p; if (lane == 0) sinv[0] = 1.f / sum; }
    __syncthreads();
    f32x4 acc = (f32x4){0.f, 0.f, 0.f, 0.f};
#pragma unroll
    for (int k8 = 0; k8 < 4; ++k8) { f32x4 vv[8];
#pragma unroll
        for (int j = 0; j < 8; ++j) vv[j] = *(const f32x4*)(Vb + (size_t)(32 * wv + 8 * k8 + j) * (NH * 256));
#pragma unroll
        for (int j = 0; j < 8; ++j) acc += vv[j] * scs[32 * wv + 8 * k8 + j]; }
    *(LAS f32x4*)(part + wv * 256 + lane * 4) = acc;
    __syncthreads();
    if (wv == 0) { f32x4 o = (f32x4){0.f, 0.f, 0.f, 0.f};
#pragma unroll
        for (int w = 0; w < 8; ++w) o += *(const LAS f32x4*)(part + w * 256 + lane * 4);
        o = o * sinv[0]; u32x2 w2; w2.x = pk2(o.x, o.y); w2.y = pk2(o.z, o.w);
        *(u32x2*)(F.OBR() + 2 * OBR_STRIDE + m * D + h * 256 + lane * 4) = w2; }
    __syncthreads();
}

struct SEpiF32 { static constexpr int NBF = 1, NSEG = 1; float* C;
    __device__ __forceinline__ int brow(int st, int) const { return 16 * st; }
    __device__ __forceinline__ void fold(f32x4 (&tot)[1], const f32x4 (&acc)[1], int, int, int, int) const { tot[0] = acc[0]; }
    __device__ __forceinline__ void store(const f32x4 (&tot)[1], int row, int st, int g) const { *(f32x4*)(C + (size_t)row * D + 16 * st + 4 * g) = tot[0]; } };
struct SEpiBf16 { static constexpr int NBF = 1, NSEG = 1; bf16_t* O; int ldc;
    __device__ __forceinline__ int brow(int st, int) const { return 16 * st; }
    __device__ __forceinline__ void fold(f32x4 (&tot)[1], const f32x4 (&acc)[1], int, int, int, int) const { tot[0] = acc[0]; }
    __device__ __forceinline__ void store(const f32x4 (&tot)[1], int row, int st, int g) const { u32x2 w; w.x = pk2(tot[0][0], tot[0][1]); w.y = pk2(tot[0][2], tot[0][3]); *(u32x2*)(O + (size_t)row * ldc + 16 * st + 4 * g) = w; } };
struct SEpiProj { static constexpr int NBF = 1, NSEG = 1; bf16_t* O; const float* gn; const float* rs;
    __device__ __forceinline__ int brow(int st, int) const { return 16 * st; }
    __device__ __forceinline__ void fold(f32x4 (&tot)[1], const f32x4 (&acc)[1], int, int, int, int) const { tot[0] = acc[0]; }
    __device__ __forceinline__ void store(const f32x4 (&tot)[1], int row, int st, int g) const { const int col = 16 * st + 4 * g; f32x4 v = tot[0] * rs[row];
        if (col >= PC_RG && col < PC_RG + 1024) {
#pragma unroll
            for (int q = 0; q < 4; ++q) v[q] = siluf_(v[q]); }
        else if (col >= PC_GZ && col < PC_GZ + 1024) {
#pragma unroll
            for (int q = 0; q < 4; ++q) v[q] = siluf_(v[q]) * gn[(col + q) & 255]; }
        u32x2 w; w.x = pk2(v[0], v[1]); w.y = pk2(v[2], v[3]); *(u32x2*)(O + (size_t)row * NWIN + col) = w; } };
struct SEpiSwiGLU { static constexpr int NBF = 2, NSEG = 1; bf16_t* O; const float* rs;
    __device__ __forceinline__ int brow(int st, int bfi) const { return (st >> 3) * 256 + (st & 7) * 16 + 128 * bfi; }
    __device__ __forceinline__ void fold(f32x4 (&tot)[2], const f32x4 (&acc)[2], int, int, int, int) const { tot[0] = acc[0]; tot[1] = acc[1]; }
    __device__ __forceinline__ void store(const f32x4 (&tot)[2], int row, int st, int g) const { float r[4];
#pragma unroll
        for (int j = 0; j < 4; ++j) r[j] = siluf_(tot[0][j] * rs[row]) * (tot[1][j] * rs[row]);
        u32x2 w; w.x = pk2(r[0], r[1]); w.y = pk2(r[2], r[3]); *(u32x2*)(O + (size_t)row * DFF + 16 * st + 4 * g) = w; } };
struct SEpiBranch { static constexpr int NBF = 1, NSEG = 3; bf16_t* O; const bf16_t* proj;
    __device__ __forceinline__ int brow(int st, int) const { return 16 * st; }
    __device__ __forceinline__ void fold(f32x4 (&tot)[1], const f32x4 (&acc)[1], int seg, int row, int st, int g) const {
        const u32x2 gw = *(const u32x2*)(proj + (size_t)row * NWIN + PC_GATE + seg * D + 16 * st + 4 * g);
        const f32x4 gt = (f32x4){sigmoidf_(bf2f(gw.x & 0xffffu)), sigmoidf_(bf2f(gw.x >> 16)), sigmoidf_(bf2f(gw.y & 0xffffu)), sigmoidf_(bf2f(gw.y >> 16))};
        tot[0] = (seg == 0) ? gt * acc[0] : tot[0] + gt * acc[0]; }
    __device__ __forceinline__ void store(const f32x4 (&tot)[1], int row, int st, int g) const { u32x2 w; w.x = pk2(tot[0][0], tot[0][1]); w.y = pk2(tot[0][2], tot[0][3]); *(u32x2*)(O + (size_t)row * D + 16 * st + 4 * g) = w; } };
template <int K, class EpiS, int RT = 4, int NS = 1> __device__ __forceinline__ void small_gemm(const Frame& F, const bf16_t* A, size_t aseg, const bf16_t* Bt, size_t bseg, int nstrips, int first, int count, const EpiS& E) {
    static_assert(RT == 4 ? NS == 1 : (NS == 1 || NS == 4), "small_gemm shapes");
    const int j = (F.bid - first + F.G) % F.G; if (j >= count) return;
    constexpr int NBF = EpiS::NBF, KQ = K / 4, NKS = KQ / 32, BATCH = (RT == 1 && NS == 1 && NBF == 1) ? NKS : (NBF == 2) ? 4 : 8, RQ = 4 / RT, NT = RT * NS;
    const int lane = F.lane, wv = F.wave, c = lane & 15, g = lane >> 4, rh = wv & 1, kq = wv >> 1;
    LAS f32x4* red = (LAS f32x4*)F.lds;
    for (int it = j; it < (nstrips / NS) * RQ; it += count) {
        const int sg = it / RQ, rq = it - sg * RQ, t0 = (RT == 4) ? rh * 4 : rq * 2 + rh;
        f32x4 tot[NBF][NT];
#pragma unroll
        for (int seg = 0; seg < EpiS::NSEG; ++seg) {
            f32x4 acc[NBF][NT];
#pragma unroll
            for (int q = 0; q < NBF; ++q)
#pragma unroll
                for (int t = 0; t < NT; ++t) acc[q][t] = (f32x4){0.f, 0.f, 0.f, 0.f};
            const char* ap = (const char*)(A + seg * aseg); unsigned ao = ((unsigned)(MP + t0 * 16 + c) * K + kq * KQ + 8 * g) * 2u; asm volatile("" : "+v"(ao));
            const char* bp = (const char*)(Bt + seg * bseg); unsigned bo[NBF][NS];
#pragma unroll
            for (int q = 0; q < NBF; ++q)
#pragma unroll
                for (int n = 0; n < NS; ++n) { bo[q][n] = ((unsigned)(E.brow(sg * NS + n, q) + c) * K + kq * KQ + 8 * g) * 2u; asm volatile("" : "+v"(bo[q][n])); }
#pragma unroll
            for (int ks0 = 0; ks0 < NKS; ks0 += BATCH) {
                bf16x8 af[RT][BATCH], bfr[NBF][NS][BATCH];
#pragma unroll
                for (int s = 0; s < BATCH; ++s) if (ks0 + s < NKS) {
#pragma unroll
                    for (int q = 0; q < NBF; ++q)
#pragma unroll
                        for (int n = 0; n < NS; ++n) bfr[q][n][s] = *(const bf16x8*)(bp + (bo[q][n] + (unsigned)(ks0 + s) * 64u));
#pragma unroll
                    for (int t = 0; t < RT; ++t) af[t][s] = *(const bf16x8*)(ap + (ao + (unsigned)(t * 16 * K * 2) + (unsigned)(ks0 + s) * 64u)); }
#pragma unroll
                for (int s = 0; s < BATCH; ++s) if (ks0 + s < NKS) {
#pragma unroll
                    for (int q = 0; q < NBF; ++q)
#pragma unroll
                        for (int n = 0; n < NS; ++n)
#pragma unroll
                            for (int t = 0; t < RT; ++t) acc[q][n * RT + t] = MFMA16(bfr[q][n][s], af[t][s], acc[q][n * RT + t]); }
                CBAR();
            }
#pragma unroll
            for (int n = 0; n < NS; ++n)
#pragma unroll
                for (int t = 0; t < RT; ++t) { f32x4 a1[NBF], t1[NBF];
#pragma unroll
                    for (int q = 0; q < NBF; ++q) { a1[q] = acc[q][n * RT + t]; t1[q] = tot[q][n * RT + t]; }
                    E.fold(t1, a1, seg, MP + (t0 + t) * 16 + c, sg * NS + n, g);
#pragma unroll
                    for (int q = 0; q < NBF; ++q) tot[q][n * RT + t] = t1[q]; }
        }
#pragma unroll
        for (int q = 0; q < NBF; ++q)
#pragma unroll
            for (int t = 0; t < NT; ++t) red[((q * 8 + wv) * NT + t) * 64 + lane] = tot[q][t];
        __syncthreads();
        if (NT == 4 || kq == 0) {
            const int tf = (NT == 4) ? kq : 0; f32x4 fin[NBF];
#pragma unroll
            for (int q = 0; q < NBF; ++q) { f32x4 s4 = (f32x4){0.f, 0.f, 0.f, 0.f};
#pragma unroll
                for (int k2 = 0; k2 < 4; ++k2) s4 += red[((q * 8 + rh + 2 * k2) * NT + tf) * 64 + lane];
                fin[q] = s4; }
            E.store(fin, MP + (t0 + (RT == 4 ? tf : 0)) * 16 + c, sg * NS + (RT == 4 ? 0 : tf), g); }
        __syncthreads();
    }
}

__device__ __forceinline__ const void* opaque_ptr(const void* p) { unsigned lo = __builtin_amdgcn_readfirstlane((unsigned)(size_t)p), hi = __builtin_amdgcn_readfirstlane((unsigned)((size_t)p >> 32));
    asm volatile("" : "+s"(lo), "+s"(hi)); return (const void*)(const GAS void*)(((size_t)hi << 32) | lo); }
__device__ __forceinline__ void stagger(int bid, int step_ticks) { const unsigned long long t0 = __builtin_amdgcn_s_memrealtime(), d = (unsigned long long)((bid >> 3) & 3) * (unsigned long long)step_ticks;
    while (__builtin_amdgcn_s_memrealtime() - t0 < d) __builtin_amdgcn_s_sleep(8); }
#ifndef STAG_TICKS
#define STAG_TICKS 0
#endif
#ifndef EN_SITES
#define EN_SITES 0x7ff
#endif
#define SITE(k) ((EN_SITES >> (k)) & 1)
#ifndef EN_PP
#define EN_PP 0xf
#endif
#ifndef EN_SP
#define EN_SP 0x1f
#endif
#define PP(k) ((EN_PP >> (k)) & 1)
#define SP(k) ((EN_SP >> (k)) & 1)
constexpr int NPHASE = 25;
__global__ void __launch_bounds__(NWAVES * 64, 2) fwd(Args args) {
    extern __shared__ __attribute__((aligned(16))) unsigned char lds_raw[];
    Frame F;
    F.lds = (LAS unsigned char*)lds_raw; F.tid = threadIdx.x; F.lane = F.tid & 63; F.wave = __builtin_amdgcn_readfirstlane(F.tid >> 6); F.G = gridDim.x; F.bid = blockIdx.x;
    F.A = &args; F.zo = 0; F.out = args.out; F.ws = args.ws; unsigned char* ws = args.ws;
    volatile LAS unsigned* MISC = (volatile LAS unsigned*)(F.lds + MISC_OFF);
    if (F.tid < 64) ((LAS unsigned*)(F.lds + MISC_OFF))[F.tid] = 0u;
    __syncthreads();
    const int lo = args.ph_lo, hi = args.ph_hi, sel = args.sel;
    XcdBarrier bar; bar.bar = (unsigned*)(ws + WS_CTL) + CW_BAR; bar.x = 0; bar.st = nullptr;
    if (hi - lo > 1) bar = xcd_barrier_post((unsigned*)(ws + WS_CTL) + CW_BAR, MISC + 8);
#define IN(k) (lo <= (k) && (k) < hi)
#define SITE_FRAME() Frame Fp = F; { Fp.ws = (unsigned char*)opaque_ptr(F.ws); Fp.out = (float*)opaque_ptr(F.out); } { int t_ = (int)threadIdx.x, b_ = (int)blockIdx.x, z_; asm volatile("s_mov_b32 %0, 0" : "=s"(z_)); Fp.zo = z_; asm volatile("" : "+v"(t_), "+s"(b_)); Fp.tid = t_; Fp.lane = t_ & 63; Fp.wave = __builtin_amdgcn_readfirstlane(t_ >> 6); Fp.bid = b_; } const int bid = Fp.bid
#define SEAM(k) do { if (IN(k) && IN((k) + 1)) { XcdBarrier b2_ = bar; b2_.bar = (unsigned*)opaque_ptr(bar.bar); xcd_barrier(b2_, Fp.tid == 0); } } while (0)
    const int G = F.G;

    if (SITE(0) && IN(0)) { SITE_FRAME(); p0_prologue(Fp); SEAM(0); }
    for (int l = 0; l < 2; ++l) {
        const int base = 1 + 12 * l;
        for (int half = 0; half < 2; ++half) {
            const int pb = base + 9 * half;
            if (SITE(2) && IN(pb)) { SITE_FRAME();
                pg8::Gemm g{Fp.H(), (const bf16_t*)(Fp.ws + WS_W0 + (size_t)l * WS_WL + (half ? OFF_W2I : OFF_W1I)), D};
                pg8::EpiSwiGLU E{Fp.ACT(), Fp.RS()};
                const bool split_tail = !(l == 0 && half == 0) && (G & 1) == 0 && 2 * (((MP / 256) * (NFFI / 256)) % G) <= G;
                if (split_tail) { pg8::HalfTailOrder S; S.init(MP, NFFI, D, G, bid); pg8::gemm_phase<pg8::EpiSwiGLU, pg8::HalfTailOrder, true, true, true>(Fp.lds, g, S, E, Fp.tid); }
                else { pg8::StaticOrder S; S.init(MP, NFFI, D, G, bid); pg8::gemm_phase<pg8::EpiSwiGLU, pg8::StaticOrder, true, true>(Fp.lds, g, S, E, Fp.tid); }
                if (l == 0 && half == 0 && bid >= G / 2) {
                    pg8::Gemm g2{Fp.MEMN(), (const bf16_t*)(Fp.ws + WS_WMKV), D}; pg8::GroupAOrder S2; S2.init(NB * NMEM, 4096, D, G / 2, bid - G / 2); S2.grp = 8; S2.astride = (size_t)NB * NMEM * D * 2;
                    pg8::EpiMemKV E2{Fp.out + O_MKP, Fp.out + O_MVP, Fp.MK(), Fp.MVT()};
                    pg8::gemm_phase<pg8::EpiMemKV, pg8::GroupAOrder, false, true>(Fp.lds, g2, S2, E2, Fp.tid);
                }
                { SEpiSwiGLU SE{Fp.ACT(), Fp.RS()}; if (split_tail) small_gemm<D>(Fp, g.A, 0, g.Bt, 0, DFF / 16, 0, G, SE); else small_gemm<D>(Fp, g.A, 0, g.Bt, 0, DFF / 16, G / 2, G / 2, SE); }
                SEAM(pb);
            }
            if (SITE(3) && IN(pb + 1)) { SITE_FRAME();
                pg8::Gemm g{Fp.ACT(), (const bf16_t*)(Fp.ws + WS_W0 + (size_t)l * WS_WL + (half ? OFF_W2O : OFF_W1O)), DFF}; pg8::StaticOrder S; S.init(MP, D, DFF, G, bid, WGM_N1024);
                pg8::EpiBf16 E{Fp.TMP(), D};
                pg8::gemm_phase<pg8::EpiBf16, pg8::StaticOrder, true, true>(Fp.lds, g, S, E, Fp.tid);
                { SEpiBf16 SE{Fp.TMP(), D}; small_gemm<DFF, SEpiBf16, 1>(Fp, g.A, 0, g.Bt, 0, D / 16, 0, G, SE); }
                SEAM(pb + 1);
            }
            if (SITE(4) && IN(pb + 2)) { SITE_FRAME();
                NormArgs na; na.tmp = Fp.TMP(); na.scale = 0.5f; na.first = 0;
                if (half == 0) { na.gpost = Fp.inp(9) + l * D; na.gpre = Fp.inp(12) + l * D; na.wab = Fp.WAB() + (size_t)l * 8 * D; na.fin = 0; }
                else { na.gpost = Fp.inp(27) + l * D; na.gpre = Fp.inp(8) + (l == 0 ? D : 0); na.wab = nullptr; na.fin = (l == 1); }
                norm_phase(Fp, na);
                SEAM(pb + 2);
            }
            if (half == 0) {
                if (SITE(5) && IN(base + 3)) { SITE_FRAME();
                    pg8::Gemm g{Fp.H(), (const bf16_t*)(Fp.ws + WS_W0 + (size_t)l * WS_WL + OFF_WIN), D}; pg8::StaticOrder S; S.init(MP, NWIN, D, G, bid);
                    pg8::EpiProj E{Fp.PROJ(), Fp.inp(18) + l * DV, Fp.RS()};
                    pg8::gemm_phase<pg8::EpiProj, pg8::StaticOrder, true, true>(Fp.lds, g, S, E, Fp.tid);
                    { SEpiProj SE{Fp.PROJ(), Fp.inp(18) + l * DV, Fp.RS()}; small_gemm<D, SEpiProj, 1, 4>(Fp, g.A, 0, g.Bt, 0, NWIN / 16, 0, G, SE); }
                    SEAM(base + 3);
                }
                if (SITE(6) && IN(base + 4)) { SITE_FRAME();
                    if (PP(0) && (sel & 1)) for (int ci = bid; ci < NB * NH * NCH; ci += G) gdn_prep(Fp, l, ci);
                    if (PP(1) && (sel & 2)) for (int ci = bid; ci < NB * NH * NCH; ci += G) ret_prep(Fp, ci);
                    if (PP(2) && (sel & 4) && l == 0) { const int xcd = bid & 7, slot = bid >> 3, per = G >> 3;
                        if ((G & 7) == 0) { for (int ux = slot; ux < 64; ux += per) mem_attn_unit(Fp, l, (xcd * 4 + (ux >> 4)) * 16 + (ux & 15)); }
                        else for (int u = bid; u < NB * NH * 16; u += G) mem_attn_unit(Fp, l, u); }
                    if (PP(3) && bid < NB) { for (int i = Fp.tid; i < 3 * CONVD; i += NWAVES * 64) { const int j = i / CONVD, C = i % CONVD;
                        Fp.out[O_CVP + ((size_t)(l * NB + bid) * 3 + j) * CONVD + C] = bf2f(Fp.PROJ()[(size_t)(bid * SEQ + SEQ - 3 + j) * NWIN + PC_GQKV + C]); } }
                    SEAM(base + 4);
                }
                if (SITE(7) && IN(base + 5)) { SITE_FRAME();
                    if (bid < 32) { if (SP(0) && (sel & 8)) scan_bh<false>(Fp, l, bid); }
                    else if (bid < 64) { if (SP(1) && (sel & 8)) scan_bh<true>(Fp, l, bid - 32); }
                    else { const int nw = G - 64;
                        if (SP(2) && (sel & 16)) for (int it = bid - 64; it < MS * NH; it += nw) sample_step<true>(Fp, l, it);
                        if (SP(3) && (sel & 16)) for (int it = bid - 64; it < MS * NH; it += nw) sample_step<false>(Fp, l, it);
                        if (SP(4) && (sel & 32)) for (int it = bid - 64; it < MS * NH; it += nw) sample_attn(Fp, l, it);
                        if (l == 0 && (sel & 64)) convert_layer1(Fp, bid - 64, nw);
                        if (l == 1 && (sel & 4)) {
                            if ((G & 7) == 0) { const int xcd = bid & 7, slot = (bid >> 3) - 8, per = (G >> 3) - 8; for (int ux = slot; ux < 64; ux += per) mem_attn_unit(Fp, l, (xcd * 4 + (ux >> 4)) * 16 + (ux & 15)); }
                            else for (int u = bid - 64; u < NB * NH * 16; u += nw) mem_attn_unit(Fp, l, u); } }
                    SEAM(base + 5);
                }
                if (SITE(8) && IN(base + 6)) { SITE_FRAME();
                    pg8::Gemm g{Fp.OBR(), (const bf16_t*)(Fp.ws + WS_W0 + (size_t)l * WS_WL + OFF_WBR), D}; pg8::SegOrder S; S.init(MP, D, D, G, bid, WGM_N1024); S.nseg = 3; S.aseg = OBR_STRIDE * 2; S.bseg = (size_t)D * D * 2;
                    pg8::EpiBranch E{Fp.MERGED(), Fp.PROJ()};
                    pg8::gemm_phase<pg8::EpiBranch, pg8::SegOrder, true, true>(Fp.lds, g, S, E, Fp.tid);
                    { SEpiBranch SE{Fp.MERGED(), Fp.PROJ()}; small_gemm<D, SEpiBranch, 1>(Fp, g.A, OBR_STRIDE, g.Bt, (size_t)D * D, D / 16, 0, G, SE); }
                    SEAM(base + 6);
                }
                if (SITE(9) && IN(base + 7)) { SITE_FRAME();
                    pg8::Gemm g{Fp.MERGED(), (const bf16_t*)(Fp.ws + WS_W0 + (size_t)l * WS_WL + OFF_WO), D}; pg8::StaticOrder S; S.init(MP, D, D, G, bid, WGM_N1024);
                    pg8::EpiBf16 E{Fp.TMP(), D};
                    pg8::gemm_phase<pg8::EpiBf16, pg8::StaticOrder, true, true>(Fp.lds, g, S, E, Fp.tid);
                    { SEpiBf16 SE{Fp.TMP(), D}; small_gemm<D, SEpiBf16, 1>(Fp, g.A, 0, g.Bt, 0, D / 16, 0, G, SE); }
                    SEAM(base + 7);
                }
                if (SITE(10) && IN(base + 8)) { SITE_FRAME();
                    NormArgs na; na.tmp = Fp.TMP(); na.scale = 1.0f; na.first = 0; na.gpost = Fp.inp(13) + l * D; na.gpre = Fp.inp(26) + l * D; na.wab = nullptr; na.fin = 0;
                    norm_phase(Fp, na);
                    SEAM(base + 8);
                }
            }
        }
    }
#undef IN
#undef SEAM
}

extern "C" void kernel_launch(void* const* d_in, const int* in_sizes, int n_in, void* d_out, int out_size, void* d_ws, size_t ws_size, hipStream_t stream) {
    static int grid = 0;
    if (grid == 0) {
        if (n_in != 30 || (size_t)out_size != O_END || ws_size < WS_END) { fprintf(stderr, "kernel_launch: unexpected shapes: n_in %d out %d ws %zu (need %zu)\n", n_in, out_size, ws_size, (size_t)WS_END); grid = -1; return; }
        int dev = 0, cus = 0, per_cu = 0;
        if (hipGetDevice(&dev) != hipSuccess || hipDeviceGetAttribute(&cus, hipDeviceAttributeMultiprocessorCount, dev) != hipSuccess) { grid = -1; return; }
        if (hipFuncSetAttribute((const void*)fwd, hipFuncAttributeMaxDynamicSharedMemorySize, LDS_BYTES) != hipSuccess) { fprintf(stderr, "kernel_launch: hipFuncSetAttribute failed\n"); grid = -1; return; }
        if (hipOccupancyMaxActiveBlocksPerMultiprocessor(&per_cu, (const void*)fwd, NWAVES * 64, LDS_BYTES) != hipSuccess || per_cu < 1) { fprintf(stderr, "kernel_launch: occupancy query reports %d\n", per_cu); }
        (void)hipGetLastError();
        grid = cus;
        if (grid < 64) { fprintf(stderr, "kernel_launch: needs >= 64 CUs\n"); grid = -1; return; }
    }
    if (grid < 0) return;
    if (hipMemsetAsync((char*)d_ws + WS_CTL, 0, CTL_ZERO_BYTES, stream) != hipSuccess) return;
    Args a{};
    for (int i = 0; i < 30; ++i) a.in[i] = (const float*)d_in[i];
    a.out = (float*)d_out; a.ws = (unsigned char*)d_ws;
#ifndef MK_ONE_LAUNCH
#define MK_ONE_LAUNCH 1
#endif
    a.sel = 0xff; a.pad = 0;
#ifndef PROBE_PH
#define PROBE_PH -1
#endif
#ifndef PROBE_SEL
#define PROBE_SEL 0xff
#endif
    if (MK_ONE_LAUNCH) { a.ph_lo = 0; a.ph_hi = NPHASE; hipLaunchKernelGGL(fwd, dim3(grid), dim3(NWAVES * 64), LDS_BYTES, stream, a); }
    else for (int p = 0; p < NPHASE; ++p) { a.ph_lo = p; a.ph_hi = p + 1; a.sel = 0xff; hipLaunchKernelGGL(fwd, dim3(grid), dim3(NWAVES * 64), LDS_BYTES, stream, a);
        if (PROBE_PH >= 0 && (p == PROBE_PH || (PROBE_PH >= 1 && p == PROBE_PH + 12))) { a.sel = PROBE_SEL; hipLaunchKernelGGL(fwd, dim3(grid), dim3(NWAVES * 64), LDS_BYTES, stream, a); } }
}
```

```cpp
#include <hip/hip_runtime.h>
#include <cstdio>
#include <cstdint>

#define LAS __attribute__((address_space(3)))
#define GAS __attribute__((address_space(1)))
typedef unsigned short bf16_t;
typedef short bf16x8 __attribute__((ext_vector_type(8)));
typedef short bf16x4 __attribute__((ext_vector_type(4)));
typedef float f32x4 __attribute__((ext_vector_type(4)));
typedef float f32x2 __attribute__((ext_vector_type(2)));
typedef unsigned u32x4 __attribute__((ext_vector_type(4)));
typedef unsigned u32x2 __attribute__((ext_vector_type(2)));
typedef __bf16 bf16x2_t __attribute__((ext_vector_type(2)));
typedef GAS unsigned gu32;

constexpr int D = 1024, SEQ = 2048, NB = 8, MP = NB * SEQ, MS = 128, MREAL = MP + MS, MPAD = 16640;
constexpr int DFF = 2816, NFFI = 2 * DFF, NWIN = 10240, WIN_RAW = 10248;
constexpr int NH = 4, DK = 128, DV = 256, CH = 64, NCH = SEQ / CH, NMEM = 256, CONVD = 2048;
constexpr int PC_RQ = 0, PC_RK = 512, PC_RV = 1024, PC_RG = 2048, PC_GQKV = 3072, PC_GZ = 5120, PC_MQ = 6144, PC_GATE = 7168;
constexpr float EPS = 1e-6f;
constexpr int PAST_LEN = 16384;

__device__ __forceinline__ unsigned f2bf(float f) { unsigned u = __builtin_bit_cast(unsigned, f); return (u + 0x7fffu + ((u >> 16) & 1u)) >> 16; }
__device__ __forceinline__ float bf2f(unsigned b) { return __builtin_bit_cast(float, b << 16); }
__device__ __forceinline__ unsigned pk2(float lo, float hi) { f32x2 v = {lo, hi}; bf16x2_t b = __builtin_convertvector(v, bf16x2_t); return __builtin_bit_cast(unsigned, b); }
__device__ __forceinline__ bf16x8 pack8(f32x4 a, f32x4 b) { u32x4 p; p.x = pk2(a.x, a.y); p.y = pk2(a.z, a.w); p.z = pk2(b.x, b.y); p.w = pk2(b.z, b.w); return __builtin_bit_cast(bf16x8, p); }
__device__ __forceinline__ float fexp(float x) { return __builtin_amdgcn_exp2f(x * 1.4426950408889634f); }
__device__ __forceinline__ float sigmoidf_(float x) { return __builtin_amdgcn_rcpf(1.0f + fexp(-x)); }
__device__ __forceinline__ float siluf_(float x) { return x * sigmoidf_(x); }
__device__ __forceinline__ float wave_sum(float v) {
#pragma unroll
    for (int o = 1; o < 64; o <<= 1) v += __shfl_xor(v, o);
    return v;
}
#define MFMA16(a, b, c) __builtin_amdgcn_mfma_f32_16x16x32_bf16((a), (b), (c), 0, 0, 0)

namespace pg8 {
#define PG8_LAS __attribute__((address_space(3)))
constexpr int BM = 256, BK = 64, HALF = 128, HTB = HALF * BK * 2  , STAGE_BYTES = 8 * HTB, NXCD = 8;
__host__ __device__ __forceinline__ int lds_byte(int r, int c) { const int st = (r >> 4) * 2 + (c >> 5), rr = r & 15, cc = c & 31, ob = rr * 64 + cc * 2; return st * 1024 + (ob ^ (((ob >> 9) & 1) << 5)); }
__host__ __device__ __forceinline__ void stage_rc(int b, int& R, int& C) { const int st = b / 1024, sb = b % 1024, swz = sb ^ (((sb >> 9) & 1) << 5); R = (st >> 1) * 16 + swz / 64; C = (st & 1) * 32 + (swz % 64) / 2; }
__host__ __device__ __forceinline__ int perm32(int rho) { const int n = rho >> 4, i = rho & 15; return 8 * (i >> 2) + 4 * n + (i & 3); }

#ifndef WGM_DEFAULT
#define WGM_DEFAULT 2
#endif
#ifndef WGM_N1024
#define WGM_N1024 8
#endif
struct Unit { int pm, pn, seg; size_t aofs, bofs; };
struct Gemm { const bf16_t* A; const bf16_t* Bt; int K; };

struct StaticOrder {
    int nM, nN, nwg, G, c, WGM; size_t tstep;
    __device__ void init(int M, int N, int K, int G_, int c_, int wgm = WGM_DEFAULT) { nM = M / BM; nN = N / BM; nwg = nM * nN; G = G_; c = c_; WGM = wgm; tstep = (size_t)BM * K * 2; }
    __device__ bool tile(long L, int& pm, int& pn) const {
        if (L >= nwg) return false;
        int wgid = (int)L; { const int q = nwg / NXCD, r = nwg % NXCD, xcd = wgid % NXCD, off = wgid / NXCD; wgid = (xcd < r ? xcd * (q + 1) : r * (q + 1) + (xcd - r) * q) + off; }
        const int nig = WGM * nN, gid = wgid / nig, fm = gid * WGM, gsz = (nM - fm) < WGM ? (nM - fm) : WGM;
        pm = fm + ((wgid % nig) % gsz); pn = (wgid % nig) / gsz; return true;
    }
    __device__ bool next(int i, Unit& u) const {
        if (!tile((long)i * G + c, u.pm, u.pn)) return false;
        u.seg = 0; u.aofs = (size_t)u.pm * tstep; u.bofs = (size_t)u.pn * tstep; return true;
    }
    __device__ __forceinline__ void a_ready(const Unit&) const {}
    __device__ __forceinline__ void done(const Unit&) const {}
};
struct GroupAOrder : StaticOrder {
    int grp; size_t astride;
    __device__ bool next(int i, Unit& u) const {
        if (!tile((long)i * G + c, u.pm, u.pn)) return false;
        u.seg = 0; u.aofs = (size_t)(u.pn / grp) * astride + (size_t)u.pm * tstep; u.bofs = (size_t)u.pn * tstep; return true;
    }
};
struct SegOrder : StaticOrder {
    int nseg; size_t aseg, bseg;
    __device__ bool next(int i, Unit& u) const {
        const int round = i / nseg, seg = i - round * nseg;
        if (!tile((long)round * G + c, u.pm, u.pn)) return false;
        u.seg = seg; u.aofs = (size_t)seg * aseg + (size_t)u.pm * tstep; u.bofs = (size_t)seg * bseg + (size_t)u.pn * tstep; return true;
    }
};

struct EpiF32 {
    static constexpr int NST = 32; static constexpr bool RSLDS = false; static constexpr bool PERM = false, AFTER_DRAIN = false;
    float* C; int ldc;
    __device__ __forceinline__ void operator()(const f32x4 (&acc)[2][2][4][2], const Unit& u, int wr, int wc, int fr, int fq) const {
        const int row0 = u.pm * BM + wr * 64 + fr, col0 = u.pn * BM + wc * 32 + 4 * fq;
#pragma unroll
        for (int ai = 0; ai < 2; ++ai)
#pragma unroll
            for (int m = 0; m < 4; ++m) { float* rowp = C + (size_t)(row0 + ai * HALF + m * 16) * ldc + col0;
#pragma unroll
                for (int bj = 0; bj < 2; ++bj)
#pragma unroll
                    for (int n = 0; n < 2; ++n) *(f32x4*)(rowp + bj * HALF + n * 16) = acc[ai][bj][m][n]; }
    }
};
struct EpiBf16 {
    static constexpr int NST = 16; static constexpr bool RSLDS = false; static constexpr bool PERM = true, AFTER_DRAIN = false;
    bf16_t* O; int ldc;
    __device__ __forceinline__ void operator()(const f32x4 (&acc)[2][2][4][2], const Unit& u, int wr, int wc, int fr, int fq) const {
        const int row0 = u.pm * BM + wr * 64 + fr, col0 = u.pn * BM + wc * 32 + 8 * fq;
        unsigned bo = ((unsigned)row0 * (unsigned)ldc + (unsigned)col0) * 2u; asm volatile("" : "+v"(bo));
        const unsigned rs = (unsigned)ldc * 2u;
#pragma unroll
        for (int ai = 0; ai < 2; ++ai)
#pragma unroll
            for (int m = 0; m < 4; ++m) {
#pragma unroll
                for (int bj = 0; bj < 2; ++bj) { const f32x4 v0 = acc[ai][bj][m][0], v1 = acc[ai][bj][m][1];
                    u32x4 w; w.x = pk2(v0[0], v0[1]); w.y = pk2(v0[2], v0[3]); w.z = pk2(v1[0], v1[1]); w.w = pk2(v1[2], v1[3]);
                    *(u32x4*)((char*)O + (bo + (unsigned)(ai * HALF + m * 16) * rs + (unsigned)(bj * HALF * 2))) = w; } }
    }
};
struct EpiProj {
    static constexpr int NST = 16; static constexpr bool RSLDS = true; static constexpr bool PERM = true, AFTER_DRAIN = false; __device__ static __forceinline__ bool keep_acc(const Unit&) { return false; }
    bf16_t* O; const float* gn; const float* rs;
    __device__ __forceinline__ void operator()(const f32x4 (&acc)[2][2][4][2], const Unit& u, int wr, int wc, int fr, int fq, const LAS float* rsl) const {
        const int row0 = u.pm * BM + wr * 64 + fr, col0 = u.pn * BM + wc * 32 + 8 * fq;
        unsigned bo = ((unsigned)row0 * (unsigned)NWIN + (unsigned)col0) * 2u; asm volatile("" : "+v"(bo));
        const unsigned rstride = (unsigned)NWIN * 2u;
        const int mode = (u.pn >= 8 && u.pn < 12) ? 1 : (u.pn >= 20 && u.pn < 24) ? 2 : 0;
        float gs[2][8];
#pragma unroll
        for (int bj = 0; bj < 2; ++bj)
#pragma unroll
            for (int j = 0; j < 8; ++j) gs[bj][j] = (mode == 2) ? gn[(col0 + bj * HALF + j) & 255] : 1.f;
#pragma unroll
        for (int ai = 0; ai < 2; ++ai)
#pragma unroll
            for (int m = 0; m < 4; ++m) {
#pragma unroll
                for (int bj = 0; bj < 2; ++bj) { const float rv = rsl[wr * 64 + fr + ai * HALF + m * 16]; f32x4 v0 = acc[ai][bj][m][0] * rv, v1 = acc[ai][bj][m][1] * rv;
                    if (mode != 0) {
#pragma unroll
                        for (int j = 0; j < 4; ++j) { v0[j] = siluf_(v0[j]) * gs[bj][j]; v1[j] = siluf_(v1[j]) * gs[bj][4 + j]; } }
                    u32x4 w; w.x = pk2(v0[0], v0[1]); w.y = pk2(v0[2], v0[3]); w.z = pk2(v1[0], v1[1]); w.w = pk2(v1[2], v1[3]);
                    *(u32x4*)((char*)O + (bo + (unsigned)(ai * HALF + m * 16) * rstride + (unsigned)(bj * HALF * 2))) = w; } }
    }
};
struct EpiSwiGLU {
    static constexpr int NST = 8; static constexpr bool RSLDS = true; static constexpr bool PERM = true, AFTER_DRAIN = false;
    bf16_t* O; const float* rs;
    __device__ __forceinline__ void operator()(const f32x4 (&acc)[2][2][4][2], const Unit& u, int wr, int wc, int fr, int fq, const LAS float* rsl) const {
        const int row0 = u.pm * BM + wr * 64 + fr, col0 = u.pn * HALF + wc * 32 + 8 * fq;
#pragma unroll
        for (int ai = 0; ai < 2; ++ai)
#pragma unroll
            for (int m = 0; m < 4; ++m) { bf16_t* rowp = O + (size_t)(row0 + ai * HALF + m * 16) * DFF + col0;
                float r[8]; const float rv = rsl[wr * 64 + fr + ai * HALF + m * 16];
#pragma unroll
                for (int n = 0; n < 2; ++n)
#pragma unroll
                    for (int j = 0; j < 4; ++j) { const float g = acc[ai][0][m][n][j] * rv, up = acc[ai][1][m][n][j] * rv; r[4 * n + j] = siluf_(g) * up; }
                u32x4 w; w.x = pk2(r[0], r[1]); w.y = pk2(r[2], r[3]); w.z = pk2(r[4], r[5]); w.w = pk2(r[6], r[7]);
                *(u32x4*)rowp = w; }
    }
};
struct EpiMemKV {
    static constexpr int NST = 0; static constexpr bool RSLDS = false; static constexpr bool PERM = false, AFTER_DRAIN = false;
    float* outK; float* outV; bf16_t* MK; bf16_t* MVT;
    __device__ __forceinline__ void operator()(const f32x4 (&acc)[2][2][4][2], const Unit& u, int wr, int wc, int fr, int fq) const {
        const int layer = u.pn >> 3, isv = (u.pn >> 2) & 1, cb = (u.pn & 3) * BM;
        const int row0 = u.pm * BM + wr * 64 + fr, col0 = cb + wc * 32 + 4 * fq;
        float* of = (isv ? outV : outK) + (size_t)layer * (NB * NMEM * D);
#pragma unroll
        for (int ai = 0; ai < 2; ++ai)
#pragma unroll
            for (int m = 0; m < 4; ++m) { const int row = row0 + ai * HALF + m * 16;
#pragma unroll
                for (int bj = 0; bj < 2; ++bj)
#pragma unroll
                    for (int n = 0; n < 2; ++n) { const int col = col0 + bj * HALF + n * 16; const f32x4 v = acc[ai][bj][m][n];
                        *(f32x4*)(of + (size_t)row * D + col) = v;
                        const int b = row >> 8, key = row & 255, h = col >> 8, dd = col & 255;
                        unsigned char* fb = (unsigned char*)(isv ? MVT : MK) + ((((size_t)layer * NB + b) * NH + h) << 17);
                        if (!isv) { u32x2 w; w.x = pk2(v[0], v[1]); w.y = pk2(v[2], v[3]);
                            *(u32x2*)(fb + ((((key >> 4) * 8 + (dd >> 5)) * 64 + (key & 15) + 16 * ((dd & 31) >> 3)) << 4) + ((dd & 4) << 1)) = w; }
                        else {
                            const int ks = key >> 5, w5 = key & 31, gg = (w5 & 15) >> 2, jj = (w5 & 3) + 4 * (w5 >> 4);
#pragma unroll
                            for (int j = 0; j < 4; ++j) { const int e = dd + j; *(bf16_t*)(fb + (((((e >> 4) * 8 + ks) * 64 + (e & 15) + 16 * gg) << 4) + jj * 2)) = (bf16_t)f2bf(v[j]); } } } }
    }
};
struct EpiBranch {
    static constexpr int NST = 16; static constexpr bool RSLDS = false; static constexpr bool PERM = true, AFTER_DRAIN = false;
    bf16_t* O; const bf16_t* proj; int seg_base, noold_seg;
    __device__ __forceinline__ void operator()(const f32x4 (&acc)[2][2][4][2], const Unit& u, int wr, int wc, int fr, int fq) const {
        const int row0 = u.pm * BM + wr * 64 + fr, col0 = u.pn * BM + wc * 32 + 8 * fq;
        unsigned go = ((unsigned)row0 * (unsigned)NWIN + (unsigned)(PC_GATE + (u.seg + seg_base) * D + col0)) * 2u, oo = ((unsigned)row0 * (unsigned)D + (unsigned)col0) * 2u; asm volatile("" : "+v"(go), "+v"(oo));
        const char* gb = (const char*)proj; char* ob = (char*)O;
#pragma unroll
        for (int ai = 0; ai < 2; ++ai) {
            u32x4 gwv[4][2], oldv[4][2];
#pragma unroll
            for (int m = 0; m < 4; ++m)
#pragma unroll
                for (int bj = 0; bj < 2; ++bj) { gwv[m][bj] = *(const u32x4*)(gb + (go + (unsigned)((ai * HALF + m * 16) * NWIN + bj * HALF) * 2u));
                    oldv[m][bj] = (u32x4){0u, 0u, 0u, 0u}; if (u.seg + seg_base != noold_seg) oldv[m][bj] = *(const u32x4*)(ob + (oo + (unsigned)((ai * HALF + m * 16) * D + bj * HALF) * 2u)); }
            asm volatile("" ::: "memory");
#pragma unroll
            for (int m = 0; m < 4; ++m)
#pragma unroll
                for (int bj = 0; bj < 2; ++bj) { const u32x4 gw = gwv[m][bj], old = oldv[m][bj]; float r[8];
#pragma unroll
                    for (int q = 0; q < 4; ++q) { const unsigned g2 = gw[q], o2 = old[q];
                        const float a0 = acc[ai][bj][m][q >> 1][(q & 1) * 2], a1 = acc[ai][bj][m][q >> 1][(q & 1) * 2 + 1];
                        r[2 * q] = bf2f(o2 & 0xffffu) + sigmoidf_(bf2f(g2 & 0xffffu)) * a0; r[2 * q + 1] = bf2f(o2 >> 16) + sigmoidf_(bf2f(g2 >> 16)) * a1; }
                    u32x4 w; w.x = pk2(r[0], r[1]); w.y = pk2(r[2], r[3]); w.z = pk2(r[4], r[5]); w.w = pk2(r[6], r[7]);
                    *(u32x4*)(ob + (oo + (unsigned)((ai * HALF + m * 16) * D + bj * HALF) * 2u)) = w; }
            asm volatile("" ::: "memory");
        }
    }
};

template <class Epi, class Sched, bool ALIGN_EPI = false, bool SP2 = false>
__device__ __forceinline__ void gemm_phase(PG8_LAS unsigned char* lds, const Gemm g, const Sched& S, const Epi& E, const int tid) {
    const int wid = __builtin_amdgcn_readfirstlane(tid >> 6), lane = tid & 63, wr = wid >> 2, wc = wid & 3, fr = lane & 15, fq = lane >> 4;
    const int K = g.K, nt = K / BK;
    unsigned voffA[2], voffB[2];
#pragma unroll
    for (int i = 0; i < 2; ++i) { int R, C; stage_rc(tid * 16 + i * 8192, R, C); const int Rb = Epi::PERM ? ((R & ~31) + perm32(R & 31)) : R;
        voffA[i] = (unsigned)(R * K + C) * 2u; voffB[i] = (unsigned)(Rb * K + C) * 2u; }
    const size_t kstep = (size_t)(BK * 2);
    const size_t hstep = (size_t)HALF * K * 2;
    const unsigned ldsw = (unsigned)wid * 1024u;
    const int aoff = lds_byte(wr * 64 + fr, fq * 8), boff = lds_byte(wc * 32 + fr, fq * 8);
#define PG8_SA(b, h) (((b) * 2 + (h)) * HTB)
#define PG8_SB(b, h) ((4 + (b) * 2 + (h)) * HTB)
#define PG8_STAGE(bufoff, gbase, voff) do { _Pragma("unroll") for (int _i = 0; _i < 2; ++_i) \
        __builtin_amdgcn_global_load_lds((const unsigned*)((const char*)(gbase) + (voff)[_i]), (PG8_LAS unsigned*)(lds + (bufoff) + ldsw + _i * 8192), 16, 0, 0); } while (0)
#define PG8_LDA(dst, b, h) do { _Pragma("unroll") for (int m = 0; m < 4; ++m) _Pragma("unroll") for (int k = 0; k < 2; ++k) dst[m][k] = *(const PG8_LAS bf16x8*)(lds + PG8_SA(b, h) + aoff + m * 2048 + k * 1024); } while (0)
#define PG8_LDB(dst, b, h) do { _Pragma("unroll") for (int n = 0; n < 2; ++n) _Pragma("unroll") for (int k = 0; k < 2; ++k) dst[n][k] = *(const PG8_LAS bf16x8*)(lds + PG8_SB(b, h) + boff + n * 2048 + k * 1024); } while (0)
#define PG8_MMA(ai, bj, At, Bt) do { __builtin_amdgcn_s_setprio(1); _Pragma("unroll") for (int m = 0; m < 4; ++m) _Pragma("unroll") for (int n = 0; n < 2; ++n) _Pragma("unroll") for (int k = 0; k < 2; ++k) \
        acc[ai][bj][m][n] = __builtin_amdgcn_mfma_f32_16x16x32_bf16(Bt[n][k], At[m][k], acc[ai][bj][m][n], 0, 0, 0); __builtin_amdgcn_s_setprio(0); } while (0)
#define PG8_WAIT_V(n) asm volatile("s_waitcnt vmcnt(" #n ")" ::: "memory")
#define PG8_WAIT_L(n) asm volatile("s_waitcnt lgkmcnt(" #n ")" ::: "memory")
#define PG8_BAR __builtin_amdgcn_s_barrier()
#define PG8_SCHED __builtin_amdgcn_sched_barrier(0)
    Unit cur, nxt; int ui = 0;
    if (!S.next(0, cur)) return;
    f32x4 acc[2][2][4][2];
#pragma unroll
    for (int a = 0; a < 2; ++a)
#pragma unroll
        for (int b = 0; b < 2; ++b)
#pragma unroll
            for (int m = 0; m < 4; ++m)
#pragma unroll
                for (int n = 0; n < 2; ++n) acc[a][b][m][n] = (f32x4){0.f, 0.f, 0.f, 0.f};
    bf16x8 At[4][2], B0[2][2], B1[2][2];
    const char* cA = (const char*)g.A + cur.aofs; const char* cB = (const char*)g.Bt + cur.bofs;
    S.a_ready(cur);
    if constexpr (SP2) {
        PG8_STAGE(PG8_SB(0, 0), cB, voffB); PG8_STAGE(PG8_SB(0, 1), cB + hstep, voffB); PG8_STAGE(PG8_SA(0, 0), cA, voffA); PG8_STAGE(PG8_SA(0, 1), cA + hstep, voffA);
        if (wr == 1) PG8_BAR;
        PG8_WAIT_V(2); PG8_BAR;
        PG8_STAGE(PG8_SB(1, 0), cB + kstep, voffB); PG8_STAGE(PG8_SA(1, 0), cA + kstep, voffA); PG8_STAGE(PG8_SB(1, 1), cB + hstep + kstep, voffB);
        PG8_WAIT_V(6); PG8_BAR;
    } else {
        PG8_STAGE(PG8_SB(0, 0), cB, voffB); PG8_STAGE(PG8_SA(0, 0), cA, voffA); PG8_STAGE(PG8_SB(0, 1), cB + hstep, voffB); PG8_STAGE(PG8_SA(0, 1), cA + hstep, voffA);
        if (wr == 1) PG8_BAR;
        PG8_WAIT_V(4); PG8_BAR;
        PG8_STAGE(PG8_SB(1, 0), cB + kstep, voffB); PG8_STAGE(PG8_SA(1, 0), cA + kstep, voffA); PG8_STAGE(PG8_SB(1, 1), cB + hstep + kstep, voffB);
        PG8_WAIT_V(6); PG8_BAR;
    }
    for (;;) {
        const bool has_next = S.next(ui + 1, nxt);
        if constexpr (Epi::RSLDS) {
            if (wid == 0) __builtin_amdgcn_global_load_lds((const unsigned*)(E.rs + (size_t)cur.pm * BM + lane * 4), (PG8_LAS unsigned*)(lds + STAGE_BYTES + (ui & 1) * 1024), 16, 0, 0); }
        const char* nA = has_next ? (const char*)g.A + nxt.aofs : cA; const char* nB = has_next ? (const char*)g.Bt + nxt.bofs : cB;
        for (int t = 0; t < nt; t += 2) {
            const bool last = (t == nt - 2);
            const char* a1 = cA + (size_t)(t + 1) * kstep;
            const char* a2 = last ? nA : cA + (size_t)(t + 2) * kstep; const char* b2 = last ? nB : cB + (size_t)(t + 2) * kstep;
            const char* a3 = a2 + kstep; const char* b3 = b2 + kstep;
            if (last && has_next) S.a_ready(nxt);
            if constexpr (SP2) {
            PG8_LDB(B0, 0, 0); PG8_LDB(B1, 0, 1); PG8_SCHED; PG8_LDA(At, 0, 0); PG8_STAGE(PG8_SA(1, 1), a1 + hstep, voffA);
            PG8_WAIT_V(8); PG8_WAIT_L(0); PG8_BAR; PG8_MMA(0, 0, At, B0); PG8_MMA(0, 1, At, B1); PG8_BAR; PG8_SCHED;
            PG8_LDA(At, 0, 1); PG8_STAGE(PG8_SB(0, 0), b2, voffB); PG8_STAGE(PG8_SB(0, 1), b2 + hstep, voffB); PG8_STAGE(PG8_SA(0, 0), a2, voffA);
            PG8_WAIT_V(8); PG8_WAIT_L(0); PG8_BAR; PG8_MMA(1, 0, At, B0); PG8_MMA(1, 1, At, B1); PG8_BAR; PG8_SCHED;
            PG8_LDB(B0, 1, 0); PG8_LDB(B1, 1, 1); PG8_SCHED; PG8_LDA(At, 1, 0); PG8_STAGE(PG8_SA(0, 1), a2 + hstep, voffA);
            PG8_WAIT_V(8); PG8_WAIT_L(0); PG8_BAR; PG8_MMA(0, 0, At, B0); PG8_MMA(0, 1, At, B1); PG8_BAR; PG8_SCHED;
            PG8_LDA(At, 1, 1); PG8_STAGE(PG8_SB(1, 0), b3, voffB); PG8_STAGE(PG8_SB(1, 1), b3 + hstep, voffB); PG8_STAGE(PG8_SA(1, 0), a3, voffA);
            PG8_WAIT_V(8); PG8_WAIT_L(0); PG8_BAR; PG8_MMA(1, 0, At, B0); PG8_MMA(1, 1, At, B1); PG8_BAR; PG8_SCHED;
            } else {
            PG8_LDB(B0, 0, 0); PG8_SCHED; PG8_LDA(At, 0, 0); PG8_STAGE(PG8_SA(1, 1), a1 + hstep, voffA);
            PG8_WAIT_L(8); PG8_BAR; PG8_WAIT_L(0); PG8_MMA(0, 0, At, B0); PG8_BAR; PG8_SCHED;
            PG8_LDB(B1, 0, 1); PG8_STAGE(PG8_SB(0, 0), b2, voffB);
            PG8_BAR; PG8_WAIT_L(0); PG8_MMA(0, 1, At, B1); PG8_BAR;
            PG8_LDA(At, 0, 1); PG8_STAGE(PG8_SA(0, 0), a2, voffA);
            PG8_BAR; PG8_WAIT_L(0); PG8_MMA(1, 0, At, B0); PG8_BAR; PG8_SCHED;
            PG8_STAGE(PG8_SB(0, 1), b2 + hstep, voffB);
            PG8_WAIT_V(6); PG8_BAR; PG8_MMA(1, 1, At, B1); PG8_BAR;
            PG8_LDB(B0, 1, 0); PG8_SCHED; PG8_LDA(At, 1, 0); PG8_STAGE(PG8_SA(0, 1), a2 + hstep, voffA);
            PG8_WAIT_L(8); PG8_BAR; PG8_WAIT_L(0); PG8_MMA(0, 0, At, B0); PG8_BAR; PG8_SCHED;
            PG8_LDB(B1, 1, 1); PG8_STAGE(PG8_SB(1, 0), b3, voffB);
            PG8_BAR; PG8_WAIT_L(0); PG8_MMA(0, 1, At, B1); PG8_BAR;
            PG8_LDA(At, 1, 1); PG8_STAGE(PG8_SA(1, 0), a3, voffA);
            PG8_BAR; PG8_WAIT_L(0); PG8_MMA(1, 0, At, B0); PG8_BAR; PG8_SCHED;
            PG8_STAGE(PG8_SB(1, 1), b3 + hstep, voffB);
            PG8_WAIT_V(6); PG8_BAR; PG8_MMA(1, 1, At, B1); PG8_BAR;
            }
        }
        if constexpr (ALIGN_EPI) { if (wr == 0) PG8_BAR; }
        if constexpr (Epi::RSLDS) { E(acc, cur, wr, wc, fr, fq, (const PG8_LAS float*)(lds + STAGE_BYTES + (ui & 1) * 1024)); S.done(cur); } else
        if constexpr (!Epi::AFTER_DRAIN) { E(acc, cur, wr, wc, fr, fq); S.done(cur); }
        if (!has_next) break;
#pragma unroll
        for (int a = 0; a < 2; ++a)
#pragma unroll
            for (int b = 0; b < 2; ++b)
#pragma unroll
                for (int m = 0; m < 4; ++m)
#pragma unroll
                    for (int n = 0; n < 2; ++n) acc[a][b][m][n] = (f32x4){0.f, 0.f, 0.f, 0.f};
        cur = nxt; cA = nA; cB = nB; ++ui;
        if constexpr (ALIGN_EPI) { if (wr == 1) PG8_BAR; }
    }
    PG8_WAIT_V(0);
    if constexpr (!ALIGN_EPI) { if (wr == 0) PG8_BAR; }
    PG8_BAR;
    if constexpr (Epi::AFTER_DRAIN) { E.fused(acc, cur, wr, wc, fr, fq, lds, wid, lane); S.done(cur); }
#undef PG8_SA
#undef PG8_SB
#undef PG8_STAGE
#undef PG8_LDA
#undef PG8_LDB
#undef PG8_MMA
#undef PG8_WAIT_V
#undef PG8_WAIT_L
#undef PG8_BAR
#undef PG8_SCHED
}
}

constexpr size_t MiB = 1u << 20;
constexpr size_t WS_CTL = 0, CTL_ZERO_BYTES = 32768;
constexpr size_t WS_W0 = 1 * MiB, WS_WL = 61 * MiB;
constexpr size_t OFF_W1I = 0, OFF_W1O = 11 * MiB, OFF_WIN = 16 * MiB + MiB / 2, OFF_WBR = 36 * MiB + MiB / 2, OFF_WO = 42 * MiB + MiB / 2, OFF_W2I = 44 * MiB + MiB / 2, OFF_W2O = 55 * MiB + MiB / 2;
static_assert(OFF_W2O + (size_t)D * DFF * 2 == WS_WL, "layer weight map");
constexpr size_t WS_WMKV = 123 * MiB;
constexpr size_t WS_MISC = 131 * MiB;
constexpr size_t MISC_WAB = 0, MISC_COS = 65536, MISC_SIN = 65536 + 2049 * 64 * 4;
constexpr size_t WS_MEMN = 133 * MiB, WS_MK = 141 * MiB, WS_MVT = 149 * MiB, WS_AB = 157 * MiB;
constexpr size_t WS_H = 158 * MiB, WS_TMP = 223 * MiB, WS_XN = 288 * MiB, WS_MERGED = 320 * MiB + MiB / 2, WS_OBR = 353 * MiB;
constexpr size_t OBR_STRIDE = (size_t)MPAD * D;
constexpr size_t WS_BIG = 451 * MiB;
constexpr int GCH_W = 0, GCH_QD = 16384, GCH_ATT = 32768, GCH_KDT = 40960, GCH_BYTES = 57344;
constexpr int RCH_QD = 0, RCH_ATT = 16384, RCH_KDT = 24576, RCH_BYTES = 40960;
constexpr size_t WS_RCH = 776 * MiB, WS_RVT = 816 * MiB;
constexpr size_t WS_GCH = 848 * MiB, WS_GUT = 904 * MiB, WS_GDCH = 968 * MiB;
constexpr size_t WS_END = 969 * MiB;
static_assert(WS_H + (size_t)MPAD * D * 4 == WS_TMP && WS_TMP + (size_t)MPAD * D * 4 == WS_XN && WS_XN + (size_t)MPAD * D * 2 == WS_MERGED && WS_MERGED + (size_t)MPAD * D * 2 == WS_OBR, "activation map");
static_assert(WS_OBR + 3 * OBR_STRIDE * 2 <= WS_BIG && WS_BIG + (size_t)MPAD * NWIN * 2 <= WS_RCH && WS_RCH + (size_t)1024 * RCH_BYTES <= WS_RVT && WS_GCH + (size_t)1024 * GCH_BYTES <= WS_GUT, "activation map 2");
constexpr int CW_BAR = 4096;

constexpr size_t O_YP = 0, O_YS = O_YP + (size_t)MP * D, O_SRP = O_YS + (size_t)MS * D, O_SGP = O_SRP + (size_t)2 * NB * NH * DK * DV, O_CVP = O_SGP + (size_t)2 * NB * NH * DK * DV,
                 O_MKP = O_CVP + (size_t)2 * NB * 3 * CONVD, O_MVP = O_MKP + (size_t)2 * NB * NMEM * D, O_SRS = O_MVP + (size_t)2 * NB * NMEM * D, O_SGS = O_SRS + (size_t)2 * MS * NH * DK * DV,
                 O_CVS = O_SGS + (size_t)2 * MS * NH * DK * DV, O_END = O_CVS + (size_t)2 * MS * 3 * CONVD;
static_assert(O_END == 98271232, "output size");

constexpr int LDS_BYTES = 163840, MISC_OFF = LDS_BYTES - 256;

#define XB_TMO      128
#define XB_XCNT(j)  (256  + 64 * (j))
#define XB_XSUB(j)  (1280 + 64 * (j))
#define XB_XGEN(j)  (2304 + 64 * (j))
#define XB_TOP      3328
#define XB_TOPGEN   3392
#define XCD_BAR_WORDS 3456
#define XB_SPIN_CAP (1u << 18)

__device__ __forceinline__ unsigned xb_ld(unsigned* p)              { return __hip_atomic_load(p, __ATOMIC_RELAXED, __HIP_MEMORY_SCOPE_AGENT); }
__device__ __forceinline__ unsigned xb_add(unsigned* p, unsigned v) { return __hip_atomic_fetch_add(p, v, __ATOMIC_RELAXED, __HIP_MEMORY_SCOPE_AGENT); }
__device__ __forceinline__ unsigned xb_xcc_id() { return (unsigned)__builtin_amdgcn_s_getreg((3 << 11) | 20) & 0xFu; }
#define XB_SPIN(cond, bar) do { unsigned _sp = 0; while (cond) { __builtin_amdgcn_s_sleep(1); \
    if ((++_sp & 255u) == 0u) { if (xb_ld(&(bar)[XB_TMO])) break; if (_sp > XB_SPIN_CAP) { atomicAdd(&(bar)[XB_TMO], 1u); break; } } } } while (0)

struct XcdBarrier {
    unsigned* bar; unsigned x;
    volatile LAS unsigned* st;
};

__device__ __forceinline__ XcdBarrier xcd_barrier_post(unsigned* bar, volatile LAS unsigned* st) {
    XcdBarrier b; b.bar = bar; b.x = xb_xcc_id(); b.st = st;
    if (threadIdx.x == 0) (void)xb_add(&bar[XB_XCNT(b.x)], 1u);
    return b;
}
__device__ __forceinline__ void xcd_barrier_complete(unsigned* bar, unsigned x, unsigned& nloc, unsigned& nx) {
    const unsigned G = gridDim.x * gridDim.y * gridDim.z;
    unsigned sum, cnt, mine, sp = 0u;
    for (;;) {
        sum = 0u; cnt = 0u; mine = 0u;
#pragma unroll
        for (unsigned j = 0; j < 16; ++j) { const unsigned c = xb_ld(&bar[XB_XCNT(j)]); sum += c; cnt += (c > 0u) ? 1u : 0u; mine = (j == x) ? c : mine; }
        if (sum == G) break;
        __builtin_amdgcn_s_sleep(1);
        if ((++sp & 255u) == 0u) { if (xb_ld(&bar[XB_TMO])) break; if (sp > XB_SPIN_CAP) { atomicAdd(&bar[XB_TMO], 1u); break; } }
    }
    nloc = mine > 0u ? mine : 1u; nx = cnt > 0u ? cnt : 1u;
}

__device__ __forceinline__ void xcd_barrier(const XcdBarrier& b, const bool is_thread0) {
    asm volatile("s_waitcnt vmcnt(0)" ::: "memory");
    __syncthreads();
    if (is_thread0) {
        unsigned* bar = b.bar;
        __builtin_amdgcn_s_waitcnt(0);
        unsigned nloc = b.st[0], nx = b.st[1];
        if (nloc == 0u) { xcd_barrier_complete(bar, b.x, nloc, nx); b.st[0] = nloc; b.st[1] = nx; }
        const unsigned old = xb_add(&bar[XB_XSUB(b.x)], 1u);
        const unsigned gen = old / nloc;
        if (old + 1u == (gen + 1u) * nloc) {
            __builtin_amdgcn_fence(__ATOMIC_RELEASE, "agent");
            asm volatile("s_waitcnt vmcnt(0)" ::: "memory");
            const unsigned og = xb_add(&bar[XB_TOP], 1u);
            const unsigned tg = og / nx;
            if (og + 1u == (tg + 1u) * nx) xb_add(&bar[XB_TOPGEN], 1u);
            else XB_SPIN(xb_ld(&bar[XB_TOPGEN]) == tg, bar);
            __builtin_amdgcn_fence(__ATOMIC_ACQUIRE, "agent");
            xb_add(&bar[XB_XGEN(b.x)], 1u);
            asm volatile("s_waitcnt vmcnt(0)" ::: "memory");
        } else {
            XB_SPIN(xb_ld(&bar[XB_XGEN(b.x)]) == gen, bar);
            __builtin_amdgcn_fence(__ATOMIC_ACQUIRE, "agent");
            asm volatile("s_waitcnt vmcnt(0)" ::: "memory");
        }
    }
    __syncthreads();
}

constexpr int NWAVES = 8;
struct Args { const float* in[30]; float* out; unsigned char* ws; int ph_lo, ph_hi, sel, pad; };
struct Frame {
    LAS unsigned char* lds; int tid, lane, wave, G, bid;
    const Args* A; float* out; unsigned char* ws; int zo;
    __device__ __forceinline__ const float* inp(int k) const { return *(const float* const*)((const char*)A + zo + 8 * k); }
    __device__ __forceinline__ float* RS() const { return (float*)(ws + WS_XN); }
    __device__ __forceinline__ bf16_t* MERGED() const { return (bf16_t*)(ws + WS_MERGED); }
    __device__ __forceinline__ bf16_t* OBR() const { return (bf16_t*)(ws + WS_OBR); }
    __device__ __forceinline__ bf16_t* PROJ() const { return (bf16_t*)(ws + WS_BIG); }
    __device__ __forceinline__ bf16_t* ACT() const { return (bf16_t*)(ws + WS_BIG); }
    __device__ __forceinline__ bf16_t* MEMN() const { return (bf16_t*)(ws + WS_MEMN); }
    __device__ __forceinline__ bf16_t* MK() const { return (bf16_t*)(ws + WS_MK); }
    __device__ __forceinline__ bf16_t* MVT() const { return (bf16_t*)(ws + WS_MVT); }
    __device__ __forceinline__ bf16_t* H() const { return (bf16_t*)(ws + WS_H); }
    __device__ __forceinline__ bf16_t* TMP() const { return (bf16_t*)(ws + WS_TMP); }
    __device__ __forceinline__ float* AB() const { return (float*)(ws + WS_AB); }
    __device__ __forceinline__ float* WAB() const { return (float*)(ws + WS_MISC + MISC_WAB); }
    __device__ __forceinline__ float* COS() const { return (float*)(ws + WS_MISC + MISC_COS); }
    __device__ __forceinline__ float* SIN() const { return (float*)(ws + WS_MISC + MISC_SIN); }
    __device__ __forceinline__ unsigned char* RCH() const { return ws + WS_RCH; }
    __device__ __forceinline__ unsigned char* RVT() const { return ws + WS_RVT; }
    __device__ __forceinline__ unsigned char* GCH() const { return ws + WS_GCH; }
    __device__ __forceinline__ float* GUT() const { return (float*)(ws + WS_GUT); }
    __device__ __forceinline__ float* GDCH() const { return (float*)(ws + WS_GDCH); }
};
#define LDS_WAIT() asm volatile("s_waitcnt lgkmcnt(0)" ::: "memory")

enum { WM_PLAIN = 0, WM_FFNIN = 1, WM_WIN = 2 };
__device__ __forceinline__ int map_col(int mode, int n0) {
    if (mode == WM_FFNIN) { const int tile = n0 >> 8, w = n0 & 255; return (w < 128) ? tile * 128 + w : DFF + tile * 128 + (w - 128); }
    if (mode == WM_WIN) return n0 < PC_MQ ? n0 : n0 + 8;
    return n0;
}
__device__ __forceinline__ void transpose_item(const float* W, int K, int Nraw, int N, int mode, bf16_t* WT, const float* gk, LAS float* scr, int item, int lane) {
    const int nblk = N / 32, kb = item / nblk, nb = item % nblk, k0 = 64 * kb, n0 = 32 * nb, nr0 = map_col(mode, n0);
    f32x4 wv[8];
#pragma unroll
    for (int i = 0; i < 8; ++i) wv[i] = *(const f32x4*)(W + (size_t)(k0 + 8 * i + (lane >> 3)) * Nraw + nr0 + 4 * (lane & 7));
    if (gk) {
#pragma unroll
        for (int i = 0; i < 8; ++i) wv[i] = wv[i] * gk[k0 + 8 * i + (lane >> 3)]; }
#pragma unroll
    for (int i = 0; i < 8; ++i) { LAS float* d = scr + (8 * i + (lane >> 3)) * 33 + 4 * (lane & 7); d[0] = wv[i].x; d[1] = wv[i].y; d[2] = wv[i].z; d[3] = wv[i].w; }
    LDS_WAIT(); asm volatile("" ::: "memory");
    const int c = lane & 7;
#pragma unroll
    for (int j = 0; j < 4; ++j) { const int n = (lane >> 3) + 8 * j; const LAS float* s = scr + (8 * c) * 33 + n;
        u32x4 o; o.x = pk2(s[0 * 33], s[1 * 33]); o.y = pk2(s[2 * 33], s[3 * 33]); o.z = pk2(s[4 * 33], s[5 * 33]); o.w = pk2(s[6 * 33], s[7 * 33]);
        *(u32x4*)(WT + (size_t)(n0 + n) * K + k0 + 8 * c) = o; }
    LDS_WAIT(); asm volatile("" ::: "memory");
}
struct TJob { const float* W; int K, Nraw, N, mode; bf16_t* WT; const float* gk; };
__device__ __forceinline__ TJob get_job(int j, const Frame& F) {
    const int l = j / 11, t = j % 11; unsigned char* wl = F.ws + WS_W0 + (size_t)l * WS_WL; TJob r;
    switch (t) {
    case 0:  r = TJob{F.inp(10) + (size_t)l * D * NFFI, D, NFFI, NFFI, WM_FFNIN, (bf16_t*)(wl + OFF_W1I), F.inp(8) + (size_t)l * D}; break;
    case 1:  r = TJob{F.inp(11) + (size_t)l * DFF * D, DFF, D, D, WM_PLAIN, (bf16_t*)(wl + OFF_W1O), nullptr}; break;
    case 2:  r = TJob{F.inp(14) + (size_t)l * D * WIN_RAW, D, WIN_RAW, NWIN, WM_WIN, (bf16_t*)(wl + OFF_WIN), F.inp(12) + (size_t)l * D}; break;
    case 3:  r = TJob{F.inp(20) + (size_t)l * D * D, D, D, D, WM_PLAIN, (bf16_t*)(F.ws + WS_WMKV) + (size_t)(l * 2048) * D, nullptr}; break;
    case 4:  r = TJob{F.inp(21) + (size_t)l * D * D, D, D, D, WM_PLAIN, (bf16_t*)(F.ws + WS_WMKV) + (size_t)(l * 2048 + 1024) * D, nullptr}; break;
    case 5:  r = TJob{F.inp(22) + (size_t)l * D * D, D, D, D, WM_PLAIN, (bf16_t*)(wl + OFF_WBR), nullptr}; break;
    case 6:  r = TJob{F.inp(23) + (size_t)l * D * D, D, D, D, WM_PLAIN, (bf16_t*)(wl + OFF_WBR) + (size_t)D * D, nullptr}; break;
    case 7:  r = TJob{F.inp(24) + (size_t)l * D * D, D, D, D, WM_PLAIN, (bf16_t*)(wl + OFF_WBR) + (size_t)2 * D * D, nullptr}; break;
    case 8:  r = TJob{F.inp(25) + (size_t)l * D * D, D, D, D, WM_PLAIN, (bf16_t*)(wl + OFF_WO), nullptr}; break;
    case 9:  r = TJob{F.inp(28) + (size_t)l * D * NFFI, D, NFFI, NFFI, WM_FFNIN, (bf16_t*)(wl + OFF_W2I), F.inp(26) + (size_t)l * D}; break;
    default: r = TJob{F.inp(29) + (size_t)l * DFF * D, DFF, D, D, WM_PLAIN, (bf16_t*)(wl + OFF_W2O), nullptr}; break;
    }
    return r;
}

struct NormArgs { const bf16_t* tmp; const float* gpost; float scale; const float* gpre; const float* wab; int first, fin; };
__device__ __forceinline__ void norm_phase(const Frame& F, const NormArgs na) {
    const int gw = F.bid * NWAVES + F.wave, NGW = F.G * NWAVES, lane = F.lane;
#define FI(j) (2 * lane + 128 * ((j) >> 1) + ((j) & 1))
#define NP_LD(mm, hh, tt) do { if ((mm) < MREAL) { _Pragma("unroll") for (int jj = 0; jj < 2; ++jj) { hh[jj] = *((const u32x4*)(F.H() + (size_t)(mm) * D) + lane + 64 * jj); tt[jj] = *((const u32x4*)(na.tmp + (size_t)(mm) * D) + lane + 64 * jj); } } } while (0)
#define NP_LDX(mm, xx) do { if ((mm) < MREAL) { const float* src_ = ((mm) < MP) ? F.inp(0) + (size_t)(mm) * D : F.inp(1) + (size_t)((mm) - MP) * D; _Pragma("unroll") for (int j = 0; j < 4; ++j) xx[j] = *((const f32x4*)src_ + FI(j)); } } while (0)
    const u32x4 z4 = (u32x4){0u, 0u, 0u, 0u};
    f32x4 gpq[4];
#pragma unroll
    for (int j = 0; j < 4; ++j) gpq[j] = na.tmp ? *((const f32x4*)na.gpost + FI(j)) : (f32x4){0.f, 0.f, 0.f, 0.f};
    f32x4 wq[8][4];
#pragma unroll
    for (int q = 0; q < 8; ++q)
#pragma unroll
        for (int j = 0; j < 4; ++j) wq[q][j] = na.wab ? *((const f32x4*)(na.wab + q * D) + FI(j)) : (f32x4){0.f, 0.f, 0.f, 0.f};
    u32x4 h0[2] = {z4, z4}, t0[2] = {z4, z4}, h1[2] = {z4, z4}, t1[2] = {z4, z4};
    f32x4 x0[4];
#pragma unroll
    for (int j = 0; j < 4; ++j) x0[j] = (f32x4){0.f, 0.f, 0.f, 0.f};
    if (na.first) NP_LDX(gw, x0); else { NP_LD(gw, h0, t0); NP_LD(gw + NGW, h1, t1); }
    for (int m = gw; m < MREAL; m += NGW) {
        f32x4 h[4]; const u32x4 tc[2] = {t0[0], t0[1]};
        if (na.first) {
#pragma unroll
            for (int j = 0; j < 4; ++j) h[j] = x0[j];
            NP_LDX(m + NGW, x0);
        } else {
            const u32x4 hc[2] = {h0[0], h0[1]};
            h0[0] = h1[0]; h0[1] = h1[1]; t0[0] = t1[0]; t0[1] = t1[1];
            NP_LD(m + 2 * NGW, h1, t1);
#pragma unroll
            for (int jj = 0; jj < 2; ++jj) { const u32x4 w = hc[jj]; h[2 * jj] = (f32x4){bf2f(w.x & 0xffffu), bf2f(w.x >> 16), bf2f(w.y & 0xffffu), bf2f(w.y >> 16)}; h[2 * jj + 1] = (f32x4){bf2f(w.z & 0xffffu), bf2f(w.z >> 16), bf2f(w.w & 0xffffu), bf2f(w.w >> 16)}; }
        }
        if (na.tmp) {
            f32x4 t[4]; float ss = 0.f;
#pragma unroll
            for (int jj = 0; jj < 2; ++jj) { const u32x4 w = tc[jj]; t[2 * jj] = (f32x4){bf2f(w.x & 0xffffu), bf2f(w.x >> 16), bf2f(w.y & 0xffffu), bf2f(w.y >> 16)}; t[2 * jj + 1] = (f32x4){bf2f(w.z & 0xffffu), bf2f(w.z >> 16), bf2f(w.w & 0xffffu), bf2f(w.w >> 16)}; }
#pragma unroll
            for (int j = 0; j < 4; ++j) ss += (t[j].x * t[j].x + t[j].y * t[j].y) + (t[j].z * t[j].z + t[j].w * t[j].w);
            const float r = na.scale / sqrtf(wave_sum(ss) * (1.f / D) + EPS);
#pragma unroll
            for (int j = 0; j < 4; ++j) h[j] = h[j] + t[j] * gpq[j] * r;
        }
        if (!na.fin) {
#pragma unroll
            for (int jj = 0; jj < 2; ++jj) { u32x4 w; w.x = pk2(h[2 * jj].x, h[2 * jj].y); w.y = pk2(h[2 * jj].z, h[2 * jj].w); w.z = pk2(h[2 * jj + 1].x, h[2 * jj + 1].y); w.w = pk2(h[2 * jj + 1].z, h[2 * jj + 1].w); *((u32x4*)(F.H() + (size_t)m * D) + lane + 64 * jj) = w; } }
        if (na.fin && m < MREAL) {
            float* dst = (m < MP) ? F.out + O_YP + (size_t)m * D : F.out + O_YS + (size_t)(m - MP) * D;
#pragma unroll
            for (int j = 0; j < 4; ++j) *((f32x4*)dst + FI(j)) = h[j];
        }
        float s2 = 0.f;
#pragma unroll
        for (int j = 0; j < 4; ++j) s2 += (h[j].x * h[j].x + h[j].y * h[j].y) + (h[j].z * h[j].z + h[j].w * h[j].w);
        const float r2 = 1.f / sqrtf(wave_sum(s2) * (1.f / D) + EPS);
        if (lane == 0) F.RS()[m] = r2;
        if (na.wab) {
            float d8 = 0.f;
#pragma unroll
            for (int q = 0; q < 8; ++q) { float s = 0.f;
#pragma unroll
                for (int j = 0; j < 4; ++j) { const f32x4 w = wq[q][j]; s += (h[j].x * w.x + h[j].y * w.y) + (h[j].z * w.z + h[j].w * w.w); }
                s = wave_sum(s) * r2; d8 = (lane == q) ? s : d8; }
            if (lane < 8) F.AB()[(size_t)m * 8 + lane] = d8;
        }
    }
}
#undef FI
#undef NP_LD
#undef NP_LDX

__device__ __forceinline__ void p0_prologue(const Frame& F) {
    LAS float* scr = (LAS float*)(F.lds + F.wave * 16384);
    const int gw = F.bid * NWAVES + F.wave, NGW = F.G * NWAVES;
    int dealt = 0;
    for (int j = 0; j < 16; ++j) { if (j >= 5 && j != 14 && j != 15) continue;
        const TJob tj = get_job(j, F); const int nitems = (tj.K / 64) * (tj.N / 32);
        int first = (gw - dealt) % NGW; if (first < 0) first += NGW;
        for (int it = first; it < nitems; it += NGW) transpose_item(tj.W, tj.K, tj.Nraw, tj.N, tj.mode, tj.WT, tj.gk, scr, it, F.lane);
        dealt = (dealt + nitems) % NGW; }
    const int gt = F.bid * (NWAVES * 64) + F.tid, NGT = F.G * NWAVES * 64;
    for (int i = gt; i < 2 * 8 * D; i += NGT) { const int l = i / (8 * D), q = (i / D) % 8, k = i % D; F.WAB()[i] = F.inp(14)[(size_t)l * D * WIN_RAW + (size_t)k * WIN_RAW + PC_MQ + q] * F.inp(12)[(size_t)l * D + k]; }
    for (int i = gt; i < 2049 * 64; i += NGT) { const int p = i >> 6, d = i & 63; const double pos = (p == 2048) ? (double)PAST_LEN : (double)p;
        const double ang = pos * pow(10000.0, -(double)d / 64.0); F.COS()[i] = (float)cos(ang); F.SIN()[i] = (float)sin(ang); }
    for (int r = gw; r < 2 * NB * NMEM; r += NGW) { const int l = r / (NB * NMEM), row = r % (NB * NMEM);
        f32x4 v[4], gq[4]; float ss = 0.f;
#pragma unroll
        for (int j = 0; j < 4; ++j) { v[j] = *((const f32x4*)(F.inp(2) + (size_t)row * D) + F.lane + 64 * j); ss += (v[j].x * v[j].x + v[j].y * v[j].y) + (v[j].z * v[j].z + v[j].w * v[j].w); }
        const float rr = 1.f / sqrtf(wave_sum(ss) * (1.f / D) + EPS);
        u32x2* o8 = (u32x2*)(F.MEMN() + (size_t)r * D) + F.lane;
#pragma unroll
        for (int j = 0; j < 4; ++j) gq[j] = *((const f32x4*)(F.inp(19) + (size_t)l * D) + F.lane + 64 * j);
        asm volatile("" ::: "memory");
#pragma unroll
        for (int j = 0; j < 4; ++j) { const f32x4 y = v[j] * gq[j] * rr; u32x2 w; w.x = pk2(y.x, y.y); w.y = pk2(y.z, y.w); o8[64 * j] = w; }
    }
    NormArgs na{nullptr, nullptr, 0.f, F.inp(8), nullptr, 1, 0};
    norm_phase(F, na);
}

__device__ __forceinline__ void convert_layer1(const Frame& F, int idx, int nw) {
    LAS float* scr = (LAS float*)(F.lds + F.wave * 16384);
    const int gw = idx * NWAVES + F.wave, NGW = nw * NWAVES;
    int dealt = 0;
    for (int j = 5; j < 22; ++j) { if (j == 14 || j == 15) continue;
        const TJob tj = get_job(j, F); const int nitems = (tj.K / 64) * (tj.N / 32);
        int first = (gw - dealt) % NGW; if (first < 0) first += NGW;
        for (int it = first; it < nitems; it += NGW) transpose_item(tj.W, tj.K, tj.Nraw, tj.N, tj.mode, tj.WT, tj.gk, scr, it, F.lane);
        dealt = (dealt + nitems) % NGW; }
}

__device__ __forceinline__ bf16x8 ldnat(const void* base, unsigned row_boff, int s, int g) { return *(const bf16x8*)((const char*)base + (row_boff + 64u * s + 16u * g)); }
__device__ __forceinline__ bf16x8 ldperm(const void* base, unsigned row_boff, int s, int g) {
    const unsigned o = row_boff + 64u * s + 8u * g; const bf16x4 lo = *(const bf16x4*)((const char*)base + o), hi = *(const bf16x4*)((const char*)base + (o + 32u));
    return __builtin_shufflevector(lo, hi, 0, 1, 2, 3, 4, 5, 6, 7);
}
#define CBAR() asm volatile("" ::: "memory")
__device__ __forceinline__ bf16x8 lds_frag(const LAS float* rowp, int s, int g, float scale) {
    const f32x4 a = *(const LAS f32x4*)(rowp + 32 * s + 8 * g), b = *(const LAS f32x4*)(rowp + 32 * s + 8 * g + 4);
    return pack8(a * scale, b * scale);
}

__device__ __forceinline__ void ret_prep(const Frame& F, int ci) {
    const int tid = F.tid, lane = F.lane, wv = F.wave;
    const int bh = ci >> 5, n = ci & 31, b = bh >> 2, h = bh & 3, m0 = b * SEQ + n * CH;
    const float lg = log1pf(-exp2f(-5.0f - (float)h));
    LAS float* qf = (LAS float*)F.lds;
    LAS float* kf = qf + 64 * 132;
    LAS bf16_t* vs = (LAS bf16_t*)(kf + 64 * 132);
    u32x4 vr[4];
#pragma unroll
    for (int r = 0; r < 4; ++r) { const int p = tid + 512 * r, row = p >> 5, c8 = (p & 31) * 8; vr[r] = *(const u32x4*)(F.PROJ() + (size_t)(m0 + row) * NWIN + PC_RV + h * DV + c8); }
    {   const int i = tid >> 3, d0 = (tid & 7) * 8, t = n * CH + i;
        const bf16_t* qrow = F.PROJ() + (size_t)(m0 + i) * NWIN + PC_RQ + h * DK; const bf16_t* krow = F.PROJ() + (size_t)(m0 + i) * NWIN + PC_RK + h * DK;
        const u32x4 q1 = *(const u32x4*)(qrow + d0), q2 = *(const u32x4*)(qrow + 64 + d0), k1 = *(const u32x4*)(krow + d0), k2 = *(const u32x4*)(krow + 64 + d0);
        const float* cp = F.COS() + t * 64 + d0; const float* sp = F.SIN() + t * 64 + d0;
        float cs[8], sn[8];
#pragma unroll
        for (int e = 0; e < 8; ++e) { cs[e] = cp[e]; sn[e] = sp[e]; }
        const float qd = fexp(lg * (float)(i + 1));
        float o1[8], o2[8];
#pragma unroll
        for (int e = 0; e < 8; ++e) { const unsigned w1 = q1[e >> 1], w2 = q2[e >> 1]; const float x1 = (e & 1) ? bf2f(w1 >> 16) : bf2f(w1 & 0xffffu), x2 = (e & 1) ? bf2f(w2 >> 16) : bf2f(w2 & 0xffffu);
            o1[e] = x1 * cs[e] - x2 * sn[e]; o2[e] = x1 * sn[e] + x2 * cs[e]; qf[i * 132 + d0 + e] = o1[e]; qf[i * 132 + 64 + d0 + e] = o2[e]; }
        {
            unsigned char* qb = F.RCH() + (size_t)ci * RCH_BYTES + RCH_QD + (i >> 4) * 4096 + (i & 15) * 16;
#pragma unroll
            for (int hh = 0; hh < 2; ++hh) { const int D0 = d0 + 64 * hh, s = D0 >> 5, half = (D0 >> 4) & 1, g0 = (D0 & 15) >> 2; const float* o = hh ? o2 : o1;
                u32x2 w; w.x = pk2(o[0] * qd, o[1] * qd); w.y = pk2(o[2] * qd, o[3] * qd); *(u32x2*)(qb + s * 1024 + g0 * 256 + half * 8) = w;
                w.x = pk2(o[4] * qd, o[5] * qd); w.y = pk2(o[6] * qd, o[7] * qd); *(u32x2*)(qb + s * 1024 + (g0 + 1) * 256 + half * 8) = w; }
        }
        const float ksc = 0.08838834764831845f;
#pragma unroll
        for (int e = 0; e < 8; ++e) { const unsigned w1 = k1[e >> 1], w2 = k2[e >> 1]; const float x1 = (e & 1) ? bf2f(w1 >> 16) : bf2f(w1 & 0xffffu), x2 = (e & 1) ? bf2f(w2 >> 16) : bf2f(w2 & 0xffffu);
            kf[i * 132 + d0 + e] = (x1 * cs[e] - x2 * sn[e]) * ksc; kf[i * 132 + 64 + d0 + e] = (x1 * sn[e] + x2 * cs[e]) * ksc; }
    }
#pragma unroll
    for (int r = 0; r < 4; ++r) { const int p = tid + 512 * r, row = p >> 5, c8 = (p & 31) * 8; *(LAS u32x4*)(vs + row * 264 + c8) = vr[r]; }
    __syncthreads();
    {
        const int d = tid >> 2, i0 = (tid & 3) * 16; unsigned w[8];
#pragma unroll
        for (int r = 0; r < 16; r += 2) { const float v0 = kf[(i0 + r) * 132 + d] * fexp(lg * (float)(63 - (i0 + r))), v1 = kf[(i0 + r + 1) * 132 + d] * fexp(lg * (float)(62 - (i0 + r))); w[r >> 1] = pk2(v0, v1); }
        unsigned char* kb = F.RCH() + (size_t)ci * RCH_BYTES + RCH_KDT + (d >> 4) * 2048 + (d & 15) * 16 + (i0 >> 5) * 1024 + ((i0 & 31) >> 3) * 256;
        *(u32x4*)kb = (u32x4){w[0], w[1], w[2], w[3]}; *(u32x4*)(kb + 256) = (u32x4){w[4], w[5], w[6], w[7]};
    }
    {
        const int e = tid >> 1, i0 = (tid & 1) * 32; unsigned w[16];
#pragma unroll
        for (int r = 0; r < 32; r += 2) w[r >> 1] = (unsigned)vs[(i0 + r) * 264 + e] | ((unsigned)vs[(i0 + r + 1) * 264 + e] << 16);
        unsigned char* vb = F.RVT() + (size_t)ci * 32768 + ((e >> 4) * 2 + (i0 >> 5)) * 1024 + (e & 15) * 16;
#pragma unroll
        for (int q = 0; q < 4; ++q) *(u32x4*)(vb + q * 256) = (u32x4){w[4 * q], w[4 * q + 1], w[4 * q + 2], w[4 * q + 3]};
    }
    {
        const int c = lane & 15, g = lane >> 4;
#pragma unroll
        for (int x = 0; x < 2; ++x) { const int tt = 2 * wv + x, jt = tt >> 2, it = tt & 3;
            f32x4 acc = (f32x4){0.f, 0.f, 0.f, 0.f};
            if (it >= jt) {
#pragma unroll
                for (int s = 0; s < 4; ++s) { const bf16x8 A = lds_frag(kf + (16 * jt + c) * 132, s, g, 1.0f), B = lds_frag(qf + (16 * it + c) * 132, s, g, 1.0f); acc = MFMA16(A, B, acc); }
            }
            const int i = 16 * it + c; float r4[4];
#pragma unroll
            for (int r = 0; r < 4; ++r) { const int j = 16 * jt + 4 * g + r; r4[r] = (i >= j) ? acc[r] * fexp(lg * (float)(i - j)) : 0.f; }
            u32x2 w; w.x = pk2(r4[0], r4[1]); w.y = pk2(r4[2], r4[3]);
            *(u32x2*)(F.RCH() + (size_t)ci * RCH_BYTES + RCH_ATT + (it * 2 + (jt >> 1)) * 1024 + (c + 16 * (2 * (jt & 1) + (g >> 1))) * 16 + (g & 1) * 8) = w; }
    }
    __syncthreads();
}

__device__ __forceinline__ void gdn_prep(const Frame& F, int l, int ci) {
    const int tid = F.tid, lane = F.lane, wv = F.wave;
    const int bh = ci >> 5, n = ci & 31, b = bh >> 2, h = bh & 3, m0 = b * SEQ + n * CH;
    LAS bf16_t* raw = (LAS bf16_t*)F.lds;
    LAS float* qf = (LAS float*)F.lds;
    LAS float* kf = qf + 64 * 132;
    LAS bf16_t* wst = (LAS bf16_t*)F.lds;
    LAS float* Am = (LAS float*)(F.lds + 69888);
    LAS float* sm = (LAS float*)(F.lds + 86272);
    LAS float* bcum = sm; LAS float* beta = sm + 64; LAS float* rq = sm + 128; LAS float* rk = sm + 192; LAS float* eb = sm + 256;
    float ab_a = 0.f, ab_b = 0.f;
    if (wv == 0) { const int m = m0 + lane; ab_a = F.AB()[(size_t)m * 8 + h]; ab_b = F.AB()[(size_t)m * 8 + 4 + h]; }
    {
        u32x4 rv[9]; const int pc = tid & 63, col8 = pc * 8;
        const int sc = (pc < 16) ? PC_GQKV + h * DK + col8 : (pc < 32) ? PC_GQKV + 512 + h * DK + (col8 - 128) : PC_GQKV + 1024 + h * DV + (col8 - 256);
#pragma unroll
        for (int it = 0; it < 9; ++it) { const int row = (tid >> 6) + 8 * it, t = n * CH + row - 3; rv[it] = (u32x4){0u, 0u, 0u, 0u};
            if (row < 67 && t >= 0) rv[it] = *(const u32x4*)(F.PROJ() + (size_t)(b * SEQ + t) * NWIN + sc); }
        asm volatile("" ::: "memory");
#pragma unroll
        for (int it = 0; it < 9; ++it) { const int row = (tid >> 6) + 8 * it; if (row < 67) *(LAS u32x4*)(raw + row * 520 + col8) = rv[it]; }
    }
    if (wv == 0) { const float a = ab_a, bb = ab_b;
        const float x = a + F.inp(17)[l * 4 + h]; const float sp = fmaxf(x, 0.f) + log1pf(expf(-fabsf(x)));
        float gg = -expf(F.inp(16)[l * 4 + h]) * sp;
#pragma unroll
        for (int o = 1; o < 64; o <<= 1) { const float t = __shfl_up(gg, o); if (lane >= o) gg += t; }
        bcum[lane] = gg; beta[lane] = 1.f / (1.f + expf(-bb)); eb[lane] = expf(gg); }
    __syncthreads();
    LAS float* vpark = (LAS float*)(F.lds + 88832);
    {   float x[64];
        const int col = (tid < 256) ? 256 + tid : (tid < 384) ? 128 + (tid - 256) : tid - 384;
        const int C = (tid < 256) ? 1024 + h * DV + tid : (tid < 384) ? 512 + h * DK + (tid - 256) : h * DK + (tid - 384);
        const float* cw = F.inp(15) + (size_t)l * 4 * CONVD + C; const float w0 = cw[0], w1 = cw[CONVD], w2 = cw[2 * CONVD], w3 = cw[3 * CONVD];
        float r0 = bf2f(raw[0 * 520 + col]), r1 = bf2f(raw[1 * 520 + col]), r2 = bf2f(raw[2 * 520 + col]);
#pragma unroll
        for (int i0 = 0; i0 < 64; i0 += 16) { unsigned rr[16];
#pragma unroll
            for (int i = 0; i < 16; ++i) rr[i] = raw[(i0 + i + 3) * 520 + col];
            asm volatile("" ::: "memory");
#pragma unroll
            for (int i = 0; i < 16; ++i) { const float r3 = bf2f(rr[i]); x[i0 + i] = siluf_(r0 * w0 + r1 * w1 + r2 * w2 + r3 * w3); r0 = r1; r1 = r2; r2 = r3; } }
    __syncthreads();
    {
        LAS float* dst = (tid < 256) ? vpark + tid : (tid < 384) ? kf + (tid - 256) : qf + (tid - 384); const int pitch = (tid < 256) ? 260 : 132;
#pragma unroll
        for (int i = 0; i < 64; ++i) dst[i * pitch] = x[i]; }
    }
    __syncthreads();
    {   const int i = tid >> 3, p = tid & 7; float sq = 0.f, sk = 0.f;
#pragma unroll
        for (int d = 0; d < 16; ++d) { const float a = qf[i * 132 + 16 * p + d], bq = kf[i * 132 + 16 * p + d]; sq += a * a; sk += bq * bq; }
        sq += __shfl_xor(sq, 1); sq += __shfl_xor(sq, 2); sq += __shfl_xor(sq, 4); sk += __shfl_xor(sk, 1); sk += __shfl_xor(sk, 2); sk += __shfl_xor(sk, 4);
        if (p == 0) { rq[i] = 0.08838834764831845f / sqrtf(sq + EPS); rk[i] = 1.f / sqrtf(sk + EPS); } }
    __syncthreads();
    unsigned char* gch = F.GCH() + (size_t)ci * GCH_BYTES; asm volatile("" : "+s"(gch)); gch = (unsigned char*)(GAS unsigned char*)gch;
#pragma unroll
    for (int rep = 0; rep < 2; ++rep) { const int idx = tid + 512 * rep;
        {   const int i = idx >> 4, s = (idx >> 2) & 3, g = idx & 3; const float sc = rq[i] * eb[i];
            const f32x4 lo = *(const LAS f32x4*)(qf + i * 132 + 32 * s + 4 * g), hi = *(const LAS f32x4*)(qf + i * 132 + 32 * s + 16 + 4 * g);
            *(bf16x8*)(gch + GCH_QD + ((i >> 4) * 4 + s) * 1024 + ((i & 15) + 16 * g) * 16) = pack8(lo * sc, hi * sc); }
        {   const int d = idx >> 3, s = (idx >> 2) & 1, g = idx & 3; const float bl = bcum[63]; float v[8];
#pragma unroll
            for (int j = 0; j < 8; ++j) { const int p = 32 * s + 16 * (j >> 2) + 4 * g + (j & 3); v[j] = kf[p * 132 + d] * rk[p] * fexp(bl - bcum[p]); }
            u32x4 w; w.x = pk2(v[0], v[1]); w.y = pk2(v[2], v[3]); w.z = pk2(v[4], v[5]); w.w = pk2(v[6], v[7]);
            *(u32x4*)(gch + GCH_KDT + ((d >> 4) * 2 + s) * 1024 + ((d & 15) + 16 * g) * 16) = w; }
    }
    if (tid == 0) F.GDCH()[ci] = fexp(bcum[63]);
    CBAR();
    {
        const int c = lane & 15, g = lane >> 4, jt = wv >> 1;
        bf16x8 A[4];
#pragma unroll
        for (int s = 0; s < 4; ++s) A[s] = lds_frag(kf + (16 * jt + c) * 132, s, g, rk[16 * jt + c]);
#pragma unroll
        for (int xx = 0; xx < 2; ++xx) { const int it = 2 * (wv & 1) + xx, i = 16 * it + c;
            f32x4 aq = (f32x4){0.f, 0.f, 0.f, 0.f}, ak = (f32x4){0.f, 0.f, 0.f, 0.f};
            if (it >= jt) {
#pragma unroll
                for (int s = 0; s < 4; ++s) { const bf16x8 Bq = lds_frag(qf + i * 132, s, g, rq[i]), Bk = lds_frag(kf + i * 132, s, g, rk[i]); aq = MFMA16(A[s], Bq, aq); ak = MFMA16(Bk, A[s], ak); CBAR(); }
            }
            const float bi = bcum[i]; float ra[4]; f32x4 rm;
#pragma unroll
            for (int r = 0; r < 4; ++r) { const int j = 16 * jt + 4 * g + r; const float dec = fexp(fminf(bi - bcum[j], 0.f)); ra[r] = (i >= j) ? aq[r] * dec : 0.f; }
            const int j2 = 16 * jt + c; const float bj2 = bcum[j2];
#pragma unroll
            for (int r = 0; r < 4; ++r) { const int i2 = 16 * it + 4 * g + r; rm[r] = (i2 > j2) ? beta[i2] * ak[r] * fexp(fminf(bcum[i2] - bj2, 0.f)) : 0.f; }
            u32x2 w; w.x = pk2(ra[0], ra[1]); w.y = pk2(ra[2], ra[3]);
            *(u32x2*)(gch + GCH_ATT + (it * 2 + (jt >> 1)) * 1024 + (c + 16 * g) * 16 + (jt & 1) * 8) = w;
            *(LAS f32x4*)(Am + j2 * 64 + 16 * it + 4 * g) = rm; }
    }
    __syncthreads();
    if (tid < 384) {
        int z0; asm volatile("v_mov_b32 %0, 0" : "=v"(z0)); const LAS float* Amz = Am + z0; const LAS float* smz = sm + z0;
        f32x2 xv[32];
        if (tid < 256) {
#pragma unroll
            for (int i = 0; i < 64; ++i) xv[i >> 1][i & 1] = vpark[i * 260 + tid] * smz[64 + i];
        } else {
#pragma unroll
            for (int i = 0; i < 64; ++i) xv[i >> 1][i & 1] = kf[i * 132 + (tid - 256)] * (smz[64 + i] * smz[192 + i] * smz[256 + i]);
        }
#pragma unroll
        for (int j = 0; j < 63; ++j) { const float xj = xv[j >> 1][j & 1]; const f32x2 xj2 = (f32x2){xj, xj};
#pragma unroll
            for (int i4 = (j + 1) / 4; i4 < 16; ++i4) { const f32x4 a = *(const LAS f32x4*)(Amz + j * 64 + 4 * i4);
                xv[2 * i4] -= (f32x2){a.x, a.y} * xj2; xv[2 * i4 + 1] -= (f32x2){a.z, a.w} * xj2; if ((i4 & 3) == 3) CBAR(); } CBAR(); }
        float x[64];
#pragma unroll
        for (int i = 0; i < 64; ++i) x[i] = xv[i >> 1][i & 1];
        if (tid < 256) { unsigned char* dstb = (unsigned char*)F.GUT() + (size_t)ci * 32768; asm volatile("" : "+s"(dstb)); dstb = (unsigned char*)(GAS unsigned char*)dstb; unsigned char* dst = dstb + (tid >> 4) * 2048 + (tid & 15) * 16;
#pragma unroll
            for (int q = 0; q < 16; ++q) { u32x2 w; w.x = pk2(x[4 * q], x[4 * q + 1]); w.y = pk2(x[4 * q + 2], x[4 * q + 3]); *(u32x2*)(dst + (q >> 3) * 1024 + (q & 3) * 256 + ((q >> 2) & 1) * 8) = w; } }
        else { const int d = tid - 256;
#pragma unroll
            for (int i = 0; i < 64; ++i) wst[i * 136 + d] = (bf16_t)f2bf(x[i]); }
    }
    __syncthreads();
#pragma unroll
    for (int rep = 0; rep < 2; ++rep) { const int idx = tid + 512 * rep, i = idx >> 4, s = (idx >> 2) & 3, g = idx & 3;
        const u32x2 lo = *(const LAS u32x2*)(wst + i * 136 + 32 * s + 4 * g), hi = *(const LAS u32x2*)(wst + i * 136 + 32 * s + 16 + 4 * g);
        *(u32x4*)(gch + GCH_W + ((i >> 4) * 4 + s) * 1024 + ((i & 15) + 16 * g) * 16) = (u32x4){lo.x, lo.y, hi.x, hi.y}; }
    __syncthreads();
}

__device__ __forceinline__ void mem_attn_unit(const Frame& F, int l, int u) {
    const int lane = F.lane, wv = F.wave, c = lane & 15, g = lane >> 4;
    const int bh = u >> 4, qb = u & 15, b = bh >> 2, h = bh & 3, mq = b * SEQ + qb * 128 + wv * 16;
    const unsigned char* kf = (const unsigned char*)F.MK() + ((((size_t)l * NB + b) * NH + h) << 17) + lane * 16;
    const unsigned char* vf = (const unsigned char*)F.MVT() + ((((size_t)l * NB + b) * NH + h) << 17) + lane * 16;
    LAS unsigned char* ring = F.lds;
#define ATT_DMA(ch_) do { const unsigned char* src_ = ((ch_) < 4 ? kf + (ch_) * 32768 : vf + ((ch_) - 4) * 32768); LAS unsigned char* dst_ = ring + ((ch_) % 3) * 32768; \
        _Pragma("unroll") for (int k_ = 0; k_ < 4; ++k_) __builtin_amdgcn_global_load_lds((const unsigned*)(src_ + (wv + 8 * k_) * 1024), (LAS unsigned*)(dst_ + (wv + 8 * k_) * 1024), 16, 0, 0); } while (0)
#define ATT_WAIT(n_) do { if ((n_) == 4) asm volatile("s_waitcnt vmcnt(4)" ::: "memory"); else if ((n_) == 8) asm volatile("s_waitcnt vmcnt(8)" ::: "memory"); else asm volatile("s_waitcnt vmcnt(12)" ::: "memory"); \
        __builtin_amdgcn_s_barrier(); asm volatile("" ::: "memory"); } while (0)
    ATT_DMA(0); ATT_DMA(1);
    bf16x8 Qf[8]; { const unsigned qo = ((unsigned)(mq + c) * NWIN + PC_MQ + h * 256) * 2u;
#pragma unroll
        for (int s = 0; s < 8; ++s) Qf[s] = ldnat(F.PROJ(), qo, s, g); }
    asm volatile("s_waitcnt vmcnt(0)" ::: "memory");
    f32x4 sacc[16]; bf16x8 Pf[8]; float inv = 1.f;
    bf16_t* obase = F.OBR() + 2 * OBR_STRIDE; const unsigned oo = ((unsigned)(mq + c) * D + h * 256 + 4 * g) * 2u;
#pragma unroll
    for (int ch = 0; ch < 8; ++ch) {
        ATT_WAIT((ch + 1 < 8 ? 4 : 0) + (ch - 1 >= 4 ? 4 : 0) + (ch - 2 >= 4 ? 4 : 0));
        if (ch + 2 < 8) ATT_DMA(ch + 2);
        const LAS unsigned char* Bq = ring + (ch % 3) * 32768 + lane * 16;
        if (ch < 4) {
#pragma unroll
            for (int k4 = 0; k4 < 4; ++k4) { f32x4 a0 = (f32x4){0.f, 0.f, 0.f, 0.f};
#pragma unroll
                for (int s = 0; s < 8; ++s) a0 = MFMA16(*(const LAS bf16x8*)(Bq + (k4 * 8 + s) * 1024), Qf[s], a0);
                sacc[4 * ch + k4] = a0; }
            if (ch == 3) {
                float mx = -3.0e38f;
#pragma unroll
                for (int kt = 0; kt < 16; ++kt)
#pragma unroll
                    for (int r = 0; r < 4; ++r) mx = fmaxf(mx, sacc[kt][r]);
                mx = fmaxf(mx, __shfl_xor(mx, 16)); mx = fmaxf(mx, __shfl_xor(mx, 32));
                float sum = 0.f; const float sc = 0.0625f * 1.4426950408889634f;
#pragma unroll
                for (int kt = 0; kt < 16; ++kt)
#pragma unroll
                    for (int r = 0; r < 4; ++r) { const float p = __builtin_amdgcn_exp2f((sacc[kt][r] - mx) * sc); sacc[kt][r] = p; sum += p; }
                sum += __shfl_xor(sum, 16); sum += __shfl_xor(sum, 32);
                inv = 1.f / sum;
#pragma unroll
                for (int ks = 0; ks < 8; ++ks) Pf[ks] = pack8(sacc[2 * ks], sacc[2 * ks + 1]);
            }
        } else {
#pragma unroll
            for (int e4 = 0; e4 < 4; ++e4) { f32x4 a0 = (f32x4){0.f, 0.f, 0.f, 0.f}; const int et = 4 * (ch - 4) + e4;
#pragma unroll
                for (int ks = 0; ks < 8; ++ks) a0 = MFMA16(*(const LAS bf16x8*)(Bq + (e4 * 8 + ks) * 1024), Pf[ks], a0);
                u32x2 w; w.x = pk2(a0[0] * inv, a0[1] * inv); w.y = pk2(a0[2] * inv, a0[3] * inv);
                *(u32x2*)((char*)obase + (oo + 32u * et)) = w; }
        }
        asm volatile("" ::: "memory");
    }
    asm volatile("s_waitcnt lgkmcnt(0)" ::: "memory"); __builtin_amdgcn_s_barrier(); asm volatile("" ::: "memory");
#undef ATT_DMA
#undef ATT_WAIT
}

struct ScanPF { bf16x8 vb[2][2]; float dch; };
#define RAW_BAR() do { asm volatile("s_waitcnt lgkmcnt(0)" ::: "memory"); __builtin_amdgcn_s_barrier(); asm volatile("" ::: "memory"); } while (0)
template <bool GDN> __device__ __forceinline__ void scan_prefetch(const Frame& F, ScanPF& P, int bh, int n, int lane, int wv, int c, int g, int colg, float dch_ret) {
    const int b = bh >> 2, e0 = 32 * wv;
    if (GDN) { const unsigned char* up = (const unsigned char*)F.GUT() + (size_t)(bh * 32 + n) * 32768 + (2 * wv) * 2048 + lane * 16;
#pragma unroll
        for (int k = 0; k < 4; ++k) __builtin_amdgcn_global_load_lds((const unsigned*)(up + k * 1024), (LAS unsigned*)(F.lds + 2 * 57344 + 4096 + wv * 4096 + k * 1024), 16, 0, 0);
        unsigned dci = (unsigned)(bh * 32 + n) * 4u; asm volatile("" : "+v"(dci)); P.dch = *(const float*)((const char*)F.GDCH() + dci);
    } else { const unsigned char* vp = F.RVT() + (size_t)(bh * 32 + n) * 32768 + (2 * wv) * 2048 + lane * 16;
#pragma unroll
        for (int s = 0; s < 2; ++s) { P.vb[s][0] = *(const bf16x8*)(vp + s * 1024); P.vb[s][1] = *(const bf16x8*)(vp + 2048 + s * 1024); }
        P.dch = dch_ret; }
}
template <bool GDN> __device__ __forceinline__ void scan_touch(ScanPF& P) {
    asm volatile("" : "+v"(P.dch));
    if (GDN) {}
    else asm volatile("" : "+v"(P.vb[0][0]), "+v"(P.vb[0][1]), "+v"(P.vb[1][0]), "+v"(P.vb[1][1]));
}
template <bool GDN, int BUF> __device__ __forceinline__ void scan_chunk(const Frame& F, f32x4 (&S)[8][2], ScanPF& cur, ScanPF& nxt, int bh, int n, int h, int colg, float dch_ret, const float* gnp, bf16_t* obr) {
    const int lane = F.lane, wv = F.wave, c = lane & 15, g = lane >> 4, b = bh >> 2, e0 = 32 * wv;
    constexpr int CHB = GDN ? GCH_BYTES : RCH_BYTES, NBLK = CHB / 1024, OQD = GDN ? GCH_QD : RCH_QD, OATT = GDN ? GCH_ATT : RCH_ATT, OKDT = GDN ? GCH_KDT : RCH_KDT, LBUF = 57344;
    LAS unsigned char* lbuf = F.lds; LAS float* ssq = (LAS float*)(F.lds + 2 * LBUF);
    const LAS unsigned char* Bq = lbuf + BUF * LBUF + lane * 16;
#define LFRAG(off_) (*(const LAS bf16x8*)(Bq + (off_)))
    scan_touch<GDN>(cur);
    f32x4 vn[4][2];
    if (GDN) {
        const LAS unsigned char* ul = F.lds + 2 * LBUF + 4096 + wv * 4096 + lane * 16;
#pragma unroll
        for (int cb = 0; cb < 2; ++cb)
#pragma unroll
            for (int rp = 0; rp < 2; ++rp) { const u32x4 uu = *(const LAS u32x4*)(ul + (cb * 2 + rp) * 1024);
                vn[2 * rp][cb] = (f32x4){bf2f(uu.x & 0xffffu), bf2f(uu.x >> 16), bf2f(uu.y & 0xffffu), bf2f(uu.y >> 16)};
                vn[2 * rp + 1][cb] = (f32x4){bf2f(uu.z & 0xffffu), bf2f(uu.z >> 16), bf2f(uu.w & 0xffffu), bf2f(uu.w >> 16)}; }
        asm volatile("s_waitcnt lgkmcnt(0)" ::: "memory");
    }
    if (n + 1 < NCH) {
        const unsigned char* chb = (GDN ? F.GCH() : F.RCH()) + (size_t)(bh * 32 + n + 1) * CHB + lane * 16;
#pragma unroll
        for (int k = 0; k < (NBLK + 7) / 8; ++k) { const int kb = wv + 8 * k; if (kb < NBLK) __builtin_amdgcn_global_load_lds((const unsigned*)(chb + kb * 1024), (LAS unsigned*)(lbuf + (BUF ^ 1) * LBUF + kb * 1024), 16, 0, 0); }
        CBAR();
        scan_prefetch<GDN>(F, nxt, bh, n + 1, lane, wv, c, g, colg, dch_ret);
    }
    CBAR();
    bf16x8 Sb[4][2];
#pragma unroll
    for (int s = 0; s < 4; ++s) { Sb[s][0] = pack8(S[2 * s][0], S[2 * s + 1][0]); Sb[s][1] = pack8(S[2 * s][1], S[2 * s + 1][1]); }
    bf16x8 Vb[2][2];
    if (GDN) {
#pragma unroll
        for (int rt = 0; rt < 4; ++rt) { f32x4 p0 = (f32x4){0.f, 0.f, 0.f, 0.f}, p1 = p0;
#pragma unroll
            for (int s = 0; s < 4; ++s) { const bf16x8 A = LFRAG(GCH_W + (rt * 4 + s) * 1024); p0 = MFMA16(A, Sb[s][0], p0); p1 = MFMA16(A, Sb[s][1], p1); }
            vn[rt][0] -= p0; vn[rt][1] -= p1; if (rt & 1) CBAR(); }
#pragma unroll
        for (int s = 0; s < 2; ++s) { Vb[s][0] = pack8(vn[2 * s][0], vn[2 * s + 1][0]); Vb[s][1] = pack8(vn[2 * s][1], vn[2 * s + 1][1]); }
    } else {
#pragma unroll
        for (int s = 0; s < 2; ++s) { Vb[s][0] = cur.vb[s][0]; Vb[s][1] = cur.vb[s][1]; }
    }
    CBAR();
    u32x2 gw[4][2];
    {   unsigned m0g = (unsigned)(b * SEQ + n * CH + c); asm volatile("" : "+v"(m0g)); const unsigned pb = (m0g * NWIN + colg + e0 + 4 * g) * 2u; const char* PROJp = (const char*)F.PROJ();
#pragma unroll
        for (int rt = 0; rt < 4; ++rt) { gw[rt][0] = *(const u32x2*)(PROJp + (pb + (unsigned)(16 * rt) * NWIN * 2u)); gw[rt][1] = *(const u32x2*)(PROJp + (pb + (unsigned)(16 * rt) * NWIN * 2u + 32u)); } }
    CBAR();
    f32x4 OT[4][2];
#pragma unroll
    for (int rt = 0; rt < 4; ++rt) { f32x4 o0 = (f32x4){0.f, 0.f, 0.f, 0.f}, o1 = o0;
#pragma unroll
        for (int s = 0; s < 4; ++s) { const bf16x8 Bf = LFRAG(OQD + (rt * 4 + s) * 1024); o0 = MFMA16(Sb[s][0], Bf, o0); o1 = MFMA16(Sb[s][1], Bf, o1); }
#pragma unroll
        for (int s = 0; s < 2; ++s) { const bf16x8 Bf = LFRAG(OATT + (rt * 2 + s) * 1024); o0 = MFMA16(Vb[s][0], Bf, o0); o1 = MFMA16(Vb[s][1], Bf, o1); }
        OT[rt][0] = o0; OT[rt][1] = o1; if (rt & 1) CBAR(); }
    const float dch = cur.dch;
#pragma unroll
    for (int t = 0; t < 8; ++t) { f32x4 s0 = S[t][0] * dch, s1 = S[t][1] * dch;
#pragma unroll
        for (int s = 0; s < 2; ++s) { const bf16x8 A = LFRAG(OKDT + (t * 2 + s) * 1024); s0 = MFMA16(A, Vb[s][0], s0); s1 = MFMA16(A, Vb[s][1], s1); }
        S[t][0] = s0; S[t][1] = s1; if ((t & 3) == 3) CBAR(); }
#pragma unroll
    for (int rt = 0; rt < 4; ++rt) { float q = 0.f;
#pragma unroll
        for (int r = 0; r < 4; ++r) q += OT[rt][0][r] * OT[rt][0][r] + OT[rt][1][r] * OT[rt][1][r];
        q += __shfl_xor(q, 16); q += __shfl_xor(q, 32);
        if (g == 0) ssq[(BUF * 8 + wv) * 64 + 16 * rt + c] = q; }
    RAW_BAR();
    {   unsigned m0o = (unsigned)(b * SEQ + n * CH + c); asm volatile("" : "+v"(m0o));
        const unsigned ob = (m0o * D + h * DV + e0 + 4 * g) * 2u;
#pragma unroll
        for (int rt = 0; rt < 4; ++rt) { float tot = 0.f;
#pragma unroll
            for (int w = 0; w < 8; ++w) tot += ssq[(BUF * 8 + w) * 64 + 16 * rt + c];
            const float rstd = 1.f / sqrtf(tot * (1.f / DV) + EPS);
#pragma unroll
            for (int cb = 0; cb < 2; ++cb) { const u32x2 gq = gw[rt][cb]; const f32x4 o = OT[rt][cb] * rstd;
                const float r0 = o[0] * bf2f(gq.x & 0xffffu), r1 = o[1] * bf2f(gq.x >> 16), r2 = o[2] * bf2f(gq.y & 0xffffu), r3 = o[3] * bf2f(gq.y >> 16);
                u32x2 w2; w2.x = pk2(r0, r1); w2.y = pk2(r2, r3);
                *(u32x2*)((char*)obr + (ob + (unsigned)(16 * rt) * D * 2u + 32u * cb)) = w2; } } }
    asm volatile("s_waitcnt vmcnt(8)" ::: "memory"); RAW_BAR();
#undef LFRAG
}
template <bool GDN> __device__ __forceinline__ void scan_bh(const Frame& F, int l, int bh) {
    const int lane = F.lane, wv = F.wave, c = lane & 15, g = lane >> 4, b = bh >> 2, h = bh & 3, e0 = 32 * wv;
    constexpr int CHB = GDN ? GCH_BYTES : RCH_BYTES, NBLK = CHB / 1024;
    const float lg = log1pf(-exp2f(-5.0f - (float)h)); const float dch_ret = fexp(lg * 64.f);
    f32x4 S[8][2];
#pragma unroll
    for (int t = 0; t < 8; ++t) { S[t][0] = (f32x4){0.f, 0.f, 0.f, 0.f}; S[t][1] = (f32x4){0.f, 0.f, 0.f, 0.f}; }
    const int colg = (GDN ? PC_GZ : PC_RG) + h * DV;
    bf16_t* obr = F.OBR() + (GDN ? OBR_STRIDE : 0);
    const float* gnp = F.inp(18) + l * DV;
    ScanPF PA, PB;
    {   const unsigned char* chb = (GDN ? F.GCH() : F.RCH()) + (size_t)(bh * 32) * CHB + lane * 16;
#pragma unroll
        for (int k = 0; k < (NBLK + 7) / 8; ++k) { const int kb = wv + 8 * k; if (kb < NBLK) __builtin_amdgcn_global_load_lds((const unsigned*)(chb + kb * 1024), (LAS unsigned*)(F.lds + kb * 1024), 16, 0, 0); } }
    scan_prefetch<GDN>(F, PA, bh, 0, lane, wv, c, g, colg, dch_ret);
    asm volatile("s_waitcnt vmcnt(0)" ::: "memory"); RAW_BAR();
    for (int n = 0; n < NCH; n += 2) {
        asm volatile("" ::: "memory");
        scan_chunk<GDN, 0>(F, S, PA, PB, bh, n, h, colg, dch_ret, gnp, obr);
        scan_chunk<GDN, 1>(F, S, PB, PA, bh, n + 1, h, colg, dch_ret, gnp, obr);
    }
    float* so = F.out + (GDN ? O_SGP : O_SRP) + ((size_t)(l * NB + b) * NH + h) * (size_t)(DK * DV);
    unsigned sbo = (unsigned)((4 * g) * DV + e0 + c) * 4u; asm volatile("" : "+v"(sbo));
#pragma unroll
    for (int t = 0; t < 8; ++t)
#pragma unroll
        for (int cb = 0; cb < 2; ++cb)
#pragma unroll
            for (int r = 0; r < 4; ++r) *(float*)((char*)so + (sbo + (unsigned)((16 * t + r) * DV + 16 * cb) * 4u)) = S[t][cb][r];
}
#undef RAW_BAR

template <bool GDN> __device__ __forceinline__ void sample_step(const Frame& F, int l, int item) {
    const int tid = F.tid, lane = F.lane, wv = F.wave, s = item >> 2, h = item & 3; const size_t m = (size_t)(MP + s);
    LAS float* qv = (LAS float*)F.lds;
    LAS float* kv = qv + 128;
    LAS float* vv = qv + 256;
    LAS float* sc = qv + 512;
    LAS float* partq = qv + 1024;
    LAS float* partk = partq + 2048;
    float dec, beta_ = 1.f;
    if (GDN) {
        const int C = (tid < 256) ? 1024 + h * DV + tid : (tid < 384) ? 512 + h * DK + (tid - 256) : h * DK + (tid - 384);
        const float* cbp = F.inp(5) + ((size_t)(l * MS + s) * 3) * CONVD + C; const float* cw = F.inp(15) + (size_t)l * 4 * CONVD + C;
        const float c0 = cbp[0], c1 = cbp[CONVD], c2 = cbp[2 * CONVD], rw = bf2f(F.PROJ()[m * NWIN + PC_GQKV + C]);
        const float val = siluf_(c0 * cw[0] + c1 * cw[CONVD] + c2 * cw[2 * CONVD] + rw * cw[3 * CONVD]);
        float* cvo = F.out + O_CVS + ((size_t)(l * MS + s) * 3) * CONVD + C; cvo[0] = c1; cvo[CONVD] = c2; cvo[2 * CONVD] = rw;
        if (tid < 256) vv[tid] = val; else if (tid < 384) kv[tid - 256] = val; else qv[tid - 384] = val;
        __syncthreads();
        if (wv < 2) { LAS float* p = (wv == 0) ? qv : kv; const float a = p[lane], bq = p[lane + 64]; const float ss = wave_sum(a * a + bq * bq);
            if (lane == 0) sc[wv] = (wv == 0) ? 0.08838834764831845f / sqrtf(ss + EPS) : 1.f / sqrtf(ss + EPS); }
        __syncthreads();
        const float rq = sc[0], rk = sc[1];
        __syncthreads();
        if (tid < 128) { qv[tid] *= rq; kv[tid] *= rk; }
        const float a = F.AB()[m * 8 + h], bb = F.AB()[m * 8 + 4 + h]; const float x = a + F.inp(17)[l * 4 + h]; const float sp = fmaxf(x, 0.f) + log1pf(expf(-fabsf(x)));
        dec = expf(-expf(F.inp(16)[l * 4 + h]) * sp); beta_ = 1.f / (1.f + expf(-bb));
    } else {
        if (tid < 64) { const int d = tid; const bf16_t* qrow = F.PROJ() + m * NWIN + PC_RQ + h * DK; const bf16_t* krow = F.PROJ() + m * NWIN + PC_RK + h * DK;
            const float cs = F.COS()[2048 * 64 + d], sn = F.SIN()[2048 * 64 + d]; const float q1 = bf2f(qrow[d]), q2 = bf2f(qrow[d + 64]), k1 = bf2f(krow[d]), k2 = bf2f(krow[d + 64]);
            qv[d] = q1 * cs - q2 * sn; qv[d + 64] = q1 * sn + q2 * cs; kv[d] = (k1 * cs - k2 * sn) * 0.08838834764831845f; kv[d + 64] = (k1 * sn + k2 * cs) * 0.08838834764831845f; }
        else if (tid < 320) vv[tid - 64] = bf2f(F.PROJ()[m * NWIN + PC_RV + h * DV + (tid - 64)]);
        dec = 1.f - exp2f(-5.0f - (float)h);
    }
    __syncthreads();
    float qk = 0.f;
#pragma unroll 8
    for (int d = 0; d < 128; ++d) qk += qv[d] * kv[d];
    const int e4 = lane * 4, dq = wv;
    const size_t sofs = ((size_t)(l * MS + s) * NH + h) * (size_t)(DK * DV);
    const float* S0 = F.inp(GDN ? 4 : 3) + sofs + (size_t)(16 * dq) * DV + e4;
    f32x4 st[16]; f32x4 aq = (f32x4){0.f, 0.f, 0.f, 0.f}, ak = aq;
#pragma unroll
    for (int i = 0; i < 16; ++i) st[i] = *(const f32x4*)(S0 + (size_t)i * DV);
#pragma unroll
    for (int i = 0; i < 16; ++i) { aq += st[i] * qv[16 * dq + i]; if (GDN) ak += st[i] * kv[16 * dq + i]; }
    *(LAS f32x4*)(partq + dq * 256 + e4) = aq; if (GDN) *(LAS f32x4*)(partk + dq * 256 + e4) = ak;
    __syncthreads();
    f32x4 qS = (f32x4){0.f, 0.f, 0.f, 0.f}, kS = qS;
#pragma unroll
    for (int w = 0; w < 8; ++w) { qS += *(const LAS f32x4*)(partq + w * 256 + e4); if (GDN) kS += *(const LAS f32x4*)(partk + w * 256 + e4); }
    const f32x4 v4 = *(const LAS f32x4*)(vv + e4);
    const f32x4 vnew = GDN ? (v4 - kS * dec) * beta_ : v4;
    const f32x4 o = qS * dec + vnew * qk;
    float* S1 = F.out + (GDN ? O_SGS : O_SRS) + sofs + (size_t)(16 * dq) * DV + e4;
#pragma unroll
    for (int i = 0; i < 16; ++i) *(f32x4*)(S1 + (size_t)i * DV) = st[i] * dec + vnew * kv[16 * dq + i];
    const float ssq = wave_sum((o.x * o.x + o.y * o.y) + (o.z * o.z + o.w * o.w));
    if (dq == 0) { const float rstd = 1.f / sqrtf(ssq * (1.f / DV) + EPS); const bf16_t* gp = F.PROJ() + m * NWIN + (GDN ? PC_GZ : PC_RG) + h * DV + e4; float r4[4];
#pragma unroll
        for (int j = 0; j < 4; ++j) r4[j] = o[j] * rstd * bf2f(gp[j]);
        u32x2 w; w.x = pk2(r4[0], r4[1]); w.y = pk2(r4[2], r4[3]);
        *(u32x2*)(F.OBR() + (GDN ? OBR_STRIDE : 0) + m * D + h * DV + e4) = w; }
    __syncthreads();
}
__device__ __forceinline__ void sample_attn(const Frame& F, int l, int item) {
    const int tid = F.tid, lane = F.lane, wv = F.wave, s = item >> 2, h = item & 3; const size_t m = (size_t)(MP + s);
    LAS float* scs = (LAS float*)F.lds;
    LAS float* part = scs + 512;
    LAS float* sinv = scs + 256;
    f32x4 q4; { const u32x2 qw = *(const u32x2*)(F.PROJ() + m * NWIN + PC_MQ + h * 256 + lane * 4); q4 = (f32x4){bf2f(qw.x & 0xffffu), bf2f(qw.x >> 16), bf2f(qw.y & 0xffffu), bf2f(qw.y >> 16)}; }
    const float* Kb = F.inp(6) + (((size_t)(l * MS + s) * NMEM) * NH + h) * 256 + lane * 4;
    const float* Vb = F.inp(7) + (((size_t)(l * MS + s) * NMEM) * NH + h) * 256 + lane * 4;
    float myscore = 0.f;
#pragma unroll
    for (int k8 = 0; k8 < 4; ++k8) { f32x4 kk[8];
#pragma unroll
        for (int j = 0; j < 8; ++j) kk[j] = *(const f32x4*)(Kb + (size_t)(32 * wv + 8 * k8 + j) * (NH * 256));
#pragma unroll
        for (int j = 0; j < 8; ++j) { const float d = wave_sum((kk[j].x * q4.x + kk[j].y * q4.y) + (kk[j].z * q4.z + kk[j].w * q4.w)); if (lane == 8 * k8 + j) myscore = d; } }
    if (lane < 32) scs[32 * wv + lane] = myscore * 0.0625f;
    __syncthreads();
    if (wv == 0) { const f32x4 s4 = *(const LAS f32x4*)(scs + 4 * lane); float mx = fmaxf(fmaxf(s4.x, s4.y), fmaxf(s4.z, s4.w));
#pragma unroll
        for (int o = 1; o < 64; o <<= 1) mx = fmaxf(mx, __shfl_xor(mx, o));
        const f32x4 p = (f32x4){fexp(s4.x - mx), fexp(s4.y - mx), fexp(s4.z - mx), fexp(s4.w - mx)}; const float sum = wave_sum((p.x + p.y) + (p.z + p.w));
        *(LAS f32x4*)(scs + 4 * lane) = p; if (lane == 0) sinv[0] = 1.f / sum; }
    __syncthreads();
    f32x4 acc = (f32x4){0.f, 0.f, 0.f, 0.f};
#pragma unroll
    for (int k8 = 0; k8 < 4; ++k8) { f32x4 vv[8];
#pragma unroll
        for (int j = 0; j < 8; ++j) vv[j] = *(const f32x4*)(Vb + (size_t)(32 * wv + 8 * k8 + j) * (NH * 256));
#pragma unroll
        for (int j = 0; j < 8; ++j) acc += vv[j] * scs[32 * wv + 8 * k8 + j]; }
    *(LAS f32x4*)(part + wv * 256 + lane * 4) = acc;
    __syncthreads();
    if (wv == 0) { f32x4 o = (f32x4){0.f, 0.f, 0.f, 0.f};
#pragma unroll
        for (int w = 0; w < 8; ++w) o += *(const LAS f32x4*)(part + w * 256 + lane * 4);
        o = o * sinv[0]; u32x2 w2; w2.x = pk2(o.x, o.y); w2.y = pk2(o.z, o.w);
        *(u32x2*)(F.OBR() + 2 * OBR_STRIDE + m * D + h * 256 + lane * 4) = w2; }
    __syncthreads();
}

struct SEpiF32 { static constexpr int NBF = 1, NSEG = 1; float* C;
    __device__ __forceinline__ int brow(int st, int) const { return 16 * st; }
    __device__ __forceinline__ void fold(f32x4 (&tot)[1], const f32x4 (&acc)[1], int, int, int, int) const { tot[0] = acc[0]; }
    __device__ __forceinline__ void store(const f32x4 (&tot)[1], int row, int st, int g) const { *(f32x4*)(C + (size_t)row * D + 16 * st + 4 * g) = tot[0]; } };
struct SEpiBf16 { static constexpr int NBF = 1, NSEG = 1; bf16_t* O; int ldc;
    __device__ __forceinline__ int brow(int st, int) const { return 16 * st; }
    __device__ __forceinline__ void fold(f32x4 (&tot)[1], const f32x4 (&acc)[1], int, int, int, int) const { tot[0] = acc[0]; }
    __device__ __forceinline__ void store(const f32x4 (&tot)[1], int row, int st, int g) const { u32x2 w; w.x = pk2(tot[0][0], tot[0][1]); w.y = pk2(tot[0][2], tot[0][3]); *(u32x2*)(O + (size_t)row * ldc + 16 * st + 4 * g) = w; } };
struct SEpiProj { static constexpr int NBF = 1, NSEG = 1; bf16_t* O; const float* gn; const float* rs;
    __device__ __forceinline__ int brow(int st, int) const { return 16 * st; }
    __device__ __forceinline__ void fold(f32x4 (&tot)[1], const f32x4 (&acc)[1], int, int, int, int) const { tot[0] = acc[0]; }
    __device__ __forceinline__ void store(const f32x4 (&tot)[1], int row, int st, int g) const { const int col = 16 * st + 4 * g; f32x4 v = tot[0] * rs[row];
        if (col >= PC_RG && col < PC_RG + 1024) {
#pragma unroll
            for (int q = 0; q < 4; ++q) v[q] = siluf_(v[q]); }
        else if (col >= PC_GZ && col < PC_GZ + 1024) {
#pragma unroll
            for (int q = 0; q < 4; ++q) v[q] = siluf_(v[q]) * gn[(col + q) & 255]; }
        u32x2 w; w.x = pk2(v[0], v[1]); w.y = pk2(v[2], v[3]); *(u32x2*)(O + (size_t)row * NWIN + col) = w; } };
struct SEpiSwiGLU { static constexpr int NBF = 2, NSEG = 1; bf16_t* O; const float* rs;
    __device__ __forceinline__ int brow(int st, int bfi) const { return (st >> 3) * 256 + (st & 7) * 16 + 128 * bfi; }
    __device__ __forceinline__ void fold(f32x4 (&tot)[2], const f32x4 (&acc)[2], int, int, int, int) const { tot[0] = acc[0]; tot[1] = acc[1]; }
    __device__ __forceinline__ void store(const f32x4 (&tot)[2], int row, int st, int g) const { float r[4];
#pragma unroll
        for (int j = 0; j < 4; ++j) r[j] = siluf_(tot[0][j] * rs[row]) * (tot[1][j] * rs[row]);
        u32x2 w; w.x = pk2(r[0], r[1]); w.y = pk2(r[2], r[3]); *(u32x2*)(O + (size_t)row * DFF + 16 * st + 4 * g) = w; } };
struct SEpiBranch { static constexpr int NBF = 1, NSEG = 3; bf16_t* O; const bf16_t* proj;
    __device__ __forceinline__ int brow(int st, int) const { return 16 * st; }
    __device__ __forceinline__ void fold(f32x4 (&tot)[1], const f32x4 (&acc)[1], int seg, int row, int st, int g) const {
        const u32x2 gw = *(const u32x2*)(proj + (size_t)row * NWIN + PC_GATE + seg * D + 16 * st + 4 * g);
        const f32x4 gt = (f32x4){sigmoidf_(bf2f(gw.x & 0xffffu)), sigmoidf_(bf2f(gw.x >> 16)), sigmoidf_(bf2f(gw.y & 0xffffu)), sigmoidf_(bf2f(gw.y >> 16))};
        tot[0] = (seg == 0) ? gt * acc[0] : tot[0] + gt * acc[0]; }
    __device__ __forceinline__ void store(const f32x4 (&tot)[1], int row, int st, int g) const { u32x2 w; w.x = pk2(tot[0][0], tot[0][1]); w.y = pk2(tot[0][2], tot[0][3]); *(u32x2*)(O + (size_t)row * D + 16 * st + 4 * g) = w; } };
template <int K, class EpiS, int RT = 4, int NS = 1> __device__ __forceinline__ void small_gemm(const Frame& F, const bf16_t* A, size_t aseg, const bf16_t* Bt, size_t bseg, int nstrips, int first, int count, const EpiS& E) {
    static_assert(RT == 4 ? NS == 1 : (NS == 1 || NS == 4), "small_gemm shapes");
    const int j = (F.bid - first + F.G) % F.G; if (j >= count) return;
    constexpr int NBF = EpiS::NBF, KQ = K / 4, NKS = KQ / 32, BATCH = (RT == 1 && NS == 1 && NBF == 1) ? NKS : (NBF == 2) ? 4 : 8, RQ = 4 / RT, NT = RT * NS;
    const int lane = F.lane, wv = F.wave, c = lane & 15, g = lane >> 4, rh = wv & 1, kq = wv >> 1;
    LAS f32x4* red = (LAS f32x4*)F.lds;
    for (int it = j; it < (nstrips / NS) * RQ; it += count) {
        const int sg = it / RQ, rq = it - sg * RQ, t0 = (RT == 4) ? rh * 4 : rq * 2 + rh;
        f32x4 tot[NBF][NT];
#pragma unroll
        for (int seg = 0; seg < EpiS::NSEG; ++seg) {
            f32x4 acc[NBF][NT];
#pragma unroll
            for (int q = 0; q < NBF; ++q)
#pragma unroll
                for (int t = 0; t < NT; ++t) acc[q][t] = (f32x4){0.f, 0.f, 0.f, 0.f};
            const char* ap = (const char*)(A + seg * aseg); unsigned ao = ((unsigned)(MP + t0 * 16 + c) * K + kq * KQ + 8 * g) * 2u; asm volatile("" : "+v"(ao));
            const char* bp = (const char*)(Bt + seg * bseg); unsigned bo[NBF][NS];
#pragma unroll
            for (int q = 0; q < NBF; ++q)
#pragma unroll
                for (int n = 0; n < NS; ++n) { bo[q][n] = ((unsigned)(E.brow(sg * NS + n, q) + c) * K + kq * KQ + 8 * g) * 2u; asm volatile("" : "+v"(bo[q][n])); }
#pragma unroll
            for (int ks0 = 0; ks0 < NKS; ks0 += BATCH) {
                bf16x8 af[RT][BATCH], bfr[NBF][NS][BATCH];
#pragma unroll
                for (int s = 0; s < BATCH; ++s) if (ks0 + s < NKS) {
#pragma unroll
                    for (int q = 0; q < NBF; ++q)
#pragma unroll
                        for (int n = 0; n < NS; ++n) bfr[q][n][s] = *(const bf16x8*)(bp + (bo[q][n] + (unsigned)(ks0 + s) * 64u));
#pragma unroll
                    for (int t = 0; t < RT; ++t) af[t][s] = *(const bf16x8*)(ap + (ao + (unsigned)(t * 16 * K * 2) + (unsigned)(ks0 + s) * 64u)); }
#pragma unroll
                for (int s = 0; s < BATCH; ++s) if (ks0 + s < NKS) {
#pragma unroll
                    for (int q = 0; q < NBF; ++q)
#pragma unroll
                        for (int n = 0; n < NS; ++n)
#pragma unroll
                            for (int t = 0; t < RT; ++t) acc[q][n * RT + t] = MFMA16(bfr[q][n][s], af[t][s], acc[q][n * RT + t]); }
                CBAR();
            }
#pragma unroll
            for (int n = 0; n < NS; ++n)
#pragma unroll
                for (int t = 0; t < RT; ++t) { f32x4 a1[NBF], t1[NBF];
#pragma unroll
                    for (int q = 0; q < NBF; ++q) { a1[q] = acc[q][n * RT + t]; t1[q] = tot[q][n * RT + t]; }
                    E.fold(t1, a1, seg, MP + (t0 + t) * 16 + c, sg * NS + n, g);
#pragma unroll
                    for (int q = 0; q < NBF; ++q) tot[q][n * RT + t] = t1[q]; }
        }
#pragma unroll
        for (int q = 0; q < NBF; ++q)
#pragma unroll
            for (int t = 0; t < NT; ++t) red[((q * 8 + wv) * NT + t) * 64 + lane] = tot[q][t];
        __syncthreads();
        if (NT == 4 || kq == 0) {
            const int tf = (NT == 4) ? kq : 0; f32x4 fin[NBF];
#pragma unroll
            for (int q = 0; q < NBF; ++q) { f32x4 s4 = (f32x4){0.f, 0.f, 0.f, 0.f};
#pragma unroll
                for (int k2 = 0; k2 < 4; ++k2) s4 += red[((q * 8 + rh + 2 * k2) * NT + tf) * 64 + lane];
                fin[q] = s4; }
            E.store(fin, MP + (t0 + (RT == 4 ? tf : 0)) * 16 + c, sg * NS + (RT == 4 ? 0 : tf), g); }
        __syncthreads();
    }
}

__device__ __forceinline__ const void* opaque_ptr(const void* p) { unsigned lo = __builtin_amdgcn_readfirstlane((unsigned)(size_t)p), hi = __builtin_amdgcn_readfirstlane((unsigned)((size_t)p >> 32));
    asm volatile("" : "+s"(lo), "+s"(hi)); return (const void*)(const GAS void*)(((size_t)hi << 32) | lo); }
__device__ __forceinline__ void stagger(int bid, int step_ticks) { const unsigned long long t0 = __builtin_amdgcn_s_memrealtime(), d = (unsigned long long)((bid >> 3) & 3) * (unsigned long long)step_ticks;
    while (__builtin_amdgcn_s_memrealtime() - t0 < d) __builtin_amdgcn_s_sleep(8); }
#ifndef STAG_TICKS
#define STAG_TICKS 0
#endif
#ifndef EN_SITES
#define EN_SITES 0x7ff
#endif
#define SITE(k) ((EN_SITES >> (k)) & 1)
#ifndef EN_PP
#define EN_PP 0xf
#endif
#ifndef EN_SP
#define EN_SP 0x1f
#endif
#define PP(k) ((EN_PP >> (k)) & 1)
#define SP(k) ((EN_SP >> (k)) & 1)
constexpr int NPHASE = 25;
__global__ void __launch_bounds__(NWAVES * 64, 2) fwd(Args args) {
    extern __shared__ __attribute__((aligned(16))) unsigned char lds_raw[];
    Frame F;
    F.lds = (LAS unsigned char*)lds_raw; F.tid = threadIdx.x; F.lane = F.tid & 63; F.wave = __builtin_amdgcn_readfirstlane(F.tid >> 6); F.G = gridDim.x; F.bid = blockIdx.x;
    F.A = &args; F.zo = 0; F.out = args.out; F.ws = args.ws; unsigned char* ws = args.ws;
    volatile LAS unsigned* MISC = (volatile LAS unsigned*)(F.lds + MISC_OFF);
    if (F.tid < 64) ((LAS unsigned*)(F.lds + MISC_OFF))[F.tid] = 0u;
    __syncthreads();
    const int lo = args.ph_lo, hi = args.ph_hi, sel = args.sel;
    XcdBarrier bar; bar.bar = (unsigned*)(ws + WS_CTL) + CW_BAR; bar.x = 0; bar.st = nullptr;
    if (hi - lo > 1) bar = xcd_barrier_post((unsigned*)(ws + WS_CTL) + CW_BAR, MISC + 8);
#define IN(k) (lo <= (k) && (k) < hi)
#define SITE_FRAME() Frame Fp = F; { Fp.ws = (unsigned char*)opaque_ptr(F.ws); Fp.out = (float*)opaque_ptr(F.out); } { int t_ = (int)threadIdx.x, b_ = (int)blockIdx.x, z_; asm volatile("s_mov_b32 %0, 0" : "=s"(z_)); Fp.zo = z_; asm volatile("" : "+v"(t_), "+s"(b_)); Fp.tid = t_; Fp.lane = t_ & 63; Fp.wave = __builtin_amdgcn_readfirstlane(t_ >> 6); Fp.bid = b_; } const int bid = Fp.bid
#define SEAM(k) do { if (IN(k) && IN((k) + 1)) { XcdBarrier b2_ = bar; b2_.bar = (unsigned*)opaque_ptr(bar.bar); xcd_barrier(b2_, Fp.tid == 0); } } while (0)
    const int G = F.G;

    if (SITE(0) && IN(0)) { SITE_FRAME(); p0_prologue(Fp); SEAM(0); }
    for (int l = 0; l < 2; ++l) {
        const int base = 1 + 12 * l;
        for (int half = 0; half < 2; ++half) {
            const int pb = base + 9 * half;
            if (SITE(2) && IN(pb)) { SITE_FRAME();
                pg8::Gemm g{Fp.H(), (const bf16_t*)(Fp.ws + WS_W0 + (size_t)l * WS_WL + (half ? OFF_W2I : OFF_W1I)), D}; pg8::StaticOrder S; S.init(MP, NFFI, D, G, bid);
                pg8::EpiSwiGLU E{Fp.ACT(), Fp.RS()};
                pg8::gemm_phase<pg8::EpiSwiGLU, pg8::StaticOrder, true, true>(Fp.lds, g, S, E, Fp.tid);
                if (l == 0 && half == 0 && bid >= G / 2) {
                    pg8::Gemm g2{Fp.MEMN(), (const bf16_t*)(Fp.ws + WS_WMKV), D}; pg8::GroupAOrder S2; S2.init(NB * NMEM, 4096, D, G / 2, bid - G / 2); S2.grp = 8; S2.astride = (size_t)NB * NMEM * D * 2;
                    pg8::EpiMemKV E2{Fp.out + O_MKP, Fp.out + O_MVP, Fp.MK(), Fp.MVT()};
                    pg8::gemm_phase<pg8::EpiMemKV, pg8::GroupAOrder, false, true>(Fp.lds, g2, S2, E2, Fp.tid);
                }
                { SEpiSwiGLU SE{Fp.ACT(), Fp.RS()}; small_gemm<D>(Fp, g.A, 0, g.Bt, 0, DFF / 16, G / 2, G / 2, SE); }
                SEAM(pb);
            }
            if (SITE(3) && IN(pb + 1)) { SITE_FRAME();
                pg8::Gemm g{Fp.ACT(), (const bf16_t*)(Fp.ws + WS_W0 + (size_t)l * WS_WL + (half ? OFF_W2O : OFF_W1O)), DFF}; pg8::StaticOrder S; S.init(MP, D, DFF, G, bid, WGM_N1024);
                pg8::EpiBf16 E{Fp.TMP(), D};
                pg8::gemm_phase<pg8::EpiBf16, pg8::StaticOrder, true, true>(Fp.lds, g, S, E, Fp.tid);
                { SEpiBf16 SE{Fp.TMP(), D}; small_gemm<DFF, SEpiBf16, 1>(Fp, g.A, 0, g.Bt, 0, D / 16, 0, G, SE); }
                SEAM(pb + 1);
            }
            if (SITE(4) && IN(pb + 2)) { SITE_FRAME();
                NormArgs na; na.tmp = Fp.TMP(); na.scale = 0.5f; na.first = 0;
                if (half == 0) { na.gpost = Fp.inp(9) + l * D; na.gpre = Fp.inp(12) + l * D; na.wab = Fp.WAB() + (size_t)l * 8 * D; na.fin = 0; }
                else { na.gpost = Fp.inp(27) + l * D; na.gpre = Fp.inp(8) + (l == 0 ? D : 0); na.wab = nullptr; na.fin = (l == 1); }
                norm_phase(Fp, na);
                SEAM(pb + 2);
            }
            if (half == 0) {
                if (SITE(5) && IN(base + 3)) { SITE_FRAME();
                    pg8::Gemm g{Fp.H(), (const bf16_t*)(Fp.ws + WS_W0 + (size_t)l * WS_WL + OFF_WIN), D}; pg8::StaticOrder S; S.init(MP, NWIN, D, G, bid);
                    pg8::EpiProj E{Fp.PROJ(), Fp.inp(18) + l * DV, Fp.RS()};
                    pg8::gemm_phase<pg8::EpiProj, pg8::StaticOrder, true, true>(Fp.lds, g, S, E, Fp.tid);
                    { SEpiProj SE{Fp.PROJ(), Fp.inp(18) + l * DV, Fp.RS()}; small_gemm<D, SEpiProj, 1, 4>(Fp, g.A, 0, g.Bt, 0, NWIN / 16, 0, G, SE); }
                    SEAM(base + 3);
                }
                if (SITE(6) && IN(base + 4)) { SITE_FRAME();
                    if (PP(0) && (sel & 1)) for (int ci = bid; ci < NB * NH * NCH; ci += G) gdn_prep(Fp, l, ci);
                    if (PP(1) && (sel & 2)) for (int ci = bid; ci < NB * NH * NCH; ci += G) ret_prep(Fp, ci);
                    if (PP(2) && (sel & 4) && l == 0) { const int xcd = bid & 7, slot = bid >> 3, per = G >> 3;
                        if ((G & 7) == 0) { for (int ux = slot; ux < 64; ux += per) mem_attn_unit(Fp, l, (xcd * 4 + (ux >> 4)) * 16 + (ux & 15)); }
                        else for (int u = bid; u < NB * NH * 16; u += G) mem_attn_unit(Fp, l, u); }
                    if (PP(3) && bid < NB) { for (int i = Fp.tid; i < 3 * CONVD; i += NWAVES * 64) { const int j = i / CONVD, C = i % CONVD;
                        Fp.out[O_CVP + ((size_t)(l * NB + bid) * 3 + j) * CONVD + C] = bf2f(Fp.PROJ()[(size_t)(bid * SEQ + SEQ - 3 + j) * NWIN + PC_GQKV + C]); } }
                    SEAM(base + 4);
                }
                if (SITE(7) && IN(base + 5)) { SITE_FRAME();
                    if (bid < 32) { if (SP(0) && (sel & 8)) scan_bh<false>(Fp, l, bid); }
                    else if (bid < 64) { if (SP(1) && (sel & 8)) scan_bh<true>(Fp, l, bid - 32); }
                    else { const int nw = G - 64;
                        if (SP(2) && (sel & 16)) for (int it = bid - 64; it < MS * NH; it += nw) sample_step<true>(Fp, l, it);
                        if (SP(3) && (sel & 16)) for (int it = bid - 64; it < MS * NH; it += nw) sample_step<false>(Fp, l, it);
                        if (SP(4) && (sel & 32)) for (int it = bid - 64; it < MS * NH; it += nw) sample_attn(Fp, l, it);
                        if (l == 0 && (sel & 64)) convert_layer1(Fp, bid - 64, nw);
                        if (l == 0 && (sel & 64)) {
                            __syncthreads();
                            pg8::Gemm g{Fp.OBR() + 2 * OBR_STRIDE, (const bf16_t*)(Fp.ws + WS_W0 + (size_t)l * WS_WL + OFF_WBR) + 2 * (size_t)D * D, D}; pg8::SegOrder S; S.init(MP, D, D, nw, (bid - 64 + 64) % nw, WGM_N1024); S.nseg = 1; S.aseg = 0; S.bseg = 0;
                            pg8::EpiBranch E{Fp.MERGED(), Fp.PROJ(), 2, 2};
                            pg8::gemm_phase<pg8::EpiBranch, pg8::SegOrder, true, true>(Fp.lds, g, S, E, Fp.tid); }
                        if (l == 1 && (sel & 4)) {
                            if ((G & 7) == 0) { const int xcd = bid & 7, slot = (bid >> 3) - 8, per = (G >> 3) - 8; for (int ux = slot; ux < 64; ux += per) mem_attn_unit(Fp, l, (xcd * 4 + (ux >> 4)) * 16 + (ux & 15)); }
                            else for (int u = bid - 64; u < NB * NH * 16; u += nw) mem_attn_unit(Fp, l, u); } }
                    SEAM(base + 5);
                }
                if (SITE(8) && IN(base + 6)) { SITE_FRAME();
                    pg8::Gemm g{Fp.OBR(), (const bf16_t*)(Fp.ws + WS_W0 + (size_t)l * WS_WL + OFF_WBR), D}; pg8::SegOrder S; S.init(MP, D, D, G, bid, WGM_N1024); S.nseg = (l == 0 ? 2 : 3); S.aseg = OBR_STRIDE * 2; S.bseg = (size_t)D * D * 2;
                    pg8::EpiBranch E{Fp.MERGED(), Fp.PROJ(), 0, (l == 0 ? 2 : 0)};
                    pg8::gemm_phase<pg8::EpiBranch, pg8::SegOrder, true, true>(Fp.lds, g, S, E, Fp.tid);
                    { SEpiBranch SE{Fp.MERGED(), Fp.PROJ()}; small_gemm<D, SEpiBranch, 1>(Fp, g.A, OBR_STRIDE, g.Bt, (size_t)D * D, D / 16, 0, G, SE); }
                    SEAM(base + 6);
                }
                if (SITE(9) && IN(base + 7)) { SITE_FRAME();
                    pg8::Gemm g{Fp.MERGED(), (const bf16_t*)(Fp.ws + WS_W0 + (size_t)l * WS_WL + OFF_WO), D}; pg8::StaticOrder S; S.init(MP, D, D, G, bid, WGM_N1024);
                    pg8::EpiBf16 E{Fp.TMP(), D};
                    pg8::gemm_phase<pg8::EpiBf16, pg8::StaticOrder, true, true>(Fp.lds, g, S, E, Fp.tid);
                    { SEpiBf16 SE{Fp.TMP(), D}; small_gemm<D, SEpiBf16, 1>(Fp, g.A, 0, g.Bt, 0, D / 16, 0, G, SE); }
                    SEAM(base + 7);
                }
                if (SITE(10) && IN(base + 8)) { SITE_FRAME();
                    NormArgs na; na.tmp = Fp.TMP(); na.scale = 1.0f; na.first = 0; na.gpost = Fp.inp(13) + l * D; na.gpre = Fp.inp(26) + l * D; na.wab = nullptr; na.fin = 0;
                    norm_phase(Fp, na);
                    SEAM(base + 8);
                }
            }
        }
    }
#undef IN
#undef SEAM
}

extern "C" void kernel_launch(void* const* d_in, const int* in_sizes, int n_in, void* d_out, int out_size, void* d_ws, size_t ws_size, hipStream_t stream) {
    static int grid = 0;
    if (grid == 0) {
        if (n_in != 30 || (size_t)out_size != O_END || ws_size < WS_END) { fprintf(stderr, "kernel_launch: unexpected shapes: n_in %d out %d ws %zu (need %zu)\n", n_in, out_size, ws_size, (size_t)WS_END); grid = -1; return; }
        int dev = 0, cus = 0, per_cu = 0;
        if (hipGetDevice(&dev) != hipSuccess || hipDeviceGetAttribute(&cus, hipDeviceAttributeMultiprocessorCount, dev) != hipSuccess) { grid = -1; return; }
        if (hipFuncSetAttribute((const void*)fwd, hipFuncAttributeMaxDynamicSharedMemorySize, LDS_BYTES) != hipSuccess) { fprintf(stderr, "kernel_launch: hipFuncSetAttribute failed\n"); grid = -1; return; }
        if (hipOccupancyMaxActiveBlocksPerMultiprocessor(&per_cu, (const void*)fwd, NWAVES * 64, LDS_BYTES) != hipSuccess || per_cu < 1) { fprintf(stderr, "kernel_launch: occupancy query reports %d\n", per_cu); }
        (void)hipGetLastError();
        grid = cus;
        if (grid < 64) { fprintf(stderr, "kernel_launch: needs >= 64 CUs\n"); grid = -1; return; }
    }
    if (grid < 0) return;
    if (hipMemsetAsync((char*)d_ws + WS_CTL, 0, CTL_ZERO_BYTES, stream) != hipSuccess) return;
    Args a{};
    for (int i = 0; i < 30; ++i) a.in[i] = (const float*)d_in[i];
    a.out = (float*)d_out; a.ws = (unsigned char*)d_ws;
#ifndef MK_ONE_LAUNCH
#define MK_ONE_LAUNCH 1
#endif
    a.sel = 0xff; a.pad = 0;
#ifndef PROBE_PH
#define PROBE_PH -1
#endif
#ifndef PROBE_SEL
#define PROBE_SEL 0xff
#endif
    if (MK_ONE_LAUNCH) { a.ph_lo = 0; a.ph_hi = NPHASE; hipLaunchKernelGGL(fwd, dim3(grid), dim3(NWAVES * 64), LDS_BYTES, stream, a); }
    else for (int p = 0; p < NPHASE; ++p) { a.ph_lo = p; a.ph_hi = p + 1; a.sel = 0xff; hipLaunchKernelGGL(fwd, dim3(grid), dim3(NWAVES * 64), LDS_BYTES, stream, a);
        if (PROBE_PH >= 0 && (p == PROBE_PH || (PROBE_PH >= 1 && p == PROBE_PH + 12))) { a.sel = PROBE_SEL; hipLaunchKernelGGL(fwd, dim3(grid), dim3(NWAVES * 64), LDS_BYTES, stream, a); } }
}
```

```cpp
#include <hip/hip_runtime.h>
#include <cstdio>
#include <cstdint>

#define LAS __attribute__((address_space(3)))
#define GAS __attribute__((address_space(1)))
typedef unsigned short bf16_t;
typedef short bf16x8 __attribute__((ext_vector_type(8)));
typedef short bf16x4 __attribute__((ext_vector_type(4)));
typedef float f32x4 __attribute__((ext_vector_type(4)));
typedef float f32x2 __attribute__((ext_vector_type(2)));
typedef unsigned u32x4 __attribute__((ext_vector_type(4)));
typedef unsigned u32x2 __attribute__((ext_vector_type(2)));
typedef __bf16 bf16x2_t __attribute__((ext_vector_type(2)));
typedef GAS unsigned gu32;

constexpr int D = 1024, SEQ = 2048, NB = 8, MP = NB * SEQ, MS = 128, MREAL = MP + MS, MPAD = 16640;
constexpr int DFF = 2816, NFFI = 2 * DFF, NWIN = 10240, WIN_RAW = 10248;
constexpr int NH = 4, DK = 128, DV = 256, CH = 64, NCH = SEQ / CH, NMEM = 256, CONVD = 2048;
constexpr int PC_RQ = 0, PC_RK = 512, PC_RV = 1024, PC_RG = 2048, PC_GQKV = 3072, PC_GZ = 5120, PC_MQ = 6144, PC_GATE = 7168;
constexpr float EPS = 1e-6f;
constexpr int PAST_LEN = 16384;

__device__ __forceinline__ unsigned f2bf(float f) { unsigned u = __builtin_bit_cast(unsigned, f); return (u + 0x7fffu + ((u >> 16) & 1u)) >> 16; }
__device__ __forceinline__ float bf2f(unsigned b) { return __builtin_bit_cast(float, b << 16); }
__device__ __forceinline__ unsigned pk2(float lo, float hi) { f32x2 v = {lo, hi}; bf16x2_t b = __builtin_convertvector(v, bf16x2_t); return __builtin_bit_cast(unsigned, b); }
__device__ __forceinline__ bf16x8 pack8(f32x4 a, f32x4 b) { u32x4 p; p.x = pk2(a.x, a.y); p.y = pk2(a.z, a.w); p.z = pk2(b.x, b.y); p.w = pk2(b.z, b.w); return __builtin_bit_cast(bf16x8, p); }
__device__ __forceinline__ float fexp(float x) { return __builtin_amdgcn_exp2f(x * 1.4426950408889634f); }
__device__ __forceinline__ float sigmoidf_(float x) { return __builtin_amdgcn_rcpf(1.0f + fexp(-x)); }
__device__ __forceinline__ float siluf_(float x) { return x * sigmoidf_(x); }
__device__ __forceinline__ float wave_sum(float v) {
#pragma unroll
    for (int o = 1; o < 64; o <<= 1) v += __shfl_xor(v, o);
    return v;
}
#define MFMA16(a, b, c) __builtin_amdgcn_mfma_f32_16x16x32_bf16((a), (b), (c), 0, 0, 0)

namespace pg8 {
#define PG8_LAS __attribute__((address_space(3)))
constexpr int BM = 256, BK = 64, HALF = 128, HTB = HALF * BK * 2  , STAGE_BYTES = 8 * HTB, NXCD = 8;
__host__ __device__ __forceinline__ int lds_byte(int r, int c) { const int st = (r >> 4) * 2 + (c >> 5), rr = r & 15, cc = c & 31, ob = rr * 64 + cc * 2; return st * 1024 + (ob ^ (((ob >> 9) & 1) << 5)); }
__host__ __device__ __forceinline__ void stage_rc(int b, int& R, int& C) { const int st = b / 1024, sb = b % 1024, swz = sb ^ (((sb >> 9) & 1) << 5); R = (st >> 1) * 16 + swz / 64; C = (st & 1) * 32 + (swz % 64) / 2; }
__host__ __device__ __forceinline__ int perm32(int rho) { const int n = rho >> 4, i = rho & 15; return 8 * (i >> 2) + 4 * n + (i & 3); }

#ifndef WGM_DEFAULT
#define WGM_DEFAULT 2
#endif
#ifndef WGM_N1024
#define WGM_N1024 8
#endif
struct Unit { int pm, pn, seg; size_t aofs, bofs; };
struct Gemm { const bf16_t* A; const bf16_t* Bt; int K; };

struct StaticOrder {
    int nM, nN, nwg, G, c, WGM; size_t tstep;
    __device__ void init(int M, int N, int K, int G_, int c_, int wgm = WGM_DEFAULT) { nM = M / BM; nN = N / BM; nwg = nM * nN; G = G_; c = c_; WGM = wgm; tstep = (size_t)BM * K * 2; }
    __device__ bool tile(long L, int& pm, int& pn) const {
        if (L >= nwg) return false;
        int wgid = (int)L; { const int q = nwg / NXCD, r = nwg % NXCD, xcd = wgid % NXCD, off = wgid / NXCD; wgid = (xcd < r ? xcd * (q + 1) : r * (q + 1) + (xcd - r) * q) + off; }
        const int nig = WGM * nN, gid = wgid / nig, fm = gid * WGM, gsz = (nM - fm) < WGM ? (nM - fm) : WGM;
        pm = fm + ((wgid % nig) % gsz); pn = (wgid % nig) / gsz; return true;
    }
    __device__ bool next(int i, Unit& u) const {
        if (!tile((long)i * G + c, u.pm, u.pn)) return false;
        u.seg = 0; u.aofs = (size_t)u.pm * tstep; u.bofs = (size_t)u.pn * tstep; return true;
    }
    __device__ __forceinline__ void a_ready(const Unit&) const {}
    __device__ __forceinline__ void done(const Unit&) const {}
};
struct GroupAOrder : StaticOrder {
    int grp; size_t astride;
    __device__ bool next(int i, Unit& u) const {
        if (!tile((long)i * G + c, u.pm, u.pn)) return false;
        u.seg = 0; u.aofs = (size_t)(u.pn / grp) * astride + (size_t)u.pm * tstep; u.bofs = (size_t)u.pn * tstep; return true;
    }
};
struct SegOrder : StaticOrder {
    int nseg; size_t aseg, bseg;
    __device__ bool next(int i, Unit& u) const {
        const int round = i / nseg, seg = i - round * nseg;
        if (!tile((long)round * G + c, u.pm, u.pn)) return false;
        u.seg = seg; u.aofs = (size_t)seg * aseg + (size_t)u.pm * tstep; u.bofs = (size_t)seg * bseg + (size_t)u.pn * tstep; return true;
    }
};

struct EpiF32 {
    static constexpr int NST = 32; static constexpr bool RSLDS = false; static constexpr bool PERM = false, AFTER_DRAIN = false;
    float* C; int ldc;
    __device__ __forceinline__ void operator()(const f32x4 (&acc)[2][2][4][2], const Unit& u, int wr, int wc, int fr, int fq) const {
        const int row0 = u.pm * BM + wr * 64 + fr, col0 = u.pn * BM + wc * 32 + 4 * fq;
#pragma unroll
        for (int ai = 0; ai < 2; ++ai)
#pragma unroll
            for (int m = 0; m < 4; ++m) { float* rowp = C + (size_t)(row0 + ai * HALF + m * 16) * ldc + col0;
#pragma unroll
                for (int bj = 0; bj < 2; ++bj)
#pragma unroll
                    for (int n = 0; n < 2; ++n) *(f32x4*)(rowp + bj * HALF + n * 16) = acc[ai][bj][m][n]; }
    }
};
struct EpiBf16 {
    static constexpr int NST = 16; static constexpr bool RSLDS = false; static constexpr bool PERM = true, AFTER_DRAIN = false;
    bf16_t* O; int ldc;
    __device__ __forceinline__ void operator()(const f32x4 (&acc)[2][2][4][2], const Unit& u, int wr, int wc, int fr, int fq) const {
        const int row0 = u.pm * BM + wr * 64 + fr, col0 = u.pn * BM + wc * 32 + 8 * fq;
        unsigned bo = ((unsigned)row0 * (unsigned)ldc + (unsigned)col0) * 2u; asm volatile("" : "+v"(bo));
        const unsigned rs = (unsigned)ldc * 2u;
#pragma unroll
        for (int ai = 0; ai < 2; ++ai)
#pragma unroll
            for (int m = 0; m < 4; ++m) {
#pragma unroll
                for (int bj = 0; bj < 2; ++bj) { const f32x4 v0 = acc[ai][bj][m][0], v1 = acc[ai][bj][m][1];
                    u32x4 w; w.x = pk2(v0[0], v0[1]); w.y = pk2(v0[2], v0[3]); w.z = pk2(v1[0], v1[1]); w.w = pk2(v1[2], v1[3]);
                    *(u32x4*)((char*)O + (bo + (unsigned)(ai * HALF + m * 16) * rs + (unsigned)(bj * HALF * 2))) = w; } }
    }
};
struct EpiProj {
    static constexpr int NST = 16; static constexpr bool RSLDS = true; static constexpr bool PERM = true, AFTER_DRAIN = false; __device__ static __forceinline__ bool keep_acc(const Unit&) { return false; }
    bf16_t* O; const float* gn; const float* rs;
    __device__ __forceinline__ void operator()(const f32x4 (&acc)[2][2][4][2], const Unit& u, int wr, int wc, int fr, int fq, const LAS float* rsl) const {
        const int row0 = u.pm * BM + wr * 64 + fr, col0 = u.pn * BM + wc * 32 + 8 * fq;
        unsigned bo = ((unsigned)row0 * (unsigned)NWIN + (unsigned)col0) * 2u; asm volatile("" : "+v"(bo));
        const unsigned rstride = (unsigned)NWIN * 2u;
        const int mode = (u.pn >= 8 && u.pn < 12) ? 1 : (u.pn >= 20 && u.pn < 24) ? 2 : 0;
        float gs[2][8];
#pragma unroll
        for (int bj = 0; bj < 2; ++bj)
#pragma unroll
            for (int j = 0; j < 8; ++j) gs[bj][j] = (mode == 2) ? gn[(col0 + bj * HALF + j) & 255] : 1.f;
#pragma unroll
        for (int ai = 0; ai < 2; ++ai)
#pragma unroll
            for (int m = 0; m < 4; ++m) {
#pragma unroll
                for (int bj = 0; bj < 2; ++bj) { const float rv = rsl[wr * 64 + fr + ai * HALF + m * 16]; f32x4 v0 = acc[ai][bj][m][0] * rv, v1 = acc[ai][bj][m][1] * rv;
                    if (mode != 0) {
#pragma unroll
                        for (int j = 0; j < 4; ++j) { v0[j] = siluf_(v0[j]) * gs[bj][j]; v1[j] = siluf_(v1[j]) * gs[bj][4 + j]; } }
                    u32x4 w; w.x = pk2(v0[0], v0[1]); w.y = pk2(v0[2], v0[3]); w.z = pk2(v1[0], v1[1]); w.w = pk2(v1[2], v1[3]);
                    *(u32x4*)((char*)O + (bo + (unsigned)(ai * HALF + m * 16) * rstride + (unsigned)(bj * HALF * 2))) = w; } }
    }
};
struct EpiSwiGLU {
    static constexpr int NST = 8; static constexpr bool RSLDS = true; static constexpr bool PERM = true, AFTER_DRAIN = false;
    bf16_t* O; const float* rs;
    __device__ __forceinline__ void operator()(const f32x4 (&acc)[2][2][4][2], const Unit& u, int wr, int wc, int fr, int fq, const LAS float* rsl) const {
        const int row0 = u.pm * BM + wr * 64 + fr, col0 = u.pn * HALF + wc * 32 + 8 * fq;
#pragma unroll
        for (int ai = 0; ai < 2; ++ai)
#pragma unroll
            for (int m = 0; m < 4; ++m) { bf16_t* rowp = O + (size_t)(row0 + ai * HALF + m * 16) * DFF + col0;
                float r[8]; const float rv = rsl[wr * 64 + fr + ai * HALF + m * 16];
#pragma unroll
                for (int n = 0; n < 2; ++n)
#pragma unroll
                    for (int j = 0; j < 4; ++j) { const float g = acc[ai][0][m][n][j] * rv, up = acc[ai][1][m][n][j] * rv; r[4 * n + j] = siluf_(g) * up; }
                u32x4 w; w.x = pk2(r[0], r[1]); w.y = pk2(r[2], r[3]); w.z = pk2(r[4], r[5]); w.w = pk2(r[6], r[7]);
                *(u32x4*)rowp = w; }
    }
};
struct EpiMemKV {
    static constexpr int NST = 0; static constexpr bool RSLDS = false; static constexpr bool PERM = false, AFTER_DRAIN = false;
    float* outK; float* outV; bf16_t* MK; bf16_t* MVT;
    __device__ __forceinline__ void operator()(const f32x4 (&acc)[2][2][4][2], const Unit& u, int wr, int wc, int fr, int fq) const {
        const int layer = u.pn >> 3, isv = (u.pn >> 2) & 1, cb = (u.pn & 3) * BM;
        const int row0 = u.pm * BM + wr * 64 + fr, col0 = cb + wc * 32 + 4 * fq;
        float* of = (isv ? outV : outK) + (size_t)layer * (NB * NMEM * D);
#pragma unroll
        for (int ai = 0; ai < 2; ++ai)
#pragma unroll
            for (int m = 0; m < 4; ++m) { const int row = row0 + ai * HALF + m * 16;
#pragma unroll
                for (int bj = 0; bj < 2; ++bj)
#pragma unroll
                    for (int n = 0; n < 2; ++n) { const int col = col0 + bj * HALF + n * 16; const f32x4 v = acc[ai][bj][m][n];
                        *(f32x4*)(of + (size_t)row * D + col) = v;
                        const int b = row >> 8, key = row & 255, h = col >> 8, dd = col & 255;
                        unsigned char* fb = (unsigned char*)(isv ? MVT : MK) + ((((size_t)layer * NB + b) * NH + h) << 17);
                        if (!isv) { u32x2 w; w.x = pk2(v[0], v[1]); w.y = pk2(v[2], v[3]);
                            *(u32x2*)(fb + ((((key >> 4) * 8 + (dd >> 5)) * 64 + (key & 15) + 16 * ((dd & 31) >> 3)) << 4) + ((dd & 4) << 1)) = w; }
                        else {
                            const int ks = key >> 5, w5 = key & 31, gg = (w5 & 15) >> 2, jj = (w5 & 3) + 4 * (w5 >> 4);
#pragma unroll
                            for (int j = 0; j < 4; ++j) { const int e = dd + j; *(bf16_t*)(fb + (((((e >> 4) * 8 + ks) * 64 + (e & 15) + 16 * gg) << 4) + jj * 2)) = (bf16_t)f2bf(v[j]); } } } }
    }
};
struct EpiBranch {
    static constexpr int NST = 16; static constexpr bool RSLDS = false; static constexpr bool PERM = true, AFTER_DRAIN = false;
    bf16_t* O; const bf16_t* proj; int seg_base, noold_seg;
    __device__ __forceinline__ void operator()(const f32x4 (&acc)[2][2][4][2], const Unit& u, int wr, int wc, int fr, int fq) const {
        const int row0 = u.pm * BM + wr * 64 + fr, col0 = u.pn * BM + wc * 32 + 8 * fq;
        unsigned go = ((unsigned)row0 * (unsigned)NWIN + (unsigned)(PC_GATE + (u.seg + seg_base) * D + col0)) * 2u, oo = ((unsigned)row0 * (unsigned)D + (unsigned)col0) * 2u; asm volatile("" : "+v"(go), "+v"(oo));
        const char* gb = (const char*)proj; char* ob = (char*)O;
#pragma unroll
        for (int ai = 0; ai < 2; ++ai) {
            u32x4 gwv[4][2], oldv[4][2];
#pragma unroll
            for (int m = 0; m < 4; ++m)
#pragma unroll
                for (int bj = 0; bj < 2; ++bj) { gwv[m][bj] = *(const u32x4*)(gb + (go + (unsigned)((ai * HALF + m * 16) * NWIN + bj * HALF) * 2u));
                    oldv[m][bj] = (u32x4){0u, 0u, 0u, 0u}; if (u.seg + seg_base != noold_seg) oldv[m][bj] = *(const u32x4*)(ob + (oo + (unsigned)((ai * HALF + m * 16) * D + bj * HALF) * 2u)); }
            asm volatile("" ::: "memory");
#pragma unroll
            for (int m = 0; m < 4; ++m)
#pragma unroll
                for (int bj = 0; bj < 2; ++bj) { const u32x4 gw = gwv[m][bj], old = oldv[m][bj]; float r[8];
#pragma unroll
                    for (int q = 0; q < 4; ++q) { const unsigned g2 = gw[q], o2 = old[q];
                        const float a0 = acc[ai][bj][m][q >> 1][(q & 1) * 2], a1 = acc[ai][bj][m][q >> 1][(q & 1) * 2 + 1];
                        r[2 * q] = bf2f(o2 & 0xffffu) + sigmoidf_(bf2f(g2 & 0xffffu)) * a0; r[2 * q + 1] = bf2f(o2 >> 16) + sigmoidf_(bf2f(g2 >> 16)) * a1; }
                    u32x4 w; w.x = pk2(r[0], r[1]); w.y = pk2(r[2], r[3]); w.z = pk2(r[4], r[5]); w.w = pk2(r[6], r[7]);
                    *(u32x4*)(ob + (oo + (unsigned)((ai * HALF + m * 16) * D + bj * HALF) * 2u)) = w; }
            asm volatile("" ::: "memory");
        }
    }
};

template <class Epi, class Sched, bool ALIGN_EPI = false, bool SP2 = false>
__device__ __forceinline__ void gemm_phase(PG8_LAS unsigned char* lds, const Gemm g, const Sched& S, const Epi& E, const int tid) {
    const int wid = __builtin_amdgcn_readfirstlane(tid >> 6), lane = tid & 63, wr = wid >> 2, wc = wid & 3, fr = lane & 15, fq = lane >> 4;
    const int K = g.K, nt = K / BK;
    unsigned voffA[2], voffB[2];
#pragma unroll
    for (int i = 0; i < 2; ++i) { int R, C; stage_rc(tid * 16 + i * 8192, R, C); const int Rb = Epi::PERM ? ((R & ~31) + perm32(R & 31)) : R;
        voffA[i] = (unsigned)(R * K + C) * 2u; voffB[i] = (unsigned)(Rb * K + C) * 2u; }
    const size_t kstep = (size_t)(BK * 2);
    const size_t hstep = (size_t)HALF * K * 2;
    const unsigned ldsw = (unsigned)wid * 1024u;
    const int aoff = lds_byte(wr * 64 + fr, fq * 8), boff = lds_byte(wc * 32 + fr, fq * 8);
#define PG8_SA(b, h) (((b) * 2 + (h)) * HTB)
#define PG8_SB(b, h) ((4 + (b) * 2 + (h)) * HTB)
#define PG8_STAGE(bufoff, gbase, voff) do { _Pragma("unroll") for (int _i = 0; _i < 2; ++_i) \
        __builtin_amdgcn_global_load_lds((const unsigned*)((const char*)(gbase) + (voff)[_i]), (PG8_LAS unsigned*)(lds + (bufoff) + ldsw + _i * 8192), 16, 0, 0); } while (0)
#define PG8_LDA(dst, b, h) do { _Pragma("unroll") for (int m = 0; m < 4; ++m) _Pragma("unroll") for (int k = 0; k < 2; ++k) dst[m][k] = *(const PG8_LAS bf16x8*)(lds + PG8_SA(b, h) + aoff + m * 2048 + k * 1024); } while (0)
#define PG8_LDB(dst, b, h) do { _Pragma("unroll") for (int n = 0; n < 2; ++n) _Pragma("unroll") for (int k = 0; k < 2; ++k) dst[n][k] = *(const PG8_LAS bf16x8*)(lds + PG8_SB(b, h) + boff + n * 2048 + k * 1024); } while (0)
#define PG8_MMA(ai, bj, At, Bt) do { __builtin_amdgcn_s_setprio(1); _Pragma("unroll") for (int m = 0; m < 4; ++m) _Pragma("unroll") for (int n = 0; n < 2; ++n) _Pragma("unroll") for (int k = 0; k < 2; ++k) \
        acc[ai][bj][m][n] = __builtin_amdgcn_mfma_f32_16x16x32_bf16(Bt[n][k], At[m][k], acc[ai][bj][m][n], 0, 0, 0); __builtin_amdgcn_s_setprio(0); } while (0)
#define PG8_WAIT_V(n) asm volatile("s_waitcnt vmcnt(" #n ")" ::: "memory")
#define PG8_WAIT_L(n) asm volatile("s_waitcnt lgkmcnt(" #n ")" ::: "memory")
#define PG8_BAR __builtin_amdgcn_s_barrier()
#define PG8_SCHED __builtin_amdgcn_sched_barrier(0)
    Unit cur, nxt; int ui = 0;
    if (!S.next(0, cur)) return;
    f32x4 acc[2][2][4][2];
#pragma unroll
    for (int a = 0; a < 2; ++a)
#pragma unroll
        for (int b = 0; b < 2; ++b)
#pragma unroll
            for (int m = 0; m < 4; ++m)
#pragma unroll
                for (int n = 0; n < 2; ++n) acc[a][b][m][n] = (f32x4){0.f, 0.f, 0.f, 0.f};
    bf16x8 At[4][2], B0[2][2], B1[2][2];
    const char* cA = (const char*)g.A + cur.aofs; const char* cB = (const char*)g.Bt + cur.bofs;
    S.a_ready(cur);
    if constexpr (SP2) {
        PG8_STAGE(PG8_SB(0, 0), cB, voffB); PG8_STAGE(PG8_SB(0, 1), cB + hstep, voffB); PG8_STAGE(PG8_SA(0, 0), cA, voffA); PG8_STAGE(PG8_SA(0, 1), cA + hstep, voffA);
        if (wr == 1) PG8_BAR;
        PG8_WAIT_V(2); PG8_BAR;
        PG8_STAGE(PG8_SB(1, 0), cB + kstep, voffB); PG8_STAGE(PG8_SA(1, 0), cA + kstep, voffA); PG8_STAGE(PG8_SB(1, 1), cB + hstep + kstep, voffB);
        PG8_WAIT_V(6); PG8_BAR;
    } else {
        PG8_STAGE(PG8_SB(0, 0), cB, voffB); PG8_STAGE(PG8_SA(0, 0), cA, voffA); PG8_STAGE(PG8_SB(0, 1), cB + hstep, voffB); PG8_STAGE(PG8_SA(0, 1), cA + hstep, voffA);
        if (wr == 1) PG8_BAR;
        PG8_WAIT_V(4); PG8_BAR;
        PG8_STAGE(PG8_SB(1, 0), cB + kstep, voffB); PG8_STAGE(PG8_SA(1, 0), cA + kstep, voffA); PG8_STAGE(PG8_SB(1, 1), cB + hstep + kstep, voffB);
        PG8_WAIT_V(6); PG8_BAR;
    }
    for (;;) {
        const bool has_next = S.next(ui + 1, nxt);
        if constexpr (Epi::RSLDS) {
            if (wid == 0) __builtin_amdgcn_global_load_lds((const unsigned*)(E.rs + (size_t)cur.pm * BM + lane * 4), (PG8_LAS unsigned*)(lds + STAGE_BYTES + (ui & 1) * 1024), 16, 0, 0); }
        const char* nA = has_next ? (const char*)g.A + nxt.aofs : cA; const char* nB = has_next ? (const char*)g.Bt + nxt.bofs : cB;
        for (int t = 0; t < nt; t += 2) {
            const bool last = (t == nt - 2);
            const char* a1 = cA + (size_t)(t + 1) * kstep;
            const char* a2 = last ? nA : cA + (size_t)(t + 2) * kstep; const char* b2 = last ? nB : cB + (size_t)(t + 2) * kstep;
            const char* a3 = a2 + kstep; const char* b3 = b2 + kstep;
            if (last && has_next) S.a_ready(nxt);
            if constexpr (SP2) {
            PG8_LDB(B0, 0, 0); PG8_LDB(B1, 0, 1); PG8_SCHED; PG8_LDA(At, 0, 0); PG8_STAGE(PG8_SA(1, 1), a1 + hstep, voffA);
            PG8_WAIT_V(8); PG8_WAIT_L(0); PG8_BAR; PG8_MMA(0, 0, At, B0); PG8_MMA(0, 1, At, B1); PG8_BAR; PG8_SCHED;
            PG8_LDA(At, 0, 1); PG8_STAGE(PG8_SB(0, 0), b2, voffB); PG8_STAGE(PG8_SB(0, 1), b2 + hstep, voffB); PG8_STAGE(PG8_SA(0, 0), a2, voffA);
            PG8_WAIT_V(8); PG8_WAIT_L(0); PG8_BAR; PG8_MMA(1, 0, At, B0); PG8_MMA(1, 1, At, B1); PG8_BAR; PG8_SCHED;
            PG8_LDB(B0, 1, 0); PG8_LDB(B1, 1, 1); PG8_SCHED; PG8_LDA(At, 1, 0); PG8_STAGE(PG8_SA(0, 1), a2 + hstep, voffA);
            PG8_WAIT_V(8); PG8_WAIT_L(0); PG8_BAR; PG8_MMA(0, 0, At, B0); PG8_MMA(0, 1, At, B1); PG8_BAR; PG8_SCHED;
            PG8_LDA(At, 1, 1); PG8_STAGE(PG8_SB(1, 0), b3, voffB); PG8_STAGE(PG8_SB(1, 1), b3 + hstep, voffB); PG8_STAGE(PG8_SA(1, 0), a3, voffA);
            PG8_WAIT_V(8); PG8_WAIT_L(0); PG8_BAR; PG8_MMA(1, 0, At, B0); PG8_MMA(1, 1, At, B1); PG8_BAR; PG8_SCHED;
            } else {
            PG8_LDB(B0, 0, 0); PG8_SCHED; PG8_LDA(At, 0, 0); PG8_STAGE(PG8_SA(1, 1), a1 + hstep, voffA);
            PG8_WAIT_L(8); PG8_BAR; PG8_WAIT_L(0); PG8_MMA(0, 0, At, B0); PG8_BAR; PG8_SCHED;
            PG8_LDB(B1, 0, 1); PG8_STAGE(PG8_SB(0, 0), b2, voffB);
            PG8_BAR; PG8_WAIT_L(0); PG8_MMA(0, 1, At, B1); PG8_BAR;
            PG8_LDA(At, 0, 1); PG8_STAGE(PG8_SA(0, 0), a2, voffA);
            PG8_BAR; PG8_WAIT_L(0); PG8_MMA(1, 0, At, B0); PG8_BAR; PG8_SCHED;
            PG8_STAGE(PG8_SB(0, 1), b2 + hstep, voffB);
            PG8_WAIT_V(6); PG8_BAR; PG8_MMA(1, 1, At, B1); PG8_BAR;
            PG8_LDB(B0, 1, 0); PG8_SCHED; PG8_LDA(At, 1, 0); PG8_STAGE(PG8_SA(0, 1), a2 + hstep, voffA);
            PG8_WAIT_L(8); PG8_BAR; PG8_WAIT_L(0); PG8_MMA(0, 0, At, B0); PG8_BAR; PG8_SCHED;
            PG8_LDB(B1, 1, 1); PG8_STAGE(PG8_SB(1, 0), b3, voffB);
            PG8_BAR; PG8_WAIT_L(0); PG8_MMA(0, 1, At, B1); PG8_BAR;
            PG8_LDA(At, 1, 1); PG8_STAGE(PG8_SA(1, 0), a3, voffA);
            PG8_BAR; PG8_WAIT_L(0); PG8_MMA(1, 0, At, B0); PG8_BAR; PG8_SCHED;
            PG8_STAGE(PG8_SB(1, 1), b3 + hstep, voffB);
            PG8_WAIT_V(6); PG8_BAR; PG8_MMA(1, 1, At, B1); PG8_BAR;
            }
        }
        if constexpr (ALIGN_EPI) { if (wr == 0) PG8_BAR; }
        if constexpr (Epi::RSLDS) { E(acc, cur, wr, wc, fr, fq, (const PG8_LAS float*)(lds + STAGE_BYTES + (ui & 1) * 1024)); S.done(cur); } else
        if constexpr (!Epi::AFTER_DRAIN) { E(acc, cur, wr, wc, fr, fq); S.done(cur); }
        if (!has_next) break;
#pragma unroll
        for (int a = 0; a < 2; ++a)
#pragma unroll
            for (int b = 0; b < 2; ++b)
#pragma unroll
                for (int m = 0; m < 4; ++m)
#pragma unroll
                    for (int n = 0; n < 2; ++n) acc[a][b][m][n] = (f32x4){0.f, 0.f, 0.f, 0.f};
        cur = nxt; cA = nA; cB = nB; ++ui;
        if constexpr (ALIGN_EPI) { if (wr == 1) PG8_BAR; }
    }
    PG8_WAIT_V(0);
    if constexpr (!ALIGN_EPI) { if (wr == 0) PG8_BAR; }
    PG8_BAR;
    if constexpr (Epi::AFTER_DRAIN) { E.fused(acc, cur, wr, wc, fr, fq, lds, wid, lane); S.done(cur); }
#undef PG8_SA
#undef PG8_SB
#undef PG8_STAGE
#undef PG8_LDA
#undef PG8_LDB
#undef PG8_MMA
#undef PG8_WAIT_V
#undef PG8_WAIT_L
#undef PG8_BAR
#undef PG8_SCHED
}
}

constexpr size_t MiB = 1u << 20;
constexpr size_t WS_CTL = 0, CTL_ZERO_BYTES = 32768;
constexpr size_t WS_W0 = 1 * MiB, WS_WL = 61 * MiB;
constexpr size_t OFF_W1I = 0, OFF_W1O = 11 * MiB, OFF_WIN = 16 * MiB + MiB / 2, OFF_WBR = 36 * MiB + MiB / 2, OFF_WO = 42 * MiB + MiB / 2, OFF_W2I = 44 * MiB + MiB / 2, OFF_W2O = 55 * MiB + MiB / 2;
static_assert(OFF_W2O + (size_t)D * DFF * 2 == WS_WL, "layer weight map");
constexpr size_t WS_WMKV = 123 * MiB;
constexpr size_t WS_MISC = 131 * MiB;
constexpr size_t MISC_WAB = 0, MISC_COS = 65536, MISC_SIN = 65536 + 2049 * 64 * 4;
constexpr size_t WS_MEMN = 133 * MiB, WS_MK = 141 * MiB, WS_MVT = 149 * MiB, WS_AB = 157 * MiB;
constexpr size_t WS_H = 158 * MiB, WS_TMP = 223 * MiB, WS_XN = 288 * MiB, WS_MERGED = 320 * MiB + MiB / 2, WS_OBR = 353 * MiB;
constexpr size_t OBR_STRIDE = (size_t)MPAD * D;
constexpr size_t WS_BIG = 451 * MiB;
constexpr int GCH_W = 0, GCH_QD = 16384, GCH_ATT = 32768, GCH_KDT = 40960, GCH_BYTES = 57344;
constexpr int RCH_QD = 0, RCH_ATT = 16384, RCH_KDT = 24576, RCH_BYTES = 40960;
constexpr size_t WS_RCH = 776 * MiB, WS_RVT = 816 * MiB;
constexpr size_t WS_GCH = 848 * MiB, WS_GUT = 904 * MiB, WS_GDCH = 968 * MiB;
constexpr size_t WS_END = 969 * MiB;
static_assert(WS_H + (size_t)MPAD * D * 4 == WS_TMP && WS_TMP + (size_t)MPAD * D * 4 == WS_XN && WS_XN + (size_t)MPAD * D * 2 == WS_MERGED && WS_MERGED + (size_t)MPAD * D * 2 == WS_OBR, "activation map");
static_assert(WS_OBR + 3 * OBR_STRIDE * 2 <= WS_BIG && WS_BIG + (size_t)MPAD * NWIN * 2 <= WS_RCH && WS_RCH + (size_t)1024 * RCH_BYTES <= WS_RVT && WS_GCH + (size_t)1024 * GCH_BYTES <= WS_GUT, "activation map 2");
constexpr int CW_BAR = 4096;

constexpr size_t O_YP = 0, O_YS = O_YP + (size_t)MP * D, O_SRP = O_YS + (size_t)MS * D, O_SGP = O_SRP + (size_t)2 * NB * NH * DK * DV, O_CVP = O_SGP + (size_t)2 * NB * NH * DK * DV,
                 O_MKP = O_CVP + (size_t)2 * NB * 3 * CONVD, O_MVP = O_MKP + (size_t)2 * NB * NMEM * D, O_SRS = O_MVP + (size_t)2 * NB * NMEM * D, O_SGS = O_SRS + (size_t)2 * MS * NH * DK * DV,
                 O_CVS = O_SGS + (size_t)2 * MS * NH * DK * DV, O_END = O_CVS + (size_t)2 * MS * 3 * CONVD;
static_assert(O_END == 98271232, "output size");

constexpr int LDS_BYTES = 163840, MISC_OFF = LDS_BYTES - 256;

#define XB_TMO      128
#define XB_XCNT(j)  (256  + 64 * (j))
#define XB_XSUB(j)  (1280 + 64 * (j))
#define XB_XGEN(j)  (2304 + 64 * (j))
#define XB_TOP      3328
#define XB_TOPGEN   3392
#define XCD_BAR_WORDS 3456
#define XB_SPIN_CAP (1u << 18)

__device__ __forceinline__ unsigned xb_ld(unsigned* p)              { return __hip_atomic_load(p, __ATOMIC_RELAXED, __HIP_MEMORY_SCOPE_AGENT); }
__device__ __forceinline__ unsigned xb_add(unsigned* p, unsigned v) { return __hip_atomic_fetch_add(p, v, __ATOMIC_RELAXED, __HIP_MEMORY_SCOPE_AGENT); }
__device__ __forceinline__ unsigned xb_xcc_id() { return (unsigned)__builtin_amdgcn_s_getreg((3 << 11) | 20) & 0xFu; }
#define XB_SPIN(cond, bar) do { unsigned _sp = 0; while (cond) { __builtin_amdgcn_s_sleep(1); \
    if ((++_sp & 255u) == 0u) { if (xb_ld(&(bar)[XB_TMO])) break; if (_sp > XB_SPIN_CAP) { atomicAdd(&(bar)[XB_TMO], 1u); break; } } } } while (0)

struct XcdBarrier {
    unsigned* bar; unsigned x;
    volatile LAS unsigned* st;
};

__device__ __forceinline__ XcdBarrier xcd_barrier_post(unsigned* bar, volatile LAS unsigned* st) {
    XcdBarrier b; b.bar = bar; b.x = xb_xcc_id(); b.st = st;
    if (threadIdx.x == 0) (void)xb_add(&bar[XB_XCNT(b.x)], 1u);
    return b;
}
__device__ __forceinline__ void xcd_barrier_complete(unsigned* bar, unsigned x, unsigned& nloc, unsigned& nx) {
    const unsigned G = gridDim.x * gridDim.y * gridDim.z;
    unsigned sum, cnt, mine, sp = 0u;
    for (;;) {
        sum = 0u; cnt = 0u; mine = 0u;
#pragma unroll
        for (unsigned j = 0; j < 16; ++j) { const unsigned c = xb_ld(&bar[XB_XCNT(j)]); sum += c; cnt += (c > 0u) ? 1u : 0u; mine = (j == x) ? c : mine; }
        if (sum == G) break;
        __builtin_amdgcn_s_sleep(1);
        if ((++sp & 255u) == 0u) { if (xb_ld(&bar[XB_TMO])) break; if (sp > XB_SPIN_CAP) { atomicAdd(&bar[XB_TMO], 1u); break; } }
    }
    nloc = mine > 0u ? mine : 1u; nx = cnt > 0u ? cnt : 1u;
}

__device__ __forceinline__ void xcd_barrier(const XcdBarrier& b, const bool is_thread0) {
    asm volatile("s_waitcnt vmcnt(0)" ::: "memory");
    __syncthreads();
    if (is_thread0) {
        unsigned* bar = b.bar;
        __builtin_amdgcn_s_waitcnt(0);
        unsigned nloc = b.st[0], nx = b.st[1];
        if (nloc == 0u) { xcd_barrier_complete(bar, b.x, nloc, nx); b.st[0] = nloc; b.st[1] = nx; }
        const unsigned old = xb_add(&bar[XB_XSUB(b.x)], 1u);
        const unsigned gen = old / nloc;
        if (old + 1u == (gen + 1u) * nloc) {
            __builtin_amdgcn_fence(__ATOMIC_RELEASE, "agent");
            asm volatile("s_waitcnt vmcnt(0)" ::: "memory");
            const unsigned og = xb_add(&bar[XB_TOP], 1u);
            const unsigned tg = og / nx;
            if (og + 1u == (tg + 1u) * nx) xb_add(&bar[XB_TOPGEN], 1u);
            else XB_SPIN(xb_ld(&bar[XB_TOPGEN]) == tg, bar);
            __builtin_amdgcn_fence(__ATOMIC_ACQUIRE, "agent");
            xb_add(&bar[XB_XGEN(b.x)], 1u);
            asm volatile("s_waitcnt vmcnt(0)" ::: "memory");
        } else {
            XB_SPIN(xb_ld(&bar[XB_XGEN(b.x)]) == gen, bar);
            __builtin_amdgcn_fence(__ATOMIC_ACQUIRE, "agent");
            asm volatile("s_waitcnt vmcnt(0)" ::: "memory");
        }
    }
    __syncthreads();
}

__device__ __forceinline__ void sub_arrive(unsigned* ctr, const bool is_thread0) {
    asm volatile("s_waitcnt vmcnt(0)" ::: "memory");
    __syncthreads();
    if (is_thread0) { __builtin_amdgcn_s_waitcnt(0); __builtin_amdgcn_fence(__ATOMIC_RELEASE, "agent"); asm volatile("s_waitcnt vmcnt(0)" ::: "memory"); (void)xb_add(ctr, 1u); }
}
__device__ __forceinline__ void sub_wait(unsigned* ctr, unsigned target, unsigned* bar, const bool is_thread0) {
    if (is_thread0) { XB_SPIN(xb_ld(ctr) < target, bar); __builtin_amdgcn_fence(__ATOMIC_ACQUIRE, "agent"); asm volatile("s_waitcnt vmcnt(0)" ::: "memory"); }
    __syncthreads();
}
constexpr int CW_SUB = 64;

constexpr int NWAVES = 8;
struct Args { const float* in[30]; float* out; unsigned char* ws; int ph_lo, ph_hi, sel, pad; };
struct Frame {
    LAS unsigned char* lds; int tid, lane, wave, G, bid;
    const Args* A; float* out; unsigned char* ws; int zo;
    __device__ __forceinline__ const float* inp(int k) const { return *(const float* const*)((const char*)A + zo + 8 * k); }
    __device__ __forceinline__ float* RS() const { return (float*)(ws + WS_XN); }
    __device__ __forceinline__ bf16_t* MERGED() const { return (bf16_t*)(ws + WS_MERGED); }
    __device__ __forceinline__ bf16_t* OBR() const { return (bf16_t*)(ws + WS_OBR); }
    __device__ __forceinline__ bf16_t* PROJ() const { return (bf16_t*)(ws + WS_BIG); }
    __device__ __forceinline__ bf16_t* ACT() const { return (bf16_t*)(ws + WS_BIG); }
    __device__ __forceinline__ bf16_t* MEMN() const { return (bf16_t*)(ws + WS_MEMN); }
    __device__ __forceinline__ bf16_t* MK() const { return (bf16_t*)(ws + WS_MK); }
    __device__ __forceinline__ bf16_t* MVT() const { return (bf16_t*)(ws + WS_MVT); }
    __device__ __forceinline__ bf16_t* H() const { return (bf16_t*)(ws + WS_H); }
    __device__ __forceinline__ bf16_t* TMP() const { return (bf16_t*)(ws + WS_TMP); }
    __device__ __forceinline__ float* AB() const { return (float*)(ws + WS_AB); }
    __device__ __forceinline__ float* WAB() const { return (float*)(ws + WS_MISC + MISC_WAB); }
    __device__ __forceinline__ float* COS() const { return (float*)(ws + WS_MISC + MISC_COS); }
    __device__ __forceinline__ float* SIN() const { return (float*)(ws + WS_MISC + MISC_SIN); }
    __device__ __forceinline__ unsigned char* RCH() const { return ws + WS_RCH; }
    __device__ __forceinline__ unsigned char* RVT() const { return ws + WS_RVT; }
    __device__ __forceinline__ unsigned char* GCH() const { return ws + WS_GCH; }
    __device__ __forceinline__ float* GUT() const { return (float*)(ws + WS_GUT); }
    __device__ __forceinline__ float* GDCH() const { return (float*)(ws + WS_GDCH); }
};
#define LDS_WAIT() asm volatile("s_waitcnt lgkmcnt(0)" ::: "memory")

enum { WM_PLAIN = 0, WM_FFNIN = 1, WM_WIN = 2 };
__device__ __forceinline__ int map_col(int mode, int n0) {
    if (mode == WM_FFNIN) { const int tile = n0 >> 8, w = n0 & 255; return (w < 128) ? tile * 128 + w : DFF + tile * 128 + (w - 128); }
    if (mode == WM_WIN) return n0 < PC_MQ ? n0 : n0 + 8;
    return n0;
}
__device__ __forceinline__ void transpose_item(const float* W, int K, int Nraw, int N, int mode, bf16_t* WT, const float* gk, LAS float* scr, int item, int lane) {
    const int nblk = N / 32, kb = item / nblk, nb = item % nblk, k0 = 64 * kb, n0 = 32 * nb, nr0 = map_col(mode, n0);
    f32x4 wv[8];
#pragma unroll
    for (int i = 0; i < 8; ++i) wv[i] = *(const f32x4*)(W + (size_t)(k0 + 8 * i + (lane >> 3)) * Nraw + nr0 + 4 * (lane & 7));
    if (gk) {
#pragma unroll
        for (int i = 0; i < 8; ++i) wv[i] = wv[i] * gk[k0 + 8 * i + (lane >> 3)]; }
#pragma unroll
    for (int i = 0; i < 8; ++i) { LAS float* d = scr + (8 * i + (lane >> 3)) * 33 + 4 * (lane & 7); d[0] = wv[i].x; d[1] = wv[i].y; d[2] = wv[i].z; d[3] = wv[i].w; }
    LDS_WAIT(); asm volatile("" ::: "memory");
    const int c = lane & 7;
#pragma unroll
    for (int j = 0; j < 4; ++j) { const int n = (lane >> 3) + 8 * j; const LAS float* s = scr + (8 * c) * 33 + n;
        u32x4 o; o.x = pk2(s[0 * 33], s[1 * 33]); o.y = pk2(s[2 * 33], s[3 * 33]); o.z = pk2(s[4 * 33], s[5 * 33]); o.w = pk2(s[6 * 33], s[7 * 33]);
        *(u32x4*)(WT + (size_t)(n0 + n) * K + k0 + 8 * c) = o; }
    LDS_WAIT(); asm volatile("" ::: "memory");
}
struct TJob { const float* W; int K, Nraw, N, mode; bf16_t* WT; const float* gk; };
__device__ __forceinline__ TJob get_job(int j, const Frame& F) {
    const int l = j / 11, t = j % 11; unsigned char* wl = F.ws + WS_W0 + (size_t)l * WS_WL; TJob r;
    switch (t) {
    case 0:  r = TJob{F.inp(10) + (size_t)l * D * NFFI, D, NFFI, NFFI, WM_FFNIN, (bf16_t*)(wl + OFF_W1I), F.inp(8) + (size_t)l * D}; break;
    case 1:  r = TJob{F.inp(11) + (size_t)l * DFF * D, DFF, D, D, WM_PLAIN, (bf16_t*)(wl + OFF_W1O), nullptr}; break;
    case 2:  r = TJob{F.inp(14) + (size_t)l * D * WIN_RAW, D, WIN_RAW, NWIN, WM_WIN, (bf16_t*)(wl + OFF_WIN), F.inp(12) + (size_t)l * D}; break;
    case 3:  r = TJob{F.inp(20) + (size_t)l * D * D, D, D, D, WM_PLAIN, (bf16_t*)(F.ws + WS_WMKV) + (size_t)(l * 2048) * D, nullptr}; break;
    case 4:  r = TJob{F.inp(21) + (size_t)l * D * D, D, D, D, WM_PLAIN, (bf16_t*)(F.ws + WS_WMKV) + (size_t)(l * 2048 + 1024) * D, nullptr}; break;
    case 5:  r = TJob{F.inp(22) + (size_t)l * D * D, D, D, D, WM_PLAIN, (bf16_t*)(wl + OFF_WBR), nullptr}; break;
    case 6:  r = TJob{F.inp(23) + (size_t)l * D * D, D, D, D, WM_PLAIN, (bf16_t*)(wl + OFF_WBR) + (size_t)D * D, nullptr}; break;
    case 7:  r = TJob{F.inp(24) + (size_t)l * D * D, D, D, D, WM_PLAIN, (bf16_t*)(wl + OFF_WBR) + (size_t)2 * D * D, nullptr}; break;
    case 8:  r = TJob{F.inp(25) + (size_t)l * D * D, D, D, D, WM_PLAIN, (bf16_t*)(wl + OFF_WO), nullptr}; break;
    case 9:  r = TJob{F.inp(28) + (size_t)l * D * NFFI, D, NFFI, NFFI, WM_FFNIN, (bf16_t*)(wl + OFF_W2I), F.inp(26) + (size_t)l * D}; break;
    default: r = TJob{F.inp(29) + (size_t)l * DFF * D, DFF, D, D, WM_PLAIN, (bf16_t*)(wl + OFF_W2O), nullptr}; break;
    }
    return r;
}

struct NormArgs { const bf16_t* tmp; const float* gpost; float scale; const float* gpre; const float* wab; int first, fin; };
__device__ __forceinline__ void norm_phase(const Frame& F, const NormArgs na) {
    const int gw = F.bid * NWAVES + F.wave, NGW = F.G * NWAVES, lane = F.lane;
#define FI(j) (2 * lane + 128 * ((j) >> 1) + ((j) & 1))
#define NP_LD(mm, hh, tt) do { if ((mm) < MREAL) { _Pragma("unroll") for (int jj = 0; jj < 2; ++jj) { hh[jj] = *((const u32x4*)(F.H() + (size_t)(mm) * D) + lane + 64 * jj); tt[jj] = *((const u32x4*)(na.tmp + (size_t)(mm) * D) + lane + 64 * jj); } } } while (0)
#define NP_LDX(mm, xx) do { if ((mm) < MREAL) { const float* src_ = ((mm) < MP) ? F.inp(0) + (size_t)(mm) * D : F.inp(1) + (size_t)((mm) - MP) * D; _Pragma("unroll") for (int j = 0; j < 4; ++j) xx[j] = *((const f32x4*)src_ + FI(j)); } } while (0)
    const u32x4 z4 = (u32x4){0u, 0u, 0u, 0u};
    f32x4 gpq[4];
#pragma unroll
    for (int j = 0; j < 4; ++j) gpq[j] = na.tmp ? *((const f32x4*)na.gpost + FI(j)) : (f32x4){0.f, 0.f, 0.f, 0.f};
    f32x4 wq[8][4];
#pragma unroll
    for (int q = 0; q < 8; ++q)
#pragma unroll
        for (int j = 0; j < 4; ++j) wq[q][j] = na.wab ? *((const f32x4*)(na.wab + q * D) + FI(j)) : (f32x4){0.f, 0.f, 0.f, 0.f};
    u32x4 h0[2] = {z4, z4}, t0[2] = {z4, z4}, h1[2] = {z4, z4}, t1[2] = {z4, z4};
    f32x4 x0[4];
#pragma unroll
    for (int j = 0; j < 4; ++j) x0[j] = (f32x4){0.f, 0.f, 0.f, 0.f};
    if (na.first) NP_LDX(gw, x0); else { NP_LD(gw, h0, t0); NP_LD(gw + NGW, h1, t1); }
    for (int m = gw; m < MREAL; m += NGW) {
        f32x4 h[4]; const u32x4 tc[2] = {t0[0], t0[1]};
        if (na.first) {
#pragma unroll
            for (int j = 0; j < 4; ++j) h[j] = x0[j];
            NP_LDX(m + NGW, x0);
        } else {
            const u32x4 hc[2] = {h0[0], h0[1]};
            h0[0] = h1[0]; h0[1] = h1[1]; t0[0] = t1[0]; t0[1] = t1[1];
            NP_LD(m + 2 * NGW, h1, t1);
#pragma unroll
            for (int jj = 0; jj < 2; ++jj) { const u32x4 w = hc[jj]; h[2 * jj] = (f32x4){bf2f(w.x & 0xffffu), bf2f(w.x >> 16), bf2f(w.y & 0xffffu), bf2f(w.y >> 16)}; h[2 * jj + 1] = (f32x4){bf2f(w.z & 0xffffu), bf2f(w.z >> 16), bf2f(w.w & 0xffffu), bf2f(w.w >> 16)}; }
        }
        if (na.tmp) {
            f32x4 t[4]; float ss = 0.f;
#pragma unroll
            for (int jj = 0; jj < 2; ++jj) { const u32x4 w = tc[jj]; t[2 * jj] = (f32x4){bf2f(w.x & 0xffffu), bf2f(w.x >> 16), bf2f(w.y & 0xffffu), bf2f(w.y >> 16)}; t[2 * jj + 1] = (f32x4){bf2f(w.z & 0xffffu), bf2f(w.z >> 16), bf2f(w.w & 0xffffu), bf2f(w.w >> 16)}; }
#pragma unroll
            for (int j = 0; j < 4; ++j) ss += (t[j].x * t[j].x + t[j].y * t[j].y) + (t[j].z * t[j].z + t[j].w * t[j].w);
            const float r = na.scale / sqrtf(wave_sum(ss) * (1.f / D) + EPS);
#pragma unroll
            for (int j = 0; j < 4; ++j) h[j] = h[j] + t[j] * gpq[j] * r;
        }
        if (!na.fin) {
#pragma unroll
            for (int jj = 0; jj < 2; ++jj) { u32x4 w; w.x = pk2(h[2 * jj].x, h[2 * jj].y); w.y = pk2(h[2 * jj].z, h[2 * jj].w); w.z = pk2(h[2 * jj + 1].x, h[2 * jj + 1].y); w.w = pk2(h[2 * jj + 1].z, h[2 * jj + 1].w); *((u32x4*)(F.H() + (size_t)m * D) + lane + 64 * jj) = w; } }
        if (na.fin && m < MREAL) {
            float* dst = (m < MP) ? F.out + O_YP + (size_t)m * D : F.out + O_YS + (size_t)(m - MP) * D;
#pragma unroll
            for (int j = 0; j < 4; ++j) *((f32x4*)dst + FI(j)) = h[j];
        }
        float s2 = 0.f;
#pragma unroll
        for (int j = 0; j < 4; ++j) s2 += (h[j].x * h[j].x + h[j].y * h[j].y) + (h[j].z * h[j].z + h[j].w * h[j].w);
        const float r2 = 1.f / sqrtf(wave_sum(s2) * (1.f / D) + EPS);
        if (lane == 0) F.RS()[m] = r2;
        if (na.wab) {
            float d8 = 0.f;
#pragma unroll
            for (int q = 0; q < 8; ++q) { float s = 0.f;
#pragma unroll
                for (int j = 0; j < 4; ++j) { const f32x4 w = wq[q][j]; s += (h[j].x * w.x + h[j].y * w.y) + (h[j].z * w.z + h[j].w * w.w); }
                s = wave_sum(s) * r2; d8 = (lane == q) ? s : d8; }
            if (lane < 8) F.AB()[(size_t)m * 8 + lane] = d8;
        }
    }
}
#undef FI
#undef NP_LD
#undef NP_LDX

__device__ __forceinline__ void p0_prologue(const Frame& F) {
    LAS float* scr = (LAS float*)(F.lds + F.wave * 16384);
    const int gw = F.bid * NWAVES + F.wave, NGW = F.G * NWAVES;
    int dealt = 0;
    for (int j = 0; j < 16; ++j) { if (j >= 5 && j != 14 && j != 15) continue;
        const TJob tj = get_job(j, F); const int nitems = (tj.K / 64) * (tj.N / 32);
        int first = (gw - dealt) % NGW; if (first < 0) first += NGW;
        for (int it = first; it < nitems; it += NGW) transpose_item(tj.W, tj.K, tj.Nraw, tj.N, tj.mode, tj.WT, tj.gk, scr, it, F.lane);
        dealt = (dealt + nitems) % NGW; }
    const int gt = F.bid * (NWAVES * 64) + F.tid, NGT = F.G * NWAVES * 64;
    for (int i = gt; i < 2 * 8 * D; i += NGT) { const int l = i / (8 * D), q = (i / D) % 8, k = i % D; F.WAB()[i] = F.inp(14)[(size_t)l * D * WIN_RAW + (size_t)k * WIN_RAW + PC_MQ + q] * F.inp(12)[(size_t)l * D + k]; }
    for (int i = gt; i < 2049 * 64; i += NGT) { const int p = i >> 6, d = i & 63; const double pos = (p == 2048) ? (double)PAST_LEN : (double)p;
        const double ang = pos * pow(10000.0, -(double)d / 64.0); F.COS()[i] = (float)cos(ang); F.SIN()[i] = (float)sin(ang); }
    for (int r = gw; r < 2 * NB * NMEM; r += NGW) { const int l = r / (NB * NMEM), row = r % (NB * NMEM);
        f32x4 v[4], gq[4]; float ss = 0.f;
#pragma unroll
        for (int j = 0; j < 4; ++j) { v[j] = *((const f32x4*)(F.inp(2) + (size_t)row * D) + F.lane + 64 * j); ss += (v[j].x * v[j].x + v[j].y * v[j].y) + (v[j].z * v[j].z + v[j].w * v[j].w); }
        const float rr = 1.f / sqrtf(wave_sum(ss) * (1.f / D) + EPS);
        u32x2* o8 = (u32x2*)(F.MEMN() + (size_t)r * D) + F.lane;
#pragma unroll
        for (int j = 0; j < 4; ++j) gq[j] = *((const f32x4*)(F.inp(19) + (size_t)l * D) + F.lane + 64 * j);
        asm volatile("" ::: "memory");
#pragma unroll
        for (int j = 0; j < 4; ++j) { const f32x4 y = v[j] * gq[j] * rr; u32x2 w; w.x = pk2(y.x, y.y); w.y = pk2(y.z, y.w); o8[64 * j] = w; }
    }
    NormArgs na{nullptr, nullptr, 0.f, F.inp(8), nullptr, 1, 0};
    norm_phase(F, na);
}

__device__ __forceinline__ void convert_layer1(const Frame& F, int idx, int nw) {
    LAS float* scr = (LAS float*)(F.lds + F.wave * 16384);
    const int gw = idx * NWAVES + F.wave, NGW = nw * NWAVES;
    int dealt = 0;
    for (int j = 5; j < 22; ++j) { if (j == 14 || j == 15) continue;
        const TJob tj = get_job(j, F); const int nitems = (tj.K / 64) * (tj.N / 32);
        int first = (gw - dealt) % NGW; if (first < 0) first += NGW;
        for (int it = first; it < nitems; it += NGW) transpose_item(tj.W, tj.K, tj.Nraw, tj.N, tj.mode, tj.WT, tj.gk, scr, it, F.lane);
        dealt = (dealt + nitems) % NGW; }
}

__device__ __forceinline__ bf16x8 ldnat(const void* base, unsigned row_boff, int s, int g) { return *(const bf16x8*)((const char*)base + (row_boff + 64u * s + 16u * g)); }
__device__ __forceinline__ bf16x8 ldperm(const void* base, unsigned row_boff, int s, int g) {
    const unsigned o = row_boff + 64u * s + 8u * g; const bf16x4 lo = *(const bf16x4*)((const char*)base + o), hi = *(const bf16x4*)((const char*)base + (o + 32u));
    return __builtin_shufflevector(lo, hi, 0, 1, 2, 3, 4, 5, 6, 7);
}
#define CBAR() asm volatile("" ::: "memory")
__device__ __forceinline__ bf16x8 lds_frag(const LAS float* rowp, int s, int g, float scale) {
    const f32x4 a = *(const LAS f32x4*)(rowp + 32 * s + 8 * g), b = *(const LAS f32x4*)(rowp + 32 * s + 8 * g + 4);
    return pack8(a * scale, b * scale);
}

__device__ __forceinline__ void ret_prep(const Frame& F, int ci) {
    const int tid = F.tid, lane = F.lane, wv = F.wave;
    const int bh = ci >> 5, n = ci & 31, b = bh >> 2, h = bh & 3, m0 = b * SEQ + n * CH;
    const float lg = log1pf(-exp2f(-5.0f - (float)h));
    LAS float* qf = (LAS float*)F.lds;
    LAS float* kf = qf + 64 * 132;
    LAS bf16_t* vs = (LAS bf16_t*)(kf + 64 * 132);
    u32x4 vr[4];
#pragma unroll
    for (int r = 0; r < 4; ++r) { const int p = tid + 512 * r, row = p >> 5, c8 = (p & 31) * 8; vr[r] = *(const u32x4*)(F.PROJ() + (size_t)(m0 + row) * NWIN + PC_RV + h * DV + c8); }
    {   const int i = tid >> 3, d0 = (tid & 7) * 8, t = n * CH + i;
        const bf16_t* qrow = F.PROJ() + (size_t)(m0 + i) * NWIN + PC_RQ + h * DK; const bf16_t* krow = F.PROJ() + (size_t)(m0 + i) * NWIN + PC_RK + h * DK;
        const u32x4 q1 = *(const u32x4*)(qrow + d0), q2 = *(const u32x4*)(qrow + 64 + d0), k1 = *(const u32x4*)(krow + d0), k2 = *(const u32x4*)(krow + 64 + d0);
        const float* cp = F.COS() + t * 64 + d0; const float* sp = F.SIN() + t * 64 + d0;
        float cs[8], sn[8];
#pragma unroll
        for (int e = 0; e < 8; ++e) { cs[e] = cp[e]; sn[e] = sp[e]; }
        const float qd = fexp(lg * (float)(i + 1));
        float o1[8], o2[8];
#pragma unroll
        for (int e = 0; e < 8; ++e) { const unsigned w1 = q1[e >> 1], w2 = q2[e >> 1]; const float x1 = (e & 1) ? bf2f(w1 >> 16) : bf2f(w1 & 0xffffu), x2 = (e & 1) ? bf2f(w2 >> 16) : bf2f(w2 & 0xffffu);
            o1[e] = x1 * cs[e] - x2 * sn[e]; o2[e] = x1 * sn[e] + x2 * cs[e]; qf[i * 132 + d0 + e] = o1[e]; qf[i * 132 + 64 + d0 + e] = o2[e]; }
        {
            unsigned char* qb = F.RCH() + (size_t)ci * RCH_BYTES + RCH_QD + (i >> 4) * 4096 + (i & 15) * 16;
#pragma unroll
            for (int hh = 0; hh < 2; ++hh) { const int D0 = d0 + 64 * hh, s = D0 >> 5, half = (D0 >> 4) & 1, g0 = (D0 & 15) >> 2; const float* o = hh ? o2 : o1;
                u32x2 w; w.x = pk2(o[0] * qd, o[1] * qd); w.y = pk2(o[2] * qd, o[3] * qd); *(u32x2*)(qb + s * 1024 + g0 * 256 + half * 8) = w;
                w.x = pk2(o[4] * qd, o[5] * qd); w.y = pk2(o[6] * qd, o[7] * qd); *(u32x2*)(qb + s * 1024 + (g0 + 1) * 256 + half * 8) = w; }
        }
        const float ksc = 0.08838834764831845f;
#pragma unroll
        for (int e = 0; e < 8; ++e) { const unsigned w1 = k1[e >> 1], w2 = k2[e >> 1]; const float x1 = (e & 1) ? bf2f(w1 >> 16) : bf2f(w1 & 0xffffu), x2 = (e & 1) ? bf2f(w2 >> 16) : bf2f(w2 & 0xffffu);
            kf[i * 132 + d0 + e] = (x1 * cs[e] - x2 * sn[e]) * ksc; kf[i * 132 + 64 + d0 + e] = (x1 * sn[e] + x2 * cs[e]) * ksc; }
    }
#pragma unroll
    for (int r = 0; r < 4; ++r) { const int p = tid + 512 * r, row = p >> 5, c8 = (p & 31) * 8; *(LAS u32x4*)(vs + row * 264 + c8) = vr[r]; }
    __syncthreads();
    {
        const int d = tid >> 2, i0 = (tid & 3) * 16; unsigned w[8];
#pragma unroll
        for (int r = 0; r < 16; r += 2) { const float v0 = kf[(i0 + r) * 132 + d] * fexp(lg * (float)(63 - (i0 + r))), v1 = kf[(i0 + r + 1) * 132 + d] * fexp(lg * (float)(62 - (i0 + r))); w[r >> 1] = pk2(v0, v1); }
        unsigned char* kb = F.RCH() + (size_t)ci * RCH_BYTES + RCH_KDT + (d >> 4) * 2048 + (d & 15) * 16 + (i0 >> 5) * 1024 + ((i0 & 31) >> 3) * 256;
        *(u32x4*)kb = (u32x4){w[0], w[1], w[2], w[3]}; *(u32x4*)(kb + 256) = (u32x4){w[4], w[5], w[6], w[7]};
    }
    {
        const int e = tid >> 1, i0 = (tid & 1) * 32; unsigned w[16];
#pragma unroll
        for (int r = 0; r < 32; r += 2) w[r >> 1] = (unsigned)vs[(i0 + r) * 264 + e] | ((unsigned)vs[(i0 + r + 1) * 264 + e] << 16);
        unsigned char* vb = F.RVT() + (size_t)ci * 32768 + ((e >> 4) * 2 + (i0 >> 5)) * 1024 + (e & 15) * 16;
#pragma unroll
        for (int q = 0; q < 4; ++q) *(u32x4*)(vb + q * 256) = (u32x4){w[4 * q], w[4 * q + 1], w[4 * q + 2], w[4 * q + 3]};
    }
    {
        const int c = lane & 15, g = lane >> 4;
#pragma unroll
        for (int x = 0; x < 2; ++x) { const int tt = 2 * wv + x, jt = tt >> 2, it = tt & 3;
            f32x4 acc = (f32x4){0.f, 0.f, 0.f, 0.f};
            if (it >= jt) {
#pragma unroll
                for (int s = 0; s < 4; ++s) { const bf16x8 A = lds_frag(kf + (16 * jt + c) * 132, s, g, 1.0f), B = lds_frag(qf + (16 * it + c) * 132, s, g, 1.0f); acc = MFMA16(A, B, acc); }
            }
            const int i = 16 * it + c; float r4[4];
#pragma unroll
            for (int r = 0; r < 4; ++r) { const int j = 16 * jt + 4 * g + r; r4[r] = (i >= j) ? acc[r] * fexp(lg * (float)(i - j)) : 0.f; }
            u32x2 w; w.x = pk2(r4[0], r4[1]); w.y = pk2(r4[2], r4[3]);
            *(u32x2*)(F.RCH() + (size_t)ci * RCH_BYTES + RCH_ATT + (it * 2 + (jt >> 1)) * 1024 + (c + 16 * (2 * (jt & 1) + (g >> 1))) * 16 + (g & 1) * 8) = w; }
    }
    __syncthreads();
}

__device__ __forceinline__ void gdn_prep(const Frame& F, int l, int ci) {
    const int tid = F.tid, lane = F.lane, wv = F.wave;
    const int bh = ci >> 5, n = ci & 31, b = bh >> 2, h = bh & 3, m0 = b * SEQ + n * CH;
    LAS bf16_t* raw = (LAS bf16_t*)F.lds;
    LAS float* qf = (LAS float*)F.lds;
    LAS float* kf = qf + 64 * 132;
    LAS bf16_t* wst = (LAS bf16_t*)F.lds;
    LAS float* Am = (LAS float*)(F.lds + 69888);
    LAS float* sm = (LAS float*)(F.lds + 86272);
    LAS float* bcum = sm; LAS float* beta = sm + 64; LAS float* rq = sm + 128; LAS float* rk = sm + 192; LAS float* eb = sm + 256;
    float ab_a = 0.f, ab_b = 0.f;
    if (wv == 0) { const int m = m0 + lane; ab_a = F.AB()[(size_t)m * 8 + h]; ab_b = F.AB()[(size_t)m * 8 + 4 + h]; }
    {
        u32x4 rv[9]; const int pc = tid & 63, col8 = pc * 8;
        const int sc = (pc < 16) ? PC_GQKV + h * DK + col8 : (pc < 32) ? PC_GQKV + 512 + h * DK + (col8 - 128) : PC_GQKV + 1024 + h * DV + (col8 - 256);
#pragma unroll
        for (int it = 0; it < 9; ++it) { const int row = (tid >> 6) + 8 * it, t = n * CH + row - 3; rv[it] = (u32x4){0u, 0u, 0u, 0u};
            if (row < 67 && t >= 0) rv[it] = *(const u32x4*)(F.PROJ() + (size_t)(b * SEQ + t) * NWIN + sc); }
        asm volatile("" ::: "memory");
#pragma unroll
        for (int it = 0; it < 9; ++it) { const int row = (tid >> 6) + 8 * it; if (row < 67) *(LAS u32x4*)(raw + row * 520 + col8) = rv[it]; }
    }
    if (wv == 0) { const float a = ab_a, bb = ab_b;
        const float x = a + F.inp(17)[l * 4 + h]; const float sp = fmaxf(x, 0.f) + log1pf(expf(-fabsf(x)));
        float gg = -expf(F.inp(16)[l * 4 + h]) * sp;
#pragma unroll
        for (int o = 1; o < 64; o <<= 1) { const float t = __shfl_up(gg, o); if (lane >= o) gg += t; }
        bcum[lane] = gg; beta[lane] = 1.f / (1.f + expf(-bb)); eb[lane] = expf(gg); }
    __syncthreads();
    LAS float* vpark = (LAS float*)(F.lds + 88832);
    {   float x[64];
        const int col = (tid < 256) ? 256 + tid : (tid < 384) ? 128 + (tid - 256) : tid - 384;
        const int C = (tid < 256) ? 1024 + h * DV + tid : (tid < 384) ? 512 + h * DK + (tid - 256) : h * DK + (tid - 384);
        const float* cw = F.inp(15) + (size_t)l * 4 * CONVD + C; const float w0 = cw[0], w1 = cw[CONVD], w2 = cw[2 * CONVD], w3 = cw[3 * CONVD];
        float r0 = bf2f(raw[0 * 520 + col]), r1 = bf2f(raw[1 * 520 + col]), r2 = bf2f(raw[2 * 520 + col]);
#pragma unroll
        for (int i0 = 0; i0 < 64; i0 += 16) { unsigned rr[16];
#pragma unroll
            for (int i = 0; i < 16; ++i) rr[i] = raw[(i0 + i + 3) * 520 + col];
            asm volatile("" ::: "memory");
#pragma unroll
            for (int i = 0; i < 16; ++i) { const float r3 = bf2f(rr[i]); x[i0 + i] = siluf_(r0 * w0 + r1 * w1 + r2 * w2 + r3 * w3); r0 = r1; r1 = r2; r2 = r3; } }
    __syncthreads();
    {
        LAS float* dst = (tid < 256) ? vpark + tid : (tid < 384) ? kf + (tid - 256) : qf + (tid - 384); const int pitch = (tid < 256) ? 260 : 132;
#pragma unroll
        for (int i = 0; i < 64; ++i) dst[i * pitch] = x[i]; }
    }
    __syncthreads();
    {   const int i = tid >> 3, p = tid & 7; float sq = 0.f, sk = 0.f;
#pragma unroll
        for (int d = 0; d < 16; ++d) { const float a = qf[i * 132 + 16 * p + d], bq = kf[i * 132 + 16 * p + d]; sq += a * a; sk += bq * bq; }
        sq += __shfl_xor(sq, 1); sq += __shfl_xor(sq, 2); sq += __shfl_xor(sq, 4); sk += __shfl_xor(sk, 1); sk += __shfl_xor(sk, 2); sk += __shfl_xor(sk, 4);
        if (p == 0) { rq[i] = 0.08838834764831845f / sqrtf(sq + EPS); rk[i] = 1.f / sqrtf(sk + EPS); } }
    __syncthreads();
    unsigned char* gch = F.GCH() + (size_t)ci * GCH_BYTES; asm volatile("" : "+s"(gch)); gch = (unsigned char*)(GAS unsigned char*)gch;
#pragma unroll
    for (int rep = 0; rep < 2; ++rep) { const int idx = tid + 512 * rep;
        {   const int i = idx >> 4, s = (idx >> 2) & 3, g = idx & 3; const float sc = rq[i] * eb[i];
            const f32x4 lo = *(const LAS f32x4*)(qf + i * 132 + 32 * s + 4 * g), hi = *(const LAS f32x4*)(qf + i * 132 + 32 * s + 16 + 4 * g);
            *(bf16x8*)(gch + GCH_QD + ((i >> 4) * 4 + s) * 1024 + ((i & 15) + 16 * g) * 16) = pack8(lo * sc, hi * sc); }
        {   const int d = idx >> 3, s = (idx >> 2) & 1, g = idx & 3; const float bl = bcum[63]; float v[8];
#pragma unroll
            for (int j = 0; j < 8; ++j) { const int p = 32 * s + 16 * (j >> 2) + 4 * g + (j & 3); v[j] = kf[p * 132 + d] * rk[p] * fexp(bl - bcum[p]); }
            u32x4 w; w.x = pk2(v[0], v[1]); w.y = pk2(v[2], v[3]); w.z = pk2(v[4], v[5]); w.w = pk2(v[6], v[7]);
            *(u32x4*)(gch + GCH_KDT + ((d >> 4) * 2 + s) * 1024 + ((d & 15) + 16 * g) * 16) = w; }
    }
    if (tid == 0) F.GDCH()[ci] = fexp(bcum[63]);
    CBAR();
    {
        const int c = lane & 15, g = lane >> 4, jt = wv >> 1;
        bf16x8 A[4];
#pragma unroll
        for (int s = 0; s < 4; ++s) A[s] = lds_frag(kf + (16 * jt + c) * 132, s, g, rk[16 * jt + c]);
#pragma unroll
        for (int xx = 0; xx < 2; ++xx) { const int it = 2 * (wv & 1) + xx, i = 16 * it + c;
            f32x4 aq = (f32x4){0.f, 0.f, 0.f, 0.f}, ak = (f32x4){0.f, 0.f, 0.f, 0.f};
            if (it >= jt) {
#pragma unroll
                for (int s = 0; s < 4; ++s) { const bf16x8 Bq = lds_frag(qf + i * 132, s, g, rq[i]), Bk = lds_frag(kf + i * 132, s, g, rk[i]); aq = MFMA16(A[s], Bq, aq); ak = MFMA16(Bk, A[s], ak); CBAR(); }
            }
            const float bi = bcum[i]; float ra[4]; f32x4 rm;
#pragma unroll
            for (int r = 0; r < 4; ++r) { const int j = 16 * jt + 4 * g + r; const float dec = fexp(fminf(bi - bcum[j], 0.f)); ra[r] = (i >= j) ? aq[r] * dec : 0.f; }
            const int j2 = 16 * jt + c; const float bj2 = bcum[j2];
#pragma unroll
            for (int r = 0; r < 4; ++r) { const int i2 = 16 * it + 4 * g + r; rm[r] = (i2 > j2) ? beta[i2] * ak[r] * fexp(fminf(bcum[i2] - bj2, 0.f)) : 0.f; }
            u32x2 w; w.x = pk2(ra[0], ra[1]); w.y = pk2(ra[2], ra[3]);
            *(u32x2*)(gch + GCH_ATT + (it * 2 + (jt >> 1)) * 1024 + (c + 16 * g) * 16 + (jt & 1) * 8) = w;
            *(LAS f32x4*)(Am + j2 * 64 + 16 * it + 4 * g) = rm; }
    }
    __syncthreads();
    if (tid < 384) {
        int z0; asm volatile("v_mov_b32 %0, 0" : "=v"(z0)); const LAS float* Amz = Am + z0; const LAS float* smz = sm + z0;
        f32x2 xv[32];
        if (tid < 256) {
#pragma unroll
            for (int i = 0; i < 64; ++i) xv[i >> 1][i & 1] = vpark[i * 260 + tid] * smz[64 + i];
        } else {
#pragma unroll
            for (int i = 0; i < 64; ++i) xv[i >> 1][i & 1] = kf[i * 132 + (tid - 256)] * (smz[64 + i] * smz[192 + i] * smz[256 + i]);
        }
#pragma unroll
        for (int j = 0; j < 63; ++j) { const float xj = xv[j >> 1][j & 1]; const f32x2 xj2 = (f32x2){xj, xj};
#pragma unroll
            for (int i4 = (j + 1) / 4; i4 < 16; ++i4) { const f32x4 a = *(const LAS f32x4*)(Amz + j * 64 + 4 * i4);
                xv[2 * i4] -= (f32x2){a.x, a.y} * xj2; xv[2 * i4 + 1] -= (f32x2){a.z, a.w} * xj2; if ((i4 & 3) == 3) CBAR(); } CBAR(); }
        float x[64];
#pragma unroll
        for (int i = 0; i < 64; ++i) x[i] = xv[i >> 1][i & 1];
        if (tid < 256) { unsigned char* dstb = (unsigned char*)F.GUT() + (size_t)ci * 32768; asm volatile("" : "+s"(dstb)); dstb = (unsigned char*)(GAS unsigned char*)dstb; unsigned char* dst = dstb + (tid >> 4) * 2048 + (tid & 15) * 16;
#pragma unroll
            for (int q = 0; q < 16; ++q) { u32x2 w; w.x = pk2(x[4 * q], x[4 * q + 1]); w.y = pk2(x[4 * q + 2], x[4 * q + 3]); *(u32x2*)(dst + (q >> 3) * 1024 + (q & 3) * 256 + ((q >> 2) & 1) * 8) = w; } }
        else { const int d = tid - 256;
#pragma unroll
            for (int i = 0; i < 64; ++i) wst[i * 136 + d] = (bf16_t)f2bf(x[i]); }
    }
    __syncthreads();
#pragma unroll
    for (int rep = 0; rep < 2; ++rep) { const int idx = tid + 512 * rep, i = idx >> 4, s = (idx >> 2) & 3, g = idx & 3;
        const u32x2 lo = *(const LAS u32x2*)(wst + i * 136 + 32 * s + 4 * g), hi = *(const LAS u32x2*)(wst + i * 136 + 32 * s + 16 + 4 * g);
        *(u32x4*)(gch + GCH_W + ((i >> 4) * 4 + s) * 1024 + ((i & 15) + 16 * g) * 16) = (u32x4){lo.x, lo.y, hi.x, hi.y}; }
    __syncthreads();
}

__device__ __forceinline__ void mem_attn_unit(const Frame& F, int l, int u) {
    const int lane = F.lane, wv = F.wave, c = lane & 15, g = lane >> 4;
    const int bh = u >> 4, qb = u & 15, b = bh >> 2, h = bh & 3, mq = b * SEQ + qb * 128 + wv * 16;
    const unsigned char* kf = (const unsigned char*)F.MK() + ((((size_t)l * NB + b) * NH + h) << 17) + lane * 16;
    const unsigned char* vf = (const unsigned char*)F.MVT() + ((((size_t)l * NB + b) * NH + h) << 17) + lane * 16;
    LAS unsigned char* ring = F.lds;
#define ATT_DMA(ch_) do { const unsigned char* src_ = ((ch_) < 4 ? kf + (ch_) * 32768 : vf + ((ch_) - 4) * 32768); LAS unsigned char* dst_ = ring + ((ch_) % 3) * 32768; \
        _Pragma("unroll") for (int k_ = 0; k_ < 4; ++k_) __builtin_amdgcn_global_load_lds((const unsigned*)(src_ + (wv + 8 * k_) * 1024), (LAS unsigned*)(dst_ + (wv + 8 * k_) * 1024), 16, 0, 0); } while (0)
#define ATT_WAIT(n_) do { if ((n_) == 4) asm volatile("s_waitcnt vmcnt(4)" ::: "memory"); else if ((n_) == 8) asm volatile("s_waitcnt vmcnt(8)" ::: "memory"); else asm volatile("s_waitcnt vmcnt(12)" ::: "memory"); \
        __builtin_amdgcn_s_barrier(); asm volatile("" ::: "memory"); } while (0)
    ATT_DMA(0); ATT_DMA(1);
    bf16x8 Qf[8]; { const unsigned qo = ((unsigned)(mq + c) * NWIN + PC_MQ + h * 256) * 2u;
#pragma unroll
        for (int s = 0; s < 8; ++s) Qf[s] = ldnat(F.PROJ(), qo, s, g); }
    asm volatile("s_waitcnt vmcnt(0)" ::: "memory");
    f32x4 sacc[16]; bf16x8 Pf[8]; float inv = 1.f;
    bf16_t* obase = F.OBR() + 2 * OBR_STRIDE; const unsigned oo = ((unsigned)(mq + c) * D + h * 256 + 4 * g) * 2u;
#pragma unroll
    for (int ch = 0; ch < 8; ++ch) {
        ATT_WAIT((ch + 1 < 8 ? 4 : 0) + (ch - 1 >= 4 ? 4 : 0) + (ch - 2 >= 4 ? 4 : 0));
        if (ch + 2 < 8) ATT_DMA(ch + 2);
        const LAS unsigned char* Bq = ring + (ch % 3) * 32768 + lane * 16;
        if (ch < 4) {
#pragma unroll
            for (int k4 = 0; k4 < 4; ++k4) { f32x4 a0 = (f32x4){0.f, 0.f, 0.f, 0.f};
#pragma unroll
                for (int s = 0; s < 8; ++s) a0 = MFMA16(*(const LAS bf16x8*)(Bq + (k4 * 8 + s) * 1024), Qf[s], a0);
                sacc[4 * ch + k4] = a0; }
            if (ch == 3) {
                float mx = -3.0e38f;
#pragma unroll
                for (int kt = 0; kt < 16; ++kt)
#pragma unroll
                    for (int r = 0; r < 4; ++r) mx = fmaxf(mx, sacc[kt][r]);
                mx = fmaxf(mx, __shfl_xor(mx, 16)); mx = fmaxf(mx, __shfl_xor(mx, 32));
                float sum = 0.f; const float sc = 0.0625f * 1.4426950408889634f;
#pragma unroll
                for (int kt = 0; kt < 16; ++kt)
#pragma unroll
                    for (int r = 0; r < 4; ++r) { const float p = __builtin_amdgcn_exp2f((sacc[kt][r] - mx) * sc); sacc[kt][r] = p; sum += p; }
                sum += __shfl_xor(sum, 16); sum += __shfl_xor(sum, 32);
                inv = 1.f / sum;
#pragma unroll
                for (int ks = 0; ks < 8; ++ks) Pf[ks] = pack8(sacc[2 * ks], sacc[2 * ks + 1]);
            }
        } else {
#pragma unroll
            for (int e4 = 0; e4 < 4; ++e4) { f32x4 a0 = (f32x4){0.f, 0.f, 0.f, 0.f}; const int et = 4 * (ch - 4) + e4;
#pragma unroll
                for (int ks = 0; ks < 8; ++ks) a0 = MFMA16(*(const LAS bf16x8*)(Bq + (e4 * 8 + ks) * 1024), Pf[ks], a0);
                u32x2 w; w.x = pk2(a0[0] * inv, a0[1] * inv); w.y = pk2(a0[2] * inv, a0[3] * inv);
                *(u32x2*)((char*)obase + (oo + 32u * et)) = w; }
        }
        asm volatile("" ::: "memory");
    }
    asm volatile("s_waitcnt lgkmcnt(0)" ::: "memory"); __builtin_amdgcn_s_barrier(); asm volatile("" ::: "memory");
#undef ATT_DMA
#undef ATT_WAIT
}

struct ScanPF { bf16x8 vb[2][2]; float dch; };
#define RAW_BAR() do { asm volatile("s_waitcnt lgkmcnt(0)" ::: "memory"); __builtin_amdgcn_s_barrier(); asm volatile("" ::: "memory"); } while (0)
template <bool GDN> __device__ __forceinline__ void scan_prefetch(const Frame& F, ScanPF& P, int bh, int n, int lane, int wv, int c, int g, int colg, float dch_ret) {
    const int b = bh >> 2, e0 = 32 * wv;
    if (GDN) { const unsigned char* up = (const unsigned char*)F.GUT() + (size_t)(bh * 32 + n) * 32768 + (2 * wv) * 2048 + lane * 16;
#pragma unroll
        for (int k = 0; k < 4; ++k) __builtin_amdgcn_global_load_lds((const unsigned*)(up + k * 1024), (LAS unsigned*)(F.lds + 2 * 57344 + 4096 + wv * 4096 + k * 1024), 16, 0, 0);
        unsigned dci = (unsigned)(bh * 32 + n) * 4u; asm volatile("" : "+v"(dci)); P.dch = *(const float*)((const char*)F.GDCH() + dci);
    } else { const unsigned char* vp = F.RVT() + (size_t)(bh * 32 + n) * 32768 + (2 * wv) * 2048 + lane * 16;
#pragma unroll
        for (int s = 0; s < 2; ++s) { P.vb[s][0] = *(const bf16x8*)(vp + s * 1024); P.vb[s][1] = *(const bf16x8*)(vp + 2048 + s * 1024); }
        P.dch = dch_ret; }
}
template <bool GDN> __device__ __forceinline__ void scan_touch(ScanPF& P) {
    asm volatile("" : "+v"(P.dch));
    if (GDN) {}
    else asm volatile("" : "+v"(P.vb[0][0]), "+v"(P.vb[0][1]), "+v"(P.vb[1][0]), "+v"(P.vb[1][1]));
}
template <bool GDN, int BUF> __device__ __forceinline__ void scan_chunk(const Frame& F, f32x4 (&S)[8][2], ScanPF& cur, ScanPF& nxt, int bh, int n, int h, int colg, float dch_ret, const float* gnp, bf16_t* obr) {
    const int lane = F.lane, wv = F.wave, c = lane & 15, g = lane >> 4, b = bh >> 2, e0 = 32 * wv;
    constexpr int CHB = GDN ? GCH_BYTES : RCH_BYTES, NBLK = CHB / 1024, OQD = GDN ? GCH_QD : RCH_QD, OATT = GDN ? GCH_ATT : RCH_ATT, OKDT = GDN ? GCH_KDT : RCH_KDT, LBUF = 57344;
    LAS unsigned char* lbuf = F.lds; LAS float* ssq = (LAS float*)(F.lds + 2 * LBUF);
    const LAS unsigned char* Bq = lbuf + BUF * LBUF + lane * 16;
#define LFRAG(off_) (*(const LAS bf16x8*)(Bq + (off_)))
    scan_touch<GDN>(cur);
    f32x4 vn[4][2];
    if (GDN) {
        const LAS unsigned char* ul = F.lds + 2 * LBUF + 4096 + wv * 4096 + lane * 16;
#pragma unroll
        for (int cb = 0; cb < 2; ++cb)
#pragma unroll
            for (int rp = 0; rp < 2; ++rp) { const u32x4 uu = *(const LAS u32x4*)(ul + (cb * 2 + rp) * 1024);
                vn[2 * rp][cb] = (f32x4){bf2f(uu.x & 0xffffu), bf2f(uu.x >> 16), bf2f(uu.y & 0xffffu), bf2f(uu.y >> 16)};
                vn[2 * rp + 1][cb] = (f32x4){bf2f(uu.z & 0xffffu), bf2f(uu.z >> 16), bf2f(uu.w & 0xffffu), bf2f(uu.w >> 16)}; }
        asm volatile("s_waitcnt lgkmcnt(0)" ::: "memory");
    }
    if (n + 1 < NCH) {
        const unsigned char* chb = (GDN ? F.GCH() : F.RCH()) + (size_t)(bh * 32 + n + 1) * CHB + lane * 16;
#pragma unroll
        for (int k = 0; k < (NBLK + 7) / 8; ++k) { const int kb = wv + 8 * k; if (kb < NBLK) __builtin_amdgcn_global_load_lds((const unsigned*)(chb + kb * 1024), (LAS unsigned*)(lbuf + (BUF ^ 1) * LBUF + kb * 1024), 16, 0, 0); }
        CBAR();
        scan_prefetch<GDN>(F, nxt, bh, n + 1, lane, wv, c, g, colg, dch_ret);
    }
    CBAR();
    bf16x8 Sb[4][2];
#pragma unroll
    for (int s = 0; s < 4; ++s) { Sb[s][0] = pack8(S[2 * s][0], S[2 * s + 1][0]); Sb[s][1] = pack8(S[2 * s][1], S[2 * s + 1][1]); }
    bf16x8 Vb[2][2];
    if (GDN) {
#pragma unroll
        for (int rt = 0; rt < 4; ++rt) { f32x4 p0 = (f32x4){0.f, 0.f, 0.f, 0.f}, p1 = p0;
#pragma unroll
            for (int s = 0; s < 4; ++s) { const bf16x8 A = LFRAG(GCH_W + (rt * 4 + s) * 1024); p0 = MFMA16(A, Sb[s][0], p0); p1 = MFMA16(A, Sb[s][1], p1); }
            vn[rt][0] -= p0; vn[rt][1] -= p1; if (rt & 1) CBAR(); }
#pragma unroll
        for (int s = 0; s < 2; ++s) { Vb[s][0] = pack8(vn[2 * s][0], vn[2 * s + 1][0]); Vb[s][1] = pack8(vn[2 * s][1], vn[2 * s + 1][1]); }
    } else {
#pragma unroll
        for (int s = 0; s < 2; ++s) { Vb[s][0] = cur.vb[s][0]; Vb[s][1] = cur.vb[s][1]; }
    }
    CBAR();
    u32x2 gw[4][2];
    {   unsigned m0g = (unsigned)(b * SEQ + n * CH + c); asm volatile("" : "+v"(m0g)); const unsigned pb = (m0g * NWIN + colg + e0 + 4 * g) * 2u; const char* PROJp = (const char*)F.PROJ();
#pragma unroll
        for (int rt = 0; rt < 4; ++rt) { gw[rt][0] = *(const u32x2*)(PROJp + (pb + (unsigned)(16 * rt) * NWIN * 2u)); gw[rt][1] = *(const u32x2*)(PROJp + (pb + (unsigned)(16 * rt) * NWIN * 2u + 32u)); } }
    CBAR();
    f32x4 OT[4][2];
#pragma unroll
    for (int rt = 0; rt < 4; ++rt) { f32x4 o0 = (f32x4){0.f, 0.f, 0.f, 0.f}, o1 = o0;
#pragma unroll
        for (int s = 0; s < 4; ++s) { const bf16x8 Bf = LFRAG(OQD + (rt * 4 + s) * 1024); o0 = MFMA16(Sb[s][0], Bf, o0); o1 = MFMA16(Sb[s][1], Bf, o1); }
#pragma unroll
        for (int s = 0; s < 2; ++s) { const bf16x8 Bf = LFRAG(OATT + (rt * 2 + s) * 1024); o0 = MFMA16(Vb[s][0], Bf, o0); o1 = MFMA16(Vb[s][1], Bf, o1); }
        OT[rt][0] = o0; OT[rt][1] = o1; if (rt & 1) CBAR(); }
    const float dch = cur.dch;
#pragma unroll
    for (int t = 0; t < 8; ++t) { f32x4 s0 = S[t][0] * dch, s1 = S[t][1] * dch;
#pragma unroll
        for (int s = 0; s < 2; ++s) { const bf16x8 A = LFRAG(OKDT + (t * 2 + s) * 1024); s0 = MFMA16(A, Vb[s][0], s0); s1 = MFMA16(A, Vb[s][1], s1); }
        S[t][0] = s0; S[t][1] = s1; if ((t & 3) == 3) CBAR(); }
#pragma unroll
    for (int rt = 0; rt < 4; ++rt) { float q = 0.f;
#pragma unroll
        for (int r = 0; r < 4; ++r) q += OT[rt][0][r] * OT[rt][0][r] + OT[rt][1][r] * OT[rt][1][r];
        q += __shfl_xor(q, 16); q += __shfl_xor(q, 32);
        if (g == 0) ssq[(BUF * 8 + wv) * 64 + 16 * rt + c] = q; }
    RAW_BAR();
    {   unsigned m0o = (unsigned)(b * SEQ + n * CH + c); asm volatile("" : "+v"(m0o));
        const unsigned ob = (m0o * D + h * DV + e0 + 4 * g) * 2u;
#pragma unroll
        for (int rt = 0; rt < 4; ++rt) { float tot = 0.f;
#pragma unroll
            for (int w = 0; w < 8; ++w) tot += ssq[(BUF * 8 + w) * 64 + 16 * rt + c];
            const float rstd = 1.f / sqrtf(tot * (1.f / DV) + EPS);
#pragma unroll
            for (int cb = 0; cb < 2; ++cb) { const u32x2 gq = gw[rt][cb]; const f32x4 o = OT[rt][cb] * rstd;
                const float r0 = o[0] * bf2f(gq.x & 0xffffu), r1 = o[1] * bf2f(gq.x >> 16), r2 = o[2] * bf2f(gq.y & 0xffffu), r3 = o[3] * bf2f(gq.y >> 16);
                u32x2 w2; w2.x = pk2(r0, r1); w2.y = pk2(r2, r3);
                *(u32x2*)((char*)obr + (ob + (unsigned)(16 * rt) * D * 2u + 32u * cb)) = w2; } } }
    asm volatile("s_waitcnt vmcnt(8)" ::: "memory"); RAW_BAR();
#undef LFRAG
}
template <bool GDN> __device__ __forceinline__ void scan_bh(const Frame& F, int l, int bh) {
    const int lane = F.lane, wv = F.wave, c = lane & 15, g = lane >> 4, b = bh >> 2, h = bh & 3, e0 = 32 * wv;
    constexpr int CHB = GDN ? GCH_BYTES : RCH_BYTES, NBLK = CHB / 1024;
    const float lg = log1pf(-exp2f(-5.0f - (float)h)); const float dch_ret = fexp(lg * 64.f);
    f32x4 S[8][2];
#pragma unroll
    for (int t = 0; t < 8; ++t) { S[t][0] = (f32x4){0.f, 0.f, 0.f, 0.f}; S[t][1] = (f32x4){0.f, 0.f, 0.f, 0.f}; }
    const int colg = (GDN ? PC_GZ : PC_RG) + h * DV;
    bf16_t* obr = F.OBR() + (GDN ? OBR_STRIDE : 0);
    const float* gnp = F.inp(18) + l * DV;
    ScanPF PA, PB;
    {   const unsigned char* chb = (GDN ? F.GCH() : F.RCH()) + (size_t)(bh * 32) * CHB + lane * 16;
#pragma unroll
        for (int k = 0; k < (NBLK + 7) / 8; ++k) { const int kb = wv + 8 * k; if (kb < NBLK) __builtin_amdgcn_global_load_lds((const unsigned*)(chb + kb * 1024), (LAS unsigned*)(F.lds + kb * 1024), 16, 0, 0); } }
    scan_prefetch<GDN>(F, PA, bh, 0, lane, wv, c, g, colg, dch_ret);
    asm volatile("s_waitcnt vmcnt(0)" ::: "memory"); RAW_BAR();
    for (int n = 0; n < NCH; n += 2) {
        asm volatile("" ::: "memory");
        scan_chunk<GDN, 0>(F, S, PA, PB, bh, n, h, colg, dch_ret, gnp, obr);
        scan_chunk<GDN, 1>(F, S, PB, PA, bh, n + 1, h, colg, dch_ret, gnp, obr);
    }
    float* so = F.out + (GDN ? O_SGP : O_SRP) + ((size_t)(l * NB + b) * NH + h) * (size_t)(DK * DV);
    unsigned sbo = (unsigned)((4 * g) * DV + e0 + c) * 4u; asm volatile("" : "+v"(sbo));
#pragma unroll
    for (int t = 0; t < 8; ++t)
#pragma unroll
        for (int cb = 0; cb < 2; ++cb)
#pragma unroll
            for (int r = 0; r < 4; ++r) *(float*)((char*)so + (sbo + (unsigned)((16 * t + r) * DV + 16 * cb) * 4u)) = S[t][cb][r];
}
#undef RAW_BAR

template <bool GDN> __device__ __forceinline__ void sample_step(const Frame& F, int l, int item) {
    const int tid = F.tid, lane = F.lane, wv = F.wave, s = item >> 2, h = item & 3; const size_t m = (size_t)(MP + s);
    LAS float* qv = (LAS float*)F.lds;
    LAS float* kv = qv + 128;
    LAS float* vv = qv + 256;
    LAS float* sc = qv + 512;
    LAS float* partq = qv + 1024;
    LAS float* partk = partq + 2048;
    float dec, beta_ = 1.f;
    if (GDN) {
        const int C = (tid < 256) ? 1024 + h * DV + tid : (tid < 384) ? 512 + h * DK + (tid - 256) : h * DK + (tid - 384);
        const float* cbp = F.inp(5) + ((size_t)(l * MS + s) * 3) * CONVD + C; const float* cw = F.inp(15) + (size_t)l * 4 * CONVD + C;
        const float c0 = cbp[0], c1 = cbp[CONVD], c2 = cbp[2 * CONVD], rw = bf2f(F.PROJ()[m * NWIN + PC_GQKV + C]);
        const float val = siluf_(c0 * cw[0] + c1 * cw[CONVD] + c2 * cw[2 * CONVD] + rw * cw[3 * CONVD]);
        float* cvo = F.out + O_CVS + ((size_t)(l * MS + s) * 3) * CONVD + C; cvo[0] = c1; cvo[CONVD] = c2; cvo[2 * CONVD] = rw;
        if (tid < 256) vv[tid] = val; else if (tid < 384) kv[tid - 256] = val; else qv[tid - 384] = val;
        __syncthreads();
        if (wv < 2) { LAS float* p = (wv == 0) ? qv : kv; const float a = p[lane], bq = p[lane + 64]; const float ss = wave_sum(a * a + bq * bq);
            if (lane == 0) sc[wv] = (wv == 0) ? 0.08838834764831845f / sqrtf(ss + EPS) : 1.f / sqrtf(ss + EPS); }
        __syncthreads();
        const float rq = sc[0], rk = sc[1];
        __syncthreads();
        if (tid < 128) { qv[tid] *= rq; kv[tid] *= rk; }
        const float a = F.AB()[m * 8 + h], bb = F.AB()[m * 8 + 4 + h]; const float x = a + F.inp(17)[l * 4 + h]; const float sp = fmaxf(x, 0.f) + log1pf(expf(-fabsf(x)));
        dec = expf(-expf(F.inp(16)[l * 4 + h]) * sp); beta_ = 1.f / (1.f + expf(-bb));
    } else {
        if (tid < 64) { const int d = tid; const bf16_t* qrow = F.PROJ() + m * NWIN + PC_RQ + h * DK; const bf16_t* krow = F.PROJ() + m * NWIN + PC_RK + h * DK;
            const float cs = F.COS()[2048 * 64 + d], sn = F.SIN()[2048 * 64 + d]; const float q1 = bf2f(qrow[d]), q2 = bf2f(qrow[d + 64]), k1 = bf2f(krow[d]), k2 = bf2f(krow[d + 64]);
            qv[d] = q1 * cs - q2 * sn; qv[d + 64] = q1 * sn + q2 * cs; kv[d] = (k1 * cs - k2 * sn) * 0.08838834764831845f; kv[d + 64] = (k1 * sn + k2 * cs) * 0.08838834764831845f; }
        else if (tid < 320) vv[tid - 64] = bf2f(F.PROJ()[m * NWIN + PC_RV + h * DV + (tid - 64)]);
        dec = 1.f - exp2f(-5.0f - (float)h);
    }
    __syncthreads();
    float qk = 0.f;
#pragma unroll 8
    for (int d = 0; d < 128; ++d) qk += qv[d] * kv[d];
    const int e4 = lane * 4, dq = wv;
    const size_t sofs = ((size_t)(l * MS + s) * NH + h) * (size_t)(DK * DV);
    const float* S0 = F.inp(GDN ? 4 : 3) + sofs + (size_t)(16 * dq) * DV + e4;
    f32x4 st[16]; f32x4 aq = (f32x4){0.f, 0.f, 0.f, 0.f}, ak = aq;
#pragma unroll
    for (int i = 0; i < 16; ++i) st[i] = *(const f32x4*)(S0 + (size_t)i * DV);
#pragma unroll
    for (int i = 0; i < 16; ++i) { aq += st[i] * qv[16 * dq + i]; if (GDN) ak += st[i] * kv[16 * dq + i]; }
    *(LAS f32x4*)(partq + dq * 256 + e4) = aq; if (GDN) *(LAS f32x4*)(partk + dq * 256 + e4) = ak;
    __syncthreads();
    f32x4 qS = (f32x4){0.f, 0.f, 0.f, 0.f}, kS = qS;
#pragma unroll
    for (int w = 0; w < 8; ++w) { qS += *(const LAS f32x4*)(partq + w * 256 + e4); if (GDN) kS += *(const LAS f32x4*)(partk + w * 256 + e4); }
    const f32x4 v4 = *(const LAS f32x4*)(vv + e4);
    const f32x4 vnew = GDN ? (v4 - kS * dec) * beta_ : v4;
    const f32x4 o = qS * dec + vnew * qk;
    float* S1 = F.out + (GDN ? O_SGS : O_SRS) + sofs + (size_t)(16 * dq) * DV + e4;
#pragma unroll
    for (int i = 0; i < 16; ++i) *(f32x4*)(S1 + (size_t)i * DV) = st[i] * dec + vnew * kv[16 * dq + i];
    const float ssq = wave_sum((o.x * o.x + o.y * o.y) + (o.z * o.z + o.w * o.w));
    if (dq == 0) { const float rstd = 1.f / sqrtf(ssq * (1.f / DV) + EPS); const bf16_t* gp = F.PROJ() + m * NWIN + (GDN ? PC_GZ : PC_RG) + h * DV + e4; float r4[4];
#pragma unroll
        for (int j = 0; j < 4; ++j) r4[j] = o[j] * rstd * bf2f(gp[j]);
        u32x2 w; w.x = pk2(r4[0], r4[1]); w.y = pk2(r4[2], r4[3]);
        *(u32x2*)(F.OBR() + (GDN ? OBR_STRIDE : 0) + m * D + h * DV + e4) = w; }
    __syncthreads();
}
__device__ __forceinline__ void sample_attn(const Frame& F, int l, int item) {
    const int tid = F.tid, lane = F.lane, wv = F.wave, s = item >> 2, h = item & 3; const size_t m = (size_t)(MP + s);
    LAS float* scs = (LAS float*)F.lds;
    LAS float* part = scs + 512;
    LAS float* sinv = scs + 256;
    f32x4 q4; { const u32x2 qw = *(const u32x2*)(F.PROJ() + m * NWIN + PC_MQ + h * 256 + lane * 4); q4 = (f32x4){bf2f(qw.x & 0xffffu), bf2f(qw.x >> 16), bf2f(qw.y & 0xffffu), bf2f(qw.y >> 16)}; }
    const float* Kb = F.inp(6) + (((size_t)(l * MS + s) * NMEM) * NH + h) * 256 + lane * 4;
    const float* Vb = F.inp(7) + (((size_t)(l * MS + s) * NMEM) * NH + h) * 256 + lane * 4;
    float myscore = 0.f;
#pragma unroll
    for (int k8 = 0; k8 < 4; ++k8) { f32x4 kk[8];
#pragma unroll
        for (int j = 0; j < 8; ++j) kk[j] = *(const f32x4*)(Kb + (size_t)(32 * wv + 8 * k8 + j) * (NH * 256));
#pragma unroll
        for (int j = 0; j < 8; ++j) { const float d = wave_sum((kk[j].x * q4.x + kk[j].y * q4.y) + (kk[j].z * q4.z + kk[j].w * q4.w)); if (lane == 8 * k8 + j) myscore = d; } }
    if (lane < 32) scs[32 * wv + lane] = myscore * 0.0625f;
    __syncthreads();
    if (wv == 0) { const f32x4 s4 = *(const LAS f32x4*)(scs + 4 * lane); float mx = fmaxf(fmaxf(s4.x, s4.y), fmaxf(s4.z, s4.w));
#pragma unroll
        for (int o = 1; o < 64; o <<= 1) mx = fmaxf(mx, __shfl_xor(mx, o));
        const f32x4 p = (f32x4){fexp(s4.x - mx), fexp(s4.y - mx), fexp(s4.z - mx), fexp(s4.w - mx)}; const float sum = wave_sum((p.x + p.y) + (p.z + p.w));
        *(LAS f32x4*)(scs + 4 * lane) = p; if (lane == 0) sinv[0] = 1.f / sum; }
    __syncthreads();
    f32x4 acc = (f32x4){0.f, 0.f, 0.f, 0.f};
#pragma unroll
    for (int k8 = 0; k8 < 4; ++k8) { f32x4 vv[8];
#pragma unroll
        for (int j = 0; j < 8; ++j) vv[j] = *(const f32x4*)(Vb + (size_t)(32 * wv + 8 * k8 + j) * (NH * 256));
#pragma unroll
        for (int j = 0; j < 8; ++j) acc += vv[j] * scs[32 * wv + 8 * k8 + j]; }
    *(LAS f32x4*)(part + wv * 256 + lane * 4) = acc;
    __syncthreads();
    if (wv == 0) { f32x4 o = (f32x4){0.f, 0.f, 0.f, 0.f};
#pragma unroll
        for (int w = 0; w < 8; ++w) o += *(const LAS f32x4*)(part + w * 256 + lane * 4);
        o = o * sinv[0]; u32x2 w2; w2.x = pk2(o.x, o.y); w2.y = pk2(o.z, o.w);
        *(u32x2*)(F.OBR() + 2 * OBR_STRIDE + m * D + h * 256 + lane * 4) = w2; }
    __syncthreads();
}

struct SEpiF32 { static constexpr int NBF = 1, NSEG = 1; float* C;
    __device__ __forceinline__ int brow(int st, int) const { return 16 * st; }
    __device__ __forceinline__ void fold(f32x4 (&tot)[1], const f32x4 (&acc)[1], int, int, int, int) const { tot[0] = acc[0]; }
    __device__ __forceinline__ void store(const f32x4 (&tot)[1], int row, int st, int g) const { *(f32x4*)(C + (size_t)row * D + 16 * st + 4 * g) = tot[0]; } };
struct SEpiBf16 { static constexpr int NBF = 1, NSEG = 1; bf16_t* O; int ldc;
    __device__ __forceinline__ int brow(int st, int) const { return 16 * st; }
    __device__ __forceinline__ void fold(f32x4 (&tot)[1], const f32x4 (&acc)[1], int, int, int, int) const { tot[0] = acc[0]; }
    __device__ __forceinline__ void store(const f32x4 (&tot)[1], int row, int st, int g) const { u32x2 w; w.x = pk2(tot[0][0], tot[0][1]); w.y = pk2(tot[0][2], tot[0][3]); *(u32x2*)(O + (size_t)row * ldc + 16 * st + 4 * g) = w; } };
struct SEpiProj { static constexpr int NBF = 1, NSEG = 1; bf16_t* O; const float* gn; const float* rs;
    __device__ __forceinline__ int brow(int st, int) const { return 16 * st; }
    __device__ __forceinline__ void fold(f32x4 (&tot)[1], const f32x4 (&acc)[1], int, int, int, int) const { tot[0] = acc[0]; }
    __device__ __forceinline__ void store(const f32x4 (&tot)[1], int row, int st, int g) const { const int col = 16 * st + 4 * g; f32x4 v = tot[0] * rs[row];
        if (col >= PC_RG && col < PC_RG + 1024) {
#pragma unroll
            for (int q = 0; q < 4; ++q) v[q] = siluf_(v[q]); }
        else if (col >= PC_GZ && col < PC_GZ + 1024) {
#pragma unroll
            for (int q = 0; q < 4; ++q) v[q] = siluf_(v[q]) * gn[(col + q) & 255]; }
        u32x2 w; w.x = pk2(v[0], v[1]); w.y = pk2(v[2], v[3]); *(u32x2*)(O + (size_t)row * NWIN + col) = w; } };
struct SEpiSwiGLU { static constexpr int NBF = 2, NSEG = 1; bf16_t* O; const float* rs;
    __device__ __forceinline__ int brow(int st, int bfi) const { return (st >> 3) * 256 + (st & 7) * 16 + 128 * bfi; }
    __device__ __forceinline__ void fold(f32x4 (&tot)[2], const f32x4 (&acc)[2], int, int, int, int) const { tot[0] = acc[0]; tot[1] = acc[1]; }
    __device__ __forceinline__ void store(const f32x4 (&tot)[2], int row, int st, int g) const { float r[4];
#pragma unroll
        for (int j = 0; j < 4; ++j) r[j] = siluf_(tot[0][j] * rs[row]) * (tot[1][j] * rs[row]);
        u32x2 w; w.x = pk2(r[0], r[1]); w.y = pk2(r[2], r[3]); *(u32x2*)(O + (size_t)row * DFF + 16 * st + 4 * g) = w; } };
struct SEpiBranch { static constexpr int NBF = 1, NSEG = 3; bf16_t* O; const bf16_t* proj;
    __device__ __forceinline__ int brow(int st, int) const { return 16 * st; }
    __device__ __forceinline__ void fold(f32x4 (&tot)[1], const f32x4 (&acc)[1], int seg, int row, int st, int g) const {
        const u32x2 gw = *(const u32x2*)(proj + (size_t)row * NWIN + PC_GATE + seg * D + 16 * st + 4 * g);
        const f32x4 gt = (f32x4){sigmoidf_(bf2f(gw.x & 0xffffu)), sigmoidf_(bf2f(gw.x >> 16)), sigmoidf_(bf2f(gw.y & 0xffffu)), sigmoidf_(bf2f(gw.y >> 16))};
        tot[0] = (seg == 0) ? gt * acc[0] : tot[0] + gt * acc[0]; }
    __device__ __forceinline__ void store(const f32x4 (&tot)[1], int row, int st, int g) const { u32x2 w; w.x = pk2(tot[0][0], tot[0][1]); w.y = pk2(tot[0][2], tot[0][3]); *(u32x2*)(O + (size_t)row * D + 16 * st + 4 * g) = w; } };
template <int K, class EpiS, int RT = 4, int NS = 1> __device__ __forceinline__ void small_gemm(const Frame& F, const bf16_t* A, size_t aseg, const bf16_t* Bt, size_t bseg, int nstrips, int first, int count, const EpiS& E) {
    static_assert(RT == 4 ? NS == 1 : (NS == 1 || NS == 4), "small_gemm shapes");
    const int j = (F.bid - first + F.G) % F.G; if (j >= count) return;
    constexpr int NBF = EpiS::NBF, KQ = K / 4, NKS = KQ / 32, BATCH = (RT == 1 && NS == 1 && NBF == 1) ? NKS : (NBF == 2) ? 4 : 8, RQ = 4 / RT, NT = RT * NS;
    const int lane = F.lane, wv = F.wave, c = lane & 15, g = lane >> 4, rh = wv & 1, kq = wv >> 1;
    LAS f32x4* red = (LAS f32x4*)F.lds;
    for (int it = j; it < (nstrips / NS) * RQ; it += count) {
        const int sg = it / RQ, rq = it - sg * RQ, t0 = (RT == 4) ? rh * 4 : rq * 2 + rh;
        f32x4 tot[NBF][NT];
#pragma unroll
        for (int seg = 0; seg < EpiS::NSEG; ++seg) {
            f32x4 acc[NBF][NT];
#pragma unroll
            for (int q = 0; q < NBF; ++q)
#pragma unroll
                for (int t = 0; t < NT; ++t) acc[q][t] = (f32x4){0.f, 0.f, 0.f, 0.f};
            const char* ap = (const char*)(A + seg * aseg); unsigned ao = ((unsigned)(MP + t0 * 16 + c) * K + kq * KQ + 8 * g) * 2u; asm volatile("" : "+v"(ao));
            const char* bp = (const char*)(Bt + seg * bseg); unsigned bo[NBF][NS];
#pragma unroll
            for (int q = 0; q < NBF; ++q)
#pragma unroll
                for (int n = 0; n < NS; ++n) { bo[q][n] = ((unsigned)(E.brow(sg * NS + n, q) + c) * K + kq * KQ + 8 * g) * 2u; asm volatile("" : "+v"(bo[q][n])); }
#pragma unroll
            for (int ks0 = 0; ks0 < NKS; ks0 += BATCH) {
                bf16x8 af[RT][BATCH], bfr[NBF][NS][BATCH];
#pragma unroll
                for (int s = 0; s < BATCH; ++s) if (ks0 + s < NKS) {
#pragma unroll
                    for (int q = 0; q < NBF; ++q)
#pragma unroll
                        for (int n = 0; n < NS; ++n) bfr[q][n][s] = *(const bf16x8*)(bp + (bo[q][n] + (unsigned)(ks0 + s) * 64u));
#pragma unroll
                    for (int t = 0; t < RT; ++t) af[t][s] = *(const bf16x8*)(ap + (ao + (unsigned)(t * 16 * K * 2) + (unsigned)(ks0 + s) * 64u)); }
#pragma unroll
                for (int s = 0; s < BATCH; ++s) if (ks0 + s < NKS) {
#pragma unroll
                    for (int q = 0; q < NBF; ++q)
#pragma unroll
                        for (int n = 0; n < NS; ++n)
#pragma unroll
                            for (int t = 0; t < RT; ++t) acc[q][n * RT + t] = MFMA16(bfr[q][n][s], af[t][s], acc[q][n * RT + t]); }
                CBAR();
            }
#pragma unroll
            for (int n = 0; n < NS; ++n)
#pragma unroll
                for (int t = 0; t < RT; ++t) { f32x4 a1[NBF], t1[NBF];
#pragma unroll
                    for (int q = 0; q < NBF; ++q) { a1[q] = acc[q][n * RT + t]; t1[q] = tot[q][n * RT + t]; }
                    E.fold(t1, a1, seg, MP + (t0 + t) * 16 + c, sg * NS + n, g);
#pragma unroll
                    for (int q = 0; q < NBF; ++q) tot[q][n * RT + t] = t1[q]; }
        }
#pragma unroll
        for (int q = 0; q < NBF; ++q)
#pragma unroll
            for (int t = 0; t < NT; ++t) red[((q * 8 + wv) * NT + t) * 64 + lane] = tot[q][t];
        __syncthreads();
        if (NT == 4 || kq == 0) {
            const int tf = (NT == 4) ? kq : 0; f32x4 fin[NBF];
#pragma unroll
            for (int q = 0; q < NBF; ++q) { f32x4 s4 = (f32x4){0.f, 0.f, 0.f, 0.f};
#pragma unroll
                for (int k2 = 0; k2 < 4; ++k2) s4 += red[((q * 8 + rh + 2 * k2) * NT + tf) * 64 + lane];
                fin[q] = s4; }
            E.store(fin, MP + (t0 + (RT == 4 ? tf : 0)) * 16 + c, sg * NS + (RT == 4 ? 0 : tf), g); }
        __syncthreads();
    }
}

__device__ __forceinline__ const void* opaque_ptr(const void* p) { unsigned lo = __builtin_amdgcn_readfirstlane((unsigned)(size_t)p), hi = __builtin_amdgcn_readfirstlane((unsigned)((size_t)p >> 32));
    asm volatile("" : "+s"(lo), "+s"(hi)); return (const void*)(const GAS void*)(((size_t)hi << 32) | lo); }
__device__ __forceinline__ void stagger(int bid, int step_ticks) { const unsigned long long t0 = __builtin_amdgcn_s_memrealtime(), d = (unsigned long long)((bid >> 3) & 3) * (unsigned long long)step_ticks;
    while (__builtin_amdgcn_s_memrealtime() - t0 < d) __builtin_amdgcn_s_sleep(8); }
#ifndef STAG_TICKS
#define STAG_TICKS 0
#endif
#ifndef EN_SITES
#define EN_SITES 0x7ff
#endif
#define SITE(k) ((EN_SITES >> (k)) & 1)
#ifndef EN_PP
#define EN_PP 0xf
#endif
#ifndef EN_SP
#define EN_SP 0x1f
#endif
#define PP(k) ((EN_PP >> (k)) & 1)
#define SP(k) ((EN_SP >> (k)) & 1)
constexpr int NPHASE = 25;
__global__ void __launch_bounds__(NWAVES * 64, 2) fwd(Args args) {
    extern __shared__ __attribute__((aligned(16))) unsigned char lds_raw[];
    Frame F;
    F.lds = (LAS unsigned char*)lds_raw; F.tid = threadIdx.x; F.lane = F.tid & 63; F.wave = __builtin_amdgcn_readfirstlane(F.tid >> 6); F.G = gridDim.x; F.bid = blockIdx.x;
    F.A = &args; F.zo = 0; F.out = args.out; F.ws = args.ws; unsigned char* ws = args.ws;
    volatile LAS unsigned* MISC = (volatile LAS unsigned*)(F.lds + MISC_OFF);
    if (F.tid < 64) ((LAS unsigned*)(F.lds + MISC_OFF))[F.tid] = 0u;
    __syncthreads();
    const int lo = args.ph_lo, hi = args.ph_hi, sel = args.sel;
    XcdBarrier bar; bar.bar = (unsigned*)(ws + WS_CTL) + CW_BAR; bar.x = 0; bar.st = nullptr;
    if (hi - lo > 1) bar = xcd_barrier_post((unsigned*)(ws + WS_CTL) + CW_BAR, MISC + 8);
#define IN(k) (lo <= (k) && (k) < hi)
#define SITE_FRAME() Frame Fp = F; { Fp.ws = (unsigned char*)opaque_ptr(F.ws); Fp.out = (float*)opaque_ptr(F.out); } { int t_ = (int)threadIdx.x, b_ = (int)blockIdx.x, z_; asm volatile("s_mov_b32 %0, 0" : "=s"(z_)); Fp.zo = z_; asm volatile("" : "+v"(t_), "+s"(b_)); Fp.tid = t_; Fp.lane = t_ & 63; Fp.wave = __builtin_amdgcn_readfirstlane(t_ >> 6); Fp.bid = b_; } const int bid = Fp.bid
#define SEAM(k) do { if (IN(k) && IN((k) + 1)) { XcdBarrier b2_ = bar; b2_.bar = (unsigned*)opaque_ptr(bar.bar); xcd_barrier(b2_, Fp.tid == 0); } } while (0)
    const int G = F.G;

    if (SITE(0) && IN(0)) { SITE_FRAME(); p0_prologue(Fp); SEAM(0); }
    for (int l = 0; l < 2; ++l) {
        const int base = 1 + 12 * l;
        for (int half = 0; half < 2; ++half) {
            const int pb = base + 9 * half;
            if (SITE(2) && IN(pb)) { SITE_FRAME();
                pg8::Gemm g{Fp.H(), (const bf16_t*)(Fp.ws + WS_W0 + (size_t)l * WS_WL + (half ? OFF_W2I : OFF_W1I)), D}; pg8::StaticOrder S; S.init(MP, NFFI, D, G, bid);
                pg8::EpiSwiGLU E{Fp.ACT(), Fp.RS()};
                pg8::gemm_phase<pg8::EpiSwiGLU, pg8::StaticOrder, true, true>(Fp.lds, g, S, E, Fp.tid);
                if (l == 0 && half == 0 && bid >= G / 2) {
                    pg8::Gemm g2{Fp.MEMN(), (const bf16_t*)(Fp.ws + WS_WMKV), D}; pg8::GroupAOrder S2; S2.init(NB * NMEM, 4096, D, G / 2, bid - G / 2); S2.grp = 8; S2.astride = (size_t)NB * NMEM * D * 2;
                    pg8::EpiMemKV E2{Fp.out + O_MKP, Fp.out + O_MVP, Fp.MK(), Fp.MVT()};
                    pg8::gemm_phase<pg8::EpiMemKV, pg8::GroupAOrder, false, true>(Fp.lds, g2, S2, E2, Fp.tid);
                }
                { SEpiSwiGLU SE{Fp.ACT(), Fp.RS()}; small_gemm<D>(Fp, g.A, 0, g.Bt, 0, DFF / 16, G / 2, G / 2, SE); }
                SEAM(pb);
            }
            if (SITE(3) && IN(pb + 1)) { SITE_FRAME();
                pg8::Gemm g{Fp.ACT(), (const bf16_t*)(Fp.ws + WS_W0 + (size_t)l * WS_WL + (half ? OFF_W2O : OFF_W1O)), DFF}; pg8::StaticOrder S; S.init(MP, D, DFF, G, bid, WGM_N1024);
                pg8::EpiBf16 E{Fp.TMP(), D};
                pg8::gemm_phase<pg8::EpiBf16, pg8::StaticOrder, true, true>(Fp.lds, g, S, E, Fp.tid);
                { SEpiBf16 SE{Fp.TMP(), D}; small_gemm<DFF, SEpiBf16, 1>(Fp, g.A, 0, g.Bt, 0, D / 16, 0, G, SE); }
                SEAM(pb + 1);
            }
            if (SITE(4) && IN(pb + 2)) { SITE_FRAME();
                NormArgs na; na.tmp = Fp.TMP(); na.scale = 0.5f; na.first = 0;
                if (half == 0) { na.gpost = Fp.inp(9) + l * D; na.gpre = Fp.inp(12) + l * D; na.wab = Fp.WAB() + (size_t)l * 8 * D; na.fin = 0; }
                else { na.gpost = Fp.inp(27) + l * D; na.gpre = Fp.inp(8) + (l == 0 ? D : 0); na.wab = nullptr; na.fin = (l == 1); }
                norm_phase(Fp, na);
                SEAM(pb + 2);
            }
            if (half == 0) {
                if (SITE(5) && IN(base + 3)) { SITE_FRAME();
                    pg8::Gemm g{Fp.H(), (const bf16_t*)(Fp.ws + WS_W0 + (size_t)l * WS_WL + OFF_WIN), D}; pg8::StaticOrder S; S.init(MP, NWIN, D, G, bid);
                    pg8::EpiProj E{Fp.PROJ(), Fp.inp(18) + l * DV, Fp.RS()};
                    pg8::gemm_phase<pg8::EpiProj, pg8::StaticOrder, true, true>(Fp.lds, g, S, E, Fp.tid);
                    { SEpiProj SE{Fp.PROJ(), Fp.inp(18) + l * DV, Fp.RS()}; small_gemm<D, SEpiProj, 1, 4>(Fp, g.A, 0, g.Bt, 0, NWIN / 16, 0, G, SE); }
                    SEAM(base + 3);
                }
                if (SITE(6) && IN(base + 4)) { SITE_FRAME();
                    if (PP(0) && (sel & 1)) for (int ci = bid; ci < NB * NH * NCH; ci += G) gdn_prep(Fp, l, ci);
                    if (PP(1) && (sel & 2)) for (int ci = bid; ci < NB * NH * NCH; ci += G) ret_prep(Fp, ci);
                    if (PP(2) && (sel & 4) && l == 0) { const int xcd = bid & 7, slot = bid >> 3, per = G >> 3;
                        if ((G & 7) == 0) { for (int ux = slot; ux < 64; ux += per) mem_attn_unit(Fp, l, (xcd * 4 + (ux >> 4)) * 16 + (ux & 15)); }
                        else for (int u = bid; u < NB * NH * 16; u += G) mem_attn_unit(Fp, l, u); }
                    if (PP(3) && bid < NB) { for (int i = Fp.tid; i < 3 * CONVD; i += NWAVES * 64) { const int j = i / CONVD, C = i % CONVD;
                        Fp.out[O_CVP + ((size_t)(l * NB + bid) * 3 + j) * CONVD + C] = bf2f(Fp.PROJ()[(size_t)(bid * SEQ + SEQ - 3 + j) * NWIN + PC_GQKV + C]); } }
                    SEAM(base + 4);
                }
                if (SITE(7) && IN(base + 5)) { SITE_FRAME();
                    if (bid < 32) { if (SP(0) && (sel & 8)) scan_bh<false>(Fp, l, bid); }
                    else if (bid < 64) { if (SP(1) && (sel & 8)) scan_bh<true>(Fp, l, bid - 32); }
                    else { const int nw = G - 64; unsigned* subc = (unsigned*)opaque_ptr(Fp.ws + WS_CTL) + CW_SUB;
                        if (l == 1 && (sel & 4)) {
                            if ((G & 7) == 0) { const int xcd = bid & 7, slot = (bid >> 3) - 8, per = (G >> 3) - 8; for (int ux = slot; ux < 64; ux += per) mem_attn_unit(Fp, l, (xcd * 4 + (ux >> 4)) * 16 + (ux & 15)); }
                            else for (int u = bid - 64; u < NB * NH * 16; u += nw) mem_attn_unit(Fp, l, u);
                            if (sel & 64) sub_arrive(subc, Fp.tid == 0); }
                        if (SP(2) && (sel & 16)) for (int it = bid - 64; it < MS * NH; it += nw) sample_step<true>(Fp, l, it);
                        if (SP(3) && (sel & 16)) for (int it = bid - 64; it < MS * NH; it += nw) sample_step<false>(Fp, l, it);
                        if (SP(4) && (sel & 32)) for (int it = bid - 64; it < MS * NH; it += nw) sample_attn(Fp, l, it);
                        if (l == 0 && (sel & 64)) convert_layer1(Fp, bid - 64, nw);
                        if (sel & 64) {
                            if (l == 1) sub_wait(subc, (unsigned)nw, (unsigned*)opaque_ptr(Fp.ws + WS_CTL) + CW_BAR, Fp.tid == 0); else __syncthreads();
                            pg8::Gemm g{Fp.OBR() + 2 * OBR_STRIDE, (const bf16_t*)(Fp.ws + WS_W0 + (size_t)l * WS_WL + OFF_WBR) + 2 * (size_t)D * D, D}; pg8::SegOrder S; S.init(MP, D, D, nw, bid % nw, WGM_N1024); S.nseg = 1; S.aseg = 0; S.bseg = 0;
                            pg8::EpiBranch E{Fp.MERGED(), Fp.PROJ(), 2, 2};
                            pg8::gemm_phase<pg8::EpiBranch, pg8::SegOrder, true, true>(Fp.lds, g, S, E, Fp.tid); } }
                    SEAM(base + 5);
                }
                if (SITE(8) && IN(base + 6)) { SITE_FRAME();
                    pg8::Gemm g{Fp.OBR(), (const bf16_t*)(Fp.ws + WS_W0 + (size_t)l * WS_WL + OFF_WBR), D}; pg8::SegOrder S; S.init(MP, D, D, G, bid, WGM_N1024); S.nseg = 2; S.aseg = OBR_STRIDE * 2; S.bseg = (size_t)D * D * 2;
                    pg8::EpiBranch E{Fp.MERGED(), Fp.PROJ(), 0, 2};
                    pg8::gemm_phase<pg8::EpiBranch, pg8::SegOrder, true, true>(Fp.lds, g, S, E, Fp.tid);
                    { SEpiBranch SE{Fp.MERGED(), Fp.PROJ()}; small_gemm<D, SEpiBranch, 1>(Fp, g.A, OBR_STRIDE, g.Bt, (size_t)D * D, D / 16, 0, G, SE); }
                    SEAM(base + 6);
                }
                if (SITE(9) && IN(base + 7)) { SITE_FRAME();
                    pg8::Gemm g{Fp.MERGED(), (const bf16_t*)(Fp.ws + WS_W0 + (size_t)l * WS_WL + OFF_WO), D}; pg8::StaticOrder S; S.init(MP, D, D, G, bid, WGM_N1024);
                    pg8::EpiBf16 E{Fp.TMP(), D};
                    pg8::gemm_phase<pg8::EpiBf16, pg8::StaticOrder, true, true>(Fp.lds, g, S, E, Fp.tid);
                    { SEpiBf16 SE{Fp.TMP(), D}; small_gemm<D, SEpiBf16, 1>(Fp, g.A, 0, g.Bt, 0, D / 16, 0, G, SE); }
                    SEAM(base + 7);
                }
                if (SITE(10) && IN(base + 8)) { SITE_FRAME();
                    NormArgs na; na.tmp = Fp.TMP(); na.scale = 1.0f; na.first = 0; na.gpost = Fp.inp(13) + l * D; na.gpre = Fp.inp(26) + l * D; na.wab = nullptr; na.fin = 0;
                    norm_phase(Fp, na);
                    SEAM(base + 8);
                }
            }
        }
    }
#undef IN
#undef SEAM
}

extern "C" void kernel_launch(void* const* d_in, const int* in_sizes, int n_in, void* d_out, int out_size, void* d_ws, size_t ws_size, hipStream_t stream) {
    static int grid = 0;
    if (grid == 0) {
        if (n_in != 30 || (size_t)out_size != O_END || ws_size < WS_END) { fprintf(stderr, "kernel_launch: unexpected shapes: n_in %d out %d ws %zu (need %zu)\n", n_in, out_size, ws_size, (size_t)WS_END); grid = -1; return; }
        int dev = 0, cus = 0, per_cu = 0;
        if (hipGetDevice(&dev) != hipSuccess || hipDeviceGetAttribute(&cus, hipDeviceAttributeMultiprocessorCount, dev) != hipSuccess) { grid = -1; return; }
        if (hipFuncSetAttribute((const void*)fwd, hipFuncAttributeMaxDynamicSharedMemorySize, LDS_BYTES) != hipSuccess) { fprintf(stderr, "kernel_launch: hipFuncSetAttribute failed\n"); grid = -1; return; }
        if (hipOccupancyMaxActiveBlocksPerMultiprocessor(&per_cu, (const void*)fwd, NWAVES * 64, LDS_BYTES) != hipSuccess || per_cu < 1) { fprintf(stderr, "kernel_launch: occupancy query reports %d\n", per_cu); }
        (void)hipGetLastError();
        grid = cus;
        if (grid < 128) { fprintf(stderr, "kernel_launch: needs >= 128 CUs\n"); grid = -1; return; }
    }
    if (grid < 0) return;
    if (hipMemsetAsync((char*)d_ws + WS_CTL, 0, CTL_ZERO_BYTES, stream) != hipSuccess) return;
    Args a{};
    for (int i = 0; i < 30; ++i) a.in[i] = (const float*)d_in[i];
    a.out = (float*)d_out; a.ws = (unsigned char*)d_ws;
#ifndef MK_ONE_LAUNCH
#define MK_ONE_LAUNCH 1
#endif
    a.sel = 0xff; a.pad = 0;
#ifndef PROBE_PH
#define PROBE_PH -1
#endif
#ifndef PROBE_SEL
#define PROBE_SEL 0xff
#endif
    if (MK_ONE_LAUNCH) { a.ph_lo = 0; a.ph_hi = NPHASE; hipLaunchKernelGGL(fwd, dim3(grid), dim3(NWAVES * 64), LDS_BYTES, stream, a); }
    else for (int p = 0; p < NPHASE; ++p) { a.ph_lo = p; a.ph_hi = p + 1; a.sel = 0xff; hipLaunchKernelGGL(fwd, dim3(grid), dim3(NWAVES * 64), LDS_BYTES, stream, a);
        if (PROBE_PH >= 0 && (p == PROBE_PH || (PROBE_PH >= 1 && p == PROBE_PH + 12))) { a.sel = PROBE_SEL; hipLaunchKernelGGL(fwd, dim3(grid), dim3(NWAVES * 64), LDS_BYTES, stream, a); } }
}
```

```cpp
#include <hip/hip_runtime.h>
#include <cstdio>
#include <cstdint>

#define LAS __attribute__((address_space(3)))
#define GAS __attribute__((address_space(1)))
typedef unsigned short bf16_t;
typedef short bf16x8 __attribute__((ext_vector_type(8)));
typedef short bf16x4 __attribute__((ext_vector_type(4)));
typedef float f32x4 __attribute__((ext_vector_type(4)));
typedef float f32x2 __attribute__((ext_vector_type(2)));
typedef unsigned u32x4 __attribute__((ext_vector_type(4)));
typedef unsigned u32x2 __attribute__((ext_vector_type(2)));
typedef __bf16 bf16x2_t __attribute__((ext_vector_type(2)));
typedef GAS unsigned gu32;

constexpr int D = 1024, SEQ = 2048, NB = 8, MP = NB * SEQ, MS = 128, MREAL = MP + MS, MPAD = 16640;
constexpr int DFF = 2816, NFFI = 2 * DFF, NWIN = 10240, WIN_RAW = 10248;
constexpr int NH = 4, DK = 128, DV = 256, CH = 64, NCH = SEQ / CH, NMEM = 256, CONVD = 2048;
constexpr int PC_RQ = 0, PC_RK = 512, PC_RV = 1024, PC_RG = 2048, PC_GQKV = 3072, PC_GZ = 5120, PC_MQ = 6144, PC_GATE = 7168;
constexpr float EPS = 1e-6f;
constexpr int PAST_LEN = 16384;

__device__ __forceinline__ unsigned f2bf(float f) { unsigned u = __builtin_bit_cast(unsigned, f); return (u + 0x7fffu + ((u >> 16) & 1u)) >> 16; }
__device__ __forceinline__ float bf2f(unsigned b) { return __builtin_bit_cast(float, b << 16); }
__device__ __forceinline__ unsigned pk2(float lo, float hi) { f32x2 v = {lo, hi}; bf16x2_t b = __builtin_convertvector(v, bf16x2_t); return __builtin_bit_cast(unsigned, b); }
__device__ __forceinline__ bf16x8 pack8(f32x4 a, f32x4 b) { u32x4 p; p.x = pk2(a.x, a.y); p.y = pk2(a.z, a.w); p.z = pk2(b.x, b.y); p.w = pk2(b.z, b.w); return __builtin_bit_cast(bf16x8, p); }
__device__ __forceinline__ float fexp(float x) { return __builtin_amdgcn_exp2f(x * 1.4426950408889634f); }
__device__ __forceinline__ float sigmoidf_(float x) { return __builtin_amdgcn_rcpf(1.0f + fexp(-x)); }
__device__ __forceinline__ float siluf_(float x) { return x * sigmoidf_(x); }
__device__ __forceinline__ float wave_sum(float v) {
#pragma unroll
    for (int o = 1; o < 64; o <<= 1) v += __shfl_xor(v, o);
    return v;
}
#define MFMA16(a, b, c) __builtin_amdgcn_mfma_f32_16x16x32_bf16((a), (b), (c), 0, 0, 0)

namespace pg8 {
#define PG8_LAS __attribute__((address_space(3)))
constexpr int BM = 256, BK = 64, HALF = 128, HTB = HALF * BK * 2  , STAGE_BYTES = 8 * HTB, NXCD = 8;
__host__ __device__ __forceinline__ int lds_byte(int r, int c) { const int st = (r >> 4) * 2 + (c >> 5), rr = r & 15, cc = c & 31, ob = rr * 64 + cc * 2; return st * 1024 + (ob ^ (((ob >> 9) & 1) << 5)); }
__host__ __device__ __forceinline__ void stage_rc(int b, int& R, int& C) { const int st = b / 1024, sb = b % 1024, swz = sb ^ (((sb >> 9) & 1) << 5); R = (st >> 1) * 16 + swz / 64; C = (st & 1) * 32 + (swz % 64) / 2; }
__host__ __device__ __forceinline__ int perm32(int rho) { const int n = rho >> 4, i = rho & 15; return 8 * (i >> 2) + 4 * n + (i & 3); }

#ifndef WGM_DEFAULT
#define WGM_DEFAULT 2
#endif
#ifndef WGM_N1024
#define WGM_N1024 8
#endif
struct Unit { int pm, pn, seg; size_t aofs, bofs; };
struct Gemm { const bf16_t* A; const bf16_t* Bt; int K; };

struct StaticOrder {
    int nM, nN, nwg, G, c, WGM; size_t tstep;
    __device__ void init(int M, int N, int K, int G_, int c_, int wgm = WGM_DEFAULT) { nM = M / BM; nN = N / BM; nwg = nM * nN; G = G_; c = c_; WGM = wgm; tstep = (size_t)BM * K * 2; }
    __device__ bool tile(long L, int& pm, int& pn) const {
        if (L >= nwg) return false;
        int wgid = (int)L; { const int q = nwg / NXCD, r = nwg % NXCD, xcd = wgid % NXCD, off = wgid / NXCD; wgid = (xcd < r ? xcd * (q + 1) : r * (q + 1) + (xcd - r) * q) + off; }
        const int nig = WGM * nN, gid = wgid / nig, fm = gid * WGM, gsz = (nM - fm) < WGM ? (nM - fm) : WGM;
        pm = fm + ((wgid % nig) % gsz); pn = (wgid % nig) / gsz; return true;
    }
    __device__ bool next(int i, Unit& u) const {
        if (!tile((long)i * G + c, u.pm, u.pn)) return false;
        u.seg = 0; u.aofs = (size_t)u.pm * tstep; u.bofs = (size_t)u.pn * tstep; return true;
    }
    __device__ __forceinline__ void a_ready(const Unit&) const {}
    __device__ __forceinline__ void done(const Unit&) const {}
};
struct GroupAOrder : StaticOrder {
    int grp; size_t astride;
    __device__ bool next(int i, Unit& u) const {
        if (!tile((long)i * G + c, u.pm, u.pn)) return false;
        u.seg = 0; u.aofs = (size_t)(u.pn / grp) * astride + (size_t)u.pm * tstep; u.bofs = (size_t)u.pn * tstep; return true;
    }
};
struct SegOrder : StaticOrder {
    int nseg; size_t aseg, bseg;
    __device__ bool next(int i, Unit& u) const {
        const int round = i / nseg, seg = i - round * nseg;
        if (!tile((long)round * G + c, u.pm, u.pn)) return false;
        u.seg = seg; u.aofs = (size_t)seg * aseg + (size_t)u.pm * tstep; u.bofs = (size_t)seg * bseg + (size_t)u.pn * tstep; return true;
    }
};

struct EpiF32 {
    static constexpr int NST = 32; static constexpr bool RSLDS = false; static constexpr bool PERM = false, AFTER_DRAIN = false;
    float* C; int ldc;
    __device__ __forceinline__ void operator()(const f32x4 (&acc)[2][2][4][2], const Unit& u, int wr, int wc, int fr, int fq) const {
        const int row0 = u.pm * BM + wr * 64 + fr, col0 = u.pn * BM + wc * 32 + 4 * fq;
#pragma unroll
        for (int ai = 0; ai < 2; ++ai)
#pragma unroll
            for (int m = 0; m < 4; ++m) { float* rowp = C + (size_t)(row0 + ai * HALF + m * 16) * ldc + col0;
#pragma unroll
                for (int bj = 0; bj < 2; ++bj)
#pragma unroll
                    for (int n = 0; n < 2; ++n) *(f32x4*)(rowp + bj * HALF + n * 16) = acc[ai][bj][m][n]; }
    }
};
struct EpiBf16 {
    static constexpr int NST = 16; static constexpr bool RSLDS = false; static constexpr bool PERM = true, AFTER_DRAIN = false;
    bf16_t* O; int ldc;
    __device__ __forceinline__ void operator()(const f32x4 (&acc)[2][2][4][2], const Unit& u, int wr, int wc, int fr, int fq) const {
        const int row0 = u.pm * BM + wr * 64 + fr, col0 = u.pn * BM + wc * 32 + 8 * fq;
        unsigned bo = ((unsigned)row0 * (unsigned)ldc + (unsigned)col0) * 2u; asm volatile("" : "+v"(bo));
        const unsigned rs = (unsigned)ldc * 2u;
#pragma unroll
        for (int ai = 0; ai < 2; ++ai)
#pragma unroll
            for (int m = 0; m < 4; ++m) {
#pragma unroll
                for (int bj = 0; bj < 2; ++bj) { const f32x4 v0 = acc[ai][bj][m][0], v1 = acc[ai][bj][m][1];
                    u32x4 w; w.x = pk2(v0[0], v0[1]); w.y = pk2(v0[2], v0[3]); w.z = pk2(v1[0], v1[1]); w.w = pk2(v1[2], v1[3]);
                    *(u32x4*)((char*)O + (bo + (unsigned)(ai * HALF + m * 16) * rs + (unsigned)(bj * HALF * 2))) = w; } }
    }
};
struct EpiProj {
    static constexpr int NST = 16; static constexpr bool RSLDS = true; static constexpr bool PERM = true, AFTER_DRAIN = false; __device__ static __forceinline__ bool keep_acc(const Unit&) { return false; }
    bf16_t* O; const float* gn; const float* rs;
    __device__ __forceinline__ void operator()(const f32x4 (&acc)[2][2][4][2], const Unit& u, int wr, int wc, int fr, int fq, const LAS float* rsl) const {
        const int row0 = u.pm * BM + wr * 64 + fr, col0 = u.pn * BM + wc * 32 + 8 * fq;
        unsigned bo = ((unsigned)row0 * (unsigned)NWIN + (unsigned)col0) * 2u; asm volatile("" : "+v"(bo));
        const unsigned rstride = (unsigned)NWIN * 2u;
        const int mode = (u.pn >= 8 && u.pn < 12) ? 1 : (u.pn >= 20 && u.pn < 24) ? 2 : 0;
        float gs[2][8];
#pragma unroll
        for (int bj = 0; bj < 2; ++bj)
#pragma unroll
            for (int j = 0; j < 8; ++j) gs[bj][j] = (mode == 2) ? gn[(col0 + bj * HALF + j) & 255] : 1.f;
#pragma unroll
        for (int ai = 0; ai < 2; ++ai)
#pragma unroll
            for (int m = 0; m < 4; ++m) {
#pragma unroll
                for (int bj = 0; bj < 2; ++bj) { const float rv = rsl[wr * 64 + fr + ai * HALF + m * 16]; f32x4 v0 = acc[ai][bj][m][0] * rv, v1 = acc[ai][bj][m][1] * rv;
                    if (mode != 0) {
#pragma unroll
                        for (int j = 0; j < 4; ++j) { v0[j] = siluf_(v0[j]) * gs[bj][j]; v1[j] = siluf_(v1[j]) * gs[bj][4 + j]; } }
                    u32x4 w; w.x = pk2(v0[0], v0[1]); w.y = pk2(v0[2], v0[3]); w.z = pk2(v1[0], v1[1]); w.w = pk2(v1[2], v1[3]);
                    *(u32x4*)((char*)O + (bo + (unsigned)(ai * HALF + m * 16) * rstride + (unsigned)(bj * HALF * 2))) = w; } }
    }
};
struct EpiSwiGLU {
    static constexpr int NST = 8; static constexpr bool RSLDS = true; static constexpr bool PERM = true, AFTER_DRAIN = false;
    bf16_t* O; const float* rs;
    __device__ __forceinline__ void operator()(const f32x4 (&acc)[2][2][4][2], const Unit& u, int wr, int wc, int fr, int fq, const LAS float* rsl) const {
        const int row0 = u.pm * BM + wr * 64 + fr, col0 = u.pn * HALF + wc * 32 + 8 * fq;
#pragma unroll
        for (int ai = 0; ai < 2; ++ai)
#pragma unroll
            for (int m = 0; m < 4; ++m) { bf16_t* rowp = O + (size_t)(row0 + ai * HALF + m * 16) * DFF + col0;
                float r[8]; const float rv = rsl[wr * 64 + fr + ai * HALF + m * 16];
#pragma unroll
                for (int n = 0; n < 2; ++n)
#pragma unroll
                    for (int j = 0; j < 4; ++j) { const float g = acc[ai][0][m][n][j] * rv, up = acc[ai][1][m][n][j] * rv; r[4 * n + j] = siluf_(g) * up; }
                u32x4 w; w.x = pk2(r[0], r[1]); w.y = pk2(r[2], r[3]); w.z = pk2(r[4], r[5]); w.w = pk2(r[6], r[7]);
                *(u32x4*)rowp = w; }
    }
};
struct EpiMemKV {
    static constexpr int NST = 0; static constexpr bool RSLDS = false; static constexpr bool PERM = false, AFTER_DRAIN = false;
    float* outK; float* outV; bf16_t* MK; bf16_t* MVT;
    __device__ __forceinline__ void operator()(const f32x4 (&acc)[2][2][4][2], const Unit& u, int wr, int wc, int fr, int fq) const {
        const int layer = u.pn >> 3, isv = (u.pn >> 2) & 1, cb = (u.pn & 3) * BM;
        const int row0 = u.pm * BM + wr * 64 + fr, col0 = cb + wc * 32 + 4 * fq;
        float* of = (isv ? outV : outK) + (size_t)layer * (NB * NMEM * D);
#pragma unroll
        for (int ai = 0; ai < 2; ++ai)
#pragma unroll
            for (int m = 0; m < 4; ++m) { const int row = row0 + ai * HALF + m * 16;
#pragma unroll
                for (int bj = 0; bj < 2; ++bj)
#pragma unroll
                    for (int n = 0; n < 2; ++n) { const int col = col0 + bj * HALF + n * 16; const f32x4 v = acc[ai][bj][m][n];
                        *(f32x4*)(of + (size_t)row * D + col) = v;
                        const int b = row >> 8, key = row & 255, h = col >> 8, dd = col & 255;
                        unsigned char* fb = (unsigned char*)(isv ? MVT : MK) + ((((size_t)layer * NB + b) * NH + h) << 17);
                        if (!isv) { u32x2 w; w.x = pk2(v[0], v[1]); w.y = pk2(v[2], v[3]);
                            *(u32x2*)(fb + ((((key >> 4) * 8 + (dd >> 5)) * 64 + (key & 15) + 16 * ((dd & 31) >> 3)) << 4) + ((dd & 4) << 1)) = w; }
                        else {
                            const int ks = key >> 5, w5 = key & 31, gg = (w5 & 15) >> 2, jj = (w5 & 3) + 4 * (w5 >> 4);
#pragma unroll
                            for (int j = 0; j < 4; ++j) { const int e = dd + j; *(bf16_t*)(fb + (((((e >> 4) * 8 + ks) * 64 + (e & 15) + 16 * gg) << 4) + jj * 2)) = (bf16_t)f2bf(v[j]); } } } }
    }
};
struct EpiBranch {
    static constexpr int NST = 16; static constexpr bool RSLDS = false; static constexpr bool PERM = true, AFTER_DRAIN = false;
    bf16_t* O; const bf16_t* proj; int seg_base, noold_seg;
    __device__ __forceinline__ void operator()(const f32x4 (&acc)[2][2][4][2], const Unit& u, int wr, int wc, int fr, int fq) const {
        const int row0 = u.pm * BM + wr * 64 + fr, col0 = u.pn * BM + wc * 32 + 8 * fq;
        unsigned go = ((unsigned)row0 * (unsigned)NWIN + (unsigned)(PC_GATE + (u.seg + seg_base) * D + col0)) * 2u, oo = ((unsigned)row0 * (unsigned)D + (unsigned)col0) * 2u; asm volatile("" : "+v"(go), "+v"(oo));
        const char* gb = (const char*)proj; char* ob = (char*)O;
#pragma unroll
        for (int ai = 0; ai < 2; ++ai) {
            u32x4 gwv[4][2], oldv[4][2];
#pragma unroll
            for (int m = 0; m < 4; ++m)
#pragma unroll
                for (int bj = 0; bj < 2; ++bj) { gwv[m][bj] = *(const u32x4*)(gb + (go + (unsigned)((ai * HALF + m * 16) * NWIN + bj * HALF) * 2u));
                    oldv[m][bj] = (u32x4){0u, 0u, 0u, 0u}; if (u.seg + seg_base != noold_seg) oldv[m][bj] = *(const u32x4*)(ob + (oo + (unsigned)((ai * HALF + m * 16) * D + bj * HALF) * 2u)); }
            asm volatile("" ::: "memory");
#pragma unroll
            for (int m = 0; m < 4; ++m)
#pragma unroll
                for (int bj = 0; bj < 2; ++bj) { const u32x4 gw = gwv[m][bj], old = oldv[m][bj]; float r[8];
#pragma unroll
                    for (int q = 0; q < 4; ++q) { const unsigned g2 = gw[q], o2 = old[q];
                        const float a0 = acc[ai][bj][m][q >> 1][(q & 1) * 2], a1 = acc[ai][bj][m][q >> 1][(q & 1) * 2 + 1];
                        r[2 * q] = bf2f(o2 & 0xffffu) + sigmoidf_(bf2f(g2 & 0xffffu)) * a0; r[2 * q + 1] = bf2f(o2 >> 16) + sigmoidf_(bf2f(g2 >> 16)) * a1; }
                    u32x4 w; w.x = pk2(r[0], r[1]); w.y = pk2(r[2], r[3]); w.z = pk2(r[4], r[5]); w.w = pk2(r[6], r[7]);
                    *(u32x4*)(ob + (oo + (unsigned)((ai * HALF + m * 16) * D + bj * HALF) * 2u)) = w; }
            asm volatile("" ::: "memory");
        }
    }
};

template <class Epi, class Sched, bool ALIGN_EPI = false, bool SP2 = false>
__device__ __forceinline__ void gemm_phase(PG8_LAS unsigned char* lds, const Gemm g, const Sched& S, const Epi& E, const int tid) {
    const int wid = __builtin_amdgcn_readfirstlane(tid >> 6), lane = tid & 63, wr = wid >> 2, wc = wid & 3, fr = lane & 15, fq = lane >> 4;
    const int K = g.K, nt = K / BK;
    unsigned voffA[2], voffB[2];
#pragma unroll
    for (int i = 0; i < 2; ++i) { int R, C; stage_rc(tid * 16 + i * 8192, R, C); const int Rb = Epi::PERM ? ((R & ~31) + perm32(R & 31)) : R;
        voffA[i] = (unsigned)(R * K + C) * 2u; voffB[i] = (unsigned)(Rb * K + C) * 2u; }
    const size_t kstep = (size_t)(BK * 2);
    const size_t hstep = (size_t)HALF * K * 2;
    const unsigned ldsw = (unsigned)wid * 1024u;
    const int aoff = lds_byte(wr * 64 + fr, fq * 8), boff = lds_byte(wc * 32 + fr, fq * 8);
#define PG8_SA(b, h) (((b) * 2 + (h)) * HTB)
#define PG8_SB(b, h) ((4 + (b) * 2 + (h)) * HTB)
#define PG8_STAGE(bufoff, gbase, voff) do { _Pragma("unroll") for (int _i = 0; _i < 2; ++_i) \
        __builtin_amdgcn_global_load_lds((const unsigned*)((const char*)(gbase) + (voff)[_i]), (PG8_LAS unsigned*)(lds + (bufoff) + ldsw + _i * 8192), 16, 0, 0); } while (0)
#define PG8_LDA(dst, b, h) do { _Pragma("unroll") for (int m = 0; m < 4; ++m) _Pragma("unroll") for (int k = 0; k < 2; ++k) dst[m][k] = *(const PG8_LAS bf16x8*)(lds + PG8_SA(b, h) + aoff + m * 2048 + k * 1024); } while (0)
#define PG8_LDB(dst, b, h) do { _Pragma("unroll") for (int n = 0; n < 2; ++n) _Pragma("unroll") for (int k = 0; k < 2; ++k) dst[n][k] = *(const PG8_LAS bf16x8*)(lds + PG8_SB(b, h) + boff + n * 2048 + k * 1024); } while (0)
#define PG8_MMA(ai, bj, At, Bt) do { __builtin_amdgcn_s_setprio(1); _Pragma("unroll") for (int m = 0; m < 4; ++m) _Pragma("unroll") for (int n = 0; n < 2; ++n) _Pragma("unroll") for (int k = 0; k < 2; ++k) \
        acc[ai][bj][m][n] = __builtin_amdgcn_mfma_f32_16x16x32_bf16(Bt[n][k], At[m][k], acc[ai][bj][m][n], 0, 0, 0); __builtin_amdgcn_s_setprio(0); } while (0)
#define PG8_WAIT_V(n) asm volatile("s_waitcnt vmcnt(" #n ")" ::: "memory")
#define PG8_WAIT_L(n) asm volatile("s_waitcnt lgkmcnt(" #n ")" ::: "memory")
#define PG8_BAR __builtin_amdgcn_s_barrier()
#define PG8_SCHED __builtin_amdgcn_sched_barrier(0)
    Unit cur, nxt; int ui = 0;
    if (!S.next(0, cur)) return;
    f32x4 acc[2][2][4][2];
#pragma unroll
    for (int a = 0; a < 2; ++a)
#pragma unroll
        for (int b = 0; b < 2; ++b)
#pragma unroll
            for (int m = 0; m < 4; ++m)
#pragma unroll
                for (int n = 0; n < 2; ++n) acc[a][b][m][n] = (f32x4){0.f, 0.f, 0.f, 0.f};
    bf16x8 At[4][2], B0[2][2], B1[2][2];
    const char* cA = (const char*)g.A + cur.aofs; const char* cB = (const char*)g.Bt + cur.bofs;
    S.a_ready(cur);
    if constexpr (SP2) {
        PG8_STAGE(PG8_SB(0, 0), cB, voffB); PG8_STAGE(PG8_SB(0, 1), cB + hstep, voffB); PG8_STAGE(PG8_SA(0, 0), cA, voffA); PG8_STAGE(PG8_SA(0, 1), cA + hstep, voffA);
        if (wr == 1) PG8_BAR;
        PG8_WAIT_V(2); PG8_BAR;
        PG8_STAGE(PG8_SB(1, 0), cB + kstep, voffB); PG8_STAGE(PG8_SA(1, 0), cA + kstep, voffA); PG8_STAGE(PG8_SB(1, 1), cB + hstep + kstep, voffB);
        PG8_WAIT_V(6); PG8_BAR;
    } else {
        PG8_STAGE(PG8_SB(0, 0), cB, voffB); PG8_STAGE(PG8_SA(0, 0), cA, voffA); PG8_STAGE(PG8_SB(0, 1), cB + hstep, voffB); PG8_STAGE(PG8_SA(0, 1), cA + hstep, voffA);
        if (wr == 1) PG8_BAR;
        PG8_WAIT_V(4); PG8_BAR;
        PG8_STAGE(PG8_SB(1, 0), cB + kstep, voffB); PG8_STAGE(PG8_SA(1, 0), cA + kstep, voffA); PG8_STAGE(PG8_SB(1, 1), cB + hstep + kstep, voffB);
        PG8_WAIT_V(6); PG8_BAR;
    }
    for (;;) {
        const bool has_next = S.next(ui + 1, nxt);
        if constexpr (Epi::RSLDS) {
            if (wid == 0) __builtin_amdgcn_global_load_lds((const unsigned*)(E.rs + (size_t)cur.pm * BM + lane * 4), (PG8_LAS unsigned*)(lds + STAGE_BYTES + (ui & 1) * 1024), 16, 0, 0); }
        const char* nA = has_next ? (const char*)g.A + nxt.aofs : cA; const char* nB = has_next ? (const char*)g.Bt + nxt.bofs : cB;
        for (int t = 0; t < nt; t += 2) {
            const bool last = (t == nt - 2);
            const char* a1 = cA + (size_t)(t + 1) * kstep;
            const char* a2 = last ? nA : cA + (size_t)(t + 2) * kstep; const char* b2 = last ? nB : cB + (size_t)(t + 2) * kstep;
            const char* a3 = a2 + kstep; const char* b3 = b2 + kstep;
            if (last && has_next) S.a_ready(nxt);
            if constexpr (SP2) {
            PG8_LDB(B0, 0, 0); PG8_LDB(B1, 0, 1); PG8_SCHED; PG8_LDA(At, 0, 0); PG8_STAGE(PG8_SA(1, 1), a1 + hstep, voffA);
            PG8_WAIT_V(8); PG8_WAIT_L(0); PG8_BAR; PG8_MMA(0, 0, At, B0); PG8_MMA(0, 1, At, B1); PG8_BAR; PG8_SCHED;
            PG8_LDA(At, 0, 1); PG8_STAGE(PG8_SB(0, 0), b2, voffB); PG8_STAGE(PG8_SB(0, 1), b2 + hstep, voffB); PG8_STAGE(PG8_SA(0, 0), a2, voffA);
            PG8_WAIT_V(8); PG8_WAIT_L(0); PG8_BAR; PG8_MMA(1, 0, At, B0); PG8_MMA(1, 1, At, B1); PG8_BAR; PG8_SCHED;
            PG8_LDB(B0, 1, 0); PG8_LDB(B1, 1, 1); PG8_SCHED; PG8_LDA(At, 1, 0); PG8_STAGE(PG8_SA(0, 1), a2 + hstep, voffA);
            PG8_WAIT_V(8); PG8_WAIT_L(0); PG8_BAR; PG8_MMA(0, 0, At, B0); PG8_MMA(0, 1, At, B1); PG8_BAR; PG8_SCHED;
            PG8_LDA(At, 1, 1); PG8_STAGE(PG8_SB(1, 0), b3, voffB); PG8_STAGE(PG8_SB(1, 1), b3 + hstep, voffB); PG8_STAGE(PG8_SA(1, 0), a3, voffA);
            PG8_WAIT_V(8); PG8_WAIT_L(0); PG8_BAR; PG8_MMA(1, 0, At, B0); PG8_MMA(1, 1, At, B1); PG8_BAR; PG8_SCHED;
            } else {
            PG8_LDB(B0, 0, 0); PG8_SCHED; PG8_LDA(At, 0, 0); PG8_STAGE(PG8_SA(1, 1), a1 + hstep, voffA);
            PG8_WAIT_L(8); PG8_BAR; PG8_WAIT_L(0); PG8_MMA(0, 0, At, B0); PG8_BAR; PG8_SCHED;
            PG8_LDB(B1, 0, 1); PG8_STAGE(PG8_SB(0, 0), b2, voffB);
            PG8_BAR; PG8_WAIT_L(0); PG8_MMA(0, 1, At, B1); PG8_BAR;
            PG8_LDA(At, 0, 1); PG8_STAGE(PG8_SA(0, 0), a2, voffA);
            PG8_BAR; PG8_WAIT_L(0); PG8_MMA(1, 0, At, B0); PG8_BAR; PG8_SCHED;
            PG8_STAGE(PG8_SB(0, 1), b2 + hstep, voffB);
            PG8_WAIT_V(6); PG8_BAR; PG8_MMA(1, 1, At, B1); PG8_BAR;
            PG8_LDB(B0, 1, 0); PG8_SCHED; PG8_LDA(At, 1, 0); PG8_STAGE(PG8_SA(0, 1), a2 + hstep, voffA);
            PG8_WAIT_L(8); PG8_BAR; PG8_WAIT_L(0); PG8_MMA(0, 0, At, B0); PG8_BAR; PG8_SCHED;
            PG8_LDB(B1, 1, 1); PG8_STAGE(PG8_SB(1, 0), b3, voffB);
            PG8_BAR; PG8_WAIT_L(0); PG8_MMA(0, 1, At, B1); PG8_BAR;
            PG8_LDA(At, 1, 1); PG8_STAGE(PG8_SA(1, 0), a3, voffA);
            PG8_BAR; PG8_WAIT_L(0); PG8_MMA(1, 0, At, B0); PG8_BAR; PG8_SCHED;
            PG8_STAGE(PG8_SB(1, 1), b3 + hstep, voffB);
            PG8_WAIT_V(6); PG8_BAR; PG8_MMA(1, 1, At, B1); PG8_BAR;
            }
        }
        if constexpr (ALIGN_EPI) { if (wr == 0) PG8_BAR; }
        if constexpr (Epi::RSLDS) { E(acc, cur, wr, wc, fr, fq, (const PG8_LAS float*)(lds + STAGE_BYTES + (ui & 1) * 1024)); S.done(cur); } else
        if constexpr (!Epi::AFTER_DRAIN) { E(acc, cur, wr, wc, fr, fq); S.done(cur); }
        if (!has_next) break;
#pragma unroll
        for (int a = 0; a < 2; ++a)
#pragma unroll
            for (int b = 0; b < 2; ++b)
#pragma unroll
                for (int m = 0; m < 4; ++m)
#pragma unroll
                    for (int n = 0; n < 2; ++n) acc[a][b][m][n] = (f32x4){0.f, 0.f, 0.f, 0.f};
        cur = nxt; cA = nA; cB = nB; ++ui;
        if constexpr (ALIGN_EPI) { if (wr == 1) PG8_BAR; }
    }
    PG8_WAIT_V(0);
    if constexpr (!ALIGN_EPI) { if (wr == 0) PG8_BAR; }
    PG8_BAR;
    if constexpr (Epi::AFTER_DRAIN) { E.fused(acc, cur, wr, wc, fr, fq, lds, wid, lane); S.done(cur); }
#undef PG8_SA
#undef PG8_SB
#undef PG8_STAGE
#undef PG8_LDA
#undef PG8_LDB
#undef PG8_MMA
#undef PG8_WAIT_V
#undef PG8_WAIT_L
#undef PG8_BAR
#undef PG8_SCHED
}
}

constexpr size_t MiB = 1u << 20;
constexpr size_t WS_CTL = 0, CTL_ZERO_BYTES = 32768;
constexpr size_t WS_W0 = 1 * MiB, WS_WL = 61 * MiB;
constexpr size_t OFF_W1I = 0, OFF_W1O = 11 * MiB, OFF_WIN = 16 * MiB + MiB / 2, OFF_WBR = 36 * MiB + MiB / 2, OFF_WO = 42 * MiB + MiB / 2, OFF_W2I = 44 * MiB + MiB / 2, OFF_W2O = 55 * MiB + MiB / 2;
static_assert(OFF_W2O + (size_t)D * DFF * 2 == WS_WL, "layer weight map");
constexpr size_t WS_WMKV = 123 * MiB;
constexpr size_t WS_MISC = 131 * MiB;
constexpr size_t MISC_WAB = 0, MISC_COS = 65536, MISC_SIN = 65536 + 2049 * 64 * 4;
constexpr size_t WS_MEMN = 133 * MiB, WS_MK = 141 * MiB, WS_MVT = 149 * MiB, WS_AB = 157 * MiB;
constexpr size_t WS_H = 158 * MiB, WS_TMP = 223 * MiB, WS_XN = 288 * MiB, WS_MERGED = 320 * MiB + MiB / 2, WS_OBR = 353 * MiB;
constexpr size_t OBR_STRIDE = (size_t)MPAD * D;
constexpr size_t WS_BIG = 451 * MiB;
constexpr int GCH_W = 0, GCH_QD = 16384, GCH_ATT = 32768, GCH_KDT = 40960, GCH_BYTES = 57344;
constexpr int RCH_QD = 0, RCH_ATT = 16384, RCH_KDT = 24576, RCH_BYTES = 40960;
constexpr size_t WS_RCH = 776 * MiB, WS_RVT = 816 * MiB;
constexpr size_t WS_GCH = 848 * MiB, WS_GUT = 904 * MiB, WS_GDCH = 968 * MiB;
constexpr size_t WS_END = 969 * MiB;
static_assert(WS_H + (size_t)MPAD * D * 4 == WS_TMP && WS_TMP + (size_t)MPAD * D * 4 == WS_XN && WS_XN + (size_t)MPAD * D * 2 == WS_MERGED && WS_MERGED + (size_t)MPAD * D * 2 == WS_OBR, "activation map");
static_assert(WS_OBR + 3 * OBR_STRIDE * 2 <= WS_BIG && WS_BIG + (size_t)MPAD * NWIN * 2 <= WS_RCH && WS_RCH + (size_t)1024 * RCH_BYTES <= WS_RVT && WS_GCH + (size_t)1024 * GCH_BYTES <= WS_GUT, "activation map 2");
constexpr int CW_BAR = 4096;

constexpr size_t O_YP = 0, O_YS = O_YP + (size_t)MP * D, O_SRP = O_YS + (size_t)MS * D, O_SGP = O_SRP + (size_t)2 * NB * NH * DK * DV, O_CVP = O_SGP + (size_t)2 * NB * NH * DK * DV,
                 O_MKP = O_CVP + (size_t)2 * NB * 3 * CONVD, O_MVP = O_MKP + (size_t)2 * NB * NMEM * D, O_SRS = O_MVP + (size_t)2 * NB * NMEM * D, O_SGS = O_SRS + (size_t)2 * MS * NH * DK * DV,
                 O_CVS = O_SGS + (size_t)2 * MS * NH * DK * DV, O_END = O_CVS + (size_t)2 * MS * 3 * CONVD;
static_assert(O_END == 98271232, "output size");

constexpr int LDS_BYTES = 163840, MISC_OFF = LDS_BYTES - 256;

#define XB_TMO      128
#define XB_XCNT(j)  (256  + 64 * (j))
#define XB_XSUB(j)  (1280 + 64 * (j))
#define XB_XGEN(j)  (2304 + 64 * (j))
#define XB_TOP      3328
#define XB_TOPGEN   3392
#define XCD_BAR_WORDS 3456
#define XB_SPIN_CAP (1u << 18)

__device__ __forceinline__ unsigned xb_ld(unsigned* p)              { return __hip_atomic_load(p, __ATOMIC_RELAXED, __HIP_MEMORY_SCOPE_AGENT); }
__device__ __forceinline__ unsigned xb_add(unsigned* p, unsigned v) { return __hip_atomic_fetch_add(p, v, __ATOMIC_RELAXED, __HIP_MEMORY_SCOPE_AGENT); }
__device__ __forceinline__ unsigned xb_xcc_id() { return (unsigned)__builtin_amdgcn_s_getreg((3 << 11) | 20) & 0xFu; }
#define XB_SPIN(cond, bar) do { unsigned _sp = 0; while (cond) { __builtin_amdgcn_s_sleep(1); \
    if ((++_sp & 255u) == 0u) { if (xb_ld(&(bar)[XB_TMO])) break; if (_sp > XB_SPIN_CAP) { atomicAdd(&(bar)[XB_TMO], 1u); break; } } } } while (0)

struct XcdBarrier {
    unsigned* bar; unsigned x;
    volatile LAS unsigned* st;
};

__device__ __forceinline__ XcdBarrier xcd_barrier_post(unsigned* bar, volatile LAS unsigned* st) {
    XcdBarrier b; b.bar = bar; b.x = xb_xcc_id(); b.st = st;
    if (threadIdx.x == 0) (void)xb_add(&bar[XB_XCNT(b.x)], 1u);
    return b;
}
__device__ __forceinline__ void xcd_barrier_complete(unsigned* bar, unsigned x, unsigned& nloc, unsigned& nx) {
    const unsigned G = gridDim.x * gridDim.y * gridDim.z;
    unsigned sum, cnt, mine, sp = 0u;
    for (;;) {
        sum = 0u; cnt = 0u; mine = 0u;
#pragma unroll
        for (unsigned j = 0; j < 16; ++j) { const unsigned c = xb_ld(&bar[XB_XCNT(j)]); sum += c; cnt += (c > 0u) ? 1u : 0u; mine = (j == x) ? c : mine; }
        if (sum == G) break;
        __builtin_amdgcn_s_sleep(1);
        if ((++sp & 255u) == 0u) { if (xb_ld(&bar[XB_TMO])) break; if (sp > XB_SPIN_CAP) { atomicAdd(&bar[XB_TMO], 1u); break; } }
    }
    nloc = mine > 0u ? mine : 1u; nx = cnt > 0u ? cnt : 1u;
}

__device__ __forceinline__ void xcd_barrier(const XcdBarrier& b, const bool is_thread0) {
    asm volatile("s_waitcnt vmcnt(0)" ::: "memory");
    __syncthreads();
    if (is_thread0) {
        unsigned* bar = b.bar;
        __builtin_amdgcn_s_waitcnt(0);
        unsigned nloc = b.st[0], nx = b.st[1];
        if (nloc == 0u) { xcd_barrier_complete(bar, b.x, nloc, nx); b.st[0] = nloc; b.st[1] = nx; }
        const unsigned old = xb_add(&bar[XB_XSUB(b.x)], 1u);
        const unsigned gen = old / nloc;
        if (old + 1u == (gen + 1u) * nloc) {
            __builtin_amdgcn_fence(__ATOMIC_RELEASE, "agent");
            asm volatile("s_waitcnt vmcnt(0)" ::: "memory");
            const unsigned og = xb_add(&bar[XB_TOP], 1u);
            const unsigned tg = og / nx;
            if (og + 1u == (tg + 1u) * nx) xb_add(&bar[XB_TOPGEN], 1u);
            else XB_SPIN(xb_ld(&bar[XB_TOPGEN]) == tg, bar);
            __builtin_amdgcn_fence(__ATOMIC_ACQUIRE, "agent");
            xb_add(&bar[XB_XGEN(b.x)], 1u);
            asm volatile("s_waitcnt vmcnt(0)" ::: "memory");
        } else {
            XB_SPIN(xb_ld(&bar[XB_XGEN(b.x)]) == gen, bar);
            __builtin_amdgcn_fence(__ATOMIC_ACQUIRE, "agent");
            asm volatile("s_waitcnt vmcnt(0)" ::: "memory");
        }
    }
    __syncthreads();
}

__device__ __forceinline__ void sub_arrive(unsigned* ctr, const bool is_thread0) {
    asm volatile("s_waitcnt vmcnt(0)" ::: "memory");
    __syncthreads();
    if (is_thread0) { __builtin_amdgcn_s_waitcnt(0); __builtin_amdgcn_fence(__ATOMIC_RELEASE, "agent"); asm volatile("s_waitcnt vmcnt(0)" ::: "memory"); (void)xb_add(ctr, 1u); }
}
__device__ __forceinline__ void sub_wait(unsigned* ctr, unsigned target, unsigned* bar, const bool is_thread0) {
    if (is_thread0) { XB_SPIN(xb_ld(ctr) < target, bar); __builtin_amdgcn_fence(__ATOMIC_ACQUIRE, "agent"); asm volatile("s_waitcnt vmcnt(0)" ::: "memory"); }
    __syncthreads();
}
constexpr int CW_SUB = 64;

constexpr int NWAVES = 8;
struct Args { const float* in[30]; float* out; unsigned char* ws; int ph_lo, ph_hi, sel, pad; };
struct Frame {
    LAS unsigned char* lds; int tid, lane, wave, G, bid;
    const Args* A; float* out; unsigned char* ws; int zo;
    __device__ __forceinline__ const float* inp(int k) const { return *(const float* const*)((const char*)A + zo + 8 * k); }
    __device__ __forceinline__ float* RS() const { return (float*)(ws + WS_XN); }
    __device__ __forceinline__ bf16_t* MERGED() const { return (bf16_t*)(ws + WS_MERGED); }
    __device__ __forceinline__ bf16_t* OBR() const { return (bf16_t*)(ws + WS_OBR); }
    __device__ __forceinline__ bf16_t* PROJ() const { return (bf16_t*)(ws + WS_BIG); }
    __device__ __forceinline__ bf16_t* ACT() const { return (bf16_t*)(ws + WS_BIG); }
    __device__ __forceinline__ bf16_t* MEMN() const { return (bf16_t*)(ws + WS_MEMN); }
    __device__ __forceinline__ bf16_t* MK() const { return (bf16_t*)(ws + WS_MK); }
    __device__ __forceinline__ bf16_t* MVT() const { return (bf16_t*)(ws + WS_MVT); }
    __device__ __forceinline__ bf16_t* H() const { return (bf16_t*)(ws + WS_H); }
    __device__ __forceinline__ bf16_t* TMP() const { return (bf16_t*)(ws + WS_TMP); }
    __device__ __forceinline__ float* AB() const { return (float*)(ws + WS_AB); }
    __device__ __forceinline__ float* WAB() const { return (float*)(ws + WS_MISC + MISC_WAB); }
    __device__ __forceinline__ float* COS() const { return (float*)(ws + WS_MISC + MISC_COS); }
    __device__ __forceinline__ float* SIN() const { return (float*)(ws + WS_MISC + MISC_SIN); }
    __device__ __forceinline__ unsigned char* RCH() const { return ws + WS_RCH; }
    __device__ __forceinline__ unsigned char* RVT() const { return ws + WS_RVT; }
    __device__ __forceinline__ unsigned char* GCH() const { return ws + WS_GCH; }
    __device__ __forceinline__ float* GUT() const { return (float*)(ws + WS_GUT); }
    __device__ __forceinline__ float* GDCH() const { return (float*)(ws + WS_GDCH); }
};
#define LDS_WAIT() asm volatile("s_waitcnt lgkmcnt(0)" ::: "memory")

enum { WM_PLAIN = 0, WM_FFNIN = 1, WM_WIN = 2 };
__device__ __forceinline__ int map_col(int mode, int n0) {
    if (mode == WM_FFNIN) { const int tile = n0 >> 8, w = n0 & 255; return (w < 128) ? tile * 128 + w : DFF + tile * 128 + (w - 128); }
    if (mode == WM_WIN) return n0 < PC_MQ ? n0 : n0 + 8;
    return n0;
}
__device__ __forceinline__ void transpose_item(const float* W, int K, int Nraw, int N, int mode, bf16_t* WT, const float* gk, LAS float* scr, int item, int lane) {
    const int nblk = N / 32, kb = item / nblk, nb = item % nblk, k0 = 64 * kb, n0 = 32 * nb, nr0 = map_col(mode, n0);
    f32x4 wv[8];
#pragma unroll
    for (int i = 0; i < 8; ++i) wv[i] = *(const f32x4*)(W + (size_t)(k0 + 8 * i + (lane >> 3)) * Nraw + nr0 + 4 * (lane & 7));
    if (gk) {
#pragma unroll
        for (int i = 0; i < 8; ++i) wv[i] = wv[i] * gk[k0 + 8 * i + (lane >> 3)]; }
#pragma unroll
    for (int i = 0; i < 8; ++i) { LAS float* d = scr + (8 * i + (lane >> 3)) * 33 + 4 * (lane & 7); d[0] = wv[i].x; d[1] = wv[i].y; d[2] = wv[i].z; d[3] = wv[i].w; }
    LDS_WAIT(); asm volatile("" ::: "memory");
    const int c = lane & 7;
#pragma unroll
    for (int j = 0; j < 4; ++j) { const int n = (lane >> 3) + 8 * j; const LAS float* s = scr + (8 * c) * 33 + n;
        u32x4 o; o.x = pk2(s[0 * 33], s[1 * 33]); o.y = pk2(s[2 * 33], s[3 * 33]); o.z = pk2(s[4 * 33], s[5 * 33]); o.w = pk2(s[6 * 33], s[7 * 33]);
        *(u32x4*)(WT + (size_t)(n0 + n) * K + k0 + 8 * c) = o; }
    LDS_WAIT(); asm volatile("" ::: "memory");
}
struct TJob { const float* W; int K, Nraw, N, mode; bf16_t* WT; const float* gk; };
__device__ __forceinline__ TJob get_job(int j, const Frame& F) {
    const int l = j / 11, t = j % 11; unsigned char* wl = F.ws + WS_W0 + (size_t)l * WS_WL; TJob r;
    switch (t) {
    case 0:  r = TJob{F.inp(10) + (size_t)l * D * NFFI, D, NFFI, NFFI, WM_FFNIN, (bf16_t*)(wl + OFF_W1I), F.inp(8) + (size_t)l * D}; break;
    case 1:  r = TJob{F.inp(11) + (size_t)l * DFF * D, DFF, D, D, WM_PLAIN, (bf16_t*)(wl + OFF_W1O), nullptr}; break;
    case 2:  r = TJob{F.inp(14) + (size_t)l * D * WIN_RAW, D, WIN_RAW, NWIN, WM_WIN, (bf16_t*)(wl + OFF_WIN), F.inp(12) + (size_t)l * D}; break;
    case 3:  r = TJob{F.inp(20) + (size_t)l * D * D, D, D, D, WM_PLAIN, (bf16_t*)(F.ws + WS_WMKV) + (size_t)(l * 2048) * D, nullptr}; break;
    case 4:  r = TJob{F.inp(21) + (size_t)l * D * D, D, D, D, WM_PLAIN, (bf16_t*)(F.ws + WS_WMKV) + (size_t)(l * 2048 + 1024) * D, nullptr}; break;
    case 5:  r = TJob{F.inp(22) + (size_t)l * D * D, D, D, D, WM_PLAIN, (bf16_t*)(wl + OFF_WBR), nullptr}; break;
    case 6:  r = TJob{F.inp(23) + (size_t)l * D * D, D, D, D, WM_PLAIN, (bf16_t*)(wl + OFF_WBR) + (size_t)D * D, nullptr}; break;
    case 7:  r = TJob{F.inp(24) + (size_t)l * D * D, D, D, D, WM_PLAIN, (bf16_t*)(wl + OFF_WBR) + (size_t)2 * D * D, nullptr}; break;
    case 8:  r = TJob{F.inp(25) + (size_t)l * D * D, D, D, D, WM_PLAIN, (bf16_t*)(wl + OFF_WO), nullptr}; break;
    case 9:  r = TJob{F.inp(28) + (size_t)l * D * NFFI, D, NFFI, NFFI, WM_FFNIN, (bf16_t*)(wl + OFF_W2I), F.inp(26) + (size_t)l * D}; break;
    default: r = TJob{F.inp(29) + (size_t)l * DFF * D, DFF, D, D, WM_PLAIN, (bf16_t*)(wl + OFF_W2O), nullptr}; break;
    }
    return r;
}

struct NormArgs { const bf16_t* tmp; const float* gpost; float scale; const float* gpre; const float* wab; int first, fin; };
__device__ __forceinline__ void norm_phase(const Frame& F, const NormArgs na) {
    const int gw = F.bid * NWAVES + F.wave, NGW = F.G * NWAVES, lane = F.lane;
#define FI(j) (2 * lane + 128 * ((j) >> 1) + ((j) & 1))
#define NP_LD(mm, hh, tt) do { if ((mm) < MREAL) { _Pragma("unroll") for (int jj = 0; jj < 2; ++jj) { hh[jj] = *((const u32x4*)(F.H() + (size_t)(mm) * D) + lane + 64 * jj); tt[jj] = *((const u32x4*)(na.tmp + (size_t)(mm) * D) + lane + 64 * jj); } } } while (0)
#define NP_LDX(mm, xx) do { if ((mm) < MREAL) { const float* src_ = ((mm) < MP) ? F.inp(0) + (size_t)(mm) * D : F.inp(1) + (size_t)((mm) - MP) * D; _Pragma("unroll") for (int j = 0; j < 4; ++j) xx[j] = *((const f32x4*)src_ + FI(j)); } } while (0)
    const u32x4 z4 = (u32x4){0u, 0u, 0u, 0u};
    f32x4 gpq[4];
#pragma unroll
    for (int j = 0; j < 4; ++j) gpq[j] = na.tmp ? *((const f32x4*)na.gpost + FI(j)) : (f32x4){0.f, 0.f, 0.f, 0.f};
    f32x4 wq[8][4];
#pragma unroll
    for (int q = 0; q < 8; ++q)
#pragma unroll
        for (int j = 0; j < 4; ++j) wq[q][j] = na.wab ? *((const f32x4*)(na.wab + q * D) + FI(j)) : (f32x4){0.f, 0.f, 0.f, 0.f};
    u32x4 h0[2] = {z4, z4}, t0[2] = {z4, z4}, h1[2] = {z4, z4}, t1[2] = {z4, z4};
    f32x4 x0[4];
#pragma unroll
    for (int j = 0; j < 4; ++j) x0[j] = (f32x4){0.f, 0.f, 0.f, 0.f};
    if (na.first) NP_LDX(gw, x0); else { NP_LD(gw, h0, t0); NP_LD(gw + NGW, h1, t1); }
    for (int m = gw; m < MREAL; m += NGW) {
        f32x4 h[4]; const u32x4 tc[2] = {t0[0], t0[1]};
        if (na.first) {
#pragma unroll
            for (int j = 0; j < 4; ++j) h[j] = x0[j];
            NP_LDX(m + NGW, x0);
        } else {
            const u32x4 hc[2] = {h0[0], h0[1]};
            h0[0] = h1[0]; h0[1] = h1[1]; t0[0] = t1[0]; t0[1] = t1[1];
            NP_LD(m + 2 * NGW, h1, t1);
#pragma unroll
            for (int jj = 0; jj < 2; ++jj) { const u32x4 w = hc[jj]; h[2 * jj] = (f32x4){bf2f(w.x & 0xffffu), bf2f(w.x >> 16), bf2f(w.y & 0xffffu), bf2f(w.y >> 16)}; h[2 * jj + 1] = (f32x4){bf2f(w.z & 0xffffu), bf2f(w.z >> 16), bf2f(w.w & 0xffffu), bf2f(w.w >> 16)}; }
        }
        if (na.tmp) {
            f32x4 t[4]; float ss = 0.f;
#pragma unroll
            for (int jj = 0; jj < 2; ++jj) { const u32x4 w = tc[jj]; t[2 * jj] = (f32x4){bf2f(w.x & 0xffffu), bf2f(w.x >> 16), bf2f(w.y & 0xffffu), bf2f(w.y >> 16)}; t[2 * jj + 1] = (f32x4){bf2f(w.z & 0xffffu), bf2f(w.z >> 16), bf2f(w.w & 0xffffu), bf2f(w.w >> 16)}; }
#pragma unroll
            for (int j = 0; j < 4; ++j) ss += (t[j].x * t[j].x + t[j].y * t[j].y) + (t[j].z * t[j].z + t[j].w * t[j].w);
            const float r = na.scale / sqrtf(wave_sum(ss) * (1.f / D) + EPS);
#pragma unroll
            for (int j = 0; j < 4; ++j) h[j] = h[j] + t[j] * gpq[j] * r;
        }
        if (!na.fin) {
#pragma unroll
            for (int jj = 0; jj < 2; ++jj) { u32x4 w; w.x = pk2(h[2 * jj].x, h[2 * jj].y); w.y = pk2(h[2 * jj].z, h[2 * jj].w); w.z = pk2(h[2 * jj + 1].x, h[2 * jj + 1].y); w.w = pk2(h[2 * jj + 1].z, h[2 * jj + 1].w); *((u32x4*)(F.H() + (size_t)m * D) + lane + 64 * jj) = w; } }
        if (na.fin && m < MREAL) {
            float* dst = (m < MP) ? F.out + O_YP + (size_t)m * D : F.out + O_YS + (size_t)(m - MP) * D;
#pragma unroll
            for (int j = 0; j < 4; ++j) *((f32x4*)dst + FI(j)) = h[j];
        }
        float s2 = 0.f;
#pragma unroll
        for (int j = 0; j < 4; ++j) s2 += (h[j].x * h[j].x + h[j].y * h[j].y) + (h[j].z * h[j].z + h[j].w * h[j].w);
        const float r2 = 1.f / sqrtf(wave_sum(s2) * (1.f / D) + EPS);
        if (lane == 0) F.RS()[m] = r2;
        if (na.wab) {
            float d8 = 0.f;
#pragma unroll
            for (int q = 0; q < 8; ++q) { float s = 0.f;
#pragma unroll
                for (int j = 0; j < 4; ++j) { const f32x4 w = wq[q][j]; s += (h[j].x * w.x + h[j].y * w.y) + (h[j].z * w.z + h[j].w * w.w); }
                s = wave_sum(s) * r2; d8 = (lane == q) ? s : d8; }
            if (lane < 8) F.AB()[(size_t)m * 8 + lane] = d8;
        }
    }
}
#undef FI
#undef NP_LD
#undef NP_LDX

__device__ __forceinline__ void p0_prologue(const Frame& F) {
    LAS float* scr = (LAS float*)(F.lds + F.wave * 16384);
    const int gw = F.bid * NWAVES + F.wave, NGW = F.G * NWAVES;
    int dealt = 0;
    for (int j = 0; j < 16; ++j) { if (j >= 5 && j != 14 && j != 15) continue;
        const TJob tj = get_job(j, F); const int nitems = (tj.K / 64) * (tj.N / 32);
        int first = (gw - dealt) % NGW; if (first < 0) first += NGW;
        for (int it = first; it < nitems; it += NGW) transpose_item(tj.W, tj.K, tj.Nraw, tj.N, tj.mode, tj.WT, tj.gk, scr, it, F.lane);
        dealt = (dealt + nitems) % NGW; }
    const int gt = F.bid * (NWAVES * 64) + F.tid, NGT = F.G * NWAVES * 64;
    for (int i = gt; i < 2 * 8 * D; i += NGT) { const int l = i / (8 * D), q = (i / D) % 8, k = i % D; F.WAB()[i] = F.inp(14)[(size_t)l * D * WIN_RAW + (size_t)k * WIN_RAW + PC_MQ + q] * F.inp(12)[(size_t)l * D + k]; }
    for (int i = gt; i < 2049 * 64; i += NGT) { const int p = i >> 6, d = i & 63; const double pos = (p == 2048) ? (double)PAST_LEN : (double)p;
        const double ang = pos * pow(10000.0, -(double)d / 64.0); F.COS()[i] = (float)cos(ang); F.SIN()[i] = (float)sin(ang); }
    for (int r = gw; r < 2 * NB * NMEM; r += NGW) { const int l = r / (NB * NMEM), row = r % (NB * NMEM);
        f32x4 v[4], gq[4]; float ss = 0.f;
#pragma unroll
        for (int j = 0; j < 4; ++j) { v[j] = *((const f32x4*)(F.inp(2) + (size_t)row * D) + F.lane + 64 * j); ss += (v[j].x * v[j].x + v[j].y * v[j].y) + (v[j].z * v[j].z + v[j].w * v[j].w); }
        const float rr = 1.f / sqrtf(wave_sum(ss) * (1.f / D) + EPS);
        u32x2* o8 = (u32x2*)(F.MEMN() + (size_t)r * D) + F.lane;
#pragma unroll
        for (int j = 0; j < 4; ++j) gq[j] = *((const f32x4*)(F.inp(19) + (size_t)l * D) + F.lane + 64 * j);
        asm volatile("" ::: "memory");
#pragma unroll
        for (int j = 0; j < 4; ++j) { const f32x4 y = v[j] * gq[j] * rr; u32x2 w; w.x = pk2(y.x, y.y); w.y = pk2(y.z, y.w); o8[64 * j] = w; }
    }
    NormArgs na{nullptr, nullptr, 0.f, F.inp(8), nullptr, 1, 0};
    norm_phase(F, na);
}

__device__ __forceinline__ void convert_layer1(const Frame& F, int idx, int nw) {
    LAS float* scr = (LAS float*)(F.lds + F.wave * 16384);
    const int gw = idx * NWAVES + F.wave, NGW = nw * NWAVES;
    int dealt = 0;
    for (int j = 5; j < 22; ++j) { if (j == 14 || j == 15) continue;
        const TJob tj = get_job(j, F); const int nitems = (tj.K / 64) * (tj.N / 32);
        int first = (gw - dealt) % NGW; if (first < 0) first += NGW;
        for (int it = first; it < nitems; it += NGW) transpose_item(tj.W, tj.K, tj.Nraw, tj.N, tj.mode, tj.WT, tj.gk, scr, it, F.lane);
        dealt = (dealt + nitems) % NGW; }
}

__device__ __forceinline__ bf16x8 ldnat(const void* base, unsigned row_boff, int s, int g) { return *(const bf16x8*)((const char*)base + (row_boff + 64u * s + 16u * g)); }
__device__ __forceinline__ bf16x8 ldperm(const void* base, unsigned row_boff, int s, int g) {
    const unsigned o = row_boff + 64u * s + 8u * g; const bf16x4 lo = *(const bf16x4*)((const char*)base + o), hi = *(const bf16x4*)((const char*)base + (o + 32u));
    return __builtin_shufflevector(lo, hi, 0, 1, 2, 3, 4, 5, 6, 7);
}
#define CBAR() asm volatile("" ::: "memory")
__device__ __forceinline__ bf16x8 lds_frag(const LAS float* rowp, int s, int g, float scale) {
    const f32x4 a = *(const LAS f32x4*)(rowp + 32 * s + 8 * g), b = *(const LAS f32x4*)(rowp + 32 * s + 8 * g + 4);
    return pack8(a * scale, b * scale);
}

__device__ __forceinline__ void ret_prep(const Frame& F, int ci) {
    const int tid = F.tid, lane = F.lane, wv = F.wave;
    const int bh = ci >> 5, n = ci & 31, b = bh >> 2, h = bh & 3, m0 = b * SEQ + n * CH;
    const float lg = log1pf(-exp2f(-5.0f - (float)h));
    LAS float* qf = (LAS float*)F.lds;
    LAS float* kf = qf + 64 * 132;
    LAS bf16_t* vs = (LAS bf16_t*)(kf + 64 * 132);
    u32x4 vr[4];
#pragma unroll
    for (int r = 0; r < 4; ++r) { const int p = tid + 512 * r, row = p >> 5, c8 = (p & 31) * 8; vr[r] = *(const u32x4*)(F.PROJ() + (size_t)(m0 + row) * NWIN + PC_RV + h * DV + c8); }
    {   const int i = tid >> 3, d0 = (tid & 7) * 8, t = n * CH + i;
        const bf16_t* qrow = F.PROJ() + (size_t)(m0 + i) * NWIN + PC_RQ + h * DK; const bf16_t* krow = F.PROJ() + (size_t)(m0 + i) * NWIN + PC_RK + h * DK;
        const u32x4 q1 = *(const u32x4*)(qrow + d0), q2 = *(const u32x4*)(qrow + 64 + d0), k1 = *(const u32x4*)(krow + d0), k2 = *(const u32x4*)(krow + 64 + d0);
        const float* cp = F.COS() + t * 64 + d0; const float* sp = F.SIN() + t * 64 + d0;
        float cs[8], sn[8];
#pragma unroll
        for (int e = 0; e < 8; ++e) { cs[e] = cp[e]; sn[e] = sp[e]; }
        const float qd = fexp(lg * (float)(i + 1));
        float o1[8], o2[8];
#pragma unroll
        for (int e = 0; e < 8; ++e) { const unsigned w1 = q1[e >> 1], w2 = q2[e >> 1]; const float x1 = (e & 1) ? bf2f(w1 >> 16) : bf2f(w1 & 0xffffu), x2 = (e & 1) ? bf2f(w2 >> 16) : bf2f(w2 & 0xffffu);
            o1[e] = x1 * cs[e] - x2 * sn[e]; o2[e] = x1 * sn[e] + x2 * cs[e]; qf[i * 132 + d0 + e] = o1[e]; qf[i * 132 + 64 + d0 + e] = o2[e]; }
        {
            unsigned char* qb = F.RCH() + (size_t)ci * RCH_BYTES + RCH_QD + (i >> 4) * 4096 + (i & 15) * 16;
#pragma unroll
            for (int hh = 0; hh < 2; ++hh) { const int D0 = d0 + 64 * hh, s = D0 >> 5, half = (D0 >> 4) & 1, g0 = (D0 & 15) >> 2; const float* o = hh ? o2 : o1;
                u32x2 w; w.x = pk2(o[0] * qd, o[1] * qd); w.y = pk2(o[2] * qd, o[3] * qd); *(u32x2*)(qb + s * 1024 + g0 * 256 + half * 8) = w;
                w.x = pk2(o[4] * qd, o[5] * qd); w.y = pk2(o[6] * qd, o[7] * qd); *(u32x2*)(qb + s * 1024 + (g0 + 1) * 256 + half * 8) = w; }
        }
        const float ksc = 0.08838834764831845f;
#pragma unroll
        for (int e = 0; e < 8; ++e) { const unsigned w1 = k1[e >> 1], w2 = k2[e >> 1]; const float x1 = (e & 1) ? bf2f(w1 >> 16) : bf2f(w1 & 0xffffu), x2 = (e & 1) ? bf2f(w2 >> 16) : bf2f(w2 & 0xffffu);
            kf[i * 132 + d0 + e] = (x1 * cs[e] - x2 * sn[e]) * ksc; kf[i * 132 + 64 + d0 + e] = (x1 * sn[e] + x2 * cs[e]) * ksc; }
    }
#pragma unroll
    for (int r = 0; r < 4; ++r) { const int p = tid + 512 * r, row = p >> 5, c8 = (p & 31) * 8; *(LAS u32x4*)(vs + row * 264 + c8) = vr[r]; }
    __syncthreads();
    {
        const int d = tid >> 2, i0 = (tid & 3) * 16; unsigned w[8];
#pragma unroll
        for (int r = 0; r < 16; r += 2) { const float v0 = kf[(i0 + r) * 132 + d] * fexp(lg * (float)(63 - (i0 + r))), v1 = kf[(i0 + r + 1) * 132 + d] * fexp(lg * (float)(62 - (i0 + r))); w[r >> 1] = pk2(v0, v1); }
        unsigned char* kb = F.RCH() + (size_t)ci * RCH_BYTES + RCH_KDT + (d >> 4) * 2048 + (d & 15) * 16 + (i0 >> 5) * 1024 + ((i0 & 31) >> 3) * 256;
        *(u32x4*)kb = (u32x4){w[0], w[1], w[2], w[3]}; *(u32x4*)(kb + 256) = (u32x4){w[4], w[5], w[6], w[7]};
    }
    {
        const int e = tid >> 1, i0 = (tid & 1) * 32; unsigned w[16];
#pragma unroll
        for (int r = 0; r < 32; r += 2) w[r >> 1] = (unsigned)vs[(i0 + r) * 264 + e] | ((unsigned)vs[(i0 + r + 1) * 264 + e] << 16);
        unsigned char* vb = F.RVT() + (size_t)ci * 32768 + ((e >> 4) * 2 + (i0 >> 5)) * 1024 + (e & 15) * 16;
#pragma unroll
        for (int q = 0; q < 4; ++q) *(u32x4*)(vb + q * 256) = (u32x4){w[4 * q], w[4 * q + 1], w[4 * q + 2], w[4 * q + 3]};
    }
    {
        const int c = lane & 15, g = lane >> 4;
#pragma unroll
        for (int x = 0; x < 2; ++x) { const int tt = 2 * wv + x, jt = tt >> 2, it = tt & 3;
            f32x4 acc = (f32x4){0.f, 0.f, 0.f, 0.f};
            if (it >= jt) {
#pragma unroll
                for (int s = 0; s < 4; ++s) { const bf16x8 A = lds_frag(kf + (16 * jt + c) * 132, s, g, 1.0f), B = lds_frag(qf + (16 * it + c) * 132, s, g, 1.0f); acc = MFMA16(A, B, acc); }
            }
            const int i = 16 * it + c; float r4[4];
#pragma unroll
            for (int r = 0; r < 4; ++r) { const int j = 16 * jt + 4 * g + r; r4[r] = (i >= j) ? acc[r] * fexp(lg * (float)(i - j)) : 0.f; }
            u32x2 w; w.x = pk2(r4[0], r4[1]); w.y = pk2(r4[2], r4[3]);
            *(u32x2*)(F.RCH() + (size_t)ci * RCH_BYTES + RCH_ATT + (it * 2 + (jt >> 1)) * 1024 + (c + 16 * (2 * (jt & 1) + (g >> 1))) * 16 + (g & 1) * 8) = w; }
    }
    __syncthreads();
}

__device__ __forceinline__ void gdn_prep(const Frame& F, int l, int ci) {
    const int tid = F.tid, lane = F.lane, wv = F.wave;
    const int bh = ci >> 5, n = ci & 31, b = bh >> 2, h = bh & 3, m0 = b * SEQ + n * CH;
    LAS bf16_t* raw = (LAS bf16_t*)F.lds;
    LAS float* qf = (LAS float*)F.lds;
    LAS float* kf = qf + 64 * 132;
    LAS bf16_t* wst = (LAS bf16_t*)F.lds;
    LAS float* Am = (LAS float*)(F.lds + 69888);
    LAS float* sm = (LAS float*)(F.lds + 86272);
    LAS float* bcum = sm; LAS float* beta = sm + 64; LAS float* rq = sm + 128; LAS float* rk = sm + 192; LAS float* eb = sm + 256;
    float ab_a = 0.f, ab_b = 0.f;
    if (wv == 0) { const int m = m0 + lane; ab_a = F.AB()[(size_t)m * 8 + h]; ab_b = F.AB()[(size_t)m * 8 + 4 + h]; }
    {
        u32x4 rv[9]; const int pc = tid & 63, col8 = pc * 8;
        const int sc = (pc < 16) ? PC_GQKV + h * DK + col8 : (pc < 32) ? PC_GQKV + 512 + h * DK + (col8 - 128) : PC_GQKV + 1024 + h * DV + (col8 - 256);
#pragma unroll
        for (int it = 0; it < 9; ++it) { const int row = (tid >> 6) + 8 * it, t = n * CH + row - 3; rv[it] = (u32x4){0u, 0u, 0u, 0u};
            if (row < 67 && t >= 0) rv[it] = *(const u32x4*)(F.PROJ() + (size_t)(b * SEQ + t) * NWIN + sc); }
        asm volatile("" ::: "memory");
#pragma unroll
        for (int it = 0; it < 9; ++it) { const int row = (tid >> 6) + 8 * it; if (row < 67) *(LAS u32x4*)(raw + row * 520 + col8) = rv[it]; }
    }
    if (wv == 0) { const float a = ab_a, bb = ab_b;
        const float x = a + F.inp(17)[l * 4 + h]; const float sp = fmaxf(x, 0.f) + log1pf(expf(-fabsf(x)));
        float gg = -expf(F.inp(16)[l * 4 + h]) * sp;
#pragma unroll
        for (int o = 1; o < 64; o <<= 1) { const float t = __shfl_up(gg, o); if (lane >= o) gg += t; }
        bcum[lane] = gg; beta[lane] = 1.f / (1.f + expf(-bb)); eb[lane] = expf(gg); }
    __syncthreads();
    LAS float* vpark = (LAS float*)(F.lds + 88832);
    {   float x[64];
        const int col = (tid < 256) ? 256 + tid : (tid < 384) ? 128 + (tid - 256) : tid - 384;
        const int C = (tid < 256) ? 1024 + h * DV + tid : (tid < 384) ? 512 + h * DK + (tid - 256) : h * DK + (tid - 384);
        const float* cw = F.inp(15) + (size_t)l * 4 * CONVD + C; const float w0 = cw[0], w1 = cw[CONVD], w2 = cw[2 * CONVD], w3 = cw[3 * CONVD];
        float r0 = bf2f(raw[0 * 520 + col]), r1 = bf2f(raw[1 * 520 + col]), r2 = bf2f(raw[2 * 520 + col]);
#pragma unroll
        for (int i0 = 0; i0 < 64; i0 += 16) { unsigned rr[16];
#pragma unroll
            for (int i = 0; i < 16; ++i) rr[i] = raw[(i0 + i + 3) * 520 + col];
            asm volatile("" ::: "memory");
#pragma unroll
            for (int i = 0; i < 16; ++i) { const float r3 = bf2f(rr[i]); x[i0 + i] = siluf_(r0 * w0 + r1 * w1 + r2 * w2 + r3 * w3); r0 = r1; r1 = r2; r2 = r3; } }
    __syncthreads();
    {
        LAS float* dst = (tid < 256) ? vpark + tid : (tid < 384) ? kf + (tid - 256) : qf + (tid - 384); const int pitch = (tid < 256) ? 260 : 132;
#pragma unroll
        for (int i = 0; i < 64; ++i) dst[i * pitch] = x[i]; }
    }
    __syncthreads();
    {   const int i = tid >> 3, p = tid & 7; float sq = 0.f, sk = 0.f;
#pragma unroll
        for (int d = 0; d < 16; ++d) { const float a = qf[i * 132 + 16 * p + d], bq = kf[i * 132 + 16 * p + d]; sq += a * a; sk += bq * bq; }
        sq += __shfl_xor(sq, 1); sq += __shfl_xor(sq, 2); sq += __shfl_xor(sq, 4); sk += __shfl_xor(sk, 1); sk += __shfl_xor(sk, 2); sk += __shfl_xor(sk, 4);
        if (p == 0) { rq[i] = 0.08838834764831845f / sqrtf(sq + EPS); rk[i] = 1.f / sqrtf(sk + EPS); } }
    __syncthreads();
    unsigned char* gch = F.GCH() + (size_t)ci * GCH_BYTES; asm volatile("" : "+s"(gch)); gch = (unsigned char*)(GAS unsigned char*)gch;
#pragma unroll
    for (int rep = 0; rep < 2; ++rep) { const int idx = tid + 512 * rep;
        {   const int i = idx >> 4, s = (idx >> 2) & 3, g = idx & 3; const float sc = rq[i] * eb[i];
            const f32x4 lo = *(const LAS f32x4*)(qf + i * 132 + 32 * s + 4 * g), hi = *(const LAS f32x4*)(qf + i * 132 + 32 * s + 16 + 4 * g);
            *(bf16x8*)(gch + GCH_QD + ((i >> 4) * 4 + s) * 1024 + ((i & 15) + 16 * g) * 16) = pack8(lo * sc, hi * sc); }
        {   const int d = idx >> 3, s = (idx >> 2) & 1, g = idx & 3; const float bl = bcum[63]; float v[8];
#pragma unroll
            for (int j = 0; j < 8; ++j) { const int p = 32 * s + 16 * (j >> 2) + 4 * g + (j & 3); v[j] = kf[p * 132 + d] * rk[p] * fexp(bl - bcum[p]); }
            u32x4 w; w.x = pk2(v[0], v[1]); w.y = pk2(v[2], v[3]); w.z = pk2(v[4], v[5]); w.w = pk2(v[6], v[7]);
            *(u32x4*)(gch + GCH_KDT + ((d >> 4) * 2 + s) * 1024 + ((d & 15) + 16 * g) * 16) = w; }
    }
    if (tid == 0) F.GDCH()[ci] = fexp(bcum[63]);
    CBAR();
    {
        const int c = lane & 15, g = lane >> 4, jt = wv >> 1;
        bf16x8 A[4];
#pragma unroll
        for (int s = 0; s < 4; ++s) A[s] = lds_frag(kf + (16 * jt + c) * 132, s, g, rk[16 * jt + c]);
#pragma unroll
        for (int xx = 0; xx < 2; ++xx) { const int it = 2 * (wv & 1) + xx, i = 16 * it + c;
            f32x4 aq = (f32x4){0.f, 0.f, 0.f, 0.f}, ak = (f32x4){0.f, 0.f, 0.f, 0.f};
            if (it >= jt) {
#pragma unroll
                for (int s = 0; s < 4; ++s) { const bf16x8 Bq = lds_frag(qf + i * 132, s, g, rq[i]), Bk = lds_frag(kf + i * 132, s, g, rk[i]); aq = MFMA16(A[s], Bq, aq); ak = MFMA16(Bk, A[s], ak); CBAR(); }
            }
            const float bi = bcum[i]; float ra[4]; f32x4 rm;
#pragma unroll
            for (int r = 0; r < 4; ++r) { const int j = 16 * jt + 4 * g + r; const float dec = fexp(fminf(bi - bcum[j], 0.f)); ra[r] = (i >= j) ? aq[r] * dec : 0.f; }
            const int j2 = 16 * jt + c; const float bj2 = bcum[j2];
#pragma unroll
            for (int r = 0; r < 4; ++r) { const int i2 = 16 * it + 4 * g + r; rm[r] = (i2 > j2) ? beta[i2] * ak[r] * fexp(fminf(bcum[i2] - bj2, 0.f)) : 0.f; }
            u32x2 w; w.x = pk2(ra[0], ra[1]); w.y = pk2(ra[2], ra[3]);
            *(u32x2*)(gch + GCH_ATT + (it * 2 + (jt >> 1)) * 1024 + (c + 16 * g) * 16 + (jt & 1) * 8) = w;
            *(LAS f32x4*)(Am + j2 * 64 + 16 * it + 4 * g) = rm; }
    }
    __syncthreads();
    if (tid < 384) {
        int z0; asm volatile("v_mov_b32 %0, 0" : "=v"(z0)); const LAS float* Amz = Am + z0; const LAS float* smz = sm + z0;
        f32x2 xv[32];
        if (tid < 256) {
#pragma unroll
            for (int i = 0; i < 64; ++i) xv[i >> 1][i & 1] = vpark[i * 260 + tid] * smz[64 + i];
        } else {
#pragma unroll
            for (int i = 0; i < 64; ++i) xv[i >> 1][i & 1] = kf[i * 132 + (tid - 256)] * (smz[64 + i] * smz[192 + i] * smz[256 + i]);
        }
#pragma unroll
        for (int j = 0; j < 63; ++j) { const float xj = xv[j >> 1][j & 1]; const f32x2 xj2 = (f32x2){xj, xj};
#pragma unroll
            for (int i4 = (j + 1) / 4; i4 < 16; ++i4) { const f32x4 a = *(const LAS f32x4*)(Amz + j * 64 + 4 * i4);
                xv[2 * i4] -= (f32x2){a.x, a.y} * xj2; xv[2 * i4 + 1] -= (f32x2){a.z, a.w} * xj2; if ((i4 & 3) == 3) CBAR(); } CBAR(); }
        float x[64];
#pragma unroll
        for (int i = 0; i < 64; ++i) x[i] = xv[i >> 1][i & 1];
        if (tid < 256) { unsigned char* dstb = (unsigned char*)F.GUT() + (size_t)ci * 32768; asm volatile("" : "+s"(dstb)); dstb = (unsigned char*)(GAS unsigned char*)dstb; unsigned char* dst = dstb + (tid >> 4) * 2048 + (tid & 15) * 16;
#pragma unroll
            for (int q = 0; q < 16; ++q) { u32x2 w; w.x = pk2(x[4 * q], x[4 * q + 1]); w.y = pk2(x[4 * q + 2], x[4 * q + 3]); *(u32x2*)(dst + (q >> 3) * 1024 + (q & 3) * 256 + ((q >> 2) & 1) * 8) = w; } }
        else { const int d = tid - 256;
#pragma unroll
            for (int i = 0; i < 64; ++i) wst[i * 136 + d] = (bf16_t)f2bf(x[i]); }
    }
    __syncthreads();
#pragma unroll
    for (int rep = 0; rep < 2; ++rep) { const int idx = tid + 512 * rep, i = idx >> 4, s = (idx >> 2) & 3, g = idx & 3;
        const u32x2 lo = *(const LAS u32x2*)(wst + i * 136 + 32 * s + 4 * g), hi = *(const LAS u32x2*)(wst + i * 136 + 32 * s + 16 + 4 * g);
        *(u32x4*)(gch + GCH_W + ((i >> 4) * 4 + s) * 1024 + ((i & 15) + 16 * g) * 16) = (u32x4){lo.x, lo.y, hi.x, hi.y}; }
    __syncthreads();
}

__device__ __forceinline__ void mem_attn_unit(const Frame& F, int l, int u) {
    const int lane = F.lane, wv = F.wave, c = lane & 15, g = lane >> 4;
    const int bh = u >> 4, qb = u & 15, b = bh >> 2, h = bh & 3, mq = b * SEQ + qb * 128 + wv * 16;
    const unsigned char* kf = (const unsigned char*)F.MK() + ((((size_t)l * NB + b) * NH + h) << 17) + lane * 16;
    const unsigned char* vf = (const unsigned char*)F.MVT() + ((((size_t)l * NB + b) * NH + h) << 17) + lane * 16;
    LAS unsigned char* ring = F.lds;
#define ATT_DMA(ch_) do { const unsigned char* src_ = ((ch_) < 4 ? kf + (ch_) * 32768 : vf + ((ch_) - 4) * 32768); LAS unsigned char* dst_ = ring + ((ch_) % 3) * 32768; \
        _Pragma("unroll") for (int k_ = 0; k_ < 4; ++k_) __builtin_amdgcn_global_load_lds((const unsigned*)(src_ + (wv + 8 * k_) * 1024), (LAS unsigned*)(dst_ + (wv + 8 * k_) * 1024), 16, 0, 0); } while (0)
#define ATT_WAIT(n_) do { if ((n_) == 4) asm volatile("s_waitcnt vmcnt(4)" ::: "memory"); else if ((n_) == 8) asm volatile("s_waitcnt vmcnt(8)" ::: "memory"); else asm volatile("s_waitcnt vmcnt(12)" ::: "memory"); \
        __builtin_amdgcn_s_barrier(); asm volatile("" ::: "memory"); } while (0)
    ATT_DMA(0); ATT_DMA(1);
    bf16x8 Qf[8]; { const unsigned qo = ((unsigned)(mq + c) * NWIN + PC_MQ + h * 256) * 2u;
#pragma unroll
        for (int s = 0; s < 8; ++s) Qf[s] = ldnat(F.PROJ(), qo, s, g); }
    asm volatile("s_waitcnt vmcnt(0)" ::: "memory");
    f32x4 sacc[16]; bf16x8 Pf[8]; float inv = 1.f;
    bf16_t* obase = F.OBR() + 2 * OBR_STRIDE; const unsigned oo = ((unsigned)(mq + c) * D + h * 256 + 4 * g) * 2u;
#pragma unroll
    for (int ch = 0; ch < 8; ++ch) {
        ATT_WAIT((ch + 1 < 8 ? 4 : 0) + (ch - 1 >= 4 ? 4 : 0) + (ch - 2 >= 4 ? 4 : 0));
        if (ch + 2 < 8) ATT_DMA(ch + 2);
        const LAS unsigned char* Bq = ring + (ch % 3) * 32768 + lane * 16;
        if (ch < 4) {
#pragma unroll
            for (int k4 = 0; k4 < 4; ++k4) { f32x4 a0 = (f32x4){0.f, 0.f, 0.f, 0.f};
#pragma unroll
                for (int s = 0; s < 8; ++s) a0 = MFMA16(*(const LAS bf16x8*)(Bq + (k4 * 8 + s) * 1024), Qf[s], a0);
                sacc[4 * ch + k4] = a0; }
            if (ch == 3) {
                float mx = -3.0e38f;
#pragma unroll
                for (int kt = 0; kt < 16; ++kt)
#pragma unroll
                    for (int r = 0; r < 4; ++r) mx = fmaxf(mx, sacc[kt][r]);
                mx = fmaxf(mx, __shfl_xor(mx, 16)); mx = fmaxf(mx, __shfl_xor(mx, 32));
                float sum = 0.f; const float sc = 0.0625f * 1.4426950408889634f;
#pragma unroll
                for (int kt = 0; kt < 16; ++kt)
#pragma unroll
                    for (int r = 0; r < 4; ++r) { const float p = __builtin_amdgcn_exp2f((sacc[kt][r] - mx) * sc); sacc[kt][r] = p; sum += p; }
                sum += __shfl_xor(sum, 16); sum += __shfl_xor(sum, 32);
                inv = 1.f / sum;
#pragma unroll
                for (int ks = 0; ks < 8; ++ks) Pf[ks] = pack8(sacc[2 * ks], sacc[2 * ks + 1]);
            }
        } else {
#pragma unroll
            for (int e4 = 0; e4 < 4; ++e4) { f32x4 a0 = (f32x4){0.f, 0.f, 0.f, 0.f}; const int et = 4 * (ch - 4) + e4;
#pragma unroll
                for (int ks = 0; ks < 8; ++ks) a0 = MFMA16(*(const LAS bf16x8*)(Bq + (e4 * 8 + ks) * 1024), Pf[ks], a0);
                u32x2 w; w.x = pk2(a0[0] * inv, a0[1] * inv); w.y = pk2(a0[2] * inv, a0[3] * inv);
                *(u32x2*)((char*)obase + (oo + 32u * et)) = w; }
        }
        asm volatile("" ::: "memory");
    }
    asm volatile("s_waitcnt lgkmcnt(0)" ::: "memory"); __builtin_amdgcn_s_barrier(); asm volatile("" ::: "memory");
#undef ATT_DMA
#undef ATT_WAIT
}

struct ScanPF { bf16x8 vb[2][2]; float dch; };
#define RAW_BAR() do { asm volatile("s_waitcnt lgkmcnt(0)" ::: "memory"); __builtin_amdgcn_s_barrier(); asm volatile("" ::: "memory"); } while (0)
template <bool GDN> __device__ __forceinline__ void scan_prefetch(const Frame& F, ScanPF& P, int bh, int n, int lane, int wv, int c, int g, int colg, float dch_ret) {
    const int b = bh >> 2, e0 = 32 * wv;
    if (GDN) { const unsigned char* up = (const unsigned char*)F.GUT() + (size_t)(bh * 32 + n) * 32768 + (2 * wv) * 2048 + lane * 16;
#pragma unroll
        for (int k = 0; k < 4; ++k) __builtin_amdgcn_global_load_lds((const unsigned*)(up + k * 1024), (LAS unsigned*)(F.lds + 2 * 57344 + 4096 + wv * 4096 + k * 1024), 16, 0, 0);
        unsigned dci = (unsigned)(bh * 32 + n) * 4u; asm volatile("" : "+v"(dci)); P.dch = *(const float*)((const char*)F.GDCH() + dci);
    } else { const unsigned char* vp = F.RVT() + (size_t)(bh * 32 + n) * 32768 + (2 * wv) * 2048 + lane * 16;
#pragma unroll
        for (int s = 0; s < 2; ++s) { P.vb[s][0] = *(const bf16x8*)(vp + s * 1024); P.vb[s][1] = *(const bf16x8*)(vp + 2048 + s * 1024); }
        P.dch = dch_ret; }
}
template <bool GDN> __device__ __forceinline__ void scan_touch(ScanPF& P) {
    asm volatile("" : "+v"(P.dch));
    if (GDN) {}
    else asm volatile("" : "+v"(P.vb[0][0]), "+v"(P.vb[0][1]), "+v"(P.vb[1][0]), "+v"(P.vb[1][1]));
}
template <bool GDN, int BUF> __device__ __forceinline__ void scan_chunk(const Frame& F, f32x4 (&S)[8][2], ScanPF& cur, ScanPF& nxt, int bh, int n, int h, int colg, float dch_ret, const float* gnp, bf16_t* obr) {
    const int lane = F.lane, wv = F.wave, c = lane & 15, g = lane >> 4, b = bh >> 2, e0 = 32 * wv;
    constexpr int CHB = GDN ? GCH_BYTES : RCH_BYTES, NBLK = CHB / 1024, OQD = GDN ? GCH_QD : RCH_QD, OATT = GDN ? GCH_ATT : RCH_ATT, OKDT = GDN ? GCH_KDT : RCH_KDT, LBUF = 57344;
    LAS unsigned char* lbuf = F.lds; LAS float* ssq = (LAS float*)(F.lds + 2 * LBUF);
    const LAS unsigned char* Bq = lbuf + BUF * LBUF + lane * 16;
#define LFRAG(off_) (*(const LAS bf16x8*)(Bq + (off_)))
    scan_touch<GDN>(cur);
    f32x4 vn[4][2];
    if (GDN) {
        const LAS unsigned char* ul = F.lds + 2 * LBUF + 4096 + wv * 4096 + lane * 16;
#pragma unroll
        for (int cb = 0; cb < 2; ++cb)
#pragma unroll
            for (int rp = 0; rp < 2; ++rp) { const u32x4 uu = *(const LAS u32x4*)(ul + (cb * 2 + rp) * 1024);
                vn[2 * rp][cb] = (f32x4){bf2f(uu.x & 0xffffu), bf2f(uu.x >> 16), bf2f(uu.y & 0xffffu), bf2f(uu.y >> 16)};
                vn[2 * rp + 1][cb] = (f32x4){bf2f(uu.z & 0xffffu), bf2f(uu.z >> 16), bf2f(uu.w & 0xffffu), bf2f(uu.w >> 16)}; }
        asm volatile("s_waitcnt lgkmcnt(0)" ::: "memory");
    }
    if (n + 1 < NCH) {
        const unsigned char* chb = (GDN ? F.GCH() : F.RCH()) + (size_t)(bh * 32 + n + 1) * CHB + lane * 16;
#pragma unroll
        for (int k = 0; k < (NBLK + 7) / 8; ++k) { const int kb = wv + 8 * k; if (kb < NBLK) __builtin_amdgcn_global_load_lds((const unsigned*)(chb + kb * 1024), (LAS unsigned*)(lbuf + (BUF ^ 1) * LBUF + kb * 1024), 16, 0, 0); }
        CBAR();
        scan_prefetch<GDN>(F, nxt, bh, n + 1, lane, wv, c, g, colg, dch_ret);
    }
    CBAR();
    bf16x8 Sb[4][2];
#pragma unroll
    for (int s = 0; s < 4; ++s) { Sb[s][0] = pack8(S[2 * s][0], S[2 * s + 1][0]); Sb[s][1] = pack8(S[2 * s][1], S[2 * s + 1][1]); }
    bf16x8 Vb[2][2];
    if (GDN) {
#pragma unroll
        for (int rt = 0; rt < 4; ++rt) { f32x4 p0 = (f32x4){0.f, 0.f, 0.f, 0.f}, p1 = p0;
#pragma unroll
            for (int s = 0; s < 4; ++s) { const bf16x8 A = LFRAG(GCH_W + (rt * 4 + s) * 1024); p0 = MFMA16(A, Sb[s][0], p0); p1 = MFMA16(A, Sb[s][1], p1); }
            vn[rt][0] -= p0; vn[rt][1] -= p1; if (rt & 1) CBAR(); }
#pragma unroll
        for (int s = 0; s < 2; ++s) { Vb[s][0] = pack8(vn[2 * s][0], vn[2 * s + 1][0]); Vb[s][1] = pack8(vn[2 * s][1], vn[2 * s + 1][1]); }
    } else {
#pragma unroll
        for (int s = 0; s < 2; ++s) { Vb[s][0] = cur.vb[s][0]; Vb[s][1] = cur.vb[s][1]; }
    }
    CBAR();
    u32x2 gw[4][2];
    {   unsigned m0g = (unsigned)(b * SEQ + n * CH + c); asm volatile("" : "+v"(m0g)); const unsigned pb = (m0g * NWIN + colg + e0 + 4 * g) * 2u; const char* PROJp = (const char*)F.PROJ();
#pragma unroll
        for (int rt = 0; rt < 4; ++rt) { gw[rt][0] = *(const u32x2*)(PROJp + (pb + (unsigned)(16 * rt) * NWIN * 2u)); gw[rt][1] = *(const u32x2*)(PROJp + (pb + (unsigned)(16 * rt) * NWIN * 2u + 32u)); } }
    CBAR();
    f32x4 OT[4][2];
#pragma unroll
    for (int rt = 0; rt < 4; ++rt) { f32x4 o0 = (f32x4){0.f, 0.f, 0.f, 0.f}, o1 = o0;
#pragma unroll
        for (int s = 0; s < 4; ++s) { const bf16x8 Bf = LFRAG(OQD + (rt * 4 + s) * 1024); o0 = MFMA16(Sb[s][0], Bf, o0); o1 = MFMA16(Sb[s][1], Bf, o1); }
#pragma unroll
        for (int s = 0; s < 2; ++s) { const bf16x8 Bf = LFRAG(OATT + (rt * 2 + s) * 1024); o0 = MFMA16(Vb[s][0], Bf, o0); o1 = MFMA16(Vb[s][1], Bf, o1); }
        OT[rt][0] = o0; OT[rt][1] = o1; if (rt & 1) CBAR(); }
    const float dch = cur.dch;
#pragma unroll
    for (int t = 0; t < 8; ++t) { f32x4 s0 = S[t][0] * dch, s1 = S[t][1] * dch;
#pragma unroll
        for (int s = 0; s < 2; ++s) { const bf16x8 A = LFRAG(OKDT + (t * 2 + s) * 1024); s0 = MFMA16(A, Vb[s][0], s0); s1 = MFMA16(A, Vb[s][1], s1); }
        S[t][0] = s0; S[t][1] = s1; if ((t & 3) == 3) CBAR(); }
#pragma unroll
    for (int rt = 0; rt < 4; ++rt) { float q = 0.f;
#pragma unroll
        for (int r = 0; r < 4; ++r) q += OT[rt][0][r] * OT[rt][0][r] + OT[rt][1][r] * OT[rt][1][r];
        q += __shfl_xor(q, 16); q += __shfl_xor(q, 32);
        if (g == 0) ssq[(BUF * 8 + wv) * 64 + 16 * rt + c] = q; }
    RAW_BAR();
    {   unsigned m0o = (unsigned)(b * SEQ + n * CH + c); asm volatile("" : "+v"(m0o));
        const unsigned ob = (m0o * D + h * DV + e0 + 4 * g) * 2u;
#pragma unroll
        for (int rt = 0; rt < 4; ++rt) { float tot = 0.f;
#pragma unroll
            for (int w = 0; w < 8; ++w) tot += ssq[(BUF * 8 + w) * 64 + 16 * rt + c];
            const float rstd = 1.f / sqrtf(tot * (1.f / DV) + EPS);
#pragma unroll
            for (int cb = 0; cb < 2; ++cb) { const u32x2 gq = gw[rt][cb]; const f32x4 o = OT[rt][cb] * rstd;
                const float r0 = o[0] * bf2f(gq.x & 0xffffu), r1 = o[1] * bf2f(gq.x >> 16), r2 = o[2] * bf2f(gq.y & 0xffffu), r3 = o[3] * bf2f(gq.y >> 16);
                u32x2 w2; w2.x = pk2(r0, r1); w2.y = pk2(r2, r3);
                *(u32x2*)((char*)obr + (ob + (unsigned)(16 * rt) * D * 2u + 32u * cb)) = w2; } } }
    asm volatile("s_waitcnt vmcnt(8)" ::: "memory"); RAW_BAR();
#undef LFRAG
}
template <bool GDN> __device__ __forceinline__ void scan_bh(const Frame& F, int l, int bh) {
    const int lane = F.lane, wv = F.wave, c = lane & 15, g = lane >> 4, b = bh >> 2, h = bh & 3, e0 = 32 * wv;
    constexpr int CHB = GDN ? GCH_BYTES : RCH_BYTES, NBLK = CHB / 1024;
    const float lg = log1pf(-exp2f(-5.0f - (float)h)); const float dch_ret = fexp(lg * 64.f);
    f32x4 S[8][2];
#pragma unroll
    for (int t = 0; t < 8; ++t) { S[t][0] = (f32x4){0.f, 0.f, 0.f, 0.f}; S[t][1] = (f32x4){0.f, 0.f, 0.f, 0.f}; }
    const int colg = (GDN ? PC_GZ : PC_RG) + h * DV;
    bf16_t* obr = F.OBR() + (GDN ? OBR_STRIDE : 0);
    const float* gnp = F.inp(18) + l * DV;
    ScanPF PA, PB;
    {   const unsigned char* chb = (GDN ? F.GCH() : F.RCH()) + (size_t)(bh * 32) * CHB + lane * 16;
#pragma unroll
        for (int k = 0; k < (NBLK + 7) / 8; ++k) { const int kb = wv + 8 * k; if (kb < NBLK) __builtin_amdgcn_global_load_lds((const unsigned*)(chb + kb * 1024), (LAS unsigned*)(F.lds + kb * 1024), 16, 0, 0); } }
    scan_prefetch<GDN>(F, PA, bh, 0, lane, wv, c, g, colg, dch_ret);
    asm volatile("s_waitcnt vmcnt(0)" ::: "memory"); RAW_BAR();
    for (int n = 0; n < NCH; n += 2) {
        asm volatile("" ::: "memory");
        scan_chunk<GDN, 0>(F, S, PA, PB, bh, n, h, colg, dch_ret, gnp, obr);
        scan_chunk<GDN, 1>(F, S, PB, PA, bh, n + 1, h, colg, dch_ret, gnp, obr);
    }
    float* so = F.out + (GDN ? O_SGP : O_SRP) + ((size_t)(l * NB + b) * NH + h) * (size_t)(DK * DV);
    unsigned sbo = (unsigned)((4 * g) * DV + e0 + c) * 4u; asm volatile("" : "+v"(sbo));
#pragma unroll
    for (int t = 0; t < 8; ++t)
#pragma unroll
        for (int cb = 0; cb < 2; ++cb)
#pragma unroll
            for (int r = 0; r < 4; ++r) *(float*)((char*)so + (sbo + (unsigned)((16 * t + r) * DV + 16 * cb) * 4u)) = S[t][cb][r];
}
#undef RAW_BAR

template <bool GDN> __device__ __forceinline__ void sample_step(const Frame& F, int l, int item) {
    const int tid = F.tid, lane = F.lane, wv = F.wave, s = item >> 2, h = item & 3; const size_t m = (size_t)(MP + s);
    LAS float* qv = (LAS float*)F.lds;
    LAS float* kv = qv + 128;
    LAS float* vv = qv + 256;
    LAS float* sc = qv + 512;
    LAS float* partq = qv + 1024;
    LAS float* partk = partq + 2048;
    float dec, beta_ = 1.f;
    if (GDN) {
        const int C = (tid < 256) ? 1024 + h * DV + tid : (tid < 384) ? 512 + h * DK + (tid - 256) : h * DK + (tid - 384);
        const float* cbp = F.inp(5) + ((size_t)(l * MS + s) * 3) * CONVD + C; const float* cw = F.inp(15) + (size_t)l * 4 * CONVD + C;
        const float c0 = cbp[0], c1 = cbp[CONVD], c2 = cbp[2 * CONVD], rw = bf2f(F.PROJ()[m * NWIN + PC_GQKV + C]);
        const float val = siluf_(c0 * cw[0] + c1 * cw[CONVD] + c2 * cw[2 * CONVD] + rw * cw[3 * CONVD]);
        float* cvo = F.out + O_CVS + ((size_t)(l * MS + s) * 3) * CONVD + C; cvo[0] = c1; cvo[CONVD] = c2; cvo[2 * CONVD] = rw;
        if (tid < 256) vv[tid] = val; else if (tid < 384) kv[tid - 256] = val; else qv[tid - 384] = val;
        __syncthreads();
        if (wv < 2) { LAS float* p = (wv == 0) ? qv : kv; const float a = p[lane], bq = p[lane + 64]; const float ss = wave_sum(a * a + bq * bq);
            if (lane == 0) sc[wv] = (wv == 0) ? 0.08838834764831845f / sqrtf(ss + EPS) : 1.f / sqrtf(ss + EPS); }
        __syncthreads();
        const float rq = sc[0], rk = sc[1];
        __syncthreads();
        if (tid < 128) { qv[tid] *= rq; kv[tid] *= rk; }
        const float a = F.AB()[m * 8 + h], bb = F.AB()[m * 8 + 4 + h]; const float x = a + F.inp(17)[l * 4 + h]; const float sp = fmaxf(x, 0.f) + log1pf(expf(-fabsf(x)));
        dec = expf(-expf(F.inp(16)[l * 4 + h]) * sp); beta_ = 1.f / (1.f + expf(-bb));
    } else {
        if (tid < 64) { const int d = tid; const bf16_t* qrow = F.PROJ() + m * NWIN + PC_RQ + h * DK; const bf16_t* krow = F.PROJ() + m * NWIN + PC_RK + h * DK;
            const float cs = F.COS()[2048 * 64 + d], sn = F.SIN()[2048 * 64 + d]; const float q1 = bf2f(qrow[d]), q2 = bf2f(qrow[d + 64]), k1 = bf2f(krow[d]), k2 = bf2f(krow[d + 64]);
            qv[d] = q1 * cs - q2 * sn; qv[d + 64] = q1 * sn + q2 * cs; kv[d] = (k1 * cs - k2 * sn) * 0.08838834764831845f; kv[d + 64] = (k1 * sn + k2 * cs) * 0.08838834764831845f; }
        else if (tid < 320) vv[tid - 64] = bf2f(F.PROJ()[m * NWIN + PC_RV + h * DV + (tid - 64)]);
        dec = 1.f - exp2f(-5.0f - (float)h);
    }
    __syncthreads();
    float qk = 0.f;
#pragma unroll 8
    for (int d = 0; d < 128; ++d) qk += qv[d] * kv[d];
    const int e4 = lane * 4, dq = wv;
    const size_t sofs = ((size_t)(l * MS + s) * NH + h) * (size_t)(DK * DV);
    const float* S0 = F.inp(GDN ? 4 : 3) + sofs + (size_t)(16 * dq) * DV + e4;
    f32x4 st[16]; f32x4 aq = (f32x4){0.f, 0.f, 0.f, 0.f}, ak = aq;
#pragma unroll
    for (int i = 0; i < 16; ++i) st[i] = *(const f32x4*)(S0 + (size_t)i * DV);
#pragma unroll
    for (int i = 0; i < 16; ++i) { aq += st[i] * qv[16 * dq + i]; if (GDN) ak += st[i] * kv[16 * dq + i]; }
    *(LAS f32x4*)(partq + dq * 256 + e4) = aq; if (GDN) *(LAS f32x4*)(partk + dq * 256 + e4) = ak;
    __syncthreads();
    f32x4 qS = (f32x4){0.f, 0.f, 0.f, 0.f}, kS = qS;
#pragma unroll
    for (int w = 0; w < 8; ++w) { qS += *(const LAS f32x4*)(partq + w * 256 + e4); if (GDN) kS += *(const LAS f32x4*)(partk + w * 256 + e4); }
    const f32x4 v4 = *(const LAS f32x4*)(vv + e4);
    const f32x4 vnew = GDN ? (v4 - kS * dec) * beta_ : v4;
    const f32x4 o = qS * dec + vnew * qk;
    float* S1 = F.out + (GDN ? O_SGS : O_SRS) + sofs + (size_t)(16 * dq) * DV + e4;
#pragma unroll
    for (int i = 0; i < 16; ++i) *(f32x4*)(S1 + (size_t)i * DV) = st[i] * dec + vnew * kv[16 * dq + i];
    const float ssq = wave_sum((o.x * o.x + o.y * o.y) + (o.z * o.z + o.w * o.w));
    if (dq == 0) { const float rstd = 1.f / sqrtf(ssq * (1.f / DV) + EPS); const bf16_t* gp = F.PROJ() + m * NWIN + (GDN ? PC_GZ : PC_RG) + h * DV + e4; float r4[4];
#pragma unroll
        for (int j = 0; j < 4; ++j) r4[j] = o[j] * rstd * bf2f(gp[j]);
        u32x2 w; w.x = pk2(r4[0], r4[1]); w.y = pk2(r4[2], r4[3]);
        *(u32x2*)(F.OBR() + (GDN ? OBR_STRIDE : 0) + m * D + h * DV + e4) = w; }
    __syncthreads();
}
__device__ __forceinline__ void sample_attn(const Frame& F, int l, int item) {
    const int tid = F.tid, lane = F.lane, wv = F.wave, s = item >> 2, h = item & 3; const size_t m = (size_t)(MP + s);
    LAS float* scs = (LAS float*)F.lds;
    LAS float* part = scs + 512;
    LAS float* sinv = scs + 256;
    f32x4 q4; { const u32x2 qw = *(const u32x2*)(F.PROJ() + m * NWIN + PC_MQ + h * 256 + lane * 4); q4 = (f32x4){bf2f(qw.x & 0xffffu), bf2f(qw.x >> 16), bf2f(qw.y & 0xffffu), bf2f(qw.y >> 16)}; }
    const float* Kb = F.inp(6) + (((size_t)(l * MS + s) * NMEM) * NH + h) * 256 + lane * 4;
    const float* Vb = F.inp(7) + (((size_t)(l * MS + s) * NMEM) * NH + h) * 256 + lane * 4;
    float myscore = 0.f;
#pragma unroll
    for (int k8 = 0; k8 < 4; ++k8) { f32x4 kk[8];
#pragma unroll
        for (int j = 0; j < 8; ++j) kk[j] = *(const f32x4*)(Kb + (size_t)(32 * wv + 8 * k8 + j) * (NH * 256));
#pragma unroll
        for (int j = 0; j < 8; ++j) { const float d = wave_sum((kk[j].x * q4.x + kk[j].y * q4.y) + (kk[j].z * q4.z + kk[j].w * q4.w)); if (lane == 8 * k8 + j) myscore = d; } }
    if (lane < 32) scs[32 * wv + lane] = myscore * 0.0625f;
    __syncthreads();
    if (wv == 0) { const f32x4 s4 = *(const LAS f32x4*)(scs + 4 * lane); float mx = fmaxf(fmaxf(s4.x, s4.y), fmaxf(s4.z, s4.w));
#pragma unroll
        for (int o = 1; o < 64; o <<= 1) mx = fmaxf(mx, __shfl_xor(mx, o));
        const f32x4 p = (f32x4){fexp(s4.x - mx), fexp(s4.y - mx), fexp(s4.z - mx), fexp(s4.w - mx)}; const float sum = wave_sum((p.x + p.y) + (p.z + p.w));
        *(LAS f32x4*)(scs + 4 * lane) = p; if (lane == 0) sinv[0] = 1.f / sum; }
    __syncthreads();
    f32x4 acc = (f32x4){0.f, 0.f, 0.f, 0.f};
#pragma unroll
    for (int k8 = 0; k8 < 4; ++k8) { f32x4 vv[8];
#pragma unroll
        for (int j = 0; j < 8; ++j) vv[j] = *(const f32x4*)(Vb + (size_t)(32 * wv + 8 * k8 + j) * (NH * 256));
#pragma unroll
        for (int j = 0; j < 8; ++j) acc += vv[j] * scs[32 * wv + 8 * k8 + j]; }
    *(LAS f32x4*)(part + wv * 256 + lane * 4) = acc;
    __syncthreads();
    if (wv == 0) { f32x4 o = (f32x4){0.f, 0.f, 0.f, 0.f};
#pragma unroll
        for (int w = 0; w < 8; ++w) o += *(const LAS f32x4*)(part + w * 256 + lane * 4);
        o = o * sinv[0]; u32x2 w2; w2.x = pk2(o.x, o.y); w2.y = pk2(o.z, o.w);
        *(u32x2*)(F.OBR() + 2 * OBR_STRIDE + m * D + h * 256 + lane * 4) = w2; }
    __syncthreads();
}

struct SEpiF32 { static constexpr int NBF = 1, NSEG = 1; float* C;
    __device__ __forceinline__ int brow(int st, int) const { return 16 * st; }
    __device__ __forceinline__ void fold(f32x4 (&tot)[1], const f32x4 (&acc)[1], int, int, int, int) const { tot[0] = acc[0]; }
    __device__ __forceinline__ void store(const f32x4 (&tot)[1], int row, int st, int g) const { *(f32x4*)(C + (size_t)row * D + 16 * st + 4 * g) = tot[0]; } };
struct SEpiBf16 { static constexpr int NBF = 1, NSEG = 1; bf16_t* O; int ldc;
    __device__ __forceinline__ int brow(int st, int) const { return 16 * st; }
    __device__ __forceinline__ void fold(f32x4 (&tot)[1], const f32x4 (&acc)[1], int, int, int, int) const { tot[0] = acc[0]; }
    __device__ __forceinline__ void store(const f32x4 (&tot)[1], int row, int st, int g) const { u32x2 w; w.x = pk2(tot[0][0], tot[0][1]); w.y = pk2(tot[0][2], tot[0][3]); *(u32x2*)(O + (size_t)row * ldc + 16 * st + 4 * g) = w; } };
struct SEpiProj { static constexpr int NBF = 1, NSEG = 1; bf16_t* O; const float* gn; const float* rs;
    __device__ __forceinline__ int brow(int st, int) const { return 16 * st; }
    __device__ __forceinline__ void fold(f32x4 (&tot)[1], const f32x4 (&acc)[1], int, int, int, int) const { tot[0] = acc[0]; }
    __device__ __forceinline__ void store(const f32x4 (&tot)[1], int row, int st, int g) const { const int col = 16 * st + 4 * g; f32x4 v = tot[0] * rs[row];
        if (col >= PC_RG && col < PC_RG + 1024) {
#pragma unroll
            for (int q = 0; q < 4; ++q) v[q] = siluf_(v[q]); }
        else if (col >= PC_GZ && col < PC_GZ + 1024) {
#pragma unroll
            for (int q = 0; q < 4; ++q) v[q] = siluf_(v[q]) * gn[(col + q) & 255]; }
        u32x2 w; w.x = pk2(v[0], v[1]); w.y = pk2(v[2], v[3]); *(u32x2*)(O + (size_t)row * NWIN + col) = w; } };
struct SEpiSwiGLU { static constexpr int NBF = 2, NSEG = 1; bf16_t* O; const float* rs;
    __device__ __forceinline__ int brow(int st, int bfi) const { return (st >> 3) * 256 + (st & 7) * 16 + 128 * bfi; }
    __device__ __forceinline__ void fold(f32x4 (&tot)[2], const f32x4 (&acc)[2], int, int, int, int) const { tot[0] = acc[0]; tot[1] = acc[1]; }
    __device__ __forceinline__ void store(const f32x4 (&tot)[2], int row, int st, int g) const { float r[4];
#pragma unroll
        for (int j = 0; j < 4; ++j) r[j] = siluf_(tot[0][j] * rs[row]) * (tot[1][j] * rs[row]);
        u32x2 w; w.x = pk2(r[0], r[1]); w.y = pk2(r[2], r[3]); *(u32x2*)(O + (size_t)row * DFF + 16 * st + 4 * g) = w; } };
struct SEpiBranch { static constexpr int NBF = 1, NSEG = 3; bf16_t* O; const bf16_t* proj;
    __device__ __forceinline__ int brow(int st, int) const { return 16 * st; }
    __device__ __forceinline__ void fold(f32x4 (&tot)[1], const f32x4 (&acc)[1], int seg, int row, int st, int g) const {
        const u32x2 gw = *(const u32x2*)(proj + (size_t)row * NWIN + PC_GATE + seg * D + 16 * st + 4 * g);
        const f32x4 gt = (f32x4){sigmoidf_(bf2f(gw.x & 0xffffu)), sigmoidf_(bf2f(gw.x >> 16)), sigmoidf_(bf2f(gw.y & 0xffffu)), sigmoidf_(bf2f(gw.y >> 16))};
        tot[0] = (seg == 0) ? gt * acc[0] : tot[0] + gt * acc[0]; }
    __device__ __forceinline__ void store(const f32x4 (&tot)[1], int row, int st, int g) const { u32x2 w; w.x = pk2(tot[0][0], tot[0][1]); w.y = pk2(tot[0][2], tot[0][3]); *(u32x2*)(O + (size_t)row * D + 16 * st + 4 * g) = w; } };
template <int K, class EpiS, int RT = 4, int NS = 1> __device__ __forceinline__ void small_gemm(const Frame& F, const bf16_t* A, size_t aseg, const bf16_t* Bt, size_t bseg, int nstrips, int first, int count, const EpiS& E) {
    static_assert(RT == 4 ? NS == 1 : (NS == 1 || NS == 4), "small_gemm shapes");
    const int j = (F.bid - first + F.G) % F.G; if (j >= count) return;
    constexpr int NBF = EpiS::NBF, KQ = K / 4, NKS = KQ / 32, BATCH = (RT == 1 && NS == 1 && NBF == 1) ? NKS : (NBF == 2) ? 4 : 8, RQ = 4 / RT, NT = RT * NS;
    const int lane = F.lane, wv = F.wave, c = lane & 15, g = lane >> 4, rh = wv & 1, kq = wv >> 1;
    LAS f32x4* red = (LAS f32x4*)F.lds;
    for (int it = j; it < (nstrips / NS) * RQ; it += count) {
        const int sg = it / RQ, rq = it - sg * RQ, t0 = (RT == 4) ? rh * 4 : rq * 2 + rh;
        f32x4 tot[NBF][NT];
#pragma unroll
        for (int seg = 0; seg < EpiS::NSEG; ++seg) {
            f32x4 acc[NBF][NT];
#pragma unroll
            for (int q = 0; q < NBF; ++q)
#pragma unroll
                for (int t = 0; t < NT; ++t) acc[q][t] = (f32x4){0.f, 0.f, 0.f, 0.f};
            const char* ap = (const char*)(A + seg * aseg); unsigned ao = ((unsigned)(MP + t0 * 16 + c) * K + kq * KQ + 8 * g) * 2u; asm volatile("" : "+v"(ao));
            const char* bp = (const char*)(Bt + seg * bseg); unsigned bo[NBF][NS];
#pragma unroll
            for (int q = 0; q < NBF; ++q)
#pragma unroll
                for (int n = 0; n < NS; ++n) { bo[q][n] = ((unsigned)(E.brow(sg * NS + n, q) + c) * K + kq * KQ + 8 * g) * 2u; asm volatile("" : "+v"(bo[q][n])); }
#pragma unroll
            for (int ks0 = 0; ks0 < NKS; ks0 += BATCH) {
                bf16x8 af[RT][BATCH], bfr[NBF][NS][BATCH];
#pragma unroll
                for (int s = 0; s < BATCH; ++s) if (ks0 + s < NKS) {
#pragma unroll
                    for (int q = 0; q < NBF; ++q)
#pragma unroll
                        for (int n = 0; n < NS; ++n) bfr[q][n][s] = *(const bf16x8*)(bp + (bo[q][n] + (unsigned)(ks0 + s) * 64u));
#pragma unroll
                    for (int t = 0; t < RT; ++t) af[t][s] = *(const bf16x8*)(ap + (ao + (unsigned)(t * 16 * K * 2) + (unsigned)(ks0 + s) * 64u)); }
#pragma unroll
                for (int s = 0; s < BATCH; ++s) if (ks0 + s < NKS) {
#pragma unroll
                    for (int q = 0; q < NBF; ++q)
#pragma unroll
                        for (int n = 0; n < NS; ++n)
#pragma unroll
                            for (int t = 0; t < RT; ++t) acc[q][n * RT + t] = MFMA16(bfr[q][n][s], af[t][s], acc[q][n * RT + t]); }
                CBAR();
            }
#pragma unroll
            for (int n = 0; n < NS; ++n)
#pragma unroll
                for (int t = 0; t < RT; ++t) { f32x4 a1[NBF], t1[NBF];
#pragma unroll
                    for (int q = 0; q < NBF; ++q) { a1[q] = acc[q][n * RT + t]; t1[q] = tot[q][n * RT + t]; }
                    E.fold(t1, a1, seg, MP + (t0 + t) * 16 + c, sg * NS + n, g);
#pragma unroll
                    for (int q = 0; q < NBF; ++q) tot[q][n * RT + t] = t1[q]; }
        }
#pragma unroll
        for (int q = 0; q < NBF; ++q)
#pragma unroll
            for (int t = 0; t < NT; ++t) red[((q * 8 + wv) * NT + t) * 64 + lane] = tot[q][t];
        __syncthreads();
        if (NT == 4 || kq == 0) {
            const int tf = (NT == 4) ? kq : 0; f32x4 fin[NBF];
#pragma unroll
            for (int q = 0; q < NBF; ++q) { f32x4 s4 = (f32x4){0.f, 0.f, 0.f, 0.f};
#pragma unroll
                for (int k2 = 0; k2 < 4; ++k2) s4 += red[((q * 8 + rh + 2 * k2) * NT + tf) * 64 + lane];
                fin[q] = s4; }
            E.store(fin, MP + (t0 + (RT == 4 ? tf : 0)) * 16 + c, sg * NS + (RT == 4 ? 0 : tf), g); }
        __syncthreads();
    }
}

__device__ __forceinline__ const void* opaque_ptr(const void* p) { unsigned lo = __builtin_amdgcn_readfirstlane((unsigned)(size_t)p), hi = __builtin_amdgcn_readfirstlane((unsigned)((size_t)p >> 32));
    asm volatile("" : "+s"(lo), "+s"(hi)); return (const void*)(const GAS void*)(((size_t)hi << 32) | lo); }
__device__ __forceinline__ void stagger(int bid, int step_ticks) { const unsigned long long t0 = __builtin_amdgcn_s_memrealtime(), d = (unsigned long long)((bid >> 3) & 3) * (unsigned long long)step_ticks;
    while (__builtin_amdgcn_s_memrealtime() - t0 < d) __builtin_amdgcn_s_sleep(8); }
#ifndef STAG_TICKS
#define STAG_TICKS 0
#endif
#ifndef EN_SITES
#define EN_SITES 0x7ff
#endif
#define SITE(k) ((EN_SITES >> (k)) & 1)
#ifndef EN_PP
#define EN_PP 0xf
#endif
#ifndef EN_SP
#define EN_SP 0x1f
#endif
#define PP(k) ((EN_PP >> (k)) & 1)
#define SP(k) ((EN_SP >> (k)) & 1)
constexpr int NPHASE = 25;
__global__ void __launch_bounds__(NWAVES * 64, 2) fwd(Args args) {
    extern __shared__ __attribute__((aligned(16))) unsigned char lds_raw[];
    Frame F;
    F.lds = (LAS unsigned char*)lds_raw; F.tid = threadIdx.x; F.lane = F.tid & 63; F.wave = __builtin_amdgcn_readfirstlane(F.tid >> 6); F.G = gridDim.x; F.bid = blockIdx.x;
    F.A = &args; F.zo = 0; F.out = args.out; F.ws = args.ws; unsigned char* ws = args.ws;
    volatile LAS unsigned* MISC = (volatile LAS unsigned*)(F.lds + MISC_OFF);
    if (F.tid < 64) ((LAS unsigned*)(F.lds + MISC_OFF))[F.tid] = 0u;
    __syncthreads();
    const int lo = args.ph_lo, hi = args.ph_hi, sel = args.sel;
    XcdBarrier bar; bar.bar = (unsigned*)(ws + WS_CTL) + CW_BAR; bar.x = 0; bar.st = nullptr;
    if (hi - lo > 1) bar = xcd_barrier_post((unsigned*)(ws + WS_CTL) + CW_BAR, MISC + 8);
#define IN(k) (lo <= (k) && (k) < hi)
#define SITE_FRAME() Frame Fp = F; { Fp.ws = (unsigned char*)opaque_ptr(F.ws); Fp.out = (float*)opaque_ptr(F.out); } { int t_ = (int)threadIdx.x, b_ = (int)blockIdx.x, z_; asm volatile("s_mov_b32 %0, 0" : "=s"(z_)); Fp.zo = z_; asm volatile("" : "+v"(t_), "+s"(b_)); Fp.tid = t_; Fp.lane = t_ & 63; Fp.wave = __builtin_amdgcn_readfirstlane(t_ >> 6); Fp.bid = b_; } const int bid = Fp.bid
#define SEAM(k) do { if (IN(k) && IN((k) + 1)) { XcdBarrier b2_ = bar; b2_.bar = (unsigned*)opaque_ptr(bar.bar); xcd_barrier(b2_, Fp.tid == 0); } } while (0)
    const int G = F.G;

    if (SITE(0) && IN(0)) { SITE_FRAME(); p0_prologue(Fp); SEAM(0); }
    for (int l = 0; l < 2; ++l) {
        const int base = 1 + 12 * l;
        for (int half = 0; half < 2; ++half) {
            const int pb = base + 9 * half;
            if (SITE(2) && IN(pb)) { SITE_FRAME();
                pg8::Gemm g{Fp.H(), (const bf16_t*)(Fp.ws + WS_W0 + (size_t)l * WS_WL + (half ? OFF_W2I : OFF_W1I)), D}; pg8::StaticOrder S; S.init(MP, NFFI, D, G, bid);
                pg8::EpiSwiGLU E{Fp.ACT(), Fp.RS()};
                pg8::gemm_phase<pg8::EpiSwiGLU, pg8::StaticOrder, true, true>(Fp.lds, g, S, E, Fp.tid);
                if (l == 0 && half == 0 && bid >= G / 2) {
                    pg8::Gemm g2{Fp.MEMN(), (const bf16_t*)(Fp.ws + WS_WMKV), D}; pg8::GroupAOrder S2; S2.init(NB * NMEM, 4096, D, G / 2, bid - G / 2); S2.grp = 8; S2.astride = (size_t)NB * NMEM * D * 2;
                    pg8::EpiMemKV E2{Fp.out + O_MKP, Fp.out + O_MVP, Fp.MK(), Fp.MVT()};
                    pg8::gemm_phase<pg8::EpiMemKV, pg8::GroupAOrder, false, true>(Fp.lds, g2, S2, E2, Fp.tid);
                }
                { SEpiSwiGLU SE{Fp.ACT(), Fp.RS()}; small_gemm<D>(Fp, g.A, 0, g.Bt, 0, DFF / 16, G / 2, G / 2, SE); }
                SEAM(pb);
            }
            if (SITE(3) && IN(pb + 1)) { SITE_FRAME();
                pg8::Gemm g{Fp.ACT(), (const bf16_t*)(Fp.ws + WS_W0 + (size_t)l * WS_WL + (half ? OFF_W2O : OFF_W1O)), DFF}; pg8::StaticOrder S; S.init(MP, D, DFF, G, bid, WGM_N1024);
                pg8::EpiBf16 E{Fp.TMP(), D};
                pg8::gemm_phase<pg8::EpiBf16, pg8::StaticOrder, true, true>(Fp.lds, g, S, E, Fp.tid);
                { SEpiBf16 SE{Fp.TMP(), D}; small_gemm<DFF, SEpiBf16, 1>(Fp, g.A, 0, g.Bt, 0, D / 16, 0, G, SE); }
                SEAM(pb + 1);
            }
            if (SITE(4) && IN(pb + 2)) { SITE_FRAME();
                NormArgs na; na.tmp = Fp.TMP(); na.scale = 0.5f; na.first = 0;
                if (half == 0) { na.gpost = Fp.inp(9) + l * D; na.gpre = Fp.inp(12) + l * D; na.wab = Fp.WAB() + (size_t)l * 8 * D; na.fin = 0; }
                else { na.gpost = Fp.inp(27) + l * D; na.gpre = Fp.inp(8) + (l == 0 ? D : 0); na.wab = nullptr; na.fin = (l == 1); }
                norm_phase(Fp, na);
                SEAM(pb + 2);
            }
            if (half == 0) {
                if (SITE(5) && IN(base + 3)) { SITE_FRAME();
                    pg8::Gemm g{Fp.H(), (const bf16_t*)(Fp.ws + WS_W0 + (size_t)l * WS_WL + OFF_WIN), D}; pg8::StaticOrder S; S.init(MP, NWIN, D, G, bid);
                    pg8::EpiProj E{Fp.PROJ(), Fp.inp(18) + l * DV, Fp.RS()};
                    pg8::gemm_phase<pg8::EpiProj, pg8::StaticOrder, true, true>(Fp.lds, g, S, E, Fp.tid);
                    { SEpiProj SE{Fp.PROJ(), Fp.inp(18) + l * DV, Fp.RS()}; small_gemm<D, SEpiProj, 1, 4>(Fp, g.A, 0, g.Bt, 0, NWIN / 16, 0, G, SE); }
                    SEAM(base + 3);
                }
                if (SITE(6) && IN(base + 4)) { SITE_FRAME();
                    if (PP(0) && (sel & 1)) for (int ci = bid; ci < NB * NH * NCH; ci += G) gdn_prep(Fp, l, ci);
                    if (PP(1) && (sel & 2)) for (int ci = bid; ci < NB * NH * NCH; ci += G) ret_prep(Fp, ci);
                    if (PP(2) && (sel & 4) && l < 0) { const int xcd = bid & 7, slot = bid >> 3, per = G >> 3;
                        if ((G & 7) == 0) { for (int ux = slot; ux < 64; ux += per) mem_attn_unit(Fp, l, (xcd * 4 + (ux >> 4)) * 16 + (ux & 15)); }
                        else for (int u = bid; u < NB * NH * 16; u += G) mem_attn_unit(Fp, l, u); }
                    if (PP(3) && bid < NB) { for (int i = Fp.tid; i < 3 * CONVD; i += NWAVES * 64) { const int j = i / CONVD, C = i % CONVD;
                        Fp.out[O_CVP + ((size_t)(l * NB + bid) * 3 + j) * CONVD + C] = bf2f(Fp.PROJ()[(size_t)(bid * SEQ + SEQ - 3 + j) * NWIN + PC_GQKV + C]); } }
                    SEAM(base + 4);
                }
                if (SITE(7) && IN(base + 5)) { SITE_FRAME();
                    if (bid < 32) { if (SP(0) && (sel & 8)) scan_bh<false>(Fp, l, bid); }
                    else if (bid < 64) { if (SP(1) && (sel & 8)) scan_bh<true>(Fp, l, bid - 32); }
                    else { const int nw = G - 64; unsigned* subc = (unsigned*)opaque_ptr(Fp.ws + WS_CTL) + CW_SUB + 64 * l;
                        if (sel & 4) {
                            if ((G & 7) == 0) { const int xcd = bid & 7, slot = (bid >> 3) - 8, per = (G >> 3) - 8; for (int ux = slot; ux < 64; ux += per) mem_attn_unit(Fp, l, (xcd * 4 + (ux >> 4)) * 16 + (ux & 15)); }
                            else for (int u = bid - 64; u < NB * NH * 16; u += nw) mem_attn_unit(Fp, l, u);
                            if (sel & 64) sub_arrive(subc, Fp.tid == 0); }
                        if (SP(2) && (sel & 16)) for (int it = bid - 64; it < MS * NH; it += nw) sample_step<true>(Fp, l, it);
                        if (SP(3) && (sel & 16)) for (int it = bid - 64; it < MS * NH; it += nw) sample_step<false>(Fp, l, it);
                        if (SP(4) && (sel & 32)) for (int it = bid - 64; it < MS * NH; it += nw) sample_attn(Fp, l, it);
                        if (l == 0 && (sel & 64)) convert_layer1(Fp, bid - 64, nw);
                        if (sel & 64) {
                            sub_wait(subc, (unsigned)nw, (unsigned*)opaque_ptr(Fp.ws + WS_CTL) + CW_BAR, Fp.tid == 0);
                            pg8::Gemm g{Fp.OBR() + 2 * OBR_STRIDE, (const bf16_t*)(Fp.ws + WS_W0 + (size_t)l * WS_WL + OFF_WBR) + 2 * (size_t)D * D, D}; pg8::SegOrder S; S.init(MP, D, D, nw, bid % nw, WGM_N1024); S.nseg = 1; S.aseg = 0; S.bseg = 0;
                            pg8::EpiBranch E{Fp.MERGED(), Fp.PROJ(), 2, 2};
                            pg8::gemm_phase<pg8::EpiBranch, pg8::SegOrder, true, true>(Fp.lds, g, S, E, Fp.tid); } }
                    SEAM(base + 5);
                }
                if (SITE(8) && IN(base + 6)) { SITE_FRAME();
                    pg8::Gemm g{Fp.OBR(), (const bf16_t*)(Fp.ws + WS_W0 + (size_t)l * WS_WL + OFF_WBR), D}; pg8::SegOrder S; S.init(MP, D, D, G, bid, WGM_N1024); S.nseg = 2; S.aseg = OBR_STRIDE * 2; S.bseg = (size_t)D * D * 2;
                    pg8::EpiBranch E{Fp.MERGED(), Fp.PROJ(), 0, 2};
                    pg8::gemm_phase<pg8::EpiBranch, pg8::SegOrder, true, true>(Fp.lds, g, S, E, Fp.tid);
                    { SEpiBranch SE{Fp.MERGED(), Fp.PROJ()}; small_gemm<D, SEpiBranch, 1>(Fp, g.A, OBR_STRIDE, g.Bt, (size_t)D * D, D / 16, 0, G, SE); }
                    SEAM(base + 6);
                }
                if (SITE(9) && IN(base + 7)) { SITE_FRAME();
                    pg8::Gemm g{Fp.MERGED(), (const bf16_t*)(Fp.ws + WS_W0 + (size_t)l * WS_WL + OFF_WO), D}; pg8::StaticOrder S; S.init(MP, D, D, G, bid, WGM_N1024);
                    pg8::EpiBf16 E{Fp.TMP(), D};
                    pg8::gemm_phase<pg8::EpiBf16, pg8::StaticOrder, true, true>(Fp.lds, g, S, E, Fp.tid);
                    { SEpiBf16 SE{Fp.TMP(), D}; small_gemm<D, SEpiBf16, 1>(Fp, g.A, 0, g.Bt, 0, D / 16, 0, G, SE); }
                    SEAM(base + 7);
                }
                if (SITE(10) && IN(base + 8)) { SITE_FRAME();
                    NormArgs na; na.tmp = Fp.TMP(); na.scale = 1.0f; na.first = 0; na.gpost = Fp.inp(13) + l * D; na.gpre = Fp.inp(26) + l * D; na.wab = nullptr; na.fin = 0;
                    norm_phase(Fp, na);
                    SEAM(base + 8);
                }
            }
        }
    }
#undef IN
#undef SEAM
}

extern "C" void kernel_launch(void* const* d_in, const int* in_sizes, int n_in, void* d_out, int out_size, void* d_ws, size_t ws_size, hipStream_t stream) {
    static int grid = 0;
    if (grid == 0) {
        if (n_in != 30 || (size_t)out_size != O_END || ws_size < WS_END) { fprintf(stderr, "kernel_launch: unexpected shapes: n_in %d out %d ws %zu (need %zu)\n", n_in, out_size, ws_size, (size_t)WS_END); grid = -1; return; }
        int dev = 0, cus = 0, per_cu = 0;
        if (hipGetDevice(&dev) != hipSuccess || hipDeviceGetAttribute(&cus, hipDeviceAttributeMultiprocessorCount, dev) != hipSuccess) { grid = -1; return; }
        if (hipFuncSetAttribute((const void*)fwd, hipFuncAttributeMaxDynamicSharedMemorySize, LDS_BYTES) != hipSuccess) { fprintf(stderr, "kernel_launch: hipFuncSetAttribute failed\n"); grid = -1; return; }
        if (hipOccupancyMaxActiveBlocksPerMultiprocessor(&per_cu, (const void*)fwd, NWAVES * 64, LDS_BYTES) != hipSuccess || per_cu < 1) { fprintf(stderr, "kernel_launch: occupancy query reports %d\n", per_cu); }
        (void)hipGetLastError();
        grid = cus;
        if (grid < 128) { fprintf(stderr, "kernel_launch: needs >= 128 CUs\n"); grid = -1; return; }
    }
    if (grid < 0) return;
    if (hipMemsetAsync((char*)d_ws + WS_CTL, 0, CTL_ZERO_BYTES, stream) != hipSuccess) return;
    Args a{};
    for (int i = 0; i < 30; ++i) a.in[i] = (const float*)d_in[i];
    a.out = (float*)d_out; a.ws = (unsigned char*)d_ws;
#ifndef MK_ONE_LAUNCH
#define MK_ONE_LAUNCH 1
#endif
    a.sel = 0xff; a.pad = 0;
#ifndef PROBE_PH
#define PROBE_PH -1
#endif
#ifndef PROBE_SEL
#define PROBE_SEL 0xff
#endif
    if (MK_ONE_LAUNCH) { a.ph_lo = 0; a.ph_hi = NPHASE; hipLaunchKernelGGL(fwd, dim3(grid), dim3(NWAVES * 64), LDS_BYTES, stream, a); }
    else for (int p = 0; p < NPHASE; ++p) { a.ph_lo = p; a.ph_hi = p + 1; a.sel = 0xff; hipLaunchKernelGGL(fwd, dim3(grid), dim3(NWAVES * 64), LDS_BYTES, stream, a);
        if (PROBE_PH >= 0 && (p == PROBE_PH || (PROBE_PH >= 1 && p == PROBE_PH + 12))) { a.sel = PROBE_SEL; hipLaunchKernelGGL(fwd, dim3(grid), dim3(NWAVES * 64), LDS_BYTES, stream, a); } }
}
```

```cpp
#include <hip/hip_runtime.h>
#include <cstdio>
#include <cstdint>

#define LAS __attribute__((address_space(3)))
#define GAS __attribute__((address_space(1)))
typedef unsigned short bf16_t;
typedef short bf16x8 __attribute__((ext_vector_type(8)));
typedef short bf16x4 __attribute__((ext_vector_type(4)));
typedef float f32x4 __attribute__((ext_vector_type(4)));
typedef float f32x2 __attribute__((ext_vector_type(2)));
typedef unsigned u32x4 __attribute__((ext_vector_type(4)));
typedef unsigned u32x2 __attribute__((ext_vector_type(2)));
typedef __bf16 bf16x2_t __attribute__((ext_vector_type(2)));
typedef GAS unsigned gu32;

constexpr int D = 1024, SEQ = 2048, NB = 8, MP = NB * SEQ, MS = 128, MREAL = MP + MS, MPAD = 16640;
constexpr int DFF = 2816, NFFI = 2 * DFF, NWIN = 10240, WIN_RAW = 10248;
constexpr int NH = 4, DK = 128, DV = 256, CH = 64, NCH = SEQ / CH, NMEM = 256, CONVD = 2048;
constexpr int PC_RQ = 0, PC_RK = 512, PC_RV = 1024, PC_RG = 2048, PC_GQKV = 3072, PC_GZ = 5120, PC_MQ = 6144, PC_GATE = 7168;
constexpr float EPS = 1e-6f;
constexpr int PAST_LEN = 16384;

__device__ __forceinline__ unsigned f2bf(float f) { unsigned u = __builtin_bit_cast(unsigned, f); return (u + 0x7fffu + ((u >> 16) & 1u)) >> 16; }
__device__ __forceinline__ float bf2f(unsigned b) { return __builtin_bit_cast(float, b << 16); }
__device__ __forceinline__ unsigned pk2(float lo, float hi) { f32x2 v = {lo, hi}; bf16x2_t b = __builtin_convertvector(v, bf16x2_t); return __builtin_bit_cast(unsigned, b); }
__device__ __forceinline__ bf16x8 pack8(f32x4 a, f32x4 b) { u32x4 p; p.x = pk2(a.x, a.y); p.y = pk2(a.z, a.w); p.z = pk2(b.x, b.y); p.w = pk2(b.z, b.w); return __builtin_bit_cast(bf16x8, p); }
__device__ __forceinline__ float fexp(float x) { return __builtin_amdgcn_exp2f(x * 1.4426950408889634f); }
__device__ __forceinline__ float sigmoidf_(float x) { return __builtin_amdgcn_rcpf(1.0f + fexp(-x)); }
__device__ __forceinline__ float siluf_(float x) { return x * sigmoidf_(x); }
__device__ __forceinline__ float wave_sum(float v) {
#pragma unroll
    for (int o = 1; o < 64; o <<= 1) v += __shfl_xor(v, o);
    return v;
}
#define MFMA16(a, b, c) __builtin_amdgcn_mfma_f32_16x16x32_bf16((a), (b), (c), 0, 0, 0)

namespace pg8 {
#define PG8_LAS __attribute__((address_space(3)))
constexpr int BM = 256, BK = 64, HALF = 128, HTB = HALF * BK * 2  , STAGE_BYTES = 8 * HTB, NXCD = 8;
__host__ __device__ __forceinline__ int lds_byte(int r, int c) { const int st = (r >> 4) * 2 + (c >> 5), rr = r & 15, cc = c & 31, ob = rr * 64 + cc * 2; return st * 1024 + (ob ^ (((ob >> 9) & 1) << 5)); }
__host__ __device__ __forceinline__ void stage_rc(int b, int& R, int& C) { const int st = b / 1024, sb = b % 1024, swz = sb ^ (((sb >> 9) & 1) << 5); R = (st >> 1) * 16 + swz / 64; C = (st & 1) * 32 + (swz % 64) / 2; }
__host__ __device__ __forceinline__ int perm32(int rho) { const int n = rho >> 4, i = rho & 15; return 8 * (i >> 2) + 4 * n + (i & 3); }

#ifndef WGM_DEFAULT
#define WGM_DEFAULT 2
#endif
#ifndef WGM_N1024
#define WGM_N1024 8
#endif
struct Unit { int pm, pn, seg; size_t aofs, bofs; };
struct Gemm { const bf16_t* A; const bf16_t* Bt; int K; };

struct StaticOrder {
    int nM, nN, nwg, G, c, WGM; size_t tstep;
    __device__ void init(int M, int N, int K, int G_, int c_, int wgm = WGM_DEFAULT) { nM = M / BM; nN = N / BM; nwg = nM * nN; G = G_; c = c_; WGM = wgm; tstep = (size_t)BM * K * 2; }
    __device__ bool tile(long L, int& pm, int& pn) const {
        if (L >= nwg) return false;
        int wgid = (int)L; { const int q = nwg / NXCD, r = nwg % NXCD, xcd = wgid % NXCD, off = wgid / NXCD; wgid = (xcd < r ? xcd * (q + 1) : r * (q + 1) + (xcd - r) * q) + off; }
        const int nig = WGM * nN, gid = wgid / nig, fm = gid * WGM, gsz = (nM - fm) < WGM ? (nM - fm) : WGM;
        pm = fm + ((wgid % nig) % gsz); pn = (wgid % nig) / gsz; return true;
    }
    __device__ bool next(int i, Unit& u) const {
        if (!tile((long)i * G + c, u.pm, u.pn)) return false;
        u.seg = 0; u.aofs = (size_t)u.pm * tstep; u.bofs = (size_t)u.pn * tstep; return true;
    }
    __device__ __forceinline__ void a_ready(const Unit&) const {}
    __device__ __forceinline__ void done(const Unit&) const {}
};
struct GroupAOrder : StaticOrder {
    int grp; size_t astride;
    __device__ bool next(int i, Unit& u) const {
        if (!tile((long)i * G + c, u.pm, u.pn)) return false;
        u.seg = 0; u.aofs = (size_t)(u.pn / grp) * astride + (size_t)u.pm * tstep; u.bofs = (size_t)u.pn * tstep; return true;
    }
};
struct SegOrder : StaticOrder {
    int nseg; size_t aseg, bseg;
    __device__ bool next(int i, Unit& u) const {
        const int round = i / nseg, seg = i - round * nseg;
        if (!tile((long)round * G + c, u.pm, u.pn)) return false;
        u.seg = seg; u.aofs = (size_t)seg * aseg + (size_t)u.pm * tstep; u.bofs = (size_t)seg * bseg + (size_t)u.pn * tstep; return true;
    }
};

struct EpiF32 {
    static constexpr int NST = 32; static constexpr bool RSLDS = false; static constexpr bool PERM = false, AFTER_DRAIN = false;
    float* C; int ldc;
    __device__ __forceinline__ void operator()(const f32x4 (&acc)[2][2][4][2], const Unit& u, int wr, int wc, int fr, int fq) const {
        const int row0 = u.pm * BM + wr * 64 + fr, col0 = u.pn * BM + wc * 32 + 4 * fq;
#pragma unroll
        for (int ai = 0; ai < 2; ++ai)
#pragma unroll
            for (int m = 0; m < 4; ++m) { float* rowp = C + (size_t)(row0 + ai * HALF + m * 16) * ldc + col0;
#pragma unroll
                for (int bj = 0; bj < 2; ++bj)
#pragma unroll
                    for (int n = 0; n < 2; ++n) *(f32x4*)(rowp + bj * HALF + n * 16) = acc[ai][bj][m][n]; }
    }
};
struct EpiBf16 {
    static constexpr int NST = 16; static constexpr bool RSLDS = false; static constexpr bool PERM = true, AFTER_DRAIN = false;
    bf16_t* O; int ldc;
    __device__ __forceinline__ void operator()(const f32x4 (&acc)[2][2][4][2], const Unit& u, int wr, int wc, int fr, int fq) const {
        const int row0 = u.pm * BM + wr * 64 + fr, col0 = u.pn * BM + wc * 32 + 8 * fq;
        unsigned bo = ((unsigned)row0 * (unsigned)ldc + (unsigned)col0) * 2u; asm volatile("" : "+v"(bo));
        const unsigned rs = (unsigned)ldc * 2u;
#pragma unroll
        for (int ai = 0; ai < 2; ++ai)
#pragma unroll
            for (int m = 0; m < 4; ++m) {
#pragma unroll
                for (int bj = 0; bj < 2; ++bj) { const f32x4 v0 = acc[ai][bj][m][0], v1 = acc[ai][bj][m][1];
                    u32x4 w; w.x = pk2(v0[0], v0[1]); w.y = pk2(v0[2], v0[3]); w.z = pk2(v1[0], v1[1]); w.w = pk2(v1[2], v1[3]);
                    *(u32x4*)((char*)O + (bo + (unsigned)(ai * HALF + m * 16) * rs + (unsigned)(bj * HALF * 2))) = w; } }
    }
};
struct EpiProj {
    static constexpr int NST = 16; static constexpr bool RSLDS = true; static constexpr bool PERM = true, AFTER_DRAIN = false; __device__ static __forceinline__ bool keep_acc(const Unit&) { return false; }
    bf16_t* O; const float* gn; const float* rs;
    __device__ __forceinline__ void operator()(const f32x4 (&acc)[2][2][4][2], const Unit& u, int wr, int wc, int fr, int fq, const LAS float* rsl) const {
        const int row0 = u.pm * BM + wr * 64 + fr, col0 = u.pn * BM + wc * 32 + 8 * fq;
        unsigned bo = ((unsigned)row0 * (unsigned)NWIN + (unsigned)col0) * 2u; asm volatile("" : "+v"(bo));
        const unsigned rstride = (unsigned)NWIN * 2u;
        const int mode = (u.pn >= 8 && u.pn < 12) ? 1 : (u.pn >= 20 && u.pn < 24) ? 2 : 0;
        float gs[2][8];
#pragma unroll
        for (int bj = 0; bj < 2; ++bj)
#pragma unroll
            for (int j = 0; j < 8; ++j) gs[bj][j] = (mode == 2) ? gn[(col0 + bj * HALF + j) & 255] : 1.f;
#pragma unroll
        for (int ai = 0; ai < 2; ++ai)
#pragma unroll
            for (int m = 0; m < 4; ++m) {
#pragma unroll
                for (int bj = 0; bj < 2; ++bj) { const float rv = rsl[wr * 64 + fr + ai * HALF + m * 16]; f32x4 v0 = acc[ai][bj][m][0] * rv, v1 = acc[ai][bj][m][1] * rv;
                    if (mode != 0) {
#pragma unroll
                        for (int j = 0; j < 4; ++j) { v0[j] = siluf_(v0[j]) * gs[bj][j]; v1[j] = siluf_(v1[j]) * gs[bj][4 + j]; } }
                    u32x4 w; w.x = pk2(v0[0], v0[1]); w.y = pk2(v0[2], v0[3]); w.z = pk2(v1[0], v1[1]); w.w = pk2(v1[2], v1[3]);
                    *(u32x4*)((char*)O + (bo + (unsigned)(ai * HALF + m * 16) * rstride + (unsigned)(bj * HALF * 2))) = w; } }
    }
};
struct EpiSwiGLU {
    static constexpr int NST = 8; static constexpr bool RSLDS = true; static constexpr bool PERM = true, AFTER_DRAIN = false;
    bf16_t* O; const float* rs;
    __device__ __forceinline__ void operator()(const f32x4 (&acc)[2][2][4][2], const Unit& u, int wr, int wc, int fr, int fq, const LAS float* rsl) const {
        const int row0 = u.pm * BM + wr * 64 + fr, col0 = u.pn * HALF + wc * 32 + 8 * fq;
#pragma unroll
        for (int ai = 0; ai < 2; ++ai)
#pragma unroll
            for (int m = 0; m < 4; ++m) { bf16_t* rowp = O + (size_t)(row0 + ai * HALF + m * 16) * DFF + col0;
                float r[8]; const float rv = rsl[wr * 64 + fr + ai * HALF + m * 16];
#pragma unroll
                for (int n = 0; n < 2; ++n)
#pragma unroll
                    for (int j = 0; j < 4; ++j) { const float g = acc[ai][0][m][n][j] * rv, up = acc[ai][1][m][n][j] * rv; r[4 * n + j] = siluf_(g) * up; }
                u32x4 w; w.x = pk2(r[0], r[1]); w.y = pk2(r[2], r[3]); w.z = pk2(r[4], r[5]); w.w = pk2(r[6], r[7]);
                *(u32x4*)rowp = w; }
    }
};
struct EpiMemKV {
    static constexpr int NST = 0; static constexpr bool RSLDS = false; static constexpr bool PERM = false, AFTER_DRAIN = false;
    float* outK; float* outV; bf16_t* MK; bf16_t* MVT;
    __device__ __forceinline__ void operator()(const f32x4 (&acc)[2][2][4][2], const Unit& u, int wr, int wc, int fr, int fq) const {
        const int layer = u.pn >> 3, isv = (u.pn >> 2) & 1, cb = (u.pn & 3) * BM;
        const int row0 = u.pm * BM + wr * 64 + fr, col0 = cb + wc * 32 + 4 * fq;
        float* of = (isv ? outV : outK) + (size_t)layer * (NB * NMEM * D);
#pragma unroll
        for (int ai = 0; ai < 2; ++ai)
#pragma unroll
            for (int m = 0; m < 4; ++m) { const int row = row0 + ai * HALF + m * 16;
#pragma unroll
                for (int bj = 0; bj < 2; ++bj)
#pragma unroll
                    for (int n = 0; n < 2; ++n) { const int col = col0 + bj * HALF + n * 16; const f32x4 v = acc[ai][bj][m][n];
                        *(f32x4*)(of + (size_t)row * D + col) = v;
                        const int b = row >> 8, key = row & 255, h = col >> 8, dd = col & 255;
                        unsigned char* fb = (unsigned char*)(isv ? MVT : MK) + ((((size_t)layer * NB + b) * NH + h) << 17);
                        if (!isv) { u32x2 w; w.x = pk2(v[0], v[1]); w.y = pk2(v[2], v[3]);
                            *(u32x2*)(fb + ((((key >> 4) * 8 + (dd >> 5)) * 64 + (key & 15) + 16 * ((dd & 31) >> 3)) << 4) + ((dd & 4) << 1)) = w; }
                        else {
                            const int ks = key >> 5, w5 = key & 31, gg = (w5 & 15) >> 2, jj = (w5 & 3) + 4 * (w5 >> 4);
#pragma unroll
                            for (int j = 0; j < 4; ++j) { const int e = dd + j; *(bf16_t*)(fb + (((((e >> 4) * 8 + ks) * 64 + (e & 15) + 16 * gg) << 4) + jj * 2)) = (bf16_t)f2bf(v[j]); } } } }
    }
};
struct EpiBranch {
    static constexpr int NST = 16; static constexpr bool RSLDS = false; static constexpr bool PERM = true, AFTER_DRAIN = false;
    bf16_t* O; const bf16_t* proj; int seg_base, noold_seg;
    __device__ __forceinline__ void operator()(const f32x4 (&acc)[2][2][4][2], const Unit& u, int wr, int wc, int fr, int fq) const {
        const int row0 = u.pm * BM + wr * 64 + fr, col0 = u.pn * BM + wc * 32 + 8 * fq;
        unsigned go = ((unsigned)row0 * (unsigned)NWIN + (unsigned)(PC_GATE + (u.seg + seg_base) * D + col0)) * 2u, oo = ((unsigned)row0 * (unsigned)D + (unsigned)col0) * 2u; asm volatile("" : "+v"(go), "+v"(oo));
        const char* gb = (const char*)proj; char* ob = (char*)O;
#pragma unroll
        for (int ai = 0; ai < 2; ++ai) {
            u32x4 gwv[4][2], oldv[4][2];
#pragma unroll
            for (int m = 0; m < 4; ++m)
#pragma unroll
                for (int bj = 0; bj < 2; ++bj) { gwv[m][bj] = *(const u32x4*)(gb + (go + (unsigned)((ai * HALF + m * 16) * NWIN + bj * HALF) * 2u));
                    oldv[m][bj] = (u32x4){0u, 0u, 0u, 0u}; if (u.seg + seg_base != noold_seg) oldv[m][bj] = *(const u32x4*)(ob + (oo + (unsigned)((ai * HALF + m * 16) * D + bj * HALF) * 2u)); }
            asm volatile("" ::: "memory");
#pragma unroll
            for (int m = 0; m < 4; ++m)
#pragma unroll
                for (int bj = 0; bj < 2; ++bj) { const u32x4 gw = gwv[m][bj], old = oldv[m][bj]; float r[8];
#pragma unroll
                    for (int q = 0; q < 4; ++q) { const unsigned g2 = gw[q], o2 = old[q];
                        const float a0 = acc[ai][bj][m][q >> 1][(q & 1) * 2], a1 = acc[ai][bj][m][q >> 1][(q & 1) * 2 + 1];
                        r[2 * q] = bf2f(o2 & 0xffffu) + sigmoidf_(bf2f(g2 & 0xffffu)) * a0; r[2 * q + 1] = bf2f(o2 >> 16) + sigmoidf_(bf2f(g2 >> 16)) * a1; }
                    u32x4 w; w.x = pk2(r[0], r[1]); w.y = pk2(r[2], r[3]); w.z = pk2(r[4], r[5]); w.w = pk2(r[6], r[7]);
                    *(u32x4*)(ob + (oo + (unsigned)((ai * HALF + m * 16) * D + bj * HALF) * 2u)) = w; }
            asm volatile("" ::: "memory");
        }
    }
};

template <class Epi, class Sched, bool ALIGN_EPI = false, bool SP2 = false>
__device__ __forceinline__ void gemm_phase(PG8_LAS unsigned char* lds, const Gemm g, const Sched& S, const Epi& E, const int tid) {
    const int wid = __builtin_amdgcn_readfirstlane(tid >> 6), lane = tid & 63, wr = wid >> 2, wc = wid & 3, fr = lane & 15, fq = lane >> 4;
    const int K = g.K, nt = K / BK;
    unsigned voffA[2], voffB[2];
#pragma unroll
    for (int i = 0; i < 2; ++i) { int R, C; stage_rc(tid * 16 + i * 8192, R, C); const int Rb = Epi::PERM ? ((R & ~31) + perm32(R & 31)) : R;
        voffA[i] = (unsigned)(R * K + C) * 2u; voffB[i] = (unsigned)(Rb * K + C) * 2u; }
    const size_t kstep = (size_t)(BK * 2);
    const size_t hstep = (size_t)HALF * K * 2;
    const unsigned ldsw = (unsigned)wid * 1024u;
    const int aoff = lds_byte(wr * 64 + fr, fq * 8), boff = lds_byte(wc * 32 + fr, fq * 8);
#define PG8_SA(b, h) (((b) * 2 + (h)) * HTB)
#define PG8_SB(b, h) ((4 + (b) * 2 + (h)) * HTB)
#define PG8_STAGE(bufoff, gbase, voff) do { _Pragma("unroll") for (int _i = 0; _i < 2; ++_i) \
        __builtin_amdgcn_global_load_lds((const unsigned*)((const char*)(gbase) + (voff)[_i]), (PG8_LAS unsigned*)(lds + (bufoff) + ldsw + _i * 8192), 16, 0, 0); } while (0)
#define PG8_LDA(dst, b, h) do { _Pragma("unroll") for (int m = 0; m < 4; ++m) _Pragma("unroll") for (int k = 0; k < 2; ++k) dst[m][k] = *(const PG8_LAS bf16x8*)(lds + PG8_SA(b, h) + aoff + m * 2048 + k * 1024); } while (0)
#define PG8_LDB(dst, b, h) do { _Pragma("unroll") for (int n = 0; n < 2; ++n) _Pragma("unroll") for (int k = 0; k < 2; ++k) dst[n][k] = *(const PG8_LAS bf16x8*)(lds + PG8_SB(b, h) + boff + n * 2048 + k * 1024); } while (0)
#define PG8_MMA(ai, bj, At, Bt) do { __builtin_amdgcn_s_setprio(1); _Pragma("unroll") for (int m = 0; m < 4; ++m) _Pragma("unroll") for (int n = 0; n < 2; ++n) _Pragma("unroll") for (int k = 0; k < 2; ++k) \
        acc[ai][bj][m][n] = __builtin_amdgcn_mfma_f32_16x16x32_bf16(Bt[n][k], At[m][k], acc[ai][bj][m][n], 0, 0, 0); __builtin_amdgcn_s_setprio(0); } while (0)
#define PG8_WAIT_V(n) asm volatile("s_waitcnt vmcnt(" #n ")" ::: "memory")
#define PG8_WAIT_L(n) asm volatile("s_waitcnt lgkmcnt(" #n ")" ::: "memory")
#define PG8_BAR __builtin_amdgcn_s_barrier()
#define PG8_SCHED __builtin_amdgcn_sched_barrier(0)
    Unit cur, nxt; int ui = 0;
    if (!S.next(0, cur)) return;
    f32x4 acc[2][2][4][2];
#pragma unroll
    for (int a = 0; a < 2; ++a)
#pragma unroll
        for (int b = 0; b < 2; ++b)
#pragma unroll
            for (int m = 0; m < 4; ++m)
#pragma unroll
                for (int n = 0; n < 2; ++n) acc[a][b][m][n] = (f32x4){0.f, 0.f, 0.f, 0.f};
    bf16x8 At[4][2], B0[2][2], B1[2][2];
    const char* cA = (const char*)g.A + cur.aofs; const char* cB = (const char*)g.Bt + cur.bofs;
    S.a_ready(cur);
    if constexpr (SP2) {
        PG8_STAGE(PG8_SB(0, 0), cB, voffB); PG8_STAGE(PG8_SB(0, 1), cB + hstep, voffB); PG8_STAGE(PG8_SA(0, 0), cA, voffA); PG8_STAGE(PG8_SA(0, 1), cA + hstep, voffA);
        if (wr == 1) PG8_BAR;
        PG8_WAIT_V(2); PG8_BAR;
        PG8_STAGE(PG8_SB(1, 0), cB + kstep, voffB); PG8_STAGE(PG8_SA(1, 0), cA + kstep, voffA); PG8_STAGE(PG8_SB(1, 1), cB + hstep + kstep, voffB);
        PG8_WAIT_V(6); PG8_BAR;
    } else {
        PG8_STAGE(PG8_SB(0, 0), cB, voffB); PG8_STAGE(PG8_SA(0, 0), cA, voffA); PG8_STAGE(PG8_SB(0, 1), cB + hstep, voffB); PG8_STAGE(PG8_SA(0, 1), cA + hstep, voffA);
        if (wr == 1) PG8_BAR;
        PG8_WAIT_V(4); PG8_BAR;
        PG8_STAGE(PG8_SB(1, 0), cB + kstep, voffB); PG8_STAGE(PG8_SA(1, 0), cA + kstep, voffA); PG8_STAGE(PG8_SB(1, 1), cB + hstep + kstep, voffB);
        PG8_WAIT_V(6); PG8_BAR;
    }
    for (;;) {
        const bool has_next = S.next(ui + 1, nxt);
        if constexpr (Epi::RSLDS) {
            if (wid == 0) __builtin_amdgcn_global_load_lds((const unsigned*)(E.rs + (size_t)cur.pm * BM + lane * 4), (PG8_LAS unsigned*)(lds + STAGE_BYTES + (ui & 1) * 1024), 16, 0, 0); }
        const char* nA = has_next ? (const char*)g.A + nxt.aofs : cA; const char* nB = has_next ? (const char*)g.Bt + nxt.bofs : cB;
        for (int t = 0; t < nt; t += 2) {
            const bool last = (t == nt - 2);
            const char* a1 = cA + (size_t)(t + 1) * kstep;
            const char* a2 = last ? nA : cA + (size_t)(t + 2) * kstep; const char* b2 = last ? nB : cB + (size_t)(t + 2) * kstep;
            const char* a3 = a2 + kstep; const char* b3 = b2 + kstep;
            if (last && has_next) S.a_ready(nxt);
            if constexpr (SP2) {
            PG8_LDB(B0, 0, 0); PG8_LDB(B1, 0, 1); PG8_SCHED; PG8_LDA(At, 0, 0); PG8_STAGE(PG8_SA(1, 1), a1 + hstep, voffA);
            PG8_WAIT_V(8); PG8_WAIT_L(0); PG8_BAR; PG8_MMA(0, 0, At, B0); PG8_MMA(0, 1, At, B1); PG8_BAR; PG8_SCHED;
            PG8_LDA(At, 0, 1); PG8_STAGE(PG8_SB(0, 0), b2, voffB); PG8_STAGE(PG8_SB(0, 1), b2 + hstep, voffB); PG8_STAGE(PG8_SA(0, 0), a2, voffA);
            PG8_WAIT_V(8); PG8_WAIT_L(0); PG8_BAR; PG8_MMA(1, 0, At, B0); PG8_MMA(1, 1, At, B1); PG8_BAR; PG8_SCHED;
            PG8_LDB(B0, 1, 0); PG8_LDB(B1, 1, 1); PG8_SCHED; PG8_LDA(At, 1, 0); PG8_STAGE(PG8_SA(0, 1), a2 + hstep, voffA);
            PG8_WAIT_V(8); PG8_WAIT_L(0); PG8_BAR; PG8_MMA(0, 0, At, B0); PG8_MMA(0, 1, At, B1); PG8_BAR; PG8_SCHED;
            PG8_LDA(At, 1, 1); PG8_STAGE(PG8_SB(1, 0), b3, voffB); PG8_STAGE(PG8_SB(1, 1), b3 + hstep, voffB); PG8_STAGE(PG8_SA(1, 0), a3, voffA);
            PG8_WAIT_V(8); PG8_WAIT_L(0); PG8_BAR; PG8_MMA(1, 0, At, B0); PG8_MMA(1, 1, At, B1); PG8_BAR; PG8_SCHED;
            } else {
            PG8_LDB(B0, 0, 0); PG8_SCHED; PG8_LDA(At, 0, 0); PG8_STAGE(PG8_SA(1, 1), a1 + hstep, voffA);
            PG8_WAIT_L(8); PG8_BAR; PG8_WAIT_L(0); PG8_MMA(0, 0, At, B0); PG8_BAR; PG8_SCHED;
            PG8_LDB(B1, 0, 1); PG8_STAGE(PG8_SB(0, 0), b2, voffB);
            PG8_BAR; PG8_WAIT_L(0); PG8_MMA(0, 1, At, B1); PG8_BAR;
            PG8_LDA(At, 0, 1); PG8_STAGE(PG8_SA(0, 0), a2, voffA);
            PG8_BAR; PG8_WAIT_L(0); PG8_MMA(1, 0, At, B0); PG8_BAR; PG8_SCHED;
            PG8_STAGE(PG8_SB(0, 1), b2 + hstep, voffB);
            PG8_WAIT_V(6); PG8_BAR; PG8_MMA(1, 1, At, B1); PG8_BAR;
            PG8_LDB(B0, 1, 0); PG8_SCHED; PG8_LDA(At, 1, 0); PG8_STAGE(PG8_SA(0, 1), a2 + hstep, voffA);
            PG8_WAIT_L(8); PG8_BAR; PG8_WAIT_L(0); PG8_MMA(0, 0, At, B0); PG8_BAR; PG8_SCHED;
            PG8_LDB(B1, 1, 1); PG8_STAGE(PG8_SB(1, 0), b3, voffB);
            PG8_BAR; PG8_WAIT_L(0); PG8_MMA(0, 1, At, B1); PG8_BAR;
            PG8_LDA(At, 1, 1); PG8_STAGE(PG8_SA(1, 0), a3, voffA);
            PG8_BAR; PG8_WAIT_L(0); PG8_MMA(1, 0, At, B0); PG8_BAR; PG8_SCHED;
            PG8_STAGE(PG8_SB(1, 1), b3 + hstep, voffB);
            PG8_WAIT_V(6); PG8_BAR; PG8_MMA(1, 1, At, B1); PG8_BAR;
            }
        }
        if constexpr (ALIGN_EPI) { if (wr == 0) PG8_BAR; }
        if constexpr (Epi::RSLDS) { E(acc, cur, wr, wc, fr, fq, (const PG8_LAS float*)(lds + STAGE_BYTES + (ui & 1) * 1024)); S.done(cur); } else
        if constexpr (!Epi::AFTER_DRAIN) { E(acc, cur, wr, wc, fr, fq); S.done(cur); }
        if (!has_next) break;
#pragma unroll
        for (int a = 0; a < 2; ++a)
#pragma unroll
            for (int b = 0; b < 2; ++b)
#pragma unroll
                for (int m = 0; m < 4; ++m)
#pragma unroll
                    for (int n = 0; n < 2; ++n) acc[a][b][m][n] = (f32x4){0.f, 0.f, 0.f, 0.f};
        cur = nxt; cA = nA; cB = nB; ++ui;
        if constexpr (ALIGN_EPI) { if (wr == 1) PG8_BAR; }
    }
    PG8_WAIT_V(0);
    if constexpr (!ALIGN_EPI) { if (wr == 0) PG8_BAR; }
    PG8_BAR;
    if constexpr (Epi::AFTER_DRAIN) { E.fused(acc, cur, wr, wc, fr, fq, lds, wid, lane); S.done(cur); }
#undef PG8_SA
#undef PG8_SB
#undef PG8_STAGE
#undef PG8_LDA
#undef PG8_LDB
#undef PG8_MMA
#undef PG8_WAIT_V
#undef PG8_WAIT_L
#undef PG8_BAR
#undef PG8_SCHED
}
}

constexpr size_t MiB = 1u << 20;
constexpr size_t WS_CTL = 0, CTL_ZERO_BYTES = 32768;
constexpr size_t WS_W0 = 1 * MiB, WS_WL = 61 * MiB;
constexpr size_t OFF_W1I = 0, OFF_W1O = 11 * MiB, OFF_WIN = 16 * MiB + MiB / 2, OFF_WBR = 36 * MiB + MiB / 2, OFF_WO = 42 * MiB + MiB / 2, OFF_W2I = 44 * MiB + MiB / 2, OFF_W2O = 55 * MiB + MiB / 2;
static_assert(OFF_W2O + (size_t)D * DFF * 2 == WS_WL, "layer weight map");
constexpr size_t WS_WMKV = 123 * MiB;
constexpr size_t WS_MISC = 131 * MiB;
constexpr size_t MISC_WAB = 0, MISC_COS = 65536, MISC_SIN = 65536 + 2049 * 64 * 4;
constexpr size_t WS_MEMN = 133 * MiB, WS_MK = 141 * MiB, WS_MVT = 149 * MiB, WS_AB = 157 * MiB;
constexpr size_t WS_H = 158 * MiB, WS_TMP = 223 * MiB, WS_XN = 288 * MiB, WS_MERGED = 320 * MiB + MiB / 2, WS_OBR = 353 * MiB;
constexpr size_t OBR_STRIDE = (size_t)MPAD * D;
constexpr size_t WS_BIG = 451 * MiB;
constexpr int GCH_W = 0, GCH_QD = 16384, GCH_ATT = 32768, GCH_KDT = 40960, GCH_BYTES = 57344;
constexpr int RCH_QD = 0, RCH_ATT = 16384, RCH_KDT = 24576, RCH_BYTES = 40960;
constexpr size_t WS_RCH = 776 * MiB, WS_RVT = 816 * MiB;
constexpr size_t WS_GCH = 848 * MiB, WS_GUT = 904 * MiB, WS_GDCH = 968 * MiB;
constexpr size_t WS_END = 969 * MiB;
static_assert(WS_H + (size_t)MPAD * D * 4 == WS_TMP && WS_TMP + (size_t)MPAD * D * 4 == WS_XN && WS_XN + (size_t)MPAD * D * 2 == WS_MERGED && WS_MERGED + (size_t)MPAD * D * 2 == WS_OBR, "activation map");
static_assert(WS_OBR + 3 * OBR_STRIDE * 2 <= WS_BIG && WS_BIG + (size_t)MPAD * NWIN * 2 <= WS_RCH && WS_RCH + (size_t)1024 * RCH_BYTES <= WS_RVT && WS_GCH + (size_t)1024 * GCH_BYTES <= WS_GUT, "activation map 2");
constexpr int CW_BAR = 4096;

constexpr size_t O_YP = 0, O_YS = O_YP + (size_t)MP * D, O_SRP = O_YS + (size_t)MS * D, O_SGP = O_SRP + (size_t)2 * NB * NH * DK * DV, O_CVP = O_SGP + (size_t)2 * NB * NH * DK * DV,
                 O_MKP = O_CVP + (size_t)2 * NB * 3 * CONVD, O_MVP = O_MKP + (size_t)2 * NB * NMEM * D, O_SRS = O_MVP + (size_t)2 * NB * NMEM * D, O_SGS = O_SRS + (size_t)2 * MS * NH * DK * DV,
                 O_CVS = O_SGS + (size_t)2 * MS * NH * DK * DV, O_END = O_CVS + (size_t)2 * MS * 3 * CONVD;
static_assert(O_END == 98271232, "output size");

constexpr int LDS_BYTES = 163840, MISC_OFF = LDS_BYTES - 256;

#define XB_TMO      128
#define XB_XCNT(j)  (256  + 64 * (j))
#define XB_XSUB(j)  (1280 + 64 * (j))
#define XB_XGEN(j)  (2304 + 64 * (j))
#define XB_TOP      3328
#define XB_TOPGEN   3392
#define XCD_BAR_WORDS 3456
#define XB_SPIN_CAP (1u << 18)

__device__ __forceinline__ unsigned xb_ld(unsigned* p)              { return __hip_atomic_load(p, __ATOMIC_RELAXED, __HIP_MEMORY_SCOPE_AGENT); }
__device__ __forceinline__ unsigned xb_add(unsigned* p, unsigned v) { return __hip_atomic_fetch_add(p, v, __ATOMIC_RELAXED, __HIP_MEMORY_SCOPE_AGENT); }
__device__ __forceinline__ unsigned xb_xcc_id() { return (unsigned)__builtin_amdgcn_s_getreg((3 << 11) | 20) & 0xFu; }
#define XB_SPIN(cond, bar) do { unsigned _sp = 0; while (cond) { __builtin_amdgcn_s_sleep(1); \
    if ((++_sp & 255u) == 0u) { if (xb_ld(&(bar)[XB_TMO])) break; if (_sp > XB_SPIN_CAP) { atomicAdd(&(bar)[XB_TMO], 1u); break; } } } } while (0)

struct XcdBarrier {
    unsigned* bar; unsigned x;
    volatile LAS unsigned* st;
};

__device__ __forceinline__ XcdBarrier xcd_barrier_post(unsigned* bar, volatile LAS unsigned* st) {
    XcdBarrier b; b.bar = bar; b.x = xb_xcc_id(); b.st = st;
    if (threadIdx.x == 0) (void)xb_add(&bar[XB_XCNT(b.x)], 1u);
    return b;
}
__device__ __forceinline__ void xcd_barrier_complete(unsigned* bar, unsigned x, unsigned& nloc, unsigned& nx) {
    const unsigned G = gridDim.x * gridDim.y * gridDim.z;
    unsigned sum, cnt, mine, sp = 0u;
    for (;;) {
        sum = 0u; cnt = 0u; mine = 0u;
#pragma unroll
        for (unsigned j = 0; j < 16; ++j) { const unsigned c = xb_ld(&bar[XB_XCNT(j)]); sum += c; cnt += (c > 0u) ? 1u : 0u; mine = (j == x) ? c : mine; }
        if (sum == G) break;
        __builtin_amdgcn_s_sleep(1);
        if ((++sp & 255u) == 0u) { if (xb_ld(&bar[XB_TMO])) break; if (sp > XB_SPIN_CAP) { atomicAdd(&bar[XB_TMO], 1u); break; } }
    }
    nloc = mine > 0u ? mine : 1u; nx = cnt > 0u ? cnt : 1u;
}

__device__ __forceinline__ void xcd_barrier(const XcdBarrier& b, const bool is_thread0) {
    asm volatile("s_waitcnt vmcnt(0)" ::: "memory");
    __syncthreads();
    if (is_thread0) {
        unsigned* bar = b.bar;
        __builtin_amdgcn_s_waitcnt(0);
        unsigned nloc = b.st[0], nx = b.st[1];
        if (nloc == 0u) { xcd_barrier_complete(bar, b.x, nloc, nx); b.st[0] = nloc; b.st[1] = nx; }
        const unsigned old = xb_add(&bar[XB_XSUB(b.x)], 1u);
        const unsigned gen = old / nloc;
        if (old + 1u == (gen + 1u) * nloc) {
            __builtin_amdgcn_fence(__ATOMIC_RELEASE, "agent");
            asm volatile("s_waitcnt vmcnt(0)" ::: "memory");
            const unsigned og = xb_add(&bar[XB_TOP], 1u);
            const unsigned tg = og / nx;
            if (og + 1u == (tg + 1u) * nx) xb_add(&bar[XB_TOPGEN], 1u);
            else XB_SPIN(xb_ld(&bar[XB_TOPGEN]) == tg, bar);
            __builtin_amdgcn_fence(__ATOMIC_ACQUIRE, "agent");
            xb_add(&bar[XB_XGEN(b.x)], 1u);
            asm volatile("s_waitcnt vmcnt(0)" ::: "memory");
        } else {
            XB_SPIN(xb_ld(&bar[XB_XGEN(b.x)]) == gen, bar);
            __builtin_amdgcn_fence(__ATOMIC_ACQUIRE, "agent");
            asm volatile("s_waitcnt vmcnt(0)" ::: "memory");
        }
    }
    __syncthreads();
}

__device__ __forceinline__ void sub_arrive(unsigned* ctr, const bool is_thread0) {
    asm volatile("s_waitcnt vmcnt(0)" ::: "memory");
    __syncthreads();
    if (is_thread0) { __builtin_amdgcn_s_waitcnt(0); __builtin_amdgcn_fence(__ATOMIC_RELEASE, "agent"); asm volatile("s_waitcnt vmcnt(0)" ::: "memory"); (void)xb_add(ctr, 1u); }
}
__device__ __forceinline__ void sub_wait(unsigned* ctr, unsigned target, unsigned* bar, const bool is_thread0) {
    if (is_thread0) { XB_SPIN(xb_ld(ctr) < target, bar); __builtin_amdgcn_fence(__ATOMIC_ACQUIRE, "agent"); asm volatile("s_waitcnt vmcnt(0)" ::: "memory"); }
    __syncthreads();
}
constexpr int CW_SUB = 64;

constexpr int NWAVES = 8;
struct Args { const float* in[30]; float* out; unsigned char* ws; int ph_lo, ph_hi, sel, pad; };
struct Frame {
    LAS unsigned char* lds; int tid, lane, wave, G, bid;
    const Args* A; float* out; unsigned char* ws; int zo;
    __device__ __forceinline__ const float* inp(int k) const { return *(const float* const*)((const char*)A + zo + 8 * k); }
    __device__ __forceinline__ float* RS() const { return (float*)(ws + WS_XN); }
    __device__ __forceinline__ bf16_t* MERGED() const { return (bf16_t*)(ws + WS_MERGED); }
    __device__ __forceinline__ bf16_t* OBR() const { return (bf16_t*)(ws + WS_OBR); }
    __device__ __forceinline__ bf16_t* PROJ() const { return (bf16_t*)(ws + WS_BIG); }
    __device__ __forceinline__ bf16_t* ACT() const { return (bf16_t*)(ws + WS_BIG); }
    __device__ __forceinline__ bf16_t* MEMN() const { return (bf16_t*)(ws + WS_MEMN); }
    __device__ __forceinline__ bf16_t* MK() const { return (bf16_t*)(ws + WS_MK); }
    __device__ __forceinline__ bf16_t* MVT() const { return (bf16_t*)(ws + WS_MVT); }
    __device__ __forceinline__ bf16_t* H() const { return (bf16_t*)(ws + WS_H); }
    __device__ __forceinline__ bf16_t* TMP() const { return (bf16_t*)(ws + WS_TMP); }
    __device__ __forceinline__ float* AB() const { return (float*)(ws + WS_AB); }
    __device__ __forceinline__ float* WAB() const { return (float*)(ws + WS_MISC + MISC_WAB); }
    __device__ __forceinline__ float* COS() const { return (float*)(ws + WS_MISC + MISC_COS); }
    __device__ __forceinline__ float* SIN() const { return (float*)(ws + WS_MISC + MISC_SIN); }
    __device__ __forceinline__ unsigned char* RCH() const { return ws + WS_RCH; }
    __device__ __forceinline__ unsigned char* RVT() const { return ws + WS_RVT; }
    __device__ __forceinline__ unsigned char* GCH() const { return ws + WS_GCH; }
    __device__ __forceinline__ float* GUT() const { return (float*)(ws + WS_GUT); }
    __device__ __forceinline__ float* GDCH() const { return (float*)(ws + WS_GDCH); }
};
#define LDS_WAIT() asm volatile("s_waitcnt lgkmcnt(0)" ::: "memory")

enum { WM_PLAIN = 0, WM_FFNIN = 1, WM_WIN = 2 };
__device__ __forceinline__ int map_col(int mode, int n0) {
    if (mode == WM_FFNIN) { const int tile = n0 >> 8, w = n0 & 255; return (w < 128) ? tile * 128 + w : DFF + tile * 128 + (w - 128); }
    if (mode == WM_WIN) return n0 < PC_MQ ? n0 : n0 + 8;
    return n0;
}
__device__ __forceinline__ void transpose_item(const float* W, int K, int Nraw, int N, int mode, bf16_t* WT, const float* gk, LAS float* scr, int item, int lane) {
    const int nblk = N / 32, kb = item / nblk, nb = item % nblk, k0 = 64 * kb, n0 = 32 * nb, nr0 = map_col(mode, n0);
    f32x4 wv[8];
#pragma unroll
    for (int i = 0; i < 8; ++i) wv[i] = *(const f32x4*)(W + (size_t)(k0 + 8 * i + (lane >> 3)) * Nraw + nr0 + 4 * (lane & 7));
    if (gk) {
#pragma unroll
        for (int i = 0; i < 8; ++i) wv[i] = wv[i] * gk[k0 + 8 * i + (lane >> 3)]; }
#pragma unroll
    for (int i = 0; i < 8; ++i) { LAS float* d = scr + (8 * i + (lane >> 3)) * 33 + 4 * (lane & 7); d[0] = wv[i].x; d[1] = wv[i].y; d[2] = wv[i].z; d[3] = wv[i].w; }
    LDS_WAIT(); asm volatile("" ::: "memory");
    const int c = lane & 7;
#pragma unroll
    for (int j = 0; j < 4; ++j) { const int n = (lane >> 3) + 8 * j; const LAS float* s = scr + (8 * c) * 33 + n;
        u32x4 o; o.x = pk2(s[0 * 33], s[1 * 33]); o.y = pk2(s[2 * 33], s[3 * 33]); o.z = pk2(s[4 * 33], s[5 * 33]); o.w = pk2(s[6 * 33], s[7 * 33]);
        *(u32x4*)(WT + (size_t)(n0 + n) * K + k0 + 8 * c) = o; }
    LDS_WAIT(); asm volatile("" ::: "memory");
}
struct TJob { const float* W; int K, Nraw, N, mode; bf16_t* WT; const float* gk; };
__device__ __forceinline__ TJob get_job(int j, const Frame& F) {
    const int l = j / 11, t = j % 11; unsigned char* wl = F.ws + WS_W0 + (size_t)l * WS_WL; TJob r;
    switch (t) {
    case 0:  r = TJob{F.inp(10) + (size_t)l * D * NFFI, D, NFFI, NFFI, WM_FFNIN, (bf16_t*)(wl + OFF_W1I), F.inp(8) + (size_t)l * D}; break;
    case 1:  r = TJob{F.inp(11) + (size_t)l * DFF * D, DFF, D, D, WM_PLAIN, (bf16_t*)(wl + OFF_W1O), nullptr}; break;
    case 2:  r = TJob{F.inp(14) + (size_t)l * D * WIN_RAW, D, WIN_RAW, NWIN, WM_WIN, (bf16_t*)(wl + OFF_WIN), F.inp(12) + (size_t)l * D}; break;
    case 3:  r = TJob{F.inp(20) + (size_t)l * D * D, D, D, D, WM_PLAIN, (bf16_t*)(F.ws + WS_WMKV) + (size_t)(l * 2048) * D, nullptr}; break;
    case 4:  r = TJob{F.inp(21) + (size_t)l * D * D, D, D, D, WM_PLAIN, (bf16_t*)(F.ws + WS_WMKV) + (size_t)(l * 2048 + 1024) * D, nullptr}; break;
    case 5:  r = TJob{F.inp(22) + (size_t)l * D * D, D, D, D, WM_PLAIN, (bf16_t*)(wl + OFF_WBR), nullptr}; break;
    case 6:  r = TJob{F.inp(23) + (size_t)l * D * D, D, D, D, WM_PLAIN, (bf16_t*)(wl + OFF_WBR) + (size_t)D * D, nullptr}; break;
    case 7:  r = TJob{F.inp(24) + (size_t)l * D * D, D, D, D, WM_PLAIN, (bf16_t*)(wl + OFF_WBR) + (size_t)2 * D * D, nullptr}; break;
    case 8:  r = TJob{F.inp(25) + (size_t)l * D * D, D, D, D, WM_PLAIN, (bf16_t*)(wl + OFF_WO), nullptr}; break;
    case 9:  r = TJob{F.inp(28) + (size_t)l * D * NFFI, D, NFFI, NFFI, WM_FFNIN, (bf16_t*)(wl + OFF_W2I), F.inp(26) + (size_t)l * D}; break;
    default: r = TJob{F.inp(29) + (size_t)l * DFF * D, DFF, D, D, WM_PLAIN, (bf16_t*)(wl + OFF_W2O), nullptr}; break;
    }
    return r;
}

struct NormArgs { const bf16_t* tmp; const float* gpost; float scale; const float* gpre; const float* wab; int first, fin; };
__device__ __forceinline__ void norm_phase(const Frame& F, const NormArgs na) {
    const int gw = F.bid * NWAVES + F.wave, NGW = F.G * NWAVES, lane = F.lane;
#define FI(j) (2 * lane + 128 * ((j) >> 1) + ((j) & 1))
#define NP_LD(mm, hh, tt) do { if ((mm) < MREAL) { _Pragma("unroll") for (int jj = 0; jj < 2; ++jj) { hh[jj] = *((const u32x4*)(F.H() + (size_t)(mm) * D) + lane + 64 * jj); tt[jj] = *((const u32x4*)(na.tmp + (size_t)(mm) * D) + lane + 64 * jj); } } } while (0)
#define NP_LDX(mm, xx) do { if ((mm) < MREAL) { const float* src_ = ((mm) < MP) ? F.inp(0) + (size_t)(mm) * D : F.inp(1) + (size_t)((mm) - MP) * D; _Pragma("unroll") for (int j = 0; j < 4; ++j) xx[j] = *((const f32x4*)src_ + FI(j)); } } while (0)
    const u32x4 z4 = (u32x4){0u, 0u, 0u, 0u};
    f32x4 gpq[4];
#pragma unroll
    for (int j = 0; j < 4; ++j) gpq[j] = na.tmp ? *((const f32x4*)na.gpost + FI(j)) : (f32x4){0.f, 0.f, 0.f, 0.f};
    f32x4 wq[8][4];
#pragma unroll
    for (int q = 0; q < 8; ++q)
#pragma unroll
        for (int j = 0; j < 4; ++j) wq[q][j] = na.wab ? *((const f32x4*)(na.wab + q * D) + FI(j)) : (f32x4){0.f, 0.f, 0.f, 0.f};
    u32x4 h0[2] = {z4, z4}, t0[2] = {z4, z4}, h1[2] = {z4, z4}, t1[2] = {z4, z4};
    f32x4 x0[4];
#pragma unroll
    for (int j = 0; j < 4; ++j) x0[j] = (f32x4){0.f, 0.f, 0.f, 0.f};
    if (na.first) NP_LDX(gw, x0); else { NP_LD(gw, h0, t0); NP_LD(gw + NGW, h1, t1); }
    for (int m = gw; m < MREAL; m += NGW) {
        f32x4 h[4]; const u32x4 tc[2] = {t0[0], t0[1]};
        if (na.first) {
#pragma unroll
            for (int j = 0; j < 4; ++j) h[j] = x0[j];
            NP_LDX(m + NGW, x0);
        } else {
            const u32x4 hc[2] = {h0[0], h0[1]};
            h0[0] = h1[0]; h0[1] = h1[1]; t0[0] = t1[0]; t0[1] = t1[1];
            NP_LD(m + 2 * NGW, h1, t1);
#pragma unroll
            for (int jj = 0; jj < 2; ++jj) { const u32x4 w = hc[jj]; h[2 * jj] = (f32x4){bf2f(w.x & 0xffffu), bf2f(w.x >> 16), bf2f(w.y & 0xffffu), bf2f(w.y >> 16)}; h[2 * jj + 1] = (f32x4){bf2f(w.z & 0xffffu), bf2f(w.z >> 16), bf2f(w.w & 0xffffu), bf2f(w.w >> 16)}; }
        }
        if (na.tmp) {
            f32x4 t[4]; float ss = 0.f;
#pragma unroll
            for (int jj = 0; jj < 2; ++jj) { const u32x4 w = tc[jj]; t[2 * jj] = (f32x4){bf2f(w.x & 0xffffu), bf2f(w.x >> 16), bf2f(w.y & 0xffffu), bf2f(w.y >> 16)}; t[2 * jj + 1] = (f32x4){bf2f(w.z & 0xffffu), bf2f(w.z >> 16), bf2f(w.w & 0xffffu), bf2f(w.w >> 16)}; }
#pragma unroll
            for (int j = 0; j < 4; ++j) ss += (t[j].x * t[j].x + t[j].y * t[j].y) + (t[j].z * t[j].z + t[j].w * t[j].w);
            const float r = na.scale / sqrtf(wave_sum(ss) * (1.f / D) + EPS);
#pragma unroll
            for (int j = 0; j < 4; ++j) h[j] = h[j] + t[j] * gpq[j] * r;
        }
        if (!na.fin) {
#pragma unroll
            for (int jj = 0; jj < 2; ++jj) { u32x4 w; w.x = pk2(h[2 * jj].x, h[2 * jj].y); w.y = pk2(h[2 * jj].z, h[2 * jj].w); w.z = pk2(h[2 * jj + 1].x, h[2 * jj + 1].y); w.w = pk2(h[2 * jj + 1].z, h[2 * jj + 1].w); *((u32x4*)(F.H() + (size_t)m * D) + lane + 64 * jj) = w; } }
        if (na.fin && m < MREAL) {
            float* dst = (m < MP) ? F.out + O_YP + (size_t)m * D : F.out + O_YS + (size_t)(m - MP) * D;
#pragma unroll
            for (int j = 0; j < 4; ++j) *((f32x4*)dst + FI(j)) = h[j];
        }
        float s2 = 0.f;
#pragma unroll
        for (int j = 0; j < 4; ++j) s2 += (h[j].x * h[j].x + h[j].y * h[j].y) + (h[j].z * h[j].z + h[j].w * h[j].w);
        const float r2 = 1.f / sqrtf(wave_sum(s2) * (1.f / D) + EPS);
        if (lane == 0) F.RS()[m] = r2;
        if (na.wab) {
            float d8 = 0.f;
#pragma unroll
            for (int q = 0; q < 8; ++q) { float s = 0.f;
#pragma unroll
                for (int j = 0; j < 4; ++j) { const f32x4 w = wq[q][j]; s += (h[j].x * w.x + h[j].y * w.y) + (h[j].z * w.z + h[j].w * w.w); }
                s = wave_sum(s) * r2; d8 = (lane == q) ? s : d8; }
            if (lane < 8) F.AB()[(size_t)m * 8 + lane] = d8;
        }
    }
}
#undef FI
#undef NP_LD
#undef NP_LDX

__device__ __forceinline__ void p0_prologue(const Frame& F) {
    LAS float* scr = (LAS float*)(F.lds + F.wave * 16384);
    const int gw = F.bid * NWAVES + F.wave, NGW = F.G * NWAVES;
    int dealt = 0;
    for (int j = 0; j < 16; ++j) { if (j >= 5 && j != 14 && j != 15) continue;
        const TJob tj = get_job(j, F); const int nitems = (tj.K / 64) * (tj.N / 32);
        int first = (gw - dealt) % NGW; if (first < 0) first += NGW;
        for (int it = first; it < nitems; it += NGW) transpose_item(tj.W, tj.K, tj.Nraw, tj.N, tj.mode, tj.WT, tj.gk, scr, it, F.lane);
        dealt = (dealt + nitems) % NGW; }
    const int gt = F.bid * (NWAVES * 64) + F.tid, NGT = F.G * NWAVES * 64;
    for (int i = gt; i < 2 * 8 * D; i += NGT) { const int l = i / (8 * D), q = (i / D) % 8, k = i % D; F.WAB()[i] = F.inp(14)[(size_t)l * D * WIN_RAW + (size_t)k * WIN_RAW + PC_MQ + q] * F.inp(12)[(size_t)l * D + k]; }
    for (int i = gt; i < 2049 * 64; i += NGT) { const int p = i >> 6, d = i & 63; const double pos = (p == 2048) ? (double)PAST_LEN : (double)p;
        const double ang = pos * pow(10000.0, -(double)d / 64.0); F.COS()[i] = (float)cos(ang); F.SIN()[i] = (float)sin(ang); }
    for (int r = gw; r < 2 * NB * NMEM; r += NGW) { const int l = r / (NB * NMEM), row = r % (NB * NMEM);
        f32x4 v[4], gq[4]; float ss = 0.f;
#pragma unroll
        for (int j = 0; j < 4; ++j) { v[j] = *((const f32x4*)(F.inp(2) + (size_t)row * D) + F.lane + 64 * j); ss += (v[j].x * v[j].x + v[j].y * v[j].y) + (v[j].z * v[j].z + v[j].w * v[j].w); }
        const float rr = 1.f / sqrtf(wave_sum(ss) * (1.f / D) + EPS);
        u32x2* o8 = (u32x2*)(F.MEMN() + (size_t)r * D) + F.lane;
#pragma unroll
        for (int j = 0; j < 4; ++j) gq[j] = *((const f32x4*)(F.inp(19) + (size_t)l * D) + F.lane + 64 * j);
        asm volatile("" ::: "memory");
#pragma unroll
        for (int j = 0; j < 4; ++j) { const f32x4 y = v[j] * gq[j] * rr; u32x2 w; w.x = pk2(y.x, y.y); w.y = pk2(y.z, y.w); o8[64 * j] = w; }
    }
    NormArgs na{nullptr, nullptr, 0.f, F.inp(8), nullptr, 1, 0};
    norm_phase(F, na);
}

__device__ __forceinline__ void convert_layer1(const Frame& F, int idx, int nw) {
    LAS float* scr = (LAS float*)(F.lds + F.wave * 16384);
    const int gw = idx * NWAVES + F.wave, NGW = nw * NWAVES;
    int dealt = 0;
    for (int j = 5; j < 22; ++j) { if (j == 14 || j == 15) continue;
        const TJob tj = get_job(j, F); const int nitems = (tj.K / 64) * (tj.N / 32);
        int first = (gw - dealt) % NGW; if (first < 0) first += NGW;
        for (int it = first; it < nitems; it += NGW) transpose_item(tj.W, tj.K, tj.Nraw, tj.N, tj.mode, tj.WT, tj.gk, scr, it, F.lane);
        dealt = (dealt + nitems) % NGW; }
}

__device__ __forceinline__ bf16x8 ldnat(const void* base, unsigned row_boff, int s, int g) { return *(const bf16x8*)((const char*)base + (row_boff + 64u * s + 16u * g)); }
__device__ __forceinline__ bf16x8 ldperm(const void* base, unsigned row_boff, int s, int g) {
    const unsigned o = row_boff + 64u * s + 8u * g; const bf16x4 lo = *(const bf16x4*)((const char*)base + o), hi = *(const bf16x4*)((const char*)base + (o + 32u));
    return __builtin_shufflevector(lo, hi, 0, 1, 2, 3, 4, 5, 6, 7);
}
#define CBAR() asm volatile("" ::: "memory")
__device__ __forceinline__ bf16x8 lds_frag(const LAS float* rowp, int s, int g, float scale) {
    const f32x4 a = *(const LAS f32x4*)(rowp + 32 * s + 8 * g), b = *(const LAS f32x4*)(rowp + 32 * s + 8 * g + 4);
    return pack8(a * scale, b * scale);
}

__device__ __forceinline__ void ret_prep(const Frame& F, int ci) {
    const int tid = F.tid, lane = F.lane, wv = F.wave;
    const int bh = ci >> 5, n = ci & 31, b = bh >> 2, h = bh & 3, m0 = b * SEQ + n * CH;
    const float lg = log1pf(-exp2f(-5.0f - (float)h));
    LAS float* qf = (LAS float*)F.lds;
    LAS float* kf = qf + 64 * 132;
    LAS bf16_t* vs = (LAS bf16_t*)(kf + 64 * 132);
    u32x4 vr[4];
#pragma unroll
    for (int r = 0; r < 4; ++r) { const int p = tid + 512 * r, row = p >> 5, c8 = (p & 31) * 8; vr[r] = *(const u32x4*)(F.PROJ() + (size_t)(m0 + row) * NWIN + PC_RV + h * DV + c8); }
    {   const int i = tid >> 3, d0 = (tid & 7) * 8, t = n * CH + i;
        const bf16_t* qrow = F.PROJ() + (size_t)(m0 + i) * NWIN + PC_RQ + h * DK; const bf16_t* krow = F.PROJ() + (size_t)(m0 + i) * NWIN + PC_RK + h * DK;
        const u32x4 q1 = *(const u32x4*)(qrow + d0), q2 = *(const u32x4*)(qrow + 64 + d0), k1 = *(const u32x4*)(krow + d0), k2 = *(const u32x4*)(krow + 64 + d0);
        const float* cp = F.COS() + t * 64 + d0; const float* sp = F.SIN() + t * 64 + d0;
        float cs[8], sn[8];
#pragma unroll
        for (int e = 0; e < 8; ++e) { cs[e] = cp[e]; sn[e] = sp[e]; }
        const float qd = fexp(lg * (float)(i + 1));
        float o1[8], o2[8];
#pragma unroll
        for (int e = 0; e < 8; ++e) { const unsigned w1 = q1[e >> 1], w2 = q2[e >> 1]; const float x1 = (e & 1) ? bf2f(w1 >> 16) : bf2f(w1 & 0xffffu), x2 = (e & 1) ? bf2f(w2 >> 16) : bf2f(w2 & 0xffffu);
            o1[e] = x1 * cs[e] - x2 * sn[e]; o2[e] = x1 * sn[e] + x2 * cs[e]; qf[i * 132 + d0 + e] = o1[e]; qf[i * 132 + 64 + d0 + e] = o2[e]; }
        {
            unsigned char* qb = F.RCH() + (size_t)ci * RCH_BYTES + RCH_QD + (i >> 4) * 4096 + (i & 15) * 16;
#pragma unroll
            for (int hh = 0; hh < 2; ++hh) { const int D0 = d0 + 64 * hh, s = D0 >> 5, half = (D0 >> 4) & 1, g0 = (D0 & 15) >> 2; const float* o = hh ? o2 : o1;
                u32x2 w; w.x = pk2(o[0] * qd, o[1] * qd); w.y = pk2(o[2] * qd, o[3] * qd); *(u32x2*)(qb + s * 1024 + g0 * 256 + half * 8) = w;
                w.x = pk2(o[4] * qd, o[5] * qd); w.y = pk2(o[6] * qd, o[7] * qd); *(u32x2*)(qb + s * 1024 + (g0 + 1) * 256 + half * 8) = w; }
        }
        const float ksc = 0.08838834764831845f;
#pragma unroll
        for (int e = 0; e < 8; ++e) { const unsigned w1 = k1[e >> 1], w2 = k2[e >> 1]; const float x1 = (e & 1) ? bf2f(w1 >> 16) : bf2f(w1 & 0xffffu), x2 = (e & 1) ? bf2f(w2 >> 16) : bf2f(w2 & 0xffffu);
            kf[i * 132 + d0 + e] = (x1 * cs[e] - x2 * sn[e]) * ksc; kf[i * 132 + 64 + d0 + e] = (x1 * sn[e] + x2 * cs[e]) * ksc; }
    }
#pragma unroll
    for (int r = 0; r < 4; ++r) { const int p = tid + 512 * r, row = p >> 5, c8 = (p & 31) * 8; *(LAS u32x4*)(vs + row * 264 + c8) = vr[r]; }
    __syncthreads();
    {
        const int d = tid >> 2, i0 = (tid & 3) * 16; unsigned w[8];
#pragma unroll
        for (int r = 0; r < 16; r += 2) { const float v0 = kf[(i0 + r) * 132 + d] * fexp(lg * (float)(63 - (i0 + r))), v1 = kf[(i0 + r + 1) * 132 + d] * fexp(lg * (float)(62 - (i0 + r))); w[r >> 1] = pk2(v0, v1); }
        unsigned char* kb = F.RCH() + (size_t)ci * RCH_BYTES + RCH_KDT + (d >> 4) * 2048 + (d & 15) * 16 + (i0 >> 5) * 1024 + ((i0 & 31) >> 3) * 256;
        *(u32x4*)kb = (u32x4){w[0], w[1], w[2], w[3]}; *(u32x4*)(kb + 256) = (u32x4){w[4], w[5], w[6], w[7]};
    }
    {
        const int e = tid >> 1, i0 = (tid & 1) * 32; unsigned w[16];
#pragma unroll
        for (int r = 0; r < 32; r += 2) w[r >> 1] = (unsigned)vs[(i0 + r) * 264 + e] | ((unsigned)vs[(i0 + r + 1) * 264 + e] << 16);
        unsigned char* vb = F.RVT() + (size_t)ci * 32768 + ((e >> 4) * 2 + (i0 >> 5)) * 1024 + (e & 15) * 16;
#pragma unroll
        for (int q = 0; q < 4; ++q) *(u32x4*)(vb + q * 256) = (u32x4){w[4 * q], w[4 * q + 1], w[4 * q + 2], w[4 * q + 3]};
    }
    {
        const int c = lane & 15, g = lane >> 4;
#pragma unroll
        for (int x = 0; x < 2; ++x) { const int tt = 2 * wv + x, jt = tt >> 2, it = tt & 3;
            f32x4 acc = (f32x4){0.f, 0.f, 0.f, 0.f};
            if (it >= jt) {
#pragma unroll
                for (int s = 0; s < 4; ++s) { const bf16x8 A = lds_frag(kf + (16 * jt + c) * 132, s, g, 1.0f), B = lds_frag(qf + (16 * it + c) * 132, s, g, 1.0f); acc = MFMA16(A, B, acc); }
            }
            const int i = 16 * it + c; float r4[4];
#pragma unroll
            for (int r = 0; r < 4; ++r) { const int j = 16 * jt + 4 * g + r; r4[r] = (i >= j) ? acc[r] * fexp(lg * (float)(i - j)) : 0.f; }
            u32x2 w; w.x = pk2(r4[0], r4[1]); w.y = pk2(r4[2], r4[3]);
            *(u32x2*)(F.RCH() + (size_t)ci * RCH_BYTES + RCH_ATT + (it * 2 + (jt >> 1)) * 1024 + (c + 16 * (2 * (jt & 1) + (g >> 1))) * 16 + (g & 1) * 8) = w; }
    }
    __syncthreads();
}

__device__ __forceinline__ void gdn_prep(const Frame& F, int l, int ci) {
    const int tid = F.tid, lane = F.lane, wv = F.wave;
    const int bh = ci >> 5, n = ci & 31, b = bh >> 2, h = bh & 3, m0 = b * SEQ + n * CH;
    LAS bf16_t* raw = (LAS bf16_t*)F.lds;
    LAS float* qf = (LAS float*)F.lds;
    LAS float* kf = qf + 64 * 132;
    LAS bf16_t* wst = (LAS bf16_t*)F.lds;
    LAS float* Am = (LAS float*)(F.lds + 69888);
    LAS float* sm = (LAS float*)(F.lds + 86272);
    LAS float* bcum = sm; LAS float* beta = sm + 64; LAS float* rq = sm + 128; LAS float* rk = sm + 192; LAS float* eb = sm + 256;
    float ab_a = 0.f, ab_b = 0.f;
    if (wv == 0) { const int m = m0 + lane; ab_a = F.AB()[(size_t)m * 8 + h]; ab_b = F.AB()[(size_t)m * 8 + 4 + h]; }
    {
        u32x4 rv[9]; const int pc = tid & 63, col8 = pc * 8;
        const int sc = (pc < 16) ? PC_GQKV + h * DK + col8 : (pc < 32) ? PC_GQKV + 512 + h * DK + (col8 - 128) : PC_GQKV + 1024 + h * DV + (col8 - 256);
#pragma unroll
        for (int it = 0; it < 9; ++it) { const int row = (tid >> 6) + 8 * it, t = n * CH + row - 3; rv[it] = (u32x4){0u, 0u, 0u, 0u};
            if (row < 67 && t >= 0) rv[it] = *(const u32x4*)(F.PROJ() + (size_t)(b * SEQ + t) * NWIN + sc); }
        asm volatile("" ::: "memory");
#pragma unroll
        for (int it = 0; it < 9; ++it) { const int row = (tid >> 6) + 8 * it; if (row < 67) *(LAS u32x4*)(raw + row * 520 + col8) = rv[it]; }
    }
    if (wv == 0) { const float a = ab_a, bb = ab_b;
        const float x = a + F.inp(17)[l * 4 + h]; const float sp = fmaxf(x, 0.f) + log1pf(expf(-fabsf(x)));
        float gg = -expf(F.inp(16)[l * 4 + h]) * sp;
#pragma unroll
        for (int o = 1; o < 64; o <<= 1) { const float t = __shfl_up(gg, o); if (lane >= o) gg += t; }
        bcum[lane] = gg; beta[lane] = 1.f / (1.f + expf(-bb)); eb[lane] = expf(gg); }
    __syncthreads();
    LAS float* vpark = (LAS float*)(F.lds + 88832);
    {   float x[64];
        const int col = (tid < 256) ? 256 + tid : (tid < 384) ? 128 + (tid - 256) : tid - 384;
        const int C = (tid < 256) ? 1024 + h * DV + tid : (tid < 384) ? 512 + h * DK + (tid - 256) : h * DK + (tid - 384);
        const float* cw = F.inp(15) + (size_t)l * 4 * CONVD + C; const float w0 = cw[0], w1 = cw[CONVD], w2 = cw[2 * CONVD], w3 = cw[3 * CONVD];
        float r0 = bf2f(raw[0 * 520 + col]), r1 = bf2f(raw[1 * 520 + col]), r2 = bf2f(raw[2 * 520 + col]);
#pragma unroll
        for (int i0 = 0; i0 < 64; i0 += 16) { unsigned rr[16];
#pragma unroll
            for (int i = 0; i < 16; ++i) rr[i] = raw[(i0 + i + 3) * 520 + col];
            asm volatile("" ::: "memory");
#pragma unroll
            for (int i = 0; i < 16; ++i) { const float r3 = bf2f(rr[i]); x[i0 + i] = siluf_(r0 * w0 + r1 * w1 + r2 * w2 + r3 * w3); r0 = r1; r1 = r2; r2 = r3; } }
    __syncthreads();
    {
        LAS float* dst = (tid < 256) ? vpark + tid : (tid < 384) ? kf + (tid - 256) : qf + (tid - 384); const int pitch = (tid < 256) ? 260 : 132;
#pragma unroll
        for (int i = 0; i < 64; ++i) dst[i * pitch] = x[i]; }
    }
    __syncthreads();
    {   const int i = tid >> 3, p = tid & 7; float sq = 0.f, sk = 0.f;
#pragma unroll
        for (int d = 0; d < 16; ++d) { const float a = qf[i * 132 + 16 * p + d], bq = kf[i * 132 + 16 * p + d]; sq += a * a; sk += bq * bq; }
        sq += __shfl_xor(sq, 1); sq += __shfl_xor(sq, 2); sq += __shfl_xor(sq, 4); sk += __shfl_xor(sk, 1); sk += __shfl_xor(sk, 2); sk += __shfl_xor(sk, 4);
        if (p == 0) { rq[i] = 0.08838834764831845f / sqrtf(sq + EPS); rk[i] = 1.f / sqrtf(sk + EPS); } }
    __syncthreads();
    unsigned char* gch = F.GCH() + (size_t)ci * GCH_BYTES; asm volatile("" : "+s"(gch)); gch = (unsigned char*)(GAS unsigned char*)gch;
#pragma unroll
    for (int rep = 0; rep < 2; ++rep) { const int idx = tid + 512 * rep;
        {   const int i = idx >> 4, s = (idx >> 2) & 3, g = idx & 3; const float sc = rq[i] * eb[i];
            const f32x4 lo = *(const LAS f32x4*)(qf + i * 132 + 32 * s + 4 * g), hi = *(const LAS f32x4*)(qf + i * 132 + 32 * s + 16 + 4 * g);
            *(bf16x8*)(gch + GCH_QD + ((i >> 4) * 4 + s) * 1024 + ((i & 15) + 16 * g) * 16) = pack8(lo * sc, hi * sc); }
        {   const int d = idx >> 3, s = (idx >> 2) & 1, g = idx & 3; const float bl = bcum[63]; float v[8];
#pragma unroll
            for (int j = 0; j < 8; ++j) { const int p = 32 * s + 16 * (j >> 2) + 4 * g + (j & 3); v[j] = kf[p * 132 + d] * rk[p] * fexp(bl - bcum[p]); }
            u32x4 w; w.x = pk2(v[0], v[1]); w.y = pk2(v[2], v[3]); w.z = pk2(v[4], v[5]); w.w = pk2(v[6], v[7]);
            *(u32x4*)(gch + GCH_KDT + ((d >> 4) * 2 + s) * 1024 + ((d & 15) + 16 * g) * 16) = w; }
    }
    if (tid == 0) F.GDCH()[ci] = fexp(bcum[63]);
    CBAR();
    {
        const int c = lane & 15, g = lane >> 4, jt = wv >> 1;
        bf16x8 A[4];
#pragma unroll
        for (int s = 0; s < 4; ++s) A[s] = lds_frag(kf + (16 * jt + c) * 132, s, g, rk[16 * jt + c]);
#pragma unroll
        for (int xx = 0; xx < 2; ++xx) { const int it = 2 * (wv & 1) + xx, i = 16 * it + c;
            f32x4 aq = (f32x4){0.f, 0.f, 0.f, 0.f}, ak = (f32x4){0.f, 0.f, 0.f, 0.f};
            if (it >= jt) {
#pragma unroll
                for (int s = 0; s < 4; ++s) { const bf16x8 Bq = lds_frag(qf + i * 132, s, g, rq[i]), Bk = lds_frag(kf + i * 132, s, g, rk[i]); aq = MFMA16(A[s], Bq, aq); ak = MFMA16(Bk, A[s], ak); CBAR(); }
            }
            const float bi = bcum[i]; float ra[4]; f32x4 rm;
#pragma unroll
            for (int r = 0; r < 4; ++r) { const int j = 16 * jt + 4 * g + r; const float dec = fexp(fminf(bi - bcum[j], 0.f)); ra[r] = (i >= j) ? aq[r] * dec : 0.f; }
            const int j2 = 16 * jt + c; const float bj2 = bcum[j2];
#pragma unroll
            for (int r = 0; r < 4; ++r) { const int i2 = 16 * it + 4 * g + r; rm[r] = (i2 > j2) ? beta[i2] * ak[r] * fexp(fminf(bcum[i2] - bj2, 0.f)) : 0.f; }
            u32x2 w; w.x = pk2(ra[0], ra[1]); w.y = pk2(ra[2], ra[3]);
            *(u32x2*)(gch + GCH_ATT + (it * 2 + (jt >> 1)) * 1024 + (c + 16 * g) * 16 + (jt & 1) * 8) = w;
            *(LAS f32x4*)(Am + j2 * 64 + 16 * it + 4 * g) = rm; }
    }
    __syncthreads();
    if (tid < 384) {
        int z0; asm volatile("v_mov_b32 %0, 0" : "=v"(z0)); const LAS float* Amz = Am + z0; const LAS float* smz = sm + z0;
        f32x2 xv[32];
        if (tid < 256) {
#pragma unroll
            for (int i = 0; i < 64; ++i) xv[i >> 1][i & 1] = vpark[i * 260 + tid] * smz[64 + i];
        } else {
#pragma unroll
            for (int i = 0; i < 64; ++i) xv[i >> 1][i & 1] = kf[i * 132 + (tid - 256)] * (smz[64 + i] * smz[192 + i] * smz[256 + i]);
        }
#pragma unroll
        for (int j = 0; j < 63; ++j) { const float xj = xv[j >> 1][j & 1]; const f32x2 xj2 = (f32x2){xj, xj};
#pragma unroll
            for (int i4 = (j + 1) / 4; i4 < 16; ++i4) { const f32x4 a = *(const LAS f32x4*)(Amz + j * 64 + 4 * i4);
                xv[2 * i4] -= (f32x2){a.x, a.y} * xj2; xv[2 * i4 + 1] -= (f32x2){a.z, a.w} * xj2; if ((i4 & 3) == 3) CBAR(); } CBAR(); }
        float x[64];
#pragma unroll
        for (int i = 0; i < 64; ++i) x[i] = xv[i >> 1][i & 1];
        if (tid < 256) { unsigned char* dstb = (unsigned char*)F.GUT() + (size_t)ci * 32768; asm volatile("" : "+s"(dstb)); dstb = (unsigned char*)(GAS unsigned char*)dstb; unsigned char* dst = dstb + (tid >> 4) * 2048 + (tid & 15) * 16;
#pragma unroll
            for (int q = 0; q < 16; ++q) { u32x2 w; w.x = pk2(x[4 * q], x[4 * q + 1]); w.y = pk2(x[4 * q + 2], x[4 * q + 3]); *(u32x2*)(dst + (q >> 3) * 1024 + (q & 3) * 256 + ((q >> 2) & 1) * 8) = w; } }
        else { const int d = tid - 256;
#pragma unroll
            for (int i = 0; i < 64; ++i) wst[i * 136 + d] = (bf16_t)f2bf(x[i]); }
    }
    __syncthreads();
#pragma unroll
    for (int rep = 0; rep < 2; ++rep) { const int idx = tid + 512 * rep, i = idx >> 4, s = (idx >> 2) & 3, g = idx & 3;
        const u32x2 lo = *(const LAS u32x2*)(wst + i * 136 + 32 * s + 4 * g), hi = *(const LAS u32x2*)(wst + i * 136 + 32 * s + 16 + 4 * g);
        *(u32x4*)(gch + GCH_W + ((i >> 4) * 4 + s) * 1024 + ((i & 15) + 16 * g) * 16) = (u32x4){lo.x, lo.y, hi.x, hi.y}; }
    __syncthreads();
}

__device__ __forceinline__ void mem_attn_unit(const Frame& F, int l, int u) {
    const int lane = F.lane, wv = F.wave, c = lane & 15, g = lane >> 4;
    const int bh = u >> 4, qb = u & 15, b = bh >> 2, h = bh & 3, mq = b * SEQ + qb * 128 + wv * 16;
    const unsigned char* kf = (const unsigned char*)F.MK() + ((((size_t)l * NB + b) * NH + h) << 17) + lane * 16;
    const unsigned char* vf = (const unsigned char*)F.MVT() + ((((size_t)l * NB + b) * NH + h) << 17) + lane * 16;
    LAS unsigned char* ring = F.lds;
#define ATT_DMA(ch_) do { const unsigned char* src_ = ((ch_) < 4 ? kf + (ch_) * 32768 : vf + ((ch_) - 4) * 32768); LAS unsigned char* dst_ = ring + ((ch_) % 3) * 32768; \
        _Pragma("unroll") for (int k_ = 0; k_ < 4; ++k_) __builtin_amdgcn_global_load_lds((const unsigned*)(src_ + (wv + 8 * k_) * 1024), (LAS unsigned*)(dst_ + (wv + 8 * k_) * 1024), 16, 0, 0); } while (0)
#define ATT_WAIT(n_) do { if ((n_) == 4) asm volatile("s_waitcnt vmcnt(4)" ::: "memory"); else if ((n_) == 8) asm volatile("s_waitcnt vmcnt(8)" ::: "memory"); else asm volatile("s_waitcnt vmcnt(12)" ::: "memory"); \
        __builtin_amdgcn_s_barrier(); asm volatile("" ::: "memory"); } while (0)
    ATT_DMA(0); ATT_DMA(1);
    bf16x8 Qf[8]; { const unsigned qo = ((unsigned)(mq + c) * NWIN + PC_MQ + h * 256) * 2u;
#pragma unroll
        for (int s = 0; s < 8; ++s) Qf[s] = ldnat(F.PROJ(), qo, s, g); }
    asm volatile("s_waitcnt vmcnt(0)" ::: "memory");
    f32x4 sacc[16]; bf16x8 Pf[8]; float inv = 1.f;
    bf16_t* obase = F.OBR() + 2 * OBR_STRIDE; const unsigned oo = ((unsigned)(mq + c) * D + h * 256 + 4 * g) * 2u;
#pragma unroll
    for (int ch = 0; ch < 8; ++ch) {
        ATT_WAIT((ch + 1 < 8 ? 4 : 0) + (ch - 1 >= 4 ? 4 : 0) + (ch - 2 >= 4 ? 4 : 0));
        if (ch + 2 < 8) ATT_DMA(ch + 2);
        const LAS unsigned char* Bq = ring + (ch % 3) * 32768 + lane * 16;
        if (ch < 4) {
#pragma unroll
            for (int k4 = 0; k4 < 4; ++k4) { f32x4 a0 = (f32x4){0.f, 0.f, 0.f, 0.f};
#pragma unroll
                for (int s = 0; s < 8; ++s) a0 = MFMA16(*(const LAS bf16x8*)(Bq + (k4 * 8 + s) * 1024), Qf[s], a0);
                sacc[4 * ch + k4] = a0; }
            if (ch == 3) {
                float mx = -3.0e38f;
#pragma unroll
                for (int kt = 0; kt < 16; ++kt)
#pragma unroll
                    for (int r = 0; r < 4; ++r) mx = fmaxf(mx, sacc[kt][r]);
                mx = fmaxf(mx, __shfl_xor(mx, 16)); mx = fmaxf(mx, __shfl_xor(mx, 32));
                float sum = 0.f; const float sc = 0.0625f * 1.4426950408889634f;
#pragma unroll
                for (int kt = 0; kt < 16; ++kt)
#pragma unroll
                    for (int r = 0; r < 4; ++r) { const float p = __builtin_amdgcn_exp2f((sacc[kt][r] - mx) * sc); sacc[kt][r] = p; sum += p; }
                sum += __shfl_xor(sum, 16); sum += __shfl_xor(sum, 32);
                inv = 1.f / sum;
#pragma unroll
                for (int ks = 0; ks < 8; ++ks) Pf[ks] = pack8(sacc[2 * ks], sacc[2 * ks + 1]);
            }
        } else {
#pragma unroll
            for (int e4 = 0; e4 < 4; ++e4) { f32x4 a0 = (f32x4){0.f, 0.f, 0.f, 0.f}; const int et = 4 * (ch - 4) + e4;
#pragma unroll
                for (int ks = 0; ks < 8; ++ks) a0 = MFMA16(*(const LAS bf16x8*)(Bq + (e4 * 8 + ks) * 1024), Pf[ks], a0);
                u32x2 w; w.x = pk2(a0[0] * inv, a0[1] * inv); w.y = pk2(a0[2] * inv, a0[3] * inv);
                *(u32x2*)((char*)obase + (oo + 32u * et)) = w; }
        }
        asm volatile("" ::: "memory");
    }
    asm volatile("s_waitcnt lgkmcnt(0)" ::: "memory"); __builtin_amdgcn_s_barrier(); asm volatile("" ::: "memory");
#undef ATT_DMA
#undef ATT_WAIT
}

struct ScanPF { bf16x8 vb[2][2]; float dch; };
#define RAW_BAR() do { asm volatile("s_waitcnt lgkmcnt(0)" ::: "memory"); __builtin_amdgcn_s_barrier(); asm volatile("" ::: "memory"); } while (0)
template <bool GDN> __device__ __forceinline__ void scan_prefetch(const Frame& F, ScanPF& P, int bh, int n, int lane, int wv, int c, int g, int colg, float dch_ret) {
    const int b = bh >> 2, e0 = 32 * wv;
    if (GDN) { const unsigned char* up = (const unsigned char*)F.GUT() + (size_t)(bh * 32 + n) * 32768 + (2 * wv) * 2048 + lane * 16;
#pragma unroll
        for (int k = 0; k < 4; ++k) __builtin_amdgcn_global_load_lds((const unsigned*)(up + k * 1024), (LAS unsigned*)(F.lds + 2 * 57344 + 4096 + wv * 4096 + k * 1024), 16, 0, 0);
        unsigned dci = (unsigned)(bh * 32 + n) * 4u; asm volatile("" : "+v"(dci)); P.dch = *(const float*)((const char*)F.GDCH() + dci);
    } else { const unsigned char* vp = F.RVT() + (size_t)(bh * 32 + n) * 32768 + (2 * wv) * 2048 + lane * 16;
#pragma unroll
        for (int s = 0; s < 2; ++s) { P.vb[s][0] = *(const bf16x8*)(vp + s * 1024); P.vb[s][1] = *(const bf16x8*)(vp + 2048 + s * 1024); }
        P.dch = dch_ret; }
}
template <bool GDN> __device__ __forceinline__ void scan_touch(ScanPF& P) {
    asm volatile("" : "+v"(P.dch));
    if (GDN) {}
    else asm volatile("" : "+v"(P.vb[0][0]), "+v"(P.vb[0][1]), "+v"(P.vb[1][0]), "+v"(P.vb[1][1]));
}
template <bool GDN, int BUF> __device__ __forceinline__ void scan_chunk(const Frame& F, f32x4 (&S)[8][2], ScanPF& cur, ScanPF& nxt, int bh, int n, int h, int colg, float dch_ret, const float* gnp, bf16_t* obr) {
    const int lane = F.lane, wv = F.wave, c = lane & 15, g = lane >> 4, b = bh >> 2, e0 = 32 * wv;
    constexpr int CHB = GDN ? GCH_BYTES : RCH_BYTES, NBLK = CHB / 1024, OQD = GDN ? GCH_QD : RCH_QD, OATT = GDN ? GCH_ATT : RCH_ATT, OKDT = GDN ? GCH_KDT : RCH_KDT, LBUF = 57344;
    LAS unsigned char* lbuf = F.lds; LAS float* ssq = (LAS float*)(F.lds + 2 * LBUF);
    const LAS unsigned char* Bq = lbuf + BUF * LBUF + lane * 16;
#define LFRAG(off_) (*(const LAS bf16x8*)(Bq + (off_)))
    scan_touch<GDN>(cur);
    f32x4 vn[4][2];
    if (GDN) {
        const LAS unsigned char* ul = F.lds + 2 * LBUF + 4096 + wv * 4096 + lane * 16;
#pragma unroll
        for (int cb = 0; cb < 2; ++cb)
#pragma unroll
            for (int rp = 0; rp < 2; ++rp) { const u32x4 uu = *(const LAS u32x4*)(ul + (cb * 2 + rp) * 1024);
                vn[2 * rp][cb] = (f32x4){bf2f(uu.x & 0xffffu), bf2f(uu.x >> 16), bf2f(uu.y & 0xffffu), bf2f(uu.y >> 16)};
                vn[2 * rp + 1][cb] = (f32x4){bf2f(uu.z & 0xffffu), bf2f(uu.z >> 16), bf2f(uu.w & 0xffffu), bf2f(uu.w >> 16)}; }
        asm volatile("s_waitcnt lgkmcnt(0)" ::: "memory");
    }
    if (n + 1 < NCH) {
        const unsigned char* chb = (GDN ? F.GCH() : F.RCH()) + (size_t)(bh * 32 + n + 1) * CHB + lane * 16;
#pragma unroll
        for (int k = 0; k < (NBLK + 7) / 8; ++k) { const int kb = wv + 8 * k; if (kb < NBLK) __builtin_amdgcn_global_load_lds((const unsigned*)(chb + kb * 1024), (LAS unsigned*)(lbuf + (BUF ^ 1) * LBUF + kb * 1024), 16, 0, 0); }
        CBAR();
        scan_prefetch<GDN>(F, nxt, bh, n + 1, lane, wv, c, g, colg, dch_ret);
    }
    CBAR();
    bf16x8 Sb[4][2];
#pragma unroll
    for (int s = 0; s < 4; ++s) { Sb[s][0] = pack8(S[2 * s][0], S[2 * s + 1][0]); Sb[s][1] = pack8(S[2 * s][1], S[2 * s + 1][1]); }
    bf16x8 Vb[2][2];
    if (GDN) {
#pragma unroll
        for (int rt = 0; rt < 4; ++rt) { f32x4 p0 = (f32x4){0.f, 0.f, 0.f, 0.f}, p1 = p0;
#pragma unroll
            for (int s = 0; s < 4; ++s) { const bf16x8 A = LFRAG(GCH_W + (rt * 4 + s) * 1024); p0 = MFMA16(A, Sb[s][0], p0); p1 = MFMA16(A, Sb[s][1], p1); }
            vn[rt][0] -= p0; vn[rt][1] -= p1; if (rt & 1) CBAR(); }
#pragma unroll
        for (int s = 0; s < 2; ++s) { Vb[s][0] = pack8(vn[2 * s][0], vn[2 * s + 1][0]); Vb[s][1] = pack8(vn[2 * s][1], vn[2 * s + 1][1]); }
    } else {
#pragma unroll
        for (int s = 0; s < 2; ++s) { Vb[s][0] = cur.vb[s][0]; Vb[s][1] = cur.vb[s][1]; }
    }
    CBAR();
    u32x2 gw[4][2];
    {   unsigned m0g = (unsigned)(b * SEQ + n * CH + c); asm volatile("" : "+v"(m0g)); const unsigned pb = (m0g * NWIN + colg + e0 + 4 * g) * 2u; const char* PROJp = (const char*)F.PROJ();
#pragma unroll
        for (int rt = 0; rt < 4; ++rt) { gw[rt][0] = *(const u32x2*)(PROJp + (pb + (unsigned)(16 * rt) * NWIN * 2u)); gw[rt][1] = *(const u32x2*)(PROJp + (pb + (unsigned)(16 * rt) * NWIN * 2u + 32u)); } }
    CBAR();
    f32x4 OT[4][2];
#pragma unroll
    for (int rt = 0; rt < 4; ++rt) { f32x4 o0 = (f32x4){0.f, 0.f, 0.f, 0.f}, o1 = o0;
#pragma unroll
        for (int s = 0; s < 4; ++s) { const bf16x8 Bf = LFRAG(OQD + (rt * 4 + s) * 1024); o0 = MFMA16(Sb[s][0], Bf, o0); o1 = MFMA16(Sb[s][1], Bf, o1); }
#pragma unroll
        for (int s = 0; s < 2; ++s) { const bf16x8 Bf = LFRAG(OATT + (rt * 2 + s) * 1024); o0 = MFMA16(Vb[s][0], Bf, o0); o1 = MFMA16(Vb[s][1], Bf, o1); }
        OT[rt][0] = o0; OT[rt][1] = o1; if (rt & 1) CBAR(); }
    const float dch = cur.dch;
#pragma unroll
    for (int t = 0; t < 8; ++t) { f32x4 s0 = S[t][0] * dch, s1 = S[t][1] * dch;
#pragma unroll
        for (int s = 0; s < 2; ++s) { const bf16x8 A = LFRAG(OKDT + (t * 2 + s) * 1024); s0 = MFMA16(A, Vb[s][0], s0); s1 = MFMA16(A, Vb[s][1], s1); }
        S[t][0] = s0; S[t][1] = s1; if ((t & 3) == 3) CBAR(); }
#pragma unroll
    for (int rt = 0; rt < 4; ++rt) { float q = 0.f;
#pragma unroll
        for (int r = 0; r < 4; ++r) q += OT[rt][0][r] * OT[rt][0][r] + OT[rt][1][r] * OT[rt][1][r];
        q += __shfl_xor(q, 16); q += __shfl_xor(q, 32);
        if (g == 0) ssq[(BUF * 8 + wv) * 64 + 16 * rt + c] = q; }
    RAW_BAR();
    {   unsigned m0o = (unsigned)(b * SEQ + n * CH + c); asm volatile("" : "+v"(m0o));
        const unsigned ob = (m0o * D + h * DV + e0 + 4 * g) * 2u;
#pragma unroll
        for (int rt = 0; rt < 4; ++rt) { float tot = 0.f;
#pragma unroll
            for (int w = 0; w < 8; ++w) tot += ssq[(BUF * 8 + w) * 64 + 16 * rt + c];
            const float rstd = 1.f / sqrtf(tot * (1.f / DV) + EPS);
#pragma unroll
            for (int cb = 0; cb < 2; ++cb) { const u32x2 gq = gw[rt][cb]; const f32x4 o = OT[rt][cb] * rstd;
                const float r0 = o[0] * bf2f(gq.x & 0xffffu), r1 = o[1] * bf2f(gq.x >> 16), r2 = o[2] * bf2f(gq.y & 0xffffu), r3 = o[3] * bf2f(gq.y >> 16);
                u32x2 w2; w2.x = pk2(r0, r1); w2.y = pk2(r2, r3);
                *(u32x2*)((char*)obr + (ob + (unsigned)(16 * rt) * D * 2u + 32u * cb)) = w2; } } }
    asm volatile("s_waitcnt vmcnt(8)" ::: "memory"); RAW_BAR();
#undef LFRAG
}
template <bool GDN> __device__ __forceinline__ void scan_bh(const Frame& F, int l, int bh) {
    const int lane = F.lane, wv = F.wave, c = lane & 15, g = lane >> 4, b = bh >> 2, h = bh & 3, e0 = 32 * wv;
    constexpr int CHB = GDN ? GCH_BYTES : RCH_BYTES, NBLK = CHB / 1024;
    const float lg = log1pf(-exp2f(-5.0f - (float)h)); const float dch_ret = fexp(lg * 64.f);
    f32x4 S[8][2];
#pragma unroll
    for (int t = 0; t < 8; ++t) { S[t][0] = (f32x4){0.f, 0.f, 0.f, 0.f}; S[t][1] = (f32x4){0.f, 0.f, 0.f, 0.f}; }
    const int colg = (GDN ? PC_GZ : PC_RG) + h * DV;
    bf16_t* obr = F.OBR() + (GDN ? OBR_STRIDE : 0);
    const float* gnp = F.inp(18) + l * DV;
    ScanPF PA, PB;
    {   const unsigned char* chb = (GDN ? F.GCH() : F.RCH()) + (size_t)(bh * 32) * CHB + lane * 16;
#pragma unroll
        for (int k = 0; k < (NBLK + 7) / 8; ++k) { const int kb = wv + 8 * k; if (kb < NBLK) __builtin_amdgcn_global_load_lds((const unsigned*)(chb + kb * 1024), (LAS unsigned*)(F.lds + kb * 1024), 16, 0, 0); } }
    scan_prefetch<GDN>(F, PA, bh, 0, lane, wv, c, g, colg, dch_ret);
    asm volatile("s_waitcnt vmcnt(0)" ::: "memory"); RAW_BAR();
    for (int n = 0; n < NCH; n += 2) {
        asm volatile("" ::: "memory");
        scan_chunk<GDN, 0>(F, S, PA, PB, bh, n, h, colg, dch_ret, gnp, obr);
        scan_chunk<GDN, 1>(F, S, PB, PA, bh, n + 1, h, colg, dch_ret, gnp, obr);
    }
    float* so = F.out + (GDN ? O_SGP : O_SRP) + ((size_t)(l * NB + b) * NH + h) * (size_t)(DK * DV);
    unsigned sbo = (unsigned)((4 * g) * DV + e0 + c) * 4u; asm volatile("" : "+v"(sbo));
#pragma unroll
    for (int t = 0; t < 8; ++t)
#pragma unroll
        for (int cb = 0; cb < 2; ++cb)
#pragma unroll
            for (int r = 0; r < 4; ++r) *(float*)((char*)so + (sbo + (unsigned)((16 * t + r) * DV + 16 * cb) * 4u)) = S[t][cb][r];
}
#undef RAW_BAR

template <bool GDN> __device__ __forceinline__ void sample_step(const Frame& F, int l, int item) {
    const int tid = F.tid, lane = F.lane, wv = F.wave, s = item >> 2, h = item & 3; const size_t m = (size_t)(MP + s);
    LAS float* qv = (LAS float*)F.lds;
    LAS float* kv = qv + 128;
    LAS float* vv = qv + 256;
    LAS float* sc = qv + 512;
    LAS float* partq = qv + 1024;
    LAS float* partk = partq + 2048;
    float dec, beta_ = 1.f;
    const int e4 = lane * 4, dq = wv;
    const size_t sofs = ((size_t)(l * MS + s) * NH + h) * (size_t)(DK * DV);
    const float* S0 = F.inp(GDN ? 4 : 3) + sofs + (size_t)(16 * dq) * DV + e4;
    f32x4 st[16];
#pragma unroll
    for (int i = 0; i < 16; ++i) st[i] = *(const f32x4*)(S0 + (size_t)i * DV);
    if (GDN) {
        const int C = (tid < 256) ? 1024 + h * DV + tid : (tid < 384) ? 512 + h * DK + (tid - 256) : h * DK + (tid - 384);
        const float* cbp = F.inp(5) + ((size_t)(l * MS + s) * 3) * CONVD + C; const float* cw = F.inp(15) + (size_t)l * 4 * CONVD + C;
        const float c0 = cbp[0], c1 = cbp[CONVD], c2 = cbp[2 * CONVD], rw = bf2f(F.PROJ()[m * NWIN + PC_GQKV + C]);
        const float val = siluf_(c0 * cw[0] + c1 * cw[CONVD] + c2 * cw[2 * CONVD] + rw * cw[3 * CONVD]);
        float* cvo = F.out + O_CVS + ((size_t)(l * MS + s) * 3) * CONVD + C; cvo[0] = c1; cvo[CONVD] = c2; cvo[2 * CONVD] = rw;
        if (tid < 256) vv[tid] = val; else if (tid < 384) kv[tid - 256] = val; else qv[tid - 384] = val;
        __syncthreads();
        if (wv < 2) { LAS float* p = (wv == 0) ? qv : kv; const float a = p[lane], bq = p[lane + 64]; const float ss = wave_sum(a * a + bq * bq);
            if (lane == 0) sc[wv] = (wv == 0) ? 0.08838834764831845f / sqrtf(ss + EPS) : 1.f / sqrtf(ss + EPS); }
        __syncthreads();
        const float rq = sc[0], rk = sc[1];
        __syncthreads();
        if (tid < 128) { qv[tid] *= rq; kv[tid] *= rk; }
        const float a = F.AB()[m * 8 + h], bb = F.AB()[m * 8 + 4 + h]; const float x = a + F.inp(17)[l * 4 + h]; const float sp = fmaxf(x, 0.f) + log1pf(expf(-fabsf(x)));
        dec = expf(-expf(F.inp(16)[l * 4 + h]) * sp); beta_ = 1.f / (1.f + expf(-bb));
    } else {
        if (tid < 64) { const int d = tid; const bf16_t* qrow = F.PROJ() + m * NWIN + PC_RQ + h * DK; const bf16_t* krow = F.PROJ() + m * NWIN + PC_RK + h * DK;
            const float cs = F.COS()[2048 * 64 + d], sn = F.SIN()[2048 * 64 + d]; const float q1 = bf2f(qrow[d]), q2 = bf2f(qrow[d + 64]), k1 = bf2f(krow[d]), k2 = bf2f(krow[d + 64]);
            qv[d] = q1 * cs - q2 * sn; qv[d + 64] = q1 * sn + q2 * cs; kv[d] = (k1 * cs - k2 * sn) * 0.08838834764831845f; kv[d + 64] = (k1 * sn + k2 * cs) * 0.08838834764831845f; }
        else if (tid < 320) vv[tid - 64] = bf2f(F.PROJ()[m * NWIN + PC_RV + h * DV + (tid - 64)]);
        dec = 1.f - exp2f(-5.0f - (float)h);
    }
    __syncthreads();
    float qk = 0.f;
#pragma unroll 8
    for (int d = 0; d < 128; ++d) qk += qv[d] * kv[d];
    f32x4 aq = (f32x4){0.f, 0.f, 0.f, 0.f}, ak = aq;
#pragma unroll
    for (int i = 0; i < 16; ++i) { aq += st[i] * qv[16 * dq + i]; if (GDN) ak += st[i] * kv[16 * dq + i]; }
    *(LAS f32x4*)(partq + dq * 256 + e4) = aq; if (GDN) *(LAS f32x4*)(partk + dq * 256 + e4) = ak;
    __syncthreads();
    f32x4 qS = (f32x4){0.f, 0.f, 0.f, 0.f}, kS = qS;
#pragma unroll
    for (int w = 0; w < 8; ++w) { qS += *(const LAS f32x4*)(partq + w * 256 + e4); if (GDN) kS += *(const LAS f32x4*)(partk + w * 256 + e4); }
    const f32x4 v4 = *(const LAS f32x4*)(vv + e4);
    const f32x4 vnew = GDN ? (v4 - kS * dec) * beta_ : v4;
    const f32x4 o = qS * dec + vnew * qk;
    float* S1 = F.out + (GDN ? O_SGS : O_SRS) + sofs + (size_t)(16 * dq) * DV + e4;
#pragma unroll
    for (int i = 0; i < 16; ++i) *(f32x4*)(S1 + (size_t)i * DV) = st[i] * dec + vnew * kv[16 * dq + i];
    const float ssq = wave_sum((o.x * o.x + o.y * o.y) + (o.z * o.z + o.w * o.w));
    if (dq == 0) { const float rstd = 1.f / sqrtf(ssq * (1.f / DV) + EPS); const bf16_t* gp = F.PROJ() + m * NWIN + (GDN ? PC_GZ : PC_RG) + h * DV + e4; float r4[4];
#pragma unroll
        for (int j = 0; j < 4; ++j) r4[j] = o[j] * rstd * bf2f(gp[j]);
        u32x2 w; w.x = pk2(r4[0], r4[1]); w.y = pk2(r4[2], r4[3]);
        *(u32x2*)(F.OBR() + (GDN ? OBR_STRIDE : 0) + m * D + h * DV + e4) = w; }
    __syncthreads();
}
__device__ __forceinline__ void sample_attn(const Frame& F, int l, int item) {
    const int tid = F.tid, lane = F.lane, wv = F.wave, s = item >> 2, h = item & 3; const size_t m = (size_t)(MP + s);
    LAS float* scs = (LAS float*)F.lds;
    LAS float* part = scs + 512;
    LAS float* sinv = scs + 256;
    f32x4 q4; { const u32x2 qw = *(const u32x2*)(F.PROJ() + m * NWIN + PC_MQ + h * 256 + lane * 4); q4 = (f32x4){bf2f(qw.x & 0xffffu), bf2f(qw.x >> 16), bf2f(qw.y & 0xffffu), bf2f(qw.y >> 16)}; }
    const float* Kb = F.inp(6) + (((size_t)(l * MS + s) * NMEM) * NH + h) * 256 + lane * 4;
    const float* Vb = F.inp(7) + (((size_t)(l * MS + s) * NMEM) * NH + h) * 256 + lane * 4;
    float myscore = 0.f;
    {   f32x4 kk[32];
#pragma unroll
        for (int j = 0; j < 32; ++j) kk[j] = *(const f32x4*)(Kb + (size_t)(32 * wv + j) * (NH * 256));
#pragma unroll
        for (int j = 0; j < 32; ++j) { const float d = wave_sum((kk[j].x * q4.x + kk[j].y * q4.y) + (kk[j].z * q4.z + kk[j].w * q4.w)); if (lane == j) myscore = d; } }
    f32x4 vv[32];
#pragma unroll
    for (int j = 0; j < 32; ++j) vv[j] = *(const f32x4*)(Vb + (size_t)(32 * wv + j) * (NH * 256));
    if (lane < 32) scs[32 * wv + lane] = myscore * 0.0625f;
    __syncthreads();
    if (wv == 0) { const f32x4 s4 = *(const LAS f32x4*)(scs + 4 * lane); float mx = fmaxf(fmaxf(s4.x, s4.y), fmaxf(s4.z, s4.w));
#pragma unroll
        for (int o = 1; o < 64; o <<= 1) mx = fmaxf(mx, __shfl_xor(mx, o));
        const f32x4 p = (f32x4){fexp(s4.x - mx), fexp(s4.y - mx), fexp(s4.z - mx), fexp(s4.w - mx)}; const float sum = wave_sum((p.x + p.y) + (p.z + p.w));
        *(LAS f32x4*)(scs + 4 * lane) = p; if (lane == 0) sinv[0] = 1.f / sum; }
    __syncthreads();
    f32x4 acc = (f32x4){0.f, 0.f, 0.f, 0.f};
#pragma unroll
    for (int j = 0; j < 32; ++j) acc += vv[j] * scs[32 * wv + j];
    *(LAS f32x4*)(part + wv * 256 + lane * 4) = acc;
    __syncthreads();
    if (wv == 0) { f32x4 o = (f32x4){0.f, 0.f, 0.f, 0.f};
#pragma unroll
        for (int w = 0; w < 8; ++w) o += *(const LAS f32x4*)(part + w * 256 + lane * 4);
        o = o * sinv[0]; u32x2 w2; w2.x = pk2(o.x, o.y); w2.y = pk2(o.z, o.w);
        *(u32x2*)(F.OBR() + 2 * OBR_STRIDE + m * D + h * 256 + lane * 4) = w2; }
    __syncthreads();
}

struct SEpiF32 { static constexpr int NBF = 1, NSEG = 1; float* C;
    __device__ __forceinline__ int brow(int st, int) const { return 16 * st; }
    __device__ __forceinline__ void fold(f32x4 (&tot)[1], const f32x4 (&acc)[1], int, int, int, int) const { tot[0] = acc[0]; }
    __device__ __forceinline__ void store(const f32x4 (&tot)[1], int row, int st, int g) const { *(f32x4*)(C + (size_t)row * D + 16 * st + 4 * g) = tot[0]; } };
struct SEpiBf16 { static constexpr int NBF = 1, NSEG = 1; bf16_t* O; int ldc;
    __device__ __forceinline__ int brow(int st, int) const { return 16 * st; }
    __device__ __forceinline__ void fold(f32x4 (&tot)[1], const f32x4 (&acc)[1], int, int, int, int) const { tot[0] = acc[0]; }
    __device__ __forceinline__ void store(const f32x4 (&tot)[1], int row, int st, int g) const { u32x2 w; w.x = pk2(tot[0][0], tot[0][1]); w.y = pk2(tot[0][2], tot[0][3]); *(u32x2*)(O + (size_t)row * ldc + 16 * st + 4 * g) = w; } };
struct SEpiProj { static constexpr int NBF = 1, NSEG = 1; bf16_t* O; const float* gn; const float* rs;
    __device__ __forceinline__ int brow(int st, int) const { return 16 * st; }
    __device__ __forceinline__ void fold(f32x4 (&tot)[1], const f32x4 (&acc)[1], int, int, int, int) const { tot[0] = acc[0]; }
    __device__ __forceinline__ void store(const f32x4 (&tot)[1], int row, int st, int g) const { const int col = 16 * st + 4 * g; f32x4 v = tot[0] * rs[row];
        if (col >= PC_RG && col < PC_RG + 1024) {
#pragma unroll
            for (int q = 0; q < 4; ++q) v[q] = siluf_(v[q]); }
        else if (col >= PC_GZ && col < PC_GZ + 1024) {
#pragma unroll
            for (int q = 0; q < 4; ++q) v[q] = siluf_(v[q]) * gn[(col + q) & 255]; }
        u32x2 w; w.x = pk2(v[0], v[1]); w.y = pk2(v[2], v[3]); *(u32x2*)(O + (size_t)row * NWIN + col) = w; } };
struct SEpiSwiGLU { static constexpr int NBF = 2, NSEG = 1; bf16_t* O; const float* rs;
    __device__ __forceinline__ int brow(int st, int bfi) const { return (st >> 3) * 256 + (st & 7) * 16 + 128 * bfi; }
    __device__ __forceinline__ void fold(f32x4 (&tot)[2], const f32x4 (&acc)[2], int, int, int, int) const { tot[0] = acc[0]; tot[1] = acc[1]; }
    __device__ __forceinline__ void store(const f32x4 (&tot)[2], int row, int st, int g) const { float r[4];
#pragma unroll
        for (int j = 0; j < 4; ++j) r[j] = siluf_(tot[0][j] * rs[row]) * (tot[1][j] * rs[row]);
        u32x2 w; w.x = pk2(r[0], r[1]); w.y = pk2(r[2], r[3]); *(u32x2*)(O + (size_t)row * DFF + 16 * st + 4 * g) = w; } };
struct SEpiBranch { static constexpr int NBF = 1, NSEG = 3; bf16_t* O; const bf16_t* proj;
    __device__ __forceinline__ int brow(int st, int) const { return 16 * st; }
    __device__ __forceinline__ void fold(f32x4 (&tot)[1], const f32x4 (&acc)[1], int seg, int row, int st, int g) const {
        const u32x2 gw = *(const u32x2*)(proj + (size_t)row * NWIN + PC_GATE + seg * D + 16 * st + 4 * g);
        const f32x4 gt = (f32x4){sigmoidf_(bf2f(gw.x & 0xffffu)), sigmoidf_(bf2f(gw.x >> 16)), sigmoidf_(bf2f(gw.y & 0xffffu)), sigmoidf_(bf2f(gw.y >> 16))};
        tot[0] = (seg == 0) ? gt * acc[0] : tot[0] + gt * acc[0]; }
    __device__ __forceinline__ void store(const f32x4 (&tot)[1], int row, int st, int g) const { u32x2 w; w.x = pk2(tot[0][0], tot[0][1]); w.y = pk2(tot[0][2], tot[0][3]); *(u32x2*)(O + (size_t)row * D + 16 * st + 4 * g) = w; } };
template <int K, class EpiS, int RT = 4, int NS = 1> __device__ __forceinline__ void small_gemm(const Frame& F, const bf16_t* A, size_t aseg, const bf16_t* Bt, size_t bseg, int nstrips, int first, int count, const EpiS& E) {
    static_assert(RT == 4 ? NS == 1 : (NS == 1 || NS == 4), "small_gemm shapes");
    const int j = (F.bid - first + F.G) % F.G; if (j >= count) return;
    constexpr int NBF = EpiS::NBF, KQ = K / 4, NKS = KQ / 32, BATCH = (RT == 1 && NS == 1 && NBF == 1) ? NKS : (NBF == 2) ? 4 : 8, RQ = 4 / RT, NT = RT * NS;
    const int lane = F.lane, wv = F.wave, c = lane & 15, g = lane >> 4, rh = wv & 1, kq = wv >> 1;
    LAS f32x4* red = (LAS f32x4*)F.lds;
    for (int it = j; it < (nstrips / NS) * RQ; it += count) {
        const int sg = it / RQ, rq = it - sg * RQ, t0 = (RT == 4) ? rh * 4 : rq * 2 + rh;
        f32x4 tot[NBF][NT];
#pragma unroll
        for (int seg = 0; seg < EpiS::NSEG; ++seg) {
            f32x4 acc[NBF][NT];
#pragma unroll
            for (int q = 0; q < NBF; ++q)
#pragma unroll
                for (int t = 0; t < NT; ++t) acc[q][t] = (f32x4){0.f, 0.f, 0.f, 0.f};
            const char* ap = (const char*)(A + seg * aseg); unsigned ao = ((unsigned)(MP + t0 * 16 + c) * K + kq * KQ + 8 * g) * 2u; asm volatile("" : "+v"(ao));
            const char* bp = (const char*)(Bt + seg * bseg); unsigned bo[NBF][NS];
#pragma unroll
            for (int q = 0; q < NBF; ++q)
#pragma unroll
                for (int n = 0; n < NS; ++n) { bo[q][n] = ((unsigned)(E.brow(sg * NS + n, q) + c) * K + kq * KQ + 8 * g) * 2u; asm volatile("" : "+v"(bo[q][n])); }
#pragma unroll
            for (int ks0 = 0; ks0 < NKS; ks0 += BATCH) {
                bf16x8 af[RT][BATCH], bfr[NBF][NS][BATCH];
#pragma unroll
                for (int s = 0; s < BATCH; ++s) if (ks0 + s < NKS) {
#pragma unroll
                    for (int q = 0; q < NBF; ++q)
#pragma unroll
                        for (int n = 0; n < NS; ++n) bfr[q][n][s] = *(const bf16x8*)(bp + (bo[q][n] + (unsigned)(ks0 + s) * 64u));
#pragma unroll
                    for (int t = 0; t < RT; ++t) af[t][s] = *(const bf16x8*)(ap + (ao + (unsigned)(t * 16 * K * 2) + (unsigned)(ks0 + s) * 64u)); }
#pragma unroll
                for (int s = 0; s < BATCH; ++s) if (ks0 + s < NKS) {
#pragma unroll
                    for (int q = 0; q < NBF; ++q)
#pragma unroll
                        for (int n = 0; n < NS; ++n)
#pragma unroll
                            for (int t = 0; t < RT; ++t) acc[q][n * RT + t] = MFMA16(bfr[q][n][s], af[t][s], acc[q][n * RT + t]); }
                CBAR();
            }
#pragma unroll
            for (int n = 0; n < NS; ++n)
#pragma unroll
                for (int t = 0; t < RT; ++t) { f32x4 a1[NBF], t1[NBF];
#pragma unroll
                    for (int q = 0; q < NBF; ++q) { a1[q] = acc[q][n * RT + t]; t1[q] = tot[q][n * RT + t]; }
                    E.fold(t1, a1, seg, MP + (t0 + t) * 16 + c, sg * NS + n, g);
#pragma unroll
                    for (int q = 0; q < NBF; ++q) tot[q][n * RT + t] = t1[q]; }
        }
#pragma unroll
        for (int q = 0; q < NBF; ++q)
#pragma unroll
            for (int t = 0; t < NT; ++t) red[((q * 8 + wv) * NT + t) * 64 + lane] = tot[q][t];
        __syncthreads();
        if (NT == 4 || kq == 0) {
            const int tf = (NT == 4) ? kq : 0; f32x4 fin[NBF];
#pragma unroll
            for (int q = 0; q < NBF; ++q) { f32x4 s4 = (f32x4){0.f, 0.f, 0.f, 0.f};
#pragma unroll
                for (int k2 = 0; k2 < 4; ++k2) s4 += red[((q * 8 + rh + 2 * k2) * NT + tf) * 64 + lane];
                fin[q] = s4; }
            E.store(fin, MP + (t0 + (RT == 4 ? tf : 0)) * 16 + c, sg * NS + (RT == 4 ? 0 : tf), g); }
        __syncthreads();
    }
}

__device__ __forceinline__ const void* opaque_ptr(const void* p) { unsigned lo = __builtin_amdgcn_readfirstlane((unsigned)(size_t)p), hi = __builtin_amdgcn_readfirstlane((unsigned)((size_t)p >> 32));
    asm volatile("" : "+s"(lo), "+s"(hi)); return (const void*)(const GAS void*)(((size_t)hi << 32) | lo); }
__device__ __forceinline__ void stagger(int bid, int step_ticks) { const unsigned long long t0 = __builtin_amdgcn_s_memrealtime(), d = (unsigned long long)((bid >> 3) & 3) * (unsigned long long)step_ticks;
    while (__builtin_amdgcn_s_memrealtime() - t0 < d) __builtin_amdgcn_s_sleep(8); }
#ifndef STAG_TICKS
#define STAG_TICKS 0
#endif
#ifndef EN_SITES
#define EN_SITES 0x7ff
#endif
#define SITE(k) ((EN_SITES >> (k)) & 1)
#ifndef EN_PP
#define EN_PP 0xf
#endif
#ifndef EN_SP
#define EN_SP 0x1f
#endif
#define PP(k) ((EN_PP >> (k)) & 1)
#define SP(k) ((EN_SP >> (k)) & 1)
constexpr int NPHASE = 25;
__global__ void __launch_bounds__(NWAVES * 64, 2) fwd(Args args) {
    extern __shared__ __attribute__((aligned(16))) unsigned char lds_raw[];
    Frame F;
    F.lds = (LAS unsigned char*)lds_raw; F.tid = threadIdx.x; F.lane = F.tid & 63; F.wave = __builtin_amdgcn_readfirstlane(F.tid >> 6); F.G = gridDim.x; F.bid = blockIdx.x;
    F.A = &args; F.zo = 0; F.out = args.out; F.ws = args.ws; unsigned char* ws = args.ws;
    volatile LAS unsigned* MISC = (volatile LAS unsigned*)(F.lds + MISC_OFF);
    if (F.tid < 64) ((LAS unsigned*)(F.lds + MISC_OFF))[F.tid] = 0u;
    __syncthreads();
    const int lo = args.ph_lo, hi = args.ph_hi, sel = args.sel;
    XcdBarrier bar; bar.bar = (unsigned*)(ws + WS_CTL) + CW_BAR; bar.x = 0; bar.st = nullptr;
    if (hi - lo > 1) bar = xcd_barrier_post((unsigned*)(ws + WS_CTL) + CW_BAR, MISC + 8);
#define IN(k) (lo <= (k) && (k) < hi)
#define SITE_FRAME() Frame Fp = F; { Fp.ws = (unsigned char*)opaque_ptr(F.ws); Fp.out = (float*)opaque_ptr(F.out); } { int t_ = (int)threadIdx.x, b_ = (int)blockIdx.x, z_; asm volatile("s_mov_b32 %0, 0" : "=s"(z_)); Fp.zo = z_; asm volatile("" : "+v"(t_), "+s"(b_)); Fp.tid = t_; Fp.lane = t_ & 63; Fp.wave = __builtin_amdgcn_readfirstlane(t_ >> 6); Fp.bid = b_; } const int bid = Fp.bid
#define SEAM(k) do { if (IN(k) && IN((k) + 1)) { XcdBarrier b2_ = bar; b2_.bar = (unsigned*)opaque_ptr(bar.bar); xcd_barrier(b2_, Fp.tid == 0); } } while (0)
    const int G = F.G;

    if (SITE(0) && IN(0)) { SITE_FRAME(); p0_prologue(Fp); SEAM(0); }
    for (int l = 0; l < 2; ++l) {
        const int base = 1 + 12 * l;
        for (int half = 0; half < 2; ++half) {
            const int pb = base + 9 * half;
            if (SITE(2) && IN(pb)) { SITE_FRAME();
                pg8::Gemm g{Fp.H(), (const bf16_t*)(Fp.ws + WS_W0 + (size_t)l * WS_WL + (half ? OFF_W2I : OFF_W1I)), D}; pg8::StaticOrder S; S.init(MP, NFFI, D, G, bid);
                pg8::EpiSwiGLU E{Fp.ACT(), Fp.RS()};
                pg8::gemm_phase<pg8::EpiSwiGLU, pg8::StaticOrder, true, true>(Fp.lds, g, S, E, Fp.tid);
                if (l == 0 && half == 0 && bid >= G / 2) {
                    pg8::Gemm g2{Fp.MEMN(), (const bf16_t*)(Fp.ws + WS_WMKV), D}; pg8::GroupAOrder S2; S2.init(NB * NMEM, 4096, D, G / 2, bid - G / 2); S2.grp = 8; S2.astride = (size_t)NB * NMEM * D * 2;
                    pg8::EpiMemKV E2{Fp.out + O_MKP, Fp.out + O_MVP, Fp.MK(), Fp.MVT()};
                    pg8::gemm_phase<pg8::EpiMemKV, pg8::GroupAOrder, false, true>(Fp.lds, g2, S2, E2, Fp.tid);
                }
                { SEpiSwiGLU SE{Fp.ACT(), Fp.RS()}; small_gemm<D>(Fp, g.A, 0, g.Bt, 0, DFF / 16, G / 2, G / 2, SE); }
                SEAM(pb);
            }
            if (SITE(3) && IN(pb + 1)) { SITE_FRAME();
                pg8::Gemm g{Fp.ACT(), (const bf16_t*)(Fp.ws + WS_W0 + (size_t)l * WS_WL + (half ? OFF_W2O : OFF_W1O)), DFF}; pg8::StaticOrder S; S.init(MP, D, DFF, G, bid, WGM_N1024);
                pg8::EpiBf16 E{Fp.TMP(), D};
                pg8::gemm_phase<pg8::EpiBf16, pg8::StaticOrder, true, true>(Fp.lds, g, S, E, Fp.tid);
                { SEpiBf16 SE{Fp.TMP(), D}; small_gemm<DFF, SEpiBf16, 1>(Fp, g.A, 0, g.Bt, 0, D / 16, 0, G, SE); }
                SEAM(pb + 1);
            }
            if (SITE(4) && IN(pb + 2)) { SITE_FRAME();
                NormArgs na; na.tmp = Fp.TMP(); na.scale = 0.5f; na.first = 0;
                if (half == 0) { na.gpost = Fp.inp(9) + l * D; na.gpre = Fp.inp(12) + l * D; na.wab = Fp.WAB() + (size_t)l * 8 * D; na.fin = 0; }
                else { na.gpost = Fp.inp(27) + l * D; na.gpre = Fp.inp(8) + (l == 0 ? D : 0); na.wab = nullptr; na.fin = (l == 1); }
                norm_phase(Fp, na);
                SEAM(pb + 2);
            }
            if (half == 0) {
                if (SITE(5) && IN(base + 3)) { SITE_FRAME();
                    pg8::Gemm g{Fp.H(), (const bf16_t*)(Fp.ws + WS_W0 + (size_t)l * WS_WL + OFF_WIN), D}; pg8::StaticOrder S; S.init(MP, NWIN, D, G, bid);
                    pg8::EpiProj E{Fp.PROJ(), Fp.inp(18) + l * DV, Fp.RS()};
                    pg8::gemm_phase<pg8::EpiProj, pg8::StaticOrder, true, true>(Fp.lds, g, S, E, Fp.tid);
                    { SEpiProj SE{Fp.PROJ(), Fp.inp(18) + l * DV, Fp.RS()}; small_gemm<D, SEpiProj, 1, 4>(Fp, g.A, 0, g.Bt, 0, NWIN / 16, 0, G, SE); }
                    SEAM(base + 3);
                }
                if (SITE(6) && IN(base + 4)) { SITE_FRAME();
                    if (PP(0) && (sel & 1)) for (int ci = bid; ci < NB * NH * NCH; ci += G) gdn_prep(Fp, l, ci);
                    if (PP(1) && (sel & 2)) for (int ci = bid; ci < NB * NH * NCH; ci += G) ret_prep(Fp, ci);
                    if (PP(2) && (sel & 4) && l < 0) { const int xcd = bid & 7, slot = bid >> 3, per = G >> 3;
                        if ((G & 7) == 0) { for (int ux = slot; ux < 64; ux += per) mem_attn_unit(Fp, l, (xcd * 4 + (ux >> 4)) * 16 + (ux & 15)); }
                        else for (int u = bid; u < NB * NH * 16; u += G) mem_attn_unit(Fp, l, u); }
                    if (PP(3) && bid < NB) { for (int i = Fp.tid; i < 3 * CONVD; i += NWAVES * 64) { const int j = i / CONVD, C = i % CONVD;
                        Fp.out[O_CVP + ((size_t)(l * NB + bid) * 3 + j) * CONVD + C] = bf2f(Fp.PROJ()[(size_t)(bid * SEQ + SEQ - 3 + j) * NWIN + PC_GQKV + C]); } }
                    SEAM(base + 4);
                }
                if (SITE(7) && IN(base + 5)) { SITE_FRAME();
                    if (bid < 32) { if (SP(0) && (sel & 8)) scan_bh<false>(Fp, l, bid); }
                    else if (bid < 64) { if (SP(1) && (sel & 8)) scan_bh<true>(Fp, l, bid - 32); }
                    else { const int nw = G - 64; unsigned* subc = (unsigned*)opaque_ptr(Fp.ws + WS_CTL) + CW_SUB + 64 * l;
                        if (sel & 4) {
                            if ((G & 7) == 0) { const int xcd = bid & 7, slot = (bid >> 3) - 8, per = (G >> 3) - 8; for (int ux = slot; ux < 64; ux += per) mem_attn_unit(Fp, l, (xcd * 4 + (ux >> 4)) * 16 + (ux & 15)); }
                            else for (int u = bid - 64; u < NB * NH * 16; u += nw) mem_attn_unit(Fp, l, u);
                            if (sel & 64) sub_arrive(subc, Fp.tid == 0); }
                        if (SP(2) && (sel & 16)) for (int it = bid - 64; it < MS * NH; it += nw) sample_step<true>(Fp, l, it);
                        if (SP(3) && (sel & 16)) for (int it = bid - 64; it < MS * NH; it += nw) sample_step<false>(Fp, l, it);
                        if (SP(4) && (sel & 32)) for (int it = bid - 64; it < MS * NH; it += nw) sample_attn(Fp, l, it);
                        if (l == 0 && (sel & 64)) convert_layer1(Fp, bid - 64, nw);
                        if (sel & 64) {
                            sub_wait(subc, (unsigned)nw, (unsigned*)opaque_ptr(Fp.ws + WS_CTL) + CW_BAR, Fp.tid == 0);
                            pg8::Gemm g{Fp.OBR() + 2 * OBR_STRIDE, (const bf16_t*)(Fp.ws + WS_W0 + (size_t)l * WS_WL + OFF_WBR) + 2 * (size_t)D * D, D}; pg8::SegOrder S; S.init(MP, D, D, nw, bid % nw, WGM_N1024); S.nseg = 1; S.aseg = 0; S.bseg = 0;
                            pg8::EpiBranch E{Fp.MERGED(), Fp.PROJ(), 2, 2};
                            pg8::gemm_phase<pg8::EpiBranch, pg8::SegOrder, true, true>(Fp.lds, g, S, E, Fp.tid); } }
                    SEAM(base + 5);
                }
                if (SITE(8) && IN(base + 6)) { SITE_FRAME();
                    pg8::Gemm g{Fp.OBR(), (const bf16_t*)(Fp.ws + WS_W0 + (size_t)l * WS_WL + OFF_WBR), D}; pg8::SegOrder S; S.init(MP, D, D, G, bid, WGM_N1024); S.nseg = 2; S.aseg = OBR_STRIDE * 2; S.bseg = (size_t)D * D * 2;
                    pg8::EpiBranch E{Fp.MERGED(), Fp.PROJ(), 0, 2};
                    pg8::gemm_phase<pg8::EpiBranch, pg8::SegOrder, true, true>(Fp.lds, g, S, E, Fp.tid);
                    { SEpiBranch SE{Fp.MERGED(), Fp.PROJ()}; small_gemm<D, SEpiBranch, 1>(Fp, g.A, OBR_STRIDE, g.Bt, (size_t)D * D, D / 16, 0, G, SE); }
                    SEAM(base + 6);
                }
                if (SITE(9) && IN(base + 7)) { SITE_FRAME();
                    pg8::Gemm g{Fp.MERGED(), (const bf16_t*)(Fp.ws + WS_W0 + (size_t)l * WS_WL + OFF_WO), D}; pg8::StaticOrder S; S.init(MP, D, D, G, bid, WGM_N1024);
                    pg8::EpiBf16 E{Fp.TMP(), D};
                    pg8::gemm_phase<pg8::EpiBf16, pg8::StaticOrder, true, true>(Fp.lds, g, S, E, Fp.tid);
                    { SEpiBf16 SE{Fp.TMP(), D}; small_gemm<D, SEpiBf16, 1>(Fp, g.A, 0, g.Bt, 0, D / 16, 0, G, SE); }
                    SEAM(base + 7);
                }
                if (SITE(10) && IN(base + 8)) { SITE_FRAME();
                    NormArgs na; na.tmp = Fp.TMP(); na.scale = 1.0f; na.first = 0; na.gpost = Fp.inp(13) + l * D; na.gpre = Fp.inp(26) + l * D; na.wab = nullptr; na.fin = 0;
                    norm_phase(Fp, na);
                    SEAM(base + 8);
                }
            }
        }
    }
#undef IN
#undef SEAM
}

extern "C" void kernel_launch(void* const* d_in, const int* in_sizes, int n_in, void* d_out, int out_size, void* d_ws, size_t ws_size, hipStream_t stream) {
    static int grid = 0;
    if (grid == 0) {
        if (n_in != 30 || (size_t)out_size != O_END || ws_size < WS_END) { fprintf(stderr, "kernel_launch: unexpected shapes: n_in %d out %d ws %zu (need %zu)\n", n_in, out_size, ws_size, (size_t)WS_END); grid = -1; return; }
        int dev = 0, cus = 0, per_cu = 0;
        if (hipGetDevice(&dev) != hipSuccess || hipDeviceGetAttribute(&cus, hipDeviceAttributeMultiprocessorCount, dev) != hipSuccess) { grid = -1; return; }
        if (hipFuncSetAttribute((const void*)fwd, hipFuncAttributeMaxDynamicSharedMemorySize, LDS_BYTES) != hipSuccess) { fprintf(stderr, "kernel_launch: hipFuncSetAttribute failed\n"); grid = -1; return; }
        if (hipOccupancyMaxActiveBlocksPerMultiprocessor(&per_cu, (const void*)fwd, NWAVES * 64, LDS_BYTES) != hipSuccess || per_cu < 1) { fprintf(stderr, "kernel_launch: occupancy query reports %d\n", per_cu); }
        (void)hipGetLastError();
        grid = cus;
        if (grid < 128) { fprintf(stderr, "kernel_launch: needs >= 128 CUs\n"); grid = -1; return; }
    }
    if (grid < 0) return;
    if (hipMemsetAsync((char*)d_ws + WS_CTL, 0, CTL_ZERO_BYTES, stream) != hipSuccess) return;
    Args a{};
    for (int i = 0; i < 30; ++i) a.in[i] = (const float*)d_in[i];
    a.out = (float*)d_out; a.ws = (unsigned char*)d_ws;
#ifndef MK_ONE_LAUNCH
#define MK_ONE_LAUNCH 1
#endif
    a.sel = 0xff; a.pad = 0;
#ifndef PROBE_PH
#define PROBE_PH -1
#endif
#ifndef PROBE_SEL
#define PROBE_SEL 0xff
#endif
    if (MK_ONE_LAUNCH) { a.ph_lo = 0; a.ph_hi = NPHASE; hipLaunchKernelGGL(fwd, dim3(grid), dim3(NWAVES * 64), LDS_BYTES, stream, a); }
    else for (int p = 0; p < NPHASE; ++p) { a.ph_lo = p; a.ph_hi = p + 1; a.sel = 0xff; hipLaunchKernelGGL(fwd, dim3(grid), dim3(NWAVES * 64), LDS_BYTES, stream, a);
        if (PROBE_PH >= 0 && (p == PROBE_PH || (PROBE_PH >= 1 && p == PROBE_PH + 12))) { a.sel = PROBE_SEL; hipLaunchKernelGGL(fwd, dim3(grid), dim3(NWAVES * 64), LDS_BYTES, stream, a); } }
}
```
